# Optimizing an MI355X kernel written in HIP

```python
import math
import jax, jax.numpy as jnp
from jax import lax
import numpy as np

D_MODEL = 1024
BATCH = 32
SEQ = 256
DEPTH = 2
DEC_BATCH = 8
DEC_SEQ = 2048
PAST_LEN = 256

GRID_W = 64
N_MIXERS = 4
D_GROUP = D_MODEL // N_MIXERS
N_ATT_HEADS = 4
V_DIM = D_GROUP // N_ATT_HEADS
DK = V_DIM // 2
ROPE_BASE = 10000.0
QBLOCK = 128
CONV_B_W = 3
CONV_C_W = 4
RG_BLOCKS = 4
RG_BW = D_GROUP // RG_BLOCKS
RG_C = 8.0
POOL_WINDOWS = (2, 4, 8, 16)
POOL_GW = D_GROUP // len(POOL_WINDOWS)
D_FF = 4 * D_MODEL
N_MOD = 6
N_IN_SPLITS = 9
D_IN = N_IN_SPLITS * D_GROUP
EPS = 1e-6

kernel_name = "hybrid_diffusion_parallel_heads_step"


def rmsnorm(x, w):
    xf = x.astype(jnp.float32)
    y = xf * lax.rsqrt(jnp.mean(xf * xf, axis=-1, keepdims=True) + EPS)
    return (y * w.astype(jnp.float32)).astype(x.dtype)


def rope_1d(x, pos):
    half = x.shape[-1] // 2
    freqs = ROPE_BASE ** (-jnp.arange(half, dtype=jnp.float32) / half)
    ang = pos.astype(jnp.float32)[:, None] * freqs[None, :]
    cos, sin = jnp.cos(ang), jnp.sin(ang)
    xf = x.astype(jnp.float32)
    x1, x2 = xf[..., :half], xf[..., half:]
    return jnp.concatenate([x1 * cos - x2 * sin, x2 * cos + x1 * sin], axis=-1).astype(x.dtype)


def rope_2d(x, rows, cols):
    h = x.shape[-1] // 2
    return jnp.concatenate([rope_1d(x[..., :h], rows), rope_1d(x[..., h:], cols)], axis=-1)


def rope_heads(t, rows, cols):
    return jnp.concatenate([rope_2d(t[..., :DK], rows, cols), rope_2d(t[..., DK:], rows, cols)], axis=-1)


def depthwise_conv(x, w, b, left):
    k_w = w.shape[0]
    t_len = x.shape[1]
    xp = jnp.pad(x, ((0, 0), (left, k_w - 1 - left), (0, 0)))
    out = xp[:, 0:t_len] * w[0]
    for j in range(1, k_w):
        out = out + xp[:, j:j + t_len] * w[j]
    if b is not None:
        out = out + b
    return out


def diff_attn(q, k, v, lam, lam_init, subln_w):
    bsz, n_h, t_len, _ = q.shape
    nb = t_len // QBLOCK
    qb = q.reshape(bsz, n_h, nb, QBLOCK, 2 * DK).transpose(2, 0, 1, 3, 4)
    k1, k2 = k[..., :DK], k[..., DK:]
    scale = DK ** -0.5

    def block(qi):
        s1 = jnp.einsum('bhqd,bhkd->bhqk', qi[..., :DK], k1).astype(jnp.float32) * scale
        s2 = jnp.einsum('bhqd,bhkd->bhqk', qi[..., DK:], k2).astype(jnp.float32) * scale
        p = jax.nn.softmax(s1, axis=-1) - lam * jax.nn.softmax(s2, axis=-1)
        return jnp.einsum('bhqk,bhkd->bhqd', p.astype(v.dtype), v)

    o = lax.map(block, qb)
    o = o.transpose(1, 2, 0, 3, 4).reshape(bsz, n_h, t_len, V_DIM)
    o = rmsnorm(o, subln_w) * (1.0 - lam_init)
    return o.transpose(0, 2, 1, 3).reshape(bsz, t_len, D_GROUP)


def _scan_combine(e1, e2):
    a1, b1 = e1
    a2, b2 = e2
    return (a1 * a2, a2 * b1 + b2)


def rglru(xc, w_g, b_g, lam, h0, reverse):
    bsz, t_len, ch = xc.shape
    xb = xc.reshape(bsz, t_len, RG_BLOCKS, RG_BW)
    g = jnp.einsum('btnc,kncd->kbtnd', xb, w_g).reshape(2, bsz, t_len, ch) + b_g[:, None, None, :]
    g = g.astype(jnp.float32)
    r = jax.nn.sigmoid(g[0])
    i = jax.nn.sigmoid(g[1])
    log_a = -RG_C * r * jax.nn.softplus(-lam.astype(jnp.float32))
    a = jnp.exp(log_a)
    b = jnp.sqrt(-jnp.expm1(2.0 * log_a)) * i * xc.astype(jnp.float32)
    if h0 is not None:
        idx = t_len - 1 if reverse else 0
        b = b.at[:, idx].add(a[:, idx] * h0.astype(jnp.float32))
    _, h = lax.associative_scan(_scan_combine, (a, b), reverse=reverse, axis=1)
    last = h[:, 0] if reverse else h[:, -1]
    return h.astype(xc.dtype), last.astype(xc.dtype)


def pool_mixer(x, w, scale):
    bsz, t_len, ch = x.shape
    xf = x.astype(jnp.float32)
    cs = jnp.concatenate([jnp.zeros((bsz, 1, ch), jnp.float32), jnp.cumsum(xf, axis=1)], axis=1)
    t = jnp.arange(t_len)
    outs = []
    for g, win in enumerate(POOL_WINDOWS):
        left = win // 2
        right = win - 1 - left
        lo = jnp.clip(t - left, 0, t_len - 1)
        hi = jnp.clip(t + right, 0, t_len - 1)
        csg = cs[..., g * POOL_GW:(g + 1) * POOL_GW]
        s = jnp.take(csg, hi + 1, axis=1) - jnp.take(csg, lo, axis=1)
        cnt = (hi - lo + 1).astype(jnp.float32)[None, :, None]
        outs.append(s / cnt - xf[..., g * POOL_GW:(g + 1) * POOL_GW])
    p = jnp.stack(outs, axis=2).astype(x.dtype)
    y = jnp.einsum('btgc,gcd->btgd', p, w).reshape(bsz, t_len, ch)
    return y * scale


def mixer(h, lp, lam_init, pos, kv_ctx, h0):
    bsz, t_len, _ = h.shape
    z = h @ lp['w_in']
    q, k, v, gb, gc, xb, xr, gr, xp = jnp.split(z, N_IN_SPLITS, axis=-1)

    def heads(t):
        return t.reshape(bsz, t_len, N_ATT_HEADS, V_DIM).transpose(0, 2, 1, 3)

    q, k, v = heads(q), heads(k), heads(v)
    if pos is not None:
        rows, cols = pos
        q = rope_heads(q, rows, cols)
        k = rope_heads(k, rows, cols)
    new_k, new_v = k, v
    if kv_ctx is not None:
        k = jnp.concatenate([kv_ctx[0], k], axis=2)
        v = jnp.concatenate([kv_ctx[1], v], axis=2)
    dl = lp['diff_lambda'].astype(jnp.float32)
    lam = jnp.exp(jnp.sum(dl[0] * dl[1])) - jnp.exp(jnp.sum(dl[2] * dl[3])) + lam_init
    y_a = diff_attn(q, k, v, lam, lam_init, lp['subln_w'])

    y_b = gb * depthwise_conv(gc * xb, lp['conv_b_w'], None, CONV_B_W // 2)

    xc = depthwise_conv(xr, lp['conv_c_w'], lp['conv_c_b'], CONV_C_W // 2)
    h0f = None if h0 is None else h0[:, 0]
    h0b = None if h0 is None else h0[:, 1]
    hf, hf_last = rglru(xc, lp['rg_w'][0], lp['rg_b'][0], lp['rg_lambda'][0], h0f, False)
    hb, hb_last = rglru(xc, lp['rg_w'][1], lp['rg_b'][1], lp['rg_lambda'][1], h0b, True)
    y_c = (hf + hb) * jax.nn.gelu(gr)

    y_d = pool_mixer(xp, lp['pool_w'], lp['pool_scale'])

    y = jnp.concatenate([y_a, y_b, y_c, y_d], axis=-1) @ lp['w_out']
    return y, new_k, new_v, jnp.stack([hf_last, hb_last], axis=1)


def layer(x, mod, lp, lam_init, pos, kv_ctx, h0):
    shift1, scale1, gate1, shift2, scale2, gate2 = jnp.split(mod, N_MOD, axis=-1)
    hn = rmsnorm(x, lp['norm_w'][0]) * (1.0 + scale1) + shift1
    y, k, v, hs = mixer(hn, lp, lam_init, pos, kv_ctx, h0)
    x = x + gate1 * y
    hn = rmsnorm(x, lp['norm_w'][1]) * (1.0 + scale2) + shift2
    x = x + gate2 * (jnp.square(jax.nn.relu(hn @ lp['w_mlp1'])) @ lp['w_mlp2'])
    return x, k, v, hs


def setup_inputs(seed: int = 0) -> dict:
    key = jax.random.key(seed)
    ks = jax.random.split(key, 26)
    f32 = jnp.float32
    nrm = lambda k, shape, s: (jax.random.normal(k, shape, f32) * s)
    a_init = jax.random.uniform(ks[20], (DEPTH, 2, D_GROUP), f32, 0.9, 0.999)
    return {
        'x_prompt': nrm(ks[0], (BATCH, SEQ, D_MODEL), 1.0),
        'x_sample': nrm(ks[1], (DEC_BATCH, DEC_SEQ, D_MODEL), 1.0),
        'cache_k': nrm(ks[2], (DEC_BATCH, DEPTH, N_ATT_HEADS, PAST_LEN, 2 * DK), 1.0),
        'cache_v': nrm(ks[3], (DEC_BATCH, DEPTH, N_ATT_HEADS, PAST_LEN, V_DIM), 1.0),
        'state_rglru': nrm(ks[4], (DEC_BATCH, DEPTH, 2, D_GROUP), 0.5),
        'c': nrm(ks[5], (DEC_BATCH, D_MODEL), 1.0),
        'c_ctx': nrm(ks[6], (D_MODEL,), 1.0),
        'w_ada': nrm(ks[7], (DEPTH, D_MODEL, N_MOD * D_MODEL), 0.5 * D_MODEL ** -0.5),
        'b_ada': nrm(ks[8], (DEPTH, N_MOD * D_MODEL), 0.02),
        'norm_w': 1.0 + nrm(ks[9], (DEPTH, 2, D_MODEL), 0.02),
        'w_in': nrm(ks[10], (DEPTH, D_MODEL, D_IN), D_MODEL ** -0.5),
        'diff_lambda': nrm(ks[11], (DEPTH, 4, DK), 0.1),
        'subln_w': 1.0 + nrm(ks[12], (DEPTH, V_DIM), 0.02),
        'conv_b_w': nrm(ks[13], (DEPTH, CONV_B_W, D_GROUP), CONV_B_W ** -0.5),
        'conv_c_w': nrm(ks[14], (DEPTH, CONV_C_W, D_GROUP), CONV_C_W ** -0.5),
        'conv_c_b': nrm(ks[15], (DEPTH, D_GROUP), 0.02),
        'rg_w': nrm(ks[16], (DEPTH, 2, 2, RG_BLOCKS, RG_BW, RG_BW), RG_BW ** -0.5),
        'rg_b': nrm(ks[17], (DEPTH, 2, 2, D_GROUP), 0.02),
        'rg_lambda': jnp.log(a_init) - jnp.log1p(-a_init),
        'pool_w': nrm(ks[18], (DEPTH, len(POOL_WINDOWS), POOL_GW, POOL_GW), POOL_GW ** -0.5),
        'pool_scale': 1.0 + nrm(ks[19], (DEPTH, D_GROUP), 0.1),
        'w_out': nrm(ks[21], (DEPTH, D_MODEL, D_MODEL), D_MODEL ** -0.5),
        'w_mlp1': nrm(ks[22], (DEPTH, D_MODEL, D_FF), D_MODEL ** -0.5),
        'w_mlp2': nrm(ks[23], (DEPTH, D_FF, D_MODEL), D_FF ** -0.5),
        'final_norm_w': 1.0 + nrm(ks[24], (D_MODEL,), 0.02),
    }


def reference(x_prompt, x_sample, cache_k, cache_v, state_rglru, c, c_ctx, w_ada, b_ada, norm_w,
              w_in, diff_lambda, subln_w, conv_b_w, conv_c_w, conv_c_b, rg_w, rg_b, rg_lambda,
              pool_w, pool_scale, w_out, w_mlp1, w_mlp2, final_norm_w):
    t_lat = x_sample.shape[1]
    n_rows = t_lat // GRID_W
    rows = jnp.repeat(jnp.arange(n_rows), GRID_W)
    cols = jnp.tile(jnp.arange(GRID_W), n_rows)
    pos = (rows, cols)

    xp = x_prompt
    xs = x_sample
    ks_out, vs_out, hs_out = [], [], []
    for l in range(DEPTH):
        lp = dict(w_in=w_in[l], diff_lambda=diff_lambda[l], subln_w=subln_w[l],
                  conv_b_w=conv_b_w[l], conv_c_w=conv_c_w[l], conv_c_b=conv_c_b[l],
                  rg_w=rg_w[l], rg_b=rg_b[l], rg_lambda=rg_lambda[l], pool_w=pool_w[l],
                  pool_scale=pool_scale[l], w_out=w_out[l], norm_w=norm_w[l],
                  w_mlp1=w_mlp1[l], w_mlp2=w_mlp2[l])
        lam_init = 0.8 - 0.6 * math.exp(-0.3 * l)
        mod_ctx = (jax.nn.silu(c_ctx) @ w_ada[l] + b_ada[l])[None, None, :]
        mod_lat = (jax.nn.silu(c) @ w_ada[l] + b_ada[l])[:, None, :]
        xp, k_new, v_new, h_new = layer(xp, mod_ctx, lp, lam_init, None, None, None)
        ks_out.append(k_new)
        vs_out.append(v_new)
        hs_out.append(h_new)
        xs, _, _, _ = layer(xs, mod_lat, lp, lam_init, pos,
                            (cache_k[:, l], cache_v[:, l]), state_rglru[:, l])
    y_prompt = rmsnorm(xp, final_norm_w)
    y_sample = rmsnorm(xs, final_norm_w)
    new_cache_k = jnp.stack(ks_out, axis=1)
    new_cache_v = jnp.stack(vs_out, axis=1)
    new_state_rglru = jnp.stack(hs_out, axis=1)
    return (y_prompt, y_sample, new_cache_k, new_cache_v, new_state_rglru)
```

```cpp
#include <hip/hip_runtime.h>
#include <cstdio>
#include <cstdint>

#ifndef MK_PER_PHASE
#define MK_PER_PHASE 1
#endif

namespace pg8 {
#define PG8_LAS __attribute__((address_space(3)))
typedef unsigned short bf16_t;
typedef short bf16x8 __attribute__((ext_vector_type(8)));
typedef float f32x4 __attribute__((ext_vector_type(4)));
typedef unsigned u32x4 __attribute__((ext_vector_type(4)));
constexpr int BM = 256, BK = 64, HALF = 128, HTB = HALF * BK * 2, STAGE_BYTES = 8 * HTB, NXCD = 8, WGM = 8;

__host__ __device__ __forceinline__ int lds_byte(int r, int c) { const int st = (r >> 4) * 2 + (c >> 5), rr = r & 15, cc = c & 31, ob = rr * 64 + cc * 2; return st * 1024 + (ob ^ (((ob >> 9) & 1) << 5)); }
__host__ __device__ __forceinline__ void stage_rc(int b, int& R, int& C) { const int st = b / 1024, sb = b % 1024, swz = sb ^ (((sb >> 9) & 1) << 5); R = (st >> 1) * 16 + swz / 64; C = (st & 1) * 32 + (swz % 64) / 2; }
__host__ __device__ __forceinline__ int perm32(int rho) { const int n = rho >> 4, i = rho & 15; return 8 * (i >> 2) + 4 * n + (i & 3); }

struct Unit { int pm, pn; };
struct Gemm { const bf16_t* A; const bf16_t* Bt; int M, N, K; };

struct StaticOrder {
    int nM, nN, nwg, G, c;
    __host__ __device__ void init(int M, int N, int G_, int c_) { nM = M / BM; nN = N / BM; nwg = nM * nN; G = G_; c = c_; }
    __host__ __device__ bool next(int i, Unit& u) const {
        const long L = (long)i * G + c; if (L >= nwg) return false;
        int wgid = (int)L; { const int q = nwg / NXCD, r = nwg % NXCD, xcd = wgid % NXCD, off = wgid / NXCD; wgid = (xcd < r ? xcd * (q + 1) : r * (q + 1) + (xcd - r) * q) + off; }
        const int nig = WGM * nN, gid = wgid / nig, fm = gid * WGM, gsz = (nM - fm) < WGM ? (nM - fm) : WGM;
        u.pm = fm + ((wgid % nig) % gsz); u.pn = (wgid % nig) / gsz; return true;
    }
    __device__ __forceinline__ void a_ready(const Unit&) const {}
    __device__ __forceinline__ void done(const Unit&) const {}
};

__device__ __forceinline__ unsigned cvt_pk_bf16(float lo, float hi) { unsigned r; asm volatile("v_cvt_pk_bf16_f32 %0, %1, %2" : "=v"(r) : "v"(lo), "v"(hi)); return r; }


struct EpiIn {
    static constexpr bool PERM = true, AFTER_DRAIN = false;
    bf16_t* Z; const float* rope; float* ck_out; float* cv_out; int layer;
    __device__ __forceinline__ void operator()(const f32x4 (&acc)[2][2][4][2], const Unit& u, int wr, int wc, int fr, int fq) const {
        const int pn = u.pn; const bool lat = u.pm >= 32; const bool dorope = lat && pn <= 1;
        const int row0 = u.pm * BM + wr * 64 + fr; const int colw = wc * 32 + 8 * fq;
        const float qs = (pn == 0) ? 0.25503486f : 1.0f;
#pragma unroll
        for (int ai = 0; ai < 2; ++ai)
#pragma unroll
            for (int m = 0; m < 4; ++m) {
                const int row = row0 + ai * HALF + m * 16;
                f32x4 cs[4];
                if (dorope) { const int t = (row - 8192) & 2047; const int pos = (fq >> 1) ? (t & 63) : (t >> 6); const f32x4* rp = (const f32x4*)(rope + pos * 16);
#pragma unroll
                    for (int e = 0; e < 4; ++e) cs[e] = rp[e]; }
#pragma unroll
                for (int bj = 0; bj < 2; ++bj) {
                    float v[8];
#pragma unroll
                    for (int e = 0; e < 4; ++e) { v[e] = acc[ai][bj][m][0][e]; v[4 + e] = acc[ai][bj][m][1][e]; }
                    if (dorope) {
#pragma unroll
                        for (int e = 0; e < 8; ++e) { const float pr = __shfl_xor(v[e], 16); const float c = cs[e >> 1][(e & 1) * 2], s = cs[e >> 1][(e & 1) * 2 + 1];
                            v[e] = (fq & 1) ? (v[e] * c + pr * s) : (v[e] * c - pr * s); }
                    }
                    if (!lat && (pn == 1 || pn == 2)) {
                        float* co = (pn == 1) ? ck_out : cv_out; const int b = row >> 8, t = row & 255; const int cc = bj * HALF + colw; const int hd = cc >> 6, d = cc & 63;
                        float* op = co + ((size_t)((b * 2 + layer) * 4 + hd) * 256 + t) * 64 + d;
                        *(f32x4*)op = (f32x4){v[0], v[1], v[2], v[3]}; *(f32x4*)(op + 4) = (f32x4){v[4], v[5], v[6], v[7]};
                    }
                    u32x4 w; w.x = cvt_pk_bf16(v[0] * qs, v[1] * qs); w.y = cvt_pk_bf16(v[2] * qs, v[3] * qs); w.z = cvt_pk_bf16(v[4] * qs, v[5] * qs); w.w = cvt_pk_bf16(v[6] * qs, v[7] * qs);
                    *(u32x4*)(Z + (size_t)row * 2304 + pn * BM + bj * HALF + colw) = w;
                }
            }
    }
};
struct EpiGateRes {
    static constexpr bool PERM = false, AFTER_DRAIN = false;
    const float* res_c; const float* res_l; float* out; const float* gate; int rowbase;
    __device__ __forceinline__ void operator()(const f32x4 (&acc)[2][2][4][2], const Unit& u, int wr, int wc, int fr, int fq) const {
        const int grow0 = rowbase + u.pm * BM; const int mi = grow0 < 8192 ? 0 : 1 + ((grow0 - 8192) >> 11);
        const float* res = grow0 < 8192 ? res_c : res_l;
        const int row0 = grow0 + wr * 64 + fr, col0 = u.pn * BM + wc * 32 + 4 * fq;
        f32x4 gv[2][2];
#pragma unroll
        for (int bj = 0; bj < 2; ++bj)
#pragma unroll
            for (int n = 0; n < 2; ++n) gv[bj][n] = *(const f32x4*)(gate + (size_t)mi * 6144 + col0 + bj * HALF + n * 16);
#pragma unroll
        for (int ai = 0; ai < 2; ++ai)
#pragma unroll
            for (int m = 0; m < 4; ++m) { const size_t off = (size_t)(row0 + ai * HALF + m * 16) * 1024 + col0;
#pragma unroll
                for (int bj = 0; bj < 2; ++bj)
#pragma unroll
                    for (int n = 0; n < 2; ++n) { const f32x4 r = *(const f32x4*)(res + off + bj * HALF + n * 16); *(f32x4*)(out + off + bj * HALF + n * 16) = r + gv[bj][n] * acc[ai][bj][m][n]; } }
    }
};
struct EpiRelu2 {
    static constexpr bool PERM = true, AFTER_DRAIN = false;
    bf16_t* H;
    __device__ __forceinline__ void operator()(const f32x4 (&acc)[2][2][4][2], const Unit& u, int wr, int wc, int fr, int fq) const {
        const int row0 = u.pm * BM + wr * 64 + fr; const int col0 = u.pn * BM + wc * 32 + 8 * fq;
#pragma unroll
        for (int ai = 0; ai < 2; ++ai)
#pragma unroll
            for (int m = 0; m < 4; ++m) { bf16_t* rowp = H + (size_t)(row0 + ai * HALF + m * 16) * 4096 + col0;
#pragma unroll
                for (int bj = 0; bj < 2; ++bj) { f32x4 v0 = acc[ai][bj][m][0], v1 = acc[ai][bj][m][1];
#pragma unroll
                    for (int e = 0; e < 4; ++e) { const float a = fmaxf(v0[e], 0.f), b = fmaxf(v1[e], 0.f); v0[e] = a * a; v1[e] = b * b; }
                    u32x4 w; w.x = cvt_pk_bf16(v0[0], v0[1]); w.y = cvt_pk_bf16(v0[2], v0[3]); w.z = cvt_pk_bf16(v1[0], v1[1]); w.w = cvt_pk_bf16(v1[2], v1[3]);
                    *(u32x4*)(rowp + bj * HALF) = w; } }
    }
};

template <class Epi, class Sched, bool ALIGN_EPI = false, bool SP2 = false>
__device__ __forceinline__ void gemm_phase(PG8_LAS unsigned char* lds, const Gemm g, const Sched& S, const Epi& E) {
    int tid = threadIdx.x; asm volatile("" : "+v"(tid));
    const int wid = __builtin_amdgcn_readfirstlane(tid >> 6), lane = tid & 63, wr = wid >> 2, wc = wid & 3, fr = lane & 15, fq = lane >> 4;
    const int K = g.K, nt = K / BK;
    unsigned voffA[2], voffB[2];
#pragma unroll
    for (int i = 0; i < 2; ++i) { int R, C; stage_rc(tid * 16 + i * 8192, R, C); const int Rb = Epi::PERM ? ((R & ~31) + perm32(R & 31)) : R;
        voffA[i] = (unsigned)(R * K + C) * 2u; voffB[i] = (unsigned)(Rb * K + C) * 2u; }
    const size_t kstep = (size_t)(BK * 2);
    const size_t hstep = (size_t)HALF * K * 2;
    const size_t tstep = 2 * hstep;
    const unsigned ldsw = (unsigned)wid * 1024u;
    const int aoff = lds_byte(wr * 64 + fr, fq * 8), boff = lds_byte(wc * 32 + fr, fq * 8);
#define PG8_SA(b, h) (((b) * 2 + (h)) * HTB)
#define PG8_SB(b, h) ((4 + (b) * 2 + (h)) * HTB)
#define PG8_STAGE(bufoff, gbase, voff) do { _Pragma("unroll") for (int _i = 0; _i < 2; ++_i) \
        __builtin_amdgcn_global_load_lds((const unsigned*)((const char*)(gbase) + (voff)[_i]), (PG8_LAS unsigned*)(lds + (bufoff) + ldsw + _i * 8192), 16, 0, 0); } while (0)
#define PG8_LDA(dst, b, h) do { _Pragma("unroll") for (int m = 0; m < 4; ++m) _Pragma("unroll") for (int k = 0; k < 2; ++k) dst[m][k] = *(const PG8_LAS bf16x8*)(lds + PG8_SA(b, h) + aoff + m * 2048 + k * 1024); } while (0)
#define PG8_LDB(dst, b, h) do { _Pragma("unroll") for (int n = 0; n < 2; ++n) _Pragma("unroll") for (int k = 0; k < 2; ++k) dst[n][k] = *(const PG8_LAS bf16x8*)(lds + PG8_SB(b, h) + boff + n * 2048 + k * 1024); } while (0)
#define PG8_MMA(ai, bj, At, Bt) do { __builtin_amdgcn_s_setprio(1); _Pragma("unroll") for (int m = 0; m < 4; ++m) _Pragma("unroll") for (int n = 0; n < 2; ++n) _Pragma("unroll") for (int k = 0; k < 2; ++k) \
        acc[ai][bj][m][n] = __builtin_amdgcn_mfma_f32_16x16x32_bf16(Bt[n][k], At[m][k], acc[ai][bj][m][n], 0, 0, 0); __builtin_amdgcn_s_setprio(0); } while (0)
#define PG8_WAIT_V(n) asm volatile("s_waitcnt vmcnt(" #n ")" ::: "memory")
#define PG8_WAIT_L(n) asm volatile("s_waitcnt lgkmcnt(" #n ")" ::: "memory")
#define PG8_BAR __builtin_amdgcn_s_barrier()
#define PG8_SCHED __builtin_amdgcn_sched_barrier(0)
    Unit cur, nxt; int ui = 0;
    if (!S.next(0, cur)) return;
    f32x4 acc[2][2][4][2];
#pragma unroll
    for (int a = 0; a < 2; ++a)
#pragma unroll
        for (int b = 0; b < 2; ++b)
#pragma unroll
            for (int m = 0; m < 4; ++m)
#pragma unroll
                for (int n = 0; n < 2; ++n) acc[a][b][m][n] = (f32x4){0.f, 0.f, 0.f, 0.f};
    bf16x8 At[4][2], B0[2][2], B1[2][2];
    const char* cA = (const char*)g.A + (size_t)cur.pm * tstep; const char* cB = (const char*)g.Bt + (size_t)cur.pn * tstep;
    S.a_ready(cur);
    if constexpr (SP2) {
        PG8_STAGE(PG8_SB(0, 0), cB, voffB); PG8_STAGE(PG8_SB(0, 1), cB + hstep, voffB); PG8_STAGE(PG8_SA(0, 0), cA, voffA); PG8_STAGE(PG8_SA(0, 1), cA + hstep, voffA);
        if (wr == 1) PG8_BAR;
        PG8_WAIT_V(2); PG8_BAR;
        PG8_STAGE(PG8_SB(1, 0), cB + kstep, voffB); PG8_STAGE(PG8_SA(1, 0), cA + kstep, voffA); PG8_STAGE(PG8_SB(1, 1), cB + hstep + kstep, voffB);
        PG8_WAIT_V(6); PG8_BAR;
    } else {
        PG8_STAGE(PG8_SB(0, 0), cB, voffB); PG8_STAGE(PG8_SA(0, 0), cA, voffA); PG8_STAGE(PG8_SB(0, 1), cB + hstep, voffB); PG8_STAGE(PG8_SA(0, 1), cA + hstep, voffA);
        if (wr == 1) PG8_BAR;
        PG8_WAIT_V(4); PG8_BAR;
        PG8_STAGE(PG8_SB(1, 0), cB + kstep, voffB); PG8_STAGE(PG8_SA(1, 0), cA + kstep, voffA); PG8_STAGE(PG8_SB(1, 1), cB + hstep + kstep, voffB);
        PG8_WAIT_V(6); PG8_BAR;
    }
    for (;;) {
        const bool has_next = S.next(ui + 1, nxt);
        const char* nA = has_next ? (const char*)g.A + (size_t)nxt.pm * tstep : cA; const char* nB = has_next ? (const char*)g.Bt + (size_t)nxt.pn * tstep : cB;
        for (int t = 0; t < nt; t += 2) {
            const bool last = (t == nt - 2);
            const char* a1 = cA + (size_t)(t + 1) * kstep;
            const char* a2 = last ? nA : cA + (size_t)(t + 2) * kstep; const char* b2 = last ? nB : cB + (size_t)(t + 2) * kstep;
            const char* a3 = a2 + kstep; const char* b3 = b2 + kstep;
            if (last && has_next) S.a_ready(nxt);
            if constexpr (SP2) {
            PG8_LDB(B0, 0, 0); PG8_LDB(B1, 0, 1); PG8_SCHED; PG8_LDA(At, 0, 0); PG8_STAGE(PG8_SA(1, 1), a1 + hstep, voffA);
            PG8_WAIT_V(8); PG8_WAIT_L(0); PG8_BAR; PG8_MMA(0, 0, At, B0); PG8_MMA(0, 1, At, B1); PG8_BAR; PG8_SCHED;
            PG8_LDA(At, 0, 1); PG8_STAGE(PG8_SB(0, 0), b2, voffB); PG8_STAGE(PG8_SB(0, 1), b2 + hstep, voffB); PG8_STAGE(PG8_SA(0, 0), a2, voffA);
            PG8_WAIT_V(8); PG8_WAIT_L(0); PG8_BAR; PG8_MMA(1, 0, At, B0); PG8_MMA(1, 1, At, B1); PG8_BAR; PG8_SCHED;
            PG8_LDB(B0, 1, 0); PG8_LDB(B1, 1, 1); PG8_SCHED; PG8_LDA(At, 1, 0); PG8_STAGE(PG8_SA(0, 1), a2 + hstep, voffA);
            PG8_WAIT_V(8); PG8_WAIT_L(0); PG8_BAR; PG8_MMA(0, 0, At, B0); PG8_MMA(0, 1, At, B1); PG8_BAR; PG8_SCHED;
            PG8_LDA(At, 1, 1); PG8_STAGE(PG8_SB(1, 0), b3, voffB); PG8_STAGE(PG8_SB(1, 1), b3 + hstep, voffB); PG8_STAGE(PG8_SA(1, 0), a3, voffA);
            PG8_WAIT_V(8); PG8_WAIT_L(0); PG8_BAR; PG8_MMA(1, 0, At, B0); PG8_MMA(1, 1, At, B1); PG8_BAR; PG8_SCHED;
            } else {
            PG8_LDB(B0, 0, 0); PG8_SCHED; PG8_LDA(At, 0, 0); PG8_STAGE(PG8_SA(1, 1), a1 + hstep, voffA);
            PG8_WAIT_L(8); PG8_BAR; PG8_WAIT_L(0); PG8_MMA(0, 0, At, B0); PG8_BAR; PG8_SCHED;
            PG8_LDB(B1, 0, 1); PG8_STAGE(PG8_SB(0, 0), b2, voffB);
            PG8_BAR; PG8_WAIT_L(0); PG8_MMA(0, 1, At, B1); PG8_BAR;
            PG8_LDA(At, 0, 1); PG8_STAGE(PG8_SA(0, 0), a2, voffA);
            PG8_BAR; PG8_WAIT_L(0); PG8_MMA(1, 0, At, B0); PG8_BAR; PG8_SCHED;
            PG8_STAGE(PG8_SB(0, 1), b2 + hstep, voffB);
            PG8_WAIT_V(6); PG8_BAR; PG8_MMA(1, 1, At, B1); PG8_BAR;
            PG8_LDB(B0, 1, 0); PG8_SCHED; PG8_LDA(At, 1, 0); PG8_STAGE(PG8_SA(0, 1), a2 + hstep, voffA);
            PG8_WAIT_L(8); PG8_BAR; PG8_WAIT_L(0); PG8_MMA(0, 0, At, B0); PG8_BAR; PG8_SCHED;
            PG8_LDB(B1, 1, 1); PG8_STAGE(PG8_SB(1, 0), b3, voffB);
            PG8_BAR; PG8_WAIT_L(0); PG8_MMA(0, 1, At, B1); PG8_BAR;
            PG8_LDA(At, 1, 1); PG8_STAGE(PG8_SA(1, 0), a3, voffA);
            PG8_BAR; PG8_WAIT_L(0); PG8_MMA(1, 0, At, B0); PG8_BAR; PG8_SCHED;
            PG8_STAGE(PG8_SB(1, 1), b3 + hstep, voffB);
            PG8_WAIT_V(6); PG8_BAR; PG8_MMA(1, 1, At, B1); PG8_BAR;
            }
        }
        if constexpr (ALIGN_EPI) { if (wr == 0) PG8_BAR; }
        if constexpr (!Epi::AFTER_DRAIN) { E(acc, cur, wr, wc, fr, fq); S.done(cur); }
        if (!has_next) break;
#pragma unroll
        for (int a = 0; a < 2; ++a)
#pragma unroll
            for (int b = 0; b < 2; ++b)
#pragma unroll
                for (int m = 0; m < 4; ++m)
#pragma unroll
                    for (int n = 0; n < 2; ++n) acc[a][b][m][n] = (f32x4){0.f, 0.f, 0.f, 0.f};
        cur = nxt; cA = nA; cB = nB; ++ui;
        if constexpr (ALIGN_EPI) { if (wr == 1) PG8_BAR; }
    }
    PG8_WAIT_V(0);
    if constexpr (!ALIGN_EPI) { if (wr == 0) PG8_BAR; }
    PG8_BAR;
#undef PG8_SA
#undef PG8_SB
#undef PG8_STAGE
#undef PG8_LDA
#undef PG8_LDB
#undef PG8_MMA
#undef PG8_WAIT_V
#undef PG8_WAIT_L
#undef PG8_BAR
#undef PG8_SCHED
}
}

constexpr int NWAVES = 8;
constexpr int D = 1024, MC = 8192, ML = 16384, M = MC + ML, DIN = 2304, DFF = 4096, DG = 256, MH = M / 2;
constexpr float EPS = 1e-6f;
constexpr size_t MiB = 1u << 20;
constexpr size_t WS_CTL = 0, CTL_ZERO_BYTES = 1 * MiB;
constexpr size_t WS_MOD = 1 * MiB;
constexpr size_t WS_ROPE = WS_MOD + 2 * 9 * 6144 * 4;
constexpr size_t WS_LAM = WS_ROPE + 64 * 16 * 4;
constexpr size_t WS_RGWT = WS_LAM + 256;
constexpr size_t WS_POOLT = WS_RGWT + 32 * 4096 * 2;
constexpr size_t WS_WIN = 2 * MiB;
constexpr size_t WS_WOUT = WS_WIN + 2ull * 2304 * 1024 * 2;
constexpr size_t WS_W1 = WS_WOUT + 2ull * 1024 * 1024 * 2;
constexpr size_t WS_W2 = WS_W1 + 2ull * 4096 * 1024 * 2;
constexpr size_t WS_CK = WS_W2 + 2ull * 4096 * 1024 * 2;
constexpr size_t WS_CV = WS_CK + 2 * MiB;
constexpr size_t WS_XN = 52 * MiB;
constexpr size_t WS_Y = 100 * MiB;
constexpr size_t WS_Z = 148 * MiB;
constexpr size_t WS_END = 256 * MiB;
static_assert(WS_POOLT + 8 * 4096 * 2 <= WS_WIN && WS_CV + 2 * MiB <= WS_XN && WS_Z + (size_t)M * DIN * 2 <= WS_END, "d_ws map");
constexpr int CW_BAR = 4096;
constexpr size_t OUT_Y = 0, OUT_CK = (size_t)M * D, OUT_CV = OUT_CK + 32ull * 2 * 4 * 256 * 64, OUT_ST = OUT_CV + 32ull * 2 * 4 * 256 * 64;
constexpr int RING_BYTES = 131072, LDSCTL_OFF = RING_BYTES, MISC_OFF = LDSCTL_OFF + 320, LDS_BYTES = 147456;

#define GAS __attribute__((address_space(1)))
#define LAS __attribute__((address_space(3)))
typedef unsigned short bf16;
typedef unsigned v4u __attribute__((ext_vector_type(4)));
typedef unsigned v2u __attribute__((ext_vector_type(2)));
typedef float f32x4 __attribute__((ext_vector_type(4)));
typedef GAS unsigned gu32;
#define RLX_AGENT __ATOMIC_RELAXED, __HIP_MEMORY_SCOPE_AGENT
#define LDS_WAIT() asm volatile("s_waitcnt lgkmcnt(0)" ::: "memory")
__device__ __forceinline__ unsigned f2bf(float f) { unsigned u = __builtin_bit_cast(unsigned, f); return (u + 0x7fffu + ((u >> 16) & 1u)) >> 16; }
__device__ __forceinline__ unsigned pk2(float lo, float hi) { return f2bf(lo) | (f2bf(hi) << 16); }
__device__ __forceinline__ float bf2f(unsigned h) { return __uint_as_float(h << 16); }
__device__ __forceinline__ float bflo(unsigned w) { return __uint_as_float(w << 16); }
__device__ __forceinline__ float bfhi(unsigned w) { return __uint_as_float(w & 0xffff0000u); }

#define XB_TMO      128
#define XB_XCNT(j)  (256  + 64 * (j))
#define XB_XSUB(j)  (1280 + 64 * (j))
#define XB_XGEN(j)  (2304 + 64 * (j))
#define XB_TOP      3328
#define XB_TOPGEN   3392
#define XCD_BAR_WORDS 3456
#define XB_SPIN_CAP (1u << 18)
__device__ __forceinline__ unsigned xb_ld(unsigned* p)              { return __hip_atomic_load(p, __ATOMIC_RELAXED, __HIP_MEMORY_SCOPE_AGENT); }
__device__ __forceinline__ unsigned xb_add(unsigned* p, unsigned v) { return __hip_atomic_fetch_add(p, v, __ATOMIC_RELAXED, __HIP_MEMORY_SCOPE_AGENT); }
__device__ __forceinline__ unsigned xb_xcc_id() { return (unsigned)__builtin_amdgcn_s_getreg((3 << 11) | 20) & 0xFu; }
#define XB_SPIN(cond, bar) do { unsigned _sp = 0; while (cond) { __builtin_amdgcn_s_sleep(1); \
    if ((++_sp & 255u) == 0u) { if (xb_ld(&(bar)[XB_TMO])) break; if (_sp > XB_SPIN_CAP) { atomicAdd(&(bar)[XB_TMO], 1u); break; } } } } while (0)
struct XcdBarrier { unsigned* bar; unsigned x; volatile LAS unsigned* st; };
__device__ __forceinline__ XcdBarrier xcd_barrier_post(unsigned* bar, volatile LAS unsigned* st) {
    XcdBarrier b; b.bar = bar; b.x = xb_xcc_id(); b.st = st;
    if (threadIdx.x == 0) (void)xb_add(&bar[XB_XCNT(b.x)], 1u);
    return b;
}
__device__ __forceinline__ void xcd_barrier_complete(unsigned* bar, unsigned x, unsigned& nloc, unsigned& nx) {
    const unsigned G = gridDim.x * gridDim.y * gridDim.z;
    unsigned sum, cnt, mine, sp = 0u;
    for (;;) {
        sum = 0u; cnt = 0u; mine = 0u;
#pragma unroll
        for (unsigned j = 0; j < 16; ++j) { const unsigned c = xb_ld(&bar[XB_XCNT(j)]); sum += c; cnt += (c > 0u) ? 1u : 0u; mine = (j == x) ? c : mine; }
        if (sum == G) break;
        __builtin_amdgcn_s_sleep(1);
        if ((++sp & 255u) == 0u) { if (xb_ld(&bar[XB_TMO])) break; if (sp > XB_SPIN_CAP) { atomicAdd(&bar[XB_TMO], 1u); break; } }
    }
    nloc = mine > 0u ? mine : 1u; nx = cnt > 0u ? cnt : 1u;
}
__device__ __forceinline__ void xcd_barrier(const XcdBarrier& b) {
    asm volatile("s_waitcnt vmcnt(0)" ::: "memory");
    __syncthreads();
    if (threadIdx.x == 0) {
        unsigned* bar = b.bar;
        __builtin_amdgcn_s_waitcnt(0);
        unsigned nloc = b.st[0], nx = b.st[1];
        if (nloc == 0u) { xcd_barrier_complete(bar, b.x, nloc, nx); b.st[0] = nloc; b.st[1] = nx; }
        const unsigned old = xb_add(&bar[XB_XSUB(b.x)], 1u);
        const unsigned gen = old / nloc;
        if (old + 1u == (gen + 1u) * nloc) {
            __builtin_amdgcn_fence(__ATOMIC_RELEASE, "agent");
            asm volatile("s_waitcnt vmcnt(0)" ::: "memory");
            const unsigned og = xb_add(&bar[XB_TOP], 1u);
            const unsigned tg = og / nx;
            if (og + 1u == (tg + 1u) * nx) xb_add(&bar[XB_TOPGEN], 1u);
            else XB_SPIN(xb_ld(&bar[XB_TOPGEN]) == tg, bar);
            __builtin_amdgcn_fence(__ATOMIC_ACQUIRE, "agent");
            xb_add(&bar[XB_XGEN(b.x)], 1u);
            asm volatile("s_waitcnt vmcnt(0)" ::: "memory");
        } else {
            XB_SPIN(xb_ld(&bar[XB_XGEN(b.x)]) == gen, bar);
            __builtin_amdgcn_fence(__ATOMIC_ACQUIRE, "agent");
            asm volatile("s_waitcnt vmcnt(0)" ::: "memory");
        }
    }
    __syncthreads();
}

struct Args { const float* in[25]; float* out; unsigned char* ws; int ph_lo, ph_hi; };
#define INP(A_, i) ((A_).in[i])
struct Frame {
    LAS unsigned char* lds; int tid, lane, wave, vcu, G;
    float* out; unsigned char* ws;
};
#define PHASE_IDS(F) do { int t_ = threadIdx.x; asm volatile("" : "+v"(t_)); (F).tid = t_; (F).lane = t_ & 63; (F).wave = __builtin_amdgcn_readfirstlane(t_ >> 6); } while (0)
enum { I_XP = 0, I_XS, I_CK, I_CV, I_ST, I_C, I_CCTX, I_WADA, I_BADA, I_NORMW, I_WIN, I_DLAM, I_SUBLN, I_CBW, I_CCW, I_CCB, I_RGW, I_RGB, I_RGLAM, I_POOLW, I_POOLS, I_WOUT, I_W1, I_W2, I_FNW };

__device__ __forceinline__ float wave_sum(float v) {
#pragma unroll
    for (int o = 1; o < 64; o <<= 1) v += __shfl_xor(v, o);
    return v;
}
__device__ __forceinline__ float wave_max(float v) {
#pragma unroll
    for (int o = 1; o < 64; o <<= 1) v = fmaxf(v, __shfl_xor(v, o));
    return v;
}
__device__ __forceinline__ float gelu_tanh(float x) { const float u = 0.7978845608028654f * (x + 0.044715f * x * x * x); return 0.5f * x * (1.0f + tanhf(u)); }

__device__ __forceinline__ void p0_transpose_item(const float* W, int K, int N, bf16* WT, LAS float* scr, int item, int lane) {
    const int nblk = N / 32, kb = item / nblk, nb = item % nblk, k0 = 64 * kb, n0 = 32 * nb;
#pragma unroll 8
    for (int i = 0; i < 32; ++i) { const int kk = 2 * i + (lane >> 5); scr[kk * 33 + (lane & 31)] = W[(size_t)(k0 + kk) * N + n0 + (lane & 31)]; }
    LDS_WAIT(); asm volatile("" ::: "memory");
    const int c = lane & 7;
#pragma unroll
    for (int j = 0; j < 4; ++j) { const int n = (lane >> 3) + 8 * j; const LAS float* s = scr + (8 * c) * 33 + n;
        v4u o; o.x = pk2(s[0 * 33], s[1 * 33]); o.y = pk2(s[2 * 33], s[3 * 33]); o.z = pk2(s[4 * 33], s[5 * 33]); o.w = pk2(s[6 * 33], s[7 * 33]);
        *(GAS v4u*)(WT + (size_t)(n0 + n) * K + k0 + 8 * c) = o; }
    LDS_WAIT(); asm volatile("" ::: "memory");
}
__device__ __forceinline__ void p0_mod_item(Frame& F, const Args& A, int item) {
    const int l = item / 48, n0 = (item % 48) * 128;
    LAS float* sv = (LAS float*)F.lds;
    LAS float* red = sv + 9 * 1024;
    const float* c = INP(A, I_C); const float* cctx = INP(A, I_CCTX);
    for (int i = F.tid; i < 9 * 1024; i += 512) { const int mi = i >> 10, k = i & 1023; const float v = mi == 0 ? cctx[k] : c[(mi - 1) * 1024 + k]; sv[i] = v / (1.0f + expf(-v)); }
    __syncthreads();
    const int cg = F.tid & 31, rg = F.tid >> 5;
    float acc[9][4];
#pragma unroll
    for (int a = 0; a < 9; ++a)
#pragma unroll
        for (int j = 0; j < 4; ++j) acc[a][j] = 0.f;
    const float* wp = INP(A, I_WADA) + (size_t)l * 1024 * 6144 + n0 + cg * 4;
#pragma unroll 4
    for (int i = 0; i < 64; ++i) { const int k = rg + 16 * i; const f32x4 w = *(const f32x4*)(wp + (size_t)k * 6144);
#pragma unroll
        for (int a = 0; a < 9; ++a) { const float s = sv[a * 1024 + k];
#pragma unroll
            for (int j = 0; j < 4; ++j) acc[a][j] += s * w[j]; } }
#pragma unroll
    for (int a = 0; a < 9; ++a)
#pragma unroll
        for (int j = 0; j < 4; ++j) red[(rg * 9 + a) * 128 + cg * 4 + j] = acc[a][j];
    __syncthreads();
    float* mod = (float*)(F.ws + WS_MOD);
    for (int o = F.tid; o < 9 * 128; o += 512) { const int mi = o >> 7, n = o & 127; float s = INP(A, I_BADA)[l * 6144 + n0 + n];
        for (int r = 0; r < 16; ++r) s += red[(r * 9 + mi) * 128 + n];
        mod[(size_t)(l * 9 + mi) * 6144 + n0 + n] = s; }
    __syncthreads();
}
__device__ __forceinline__ void sincos_d(double a, float& co, float& si) {
    const double TWO_PI = 6.283185307179586476925286766559;
    const double n = (double)(long long)(a / TWO_PI + 0.5);
    const double r = a - n * TWO_PI;
    const double r2 = r * r; double ts = r, tc = 1.0, ss = r, sc = 1.0;
    for (int k = 1; k <= 14; ++k) { tc = -tc * r2 / (double)((2 * k - 1) * (2 * k)); sc += tc; ts = -ts * r2 / (double)((2 * k) * (2 * k + 1)); ss += ts; }
    co = (float)sc; si = (float)ss;
}
__device__ __forceinline__ void p0_prologue(Frame& F, const Args& A) {
    PHASE_IDS(F);
    if (blockIdx.x < 96) p0_mod_item(F, A, blockIdx.x);
    LAS float* scr = (LAS float*)(F.lds + F.wave * 16384);
    const int gw = F.vcu * NWAVES + F.wave, NGW = F.G * NWAVES;
    constexpr int I_IN = 16 * 72, I_OUT = 16 * 32, I_1 = 16 * 128, I_2 = 64 * 32, I_L = I_IN + I_OUT + I_1 + I_2, I_RG = 32 * 2, I_PW = 8 * 2;
    constexpr int NITEMS = 2 * I_L + I_RG + I_PW;
    for (int it = gw; it < NITEMS; it += NGW) {
        int r = it;
        if (r < 2 * I_L) { const int l = r / I_L; r -= l * I_L;
            if (r < I_IN) { p0_transpose_item(INP(A, I_WIN) + (size_t)l * 1024 * 2304, 1024, 2304, (bf16*)(F.ws + WS_WIN) + (size_t)l * 2304 * 1024, scr, r, F.lane); continue; } r -= I_IN;
            if (r < I_OUT) { p0_transpose_item(INP(A, I_WOUT) + (size_t)l * 1024 * 1024, 1024, 1024, (bf16*)(F.ws + WS_WOUT) + (size_t)l * 1024 * 1024, scr, r, F.lane); continue; } r -= I_OUT;
            if (r < I_1) { p0_transpose_item(INP(A, I_W1) + (size_t)l * 1024 * 4096, 1024, 4096, (bf16*)(F.ws + WS_W1) + (size_t)l * 4096 * 1024, scr, r, F.lane); continue; } r -= I_1;
            p0_transpose_item(INP(A, I_W2) + (size_t)l * 4096 * 1024, 4096, 1024, (bf16*)(F.ws + WS_W2) + (size_t)l * 1024 * 4096, scr, r, F.lane); continue; }
        r -= 2 * I_L;
        if (r < I_RG) { const int mi = r >> 1; p0_transpose_item(INP(A, I_RGW) + (size_t)mi * 4096, 64, 64, (bf16*)(F.ws + WS_RGWT) + (size_t)mi * 4096, scr, r & 1, F.lane); continue; } r -= I_RG;
        { const int mi = r >> 1; p0_transpose_item(INP(A, I_POOLW) + (size_t)mi * 4096, 64, 64, (bf16*)(F.ws + WS_POOLT) + (size_t)mi * 4096, scr, r & 1, F.lane); }
    }
    { const int gt = F.vcu * 512 + F.tid, NGT = F.G * 512;
      for (int i = gt; i < 2 * 262144; i += NGT) { const int which = i >= 262144; const int j = which ? i - 262144 : i;
          const float* srcp = which ? INP(A, I_CV) : INP(A, I_CK); const f32x4 v = *(const f32x4*)(srcp + (size_t)j * 4); v2u o; o.x = pk2(v[0], v[1]); o.y = pk2(v[2], v[3]);
          *(GAS v2u*)((bf16*)(F.ws + (which ? WS_CV : WS_CK)) + (size_t)j * 4) = o; } }
    if (blockIdx.x == 100 % F.G) {
        const double fr[8] = {1.0, 0.31622776601683794, 0.1, 0.031622776601683794, 0.01, 0.0031622776601683794, 0.001, 0.00031622776601683794};
        float* rope = (float*)(F.ws + WS_ROPE);
        { const int pos = F.tid >> 3, j = F.tid & 7; double f = fr[0];
#pragma unroll
          for (int q = 1; q < 8; ++q) f = (j == q) ? fr[q] : f;
          float co, si; sincos_d((double)pos * f, co, si); rope[pos * 16 + j * 2] = co; rope[pos * 16 + j * 2 + 1] = si; }
        if (F.tid < 2) { const int l = F.tid; const float* dl = INP(A, I_DLAM) + l * 128; float s1 = 0.f, s2 = 0.f;
            for (int i = 0; i < 32; ++i) { s1 += dl[i] * dl[32 + i]; s2 += dl[64 + i] * dl[96 + i]; }
            const float lam_init = 0.8f - 0.6f * expf(-0.3f * (float)l);
            ((float*)(F.ws + WS_LAM))[l] = expf(s1) - expf(s2) + lam_init; }
    }
}
__device__ __forceinline__ void norm_mod_phase(Frame& F, const float* src_c, const float* src_l, const float* nw, const float* modl, int shift_off, int scale_off) {
    PHASE_IDS(F);
    bf16* XN = (bf16*)(F.ws + WS_XN);
    const int gw = F.vcu * NWAVES + F.wave, NGW = F.G * NWAVES;
    for (int r = gw; r < M; r += NGW) {
        const float* xr = (r < MC ? src_c : src_l) + (size_t)r * D; const int mi = r < MC ? 0 : 1 + ((r - MC) >> 11);
        const float* mp = modl + (size_t)mi * 6144;
        f32x4 v[4]; float s = 0.f;
#pragma unroll
        for (int j = 0; j < 4; ++j) { v[j] = *(const f32x4*)(xr + 256 * j + 4 * F.lane); s += (v[j][0] * v[j][0] + v[j][1] * v[j][1]) + (v[j][2] * v[j][2] + v[j][3] * v[j][3]); }
        const float rstd = 1.0f / sqrtf(wave_sum(s) * (1.0f / D) + EPS);
#pragma unroll
        for (int j = 0; j < 4; ++j) { const int c = 256 * j + 4 * F.lane; const f32x4 w = *(const f32x4*)(nw + c), sc = *(const f32x4*)(mp + scale_off + c), sh = *(const f32x4*)(mp + shift_off + c);
            f32x4 o;
#pragma unroll
            for (int e = 0; e < 4; ++e) o[e] = v[j][e] * rstd * w[e] * (1.0f + sc[e]) + sh[e];
            v2u pk; pk.x = pk2(o[0], o[1]); pk.y = pk2(o[2], o[3]); *(GAS v2u*)(XN + (size_t)r * D + c) = pk; }
    }
}
__device__ __forceinline__ void final_norm_phase(Frame& F, const Args& A) {
    PHASE_IDS(F);
    const int gw = F.vcu * NWAVES + F.wave, NGW = F.G * NWAVES; const float* fw = INP(A, I_FNW);
    for (int r = gw; r < M; r += NGW) {
        float* xr = F.out + (size_t)r * D; f32x4 v[4]; float s = 0.f;
#pragma unroll
        for (int j = 0; j < 4; ++j) { v[j] = *(const f32x4*)(xr + 256 * j + 4 * F.lane); s += (v[j][0] * v[j][0] + v[j][1] * v[j][1]) + (v[j][2] * v[j][2] + v[j][3] * v[j][3]); }
        const float rstd = 1.0f / sqrtf(wave_sum(s) * (1.0f / D) + EPS);
#pragma unroll
        for (int j = 0; j < 4; ++j) { const int c = 256 * j + 4 * F.lane; const f32x4 w = *(const f32x4*)(fw + c); *(f32x4*)(xr + c) = v[j] * rstd * w; }
    }
}

__device__ __forceinline__ void mix_attn_naive(Frame& F, const Args& A, int l) {
    PHASE_IDS(F);
    const bf16* Z = (const bf16*)(F.ws + WS_Z); bf16* Y = (bf16*)(F.ws + WS_Y);
    const bf16* CK = (const bf16*)(F.ws + WS_CK); const bf16* CV = (const bf16*)(F.ws + WS_CV);
    const float lam = ((const float*)(F.ws + WS_LAM))[l]; const float lam_init = 0.8f - 0.6f * expf(-0.3f * (float)l);
    const float sub = INP(A, I_SUBLN)[l * 64 + F.lane] * (1.0f - lam_init);
    const int gw = F.vcu * NWAVES + F.wave, NGW = F.G * NWAVES; const int lane = F.lane;
    for (int it = gw; it < M * 4; it += NGW) {
        const int r = it >> 2, hd = it & 3; const bool lat = r >= MC;
        const int seq0 = lat ? MC + ((r - MC) & ~2047) : (r & ~255); const int nkb = lat ? 36 : 4; const int b = lat ? (r - MC) >> 11 : 0;
        const bf16* ckp = CK + (size_t)((b * 2 + l) * 4 + hd) * 256 * 64; const bf16* cvp = CV + (size_t)((b * 2 + l) * 4 + hd) * 256 * 64;
        float q[64];
        { const v4u* qp = (const v4u*)(Z + (size_t)r * DIN + hd * 64);
#pragma unroll
          for (int c = 0; c < 8; ++c) { const v4u w = qp[c]; q[c * 8 + 0] = bflo(w.x); q[c * 8 + 1] = bfhi(w.x); q[c * 8 + 2] = bflo(w.y); q[c * 8 + 3] = bfhi(w.y); q[c * 8 + 4] = bflo(w.z); q[c * 8 + 5] = bfhi(w.z); q[c * 8 + 6] = bflo(w.w); q[c * 8 + 7] = bfhi(w.w); } }
        float m1 = -1e30f, m2 = -1e30f;
        for (int kb = 0; kb < nkb; ++kb) {
            const bool cached = lat && kb < 4; const int key = kb * 64 + lane;
            const bf16* kp = cached ? ckp + (size_t)key * 64 : Z + (size_t)(seq0 + key - (lat ? 256 : 0)) * DIN + 256 + hd * 64;
            float s1 = 0.f, s2 = 0.f;
#pragma unroll
            for (int c = 0; c < 8; ++c) { const v4u w = ((const v4u*)kp)[c];
                const float d = q[c * 8 + 0] * bflo(w.x) + q[c * 8 + 1] * bfhi(w.x) + q[c * 8 + 2] * bflo(w.y) + q[c * 8 + 3] * bfhi(w.y) + q[c * 8 + 4] * bflo(w.z) + q[c * 8 + 5] * bfhi(w.z) + q[c * 8 + 6] * bflo(w.w) + q[c * 8 + 7] * bfhi(w.w);
                if (c < 4) s1 += d; else s2 += d; }
            m1 = fmaxf(m1, s1); m2 = fmaxf(m2, s2);
        }
        m1 = wave_max(m1); m2 = wave_max(m2);
        float l1 = 0.f, l2 = 0.f, o1 = 0.f, o2 = 0.f;
        for (int kb = 0; kb < nkb; ++kb) {
            const bool cached = lat && kb < 4; const int key = kb * 64 + lane;
            const bf16* kp = cached ? ckp + (size_t)key * 64 : Z + (size_t)(seq0 + key - (lat ? 256 : 0)) * DIN + 256 + hd * 64;
            float s1 = 0.f, s2 = 0.f;
#pragma unroll
            for (int c = 0; c < 8; ++c) { const v4u w = ((const v4u*)kp)[c];
                const float d = q[c * 8 + 0] * bflo(w.x) + q[c * 8 + 1] * bfhi(w.x) + q[c * 8 + 2] * bflo(w.y) + q[c * 8 + 3] * bfhi(w.y) + q[c * 8 + 4] * bflo(w.z) + q[c * 8 + 5] * bfhi(w.z) + q[c * 8 + 6] * bflo(w.w) + q[c * 8 + 7] * bfhi(w.w);
                if (c < 4) s1 += d; else s2 += d; }
            const float p1 = __builtin_amdgcn_exp2f(s1 - m1), p2 = __builtin_amdgcn_exp2f(s2 - m2); l1 += p1; l2 += p2;
            const bf16* vp = cached ? cvp + (size_t)(kb * 64) * 64 + lane : Z + (size_t)(seq0 + kb * 64 - (lat ? 256 : 0)) * DIN + 512 + hd * 64 + lane;
            const int vstride = cached ? 64 : DIN;
#pragma unroll 8
            for (int j = 0; j < 64; ++j) { const float v = bf2f(vp[(size_t)j * vstride]); o1 += __shfl(p1, j) * v; o2 += __shfl(p2, j) * v; }
        }
        l1 = wave_sum(l1); l2 = wave_sum(l2);
        const float o = o1 / l1 - lam * (o2 / l2);
        const float ss = wave_sum(o * o);
        Y[(size_t)r * D + hd * 64 + lane] = (bf16)f2bf(o * (1.0f / sqrtf(ss * (1.0f / 64.0f) + EPS)) * sub);
    }
}
__device__ __forceinline__ void mix_conv_naive(Frame& F, const Args& A, int l) {
    PHASE_IDS(F);
    const bf16* Z = (const bf16*)(F.ws + WS_Z); bf16* Y = (bf16*)(F.ws + WS_Y); const float* cw = INP(A, I_CBW) + l * 3 * 256;
    const int gt = F.vcu * 512 + F.tid, NGT = F.G * 512;
    for (int i = gt; i < M * 256; i += NGT) {
        const int r = i >> 8, c = i & 255; const bool lat = r >= MC; const int T = lat ? 2048 : 256; const int t = lat ? ((r - MC) & 2047) : (r & 255);
        float acc = 0.f;
#pragma unroll
        for (int j = 0; j < 3; ++j) { const int tt = t + j - 1; if (tt >= 0 && tt < T) { const bf16* zp = Z + (size_t)(r + j - 1) * DIN; acc += cw[j * 256 + c] * bf2f(zp[1024 + c]) * bf2f(zp[1280 + c]); } }
        Y[(size_t)r * D + 256 + c] = (bf16)f2bf(bf2f(Z[(size_t)r * DIN + 768 + c]) * acc);
    }
}
__device__ __forceinline__ void mix_rglru_naive(Frame& F, const Args& A, int l) {
    PHASE_IDS(F);
    const bf16* Z = (const bf16*)(F.ws + WS_Z); bf16* Y = (bf16*)(F.ws + WS_Y); float* HF = (float*)(F.ws + WS_XN);
    const int gw = F.vcu * NWAVES + F.wave, NGW = F.G * NWAVES; const int lane = F.lane;
    for (int it = gw; it < 160; it += NGW) {
        const int s = it >> 2, n = it & 3; const bool lat = s >= 32; const int T = lat ? 2048 : 256; const int row0 = lat ? MC + (s - 32) * 2048 : s * 256;
        const int c = n * 64 + lane;
        float cw[4];
#pragma unroll
        for (int j = 0; j < 4; ++j) cw[j] = INP(A, I_CCW)[(l * 4 + j) * 256 + c];
        const float cb = INP(A, I_CCB)[l * 256 + c];
        for (int dir = 0; dir < 2; ++dir) {
            float Wr[64], Wi[64];
            const float* wr_ = INP(A, I_RGW) + ((size_t)(((l * 2 + dir) * 2 + 0) * 4 + n) * 64) * 64 + lane; const float* wi_ = INP(A, I_RGW) + ((size_t)(((l * 2 + dir) * 2 + 1) * 4 + n) * 64) * 64 + lane;
#pragma unroll
            for (int j = 0; j < 64; ++j) { Wr[j] = wr_[j * 64]; Wi[j] = wi_[j * 64]; }
            const float br = INP(A, I_RGB)[((l * 2 + dir) * 2 + 0) * 256 + c], bi = INP(A, I_RGB)[((l * 2 + dir) * 2 + 1) * 256 + c];
            const float lamv = INP(A, I_RGLAM)[(l * 2 + dir) * 256 + c]; const float sp = log1pf(expf(-lamv));
            float h = lat ? INP(A, I_ST)[(((s - 32) * 2 + l) * 2 + dir) * 256 + c] : 0.f;
            for (int step = 0; step < T; ++step) {
                const int t = dir ? T - 1 - step : step;
                float xc = cb;
#pragma unroll
                for (int j = 0; j < 4; ++j) { const int tt = t + j - 2; if (tt >= 0 && tt < T) xc += cw[j] * bf2f(Z[(size_t)(row0 + tt) * DIN + 1536 + c]); }
                float g0 = br, g1 = bi;
#pragma unroll
                for (int j = 0; j < 64; ++j) { const float xj = __shfl(xc, j); g0 += xj * Wr[j]; g1 += xj * Wi[j]; }
                const float rr = 1.0f / (1.0f + expf(-g0)), ii = 1.0f / (1.0f + expf(-g1));
                const float la = -8.0f * rr * sp; const float a = expf(la); const float bb = sqrtf(-expm1f(2.0f * la)) * ii * xc;
                h = a * h + bb;
                const size_t hidx = (size_t)(row0 + t) * 256 + c;
                if (dir == 0) HF[hidx] = h;
                else { const float hf = HF[hidx]; const float gr = bf2f(Z[(size_t)(row0 + t) * DIN + 1792 + c]); Y[(size_t)(row0 + t) * D + 512 + c] = (bf16)f2bf((hf + h) * gelu_tanh(gr)); }
            }
            if (!lat) F.out[OUT_ST + (size_t)((s * 2 + l) * 2 + dir) * 256 + c] = h;
        }
    }
}
__device__ __forceinline__ void mix_pool_naive(Frame& F, const Args& A, int l) {
    PHASE_IDS(F);
    const bf16* Z = (const bf16*)(F.ws + WS_Z); bf16* Y = (bf16*)(F.ws + WS_Y);
    const int gw = F.vcu * NWAVES + F.wave, NGW = F.G * NWAVES; const int lane = F.lane;
    for (int it = gw; it < M * 4; it += NGW) {
        const int r = it >> 2, g = it & 3; const bool lat = r >= MC; const int T = lat ? 2048 : 256; const int t = lat ? ((r - MC) & 2047) : (r & 255);
        const int win = 2 << g, left = win >> 1, right = win - 1 - left; const int lo = max(t - left, 0), hi = min(t + right, T - 1);
        const bf16* zc = Z + (size_t)(r - t) * DIN + 2048 + g * 64 + lane;
        float s = 0.f; for (int tt = lo; tt <= hi; ++tt) s += bf2f(zc[(size_t)tt * DIN]);
        const float p = s / (float)(hi - lo + 1) - bf2f(zc[(size_t)t * DIN]);
        const float* pw = INP(A, I_POOLW) + (size_t)(l * 4 + g) * 4096 + lane; float acc = 0.f;
#pragma unroll 8
        for (int j = 0; j < 64; ++j) acc += __shfl(p, j) * pw[j * 64];
        Y[(size_t)r * D + 768 + g * 64 + lane] = (bf16)f2bf(acc * INP(A, I_POOLS)[l * 256 + g * 64 + lane]);
    }
}

constexpr int PH_PER_LAYER = 9, NPHASE = 1 + 2 * PH_PER_LAYER + 1;
__global__ void __launch_bounds__(NWAVES * 64, 2) fwd_kernel(Args args) {
    extern __shared__ __attribute__((aligned(16))) unsigned char lds[];
    Frame F;
    F.lds = (LAS unsigned char*)lds; F.tid = threadIdx.x; F.lane = F.tid & 63; F.wave = __builtin_amdgcn_readfirstlane(F.tid >> 6);
    F.G = gridDim.x; { const int bx = blockIdx.x; F.vcu = (F.G % 8 == 0) ? (bx % 8) * (F.G / 8) + bx / 8 : bx; }
    F.out = args.out; F.ws = args.ws;
    volatile LAS unsigned* MISC = (volatile LAS unsigned*)(F.lds + MISC_OFF);
    for (int u = F.tid; u < (LDS_BYTES - LDSCTL_OFF) / 4; u += NWAVES * 64) ((LAS unsigned*)(F.lds + LDSCTL_OFF))[u] = 0u;
    __syncthreads();
    XcdBarrier bar; bar.bar = (unsigned*)(args.ws + WS_CTL) + CW_BAR; bar.x = 0; bar.st = nullptr;
#if !MK_PER_PHASE
    bar = xcd_barrier_post((unsigned*)(args.ws + WS_CTL) + CW_BAR, MISC + 8);
#endif
    const int lo = args.ph_lo, hi = args.ph_hi;
#define IN(k) (lo <= (k) && (k) < hi)
#define SEAM(k) do { if (IN(k) && IN((k) + 1)) xcd_barrier(bar); } while (0)
    float* mod = (float*)(args.ws + WS_MOD);
    bf16* XN = (bf16*)(args.ws + WS_XN); bf16* Yb = (bf16*)(args.ws + WS_Y); bf16* Zb = (bf16*)(args.ws + WS_Z);

    if (IN(0)) { p0_prologue(F, args); } SEAM(0);

    for (int l = 0; l < 2; ++l) {
        const int pb = 1 + l * PH_PER_LAYER;
        const float* modl = mod + (size_t)l * 9 * 6144;
        const float* xin_c = l == 0 ? INP(args, I_XP) : F.out; const float* xin_l = l == 0 ? INP(args, I_XS) - (size_t)MC * D : F.out;
        if (IN(pb + 0)) { norm_mod_phase(F, xin_c, xin_l, INP(args, I_NORMW) + (size_t)(l * 2 + 0) * D, modl, 0, 1024); } SEAM(pb + 0);
        if (IN(pb + 1)) {
            pg8::Gemm g{XN, (const bf16*)(args.ws + WS_WIN) + (size_t)l * DIN * D, M, DIN, D}; pg8::StaticOrder S; S.init(M, DIN, F.G, (int)blockIdx.x);
            pg8::EpiIn E{Zb, (const float*)(args.ws + WS_ROPE), F.out + OUT_CK, F.out + OUT_CV, l};
            pg8::gemm_phase<pg8::EpiIn, pg8::StaticOrder, true, true>(F.lds, g, S, E);
        } SEAM(pb + 1);
        if (IN(pb + 2)) { mix_rglru_naive(F, args, l); mix_attn_naive(F, args, l); mix_conv_naive(F, args, l); mix_pool_naive(F, args, l); } SEAM(pb + 2);
        if (IN(pb + 3)) {
            pg8::Gemm g{Yb, (const bf16*)(args.ws + WS_WOUT) + (size_t)l * D * D, M, D, D}; pg8::StaticOrder S; S.init(M, D, F.G, (int)blockIdx.x);
            pg8::EpiGateRes E{xin_c, xin_l, F.out, modl + 2048, 0};
            pg8::gemm_phase<pg8::EpiGateRes, pg8::StaticOrder, true, true>(F.lds, g, S, E);
        } SEAM(pb + 3);
        if (IN(pb + 4)) { norm_mod_phase(F, F.out, F.out, INP(args, I_NORMW) + (size_t)(l * 2 + 1) * D, modl, 3072, 4096); } SEAM(pb + 4);
        for (int hf = 0; hf < 2; ++hf) {
            if (IN(pb + 5 + 2 * hf)) {
                pg8::Gemm g{XN + (size_t)hf * MH * D, (const bf16*)(args.ws + WS_W1) + (size_t)l * DFF * D, MH, DFF, D}; pg8::StaticOrder S; S.init(MH, DFF, F.G, (int)blockIdx.x);
                pg8::EpiRelu2 E{Zb};
                pg8::gemm_phase<pg8::EpiRelu2, pg8::StaticOrder, true, true>(F.lds, g, S, E);
            } SEAM(pb + 5 + 2 * hf);
            if (IN(pb + 6 + 2 * hf)) {
                pg8::Gemm g{Zb, (const bf16*)(args.ws + WS_W2) + (size_t)l * D * DFF, MH, D, DFF}; pg8::StaticOrder S; S.init(MH, D, F.G, (int)blockIdx.x);
                pg8::EpiGateRes E{F.out, F.out, F.out, modl + 5120, hf * MH};
                pg8::gemm_phase<pg8::EpiGateRes, pg8::StaticOrder, true, true>(F.lds, g, S, E);
            } SEAM(pb + 6 + 2 * hf);
        }
    }
    if (IN(NPHASE - 1)) { final_norm_phase(F, args); }
#undef IN
#undef SEAM
}

extern "C" void kernel_launch(void* const* d_in, const int* in_sizes, int n_in, void* d_out, int out_size, void* d_ws, size_t ws_size, hipStream_t stream) {
    static int grid = 0;
    if (grid == 0) {
        if (n_in != 25 || out_size != (int)(OUT_ST + 32 * 2 * 2 * 256) || ws_size < WS_END) { fprintf(stderr, "kernel_launch: unexpected shapes (n_in %d out %d ws %zu)\n", n_in, out_size, ws_size); grid = -1; return; }
        int dev = 0, cus = 0;
        if (hipGetDevice(&dev) != hipSuccess || hipDeviceGetAttribute(&cus, hipDeviceAttributeMultiprocessorCount, dev) != hipSuccess) { grid = -1; return; }
        if (hipFuncSetAttribute((const void*)fwd_kernel, hipFuncAttributeMaxDynamicSharedMemorySize, LDS_BYTES) != hipSuccess) { fprintf(stderr, "kernel_launch: hipFuncSetAttribute failed\n"); grid = -1; return; }
        int per_cu = 0;
        if (hipOccupancyMaxActiveBlocksPerMultiprocessor(&per_cu, (const void*)fwd_kernel, NWAVES * 64, LDS_BYTES) != hipSuccess || per_cu < 1) fprintf(stderr, "kernel_launch: occupancy query says %d\n", per_cu);
        (void)hipGetLastError();
        grid = cus;
    }
    if (grid < 0) return;
    (void)hipMemsetAsync((char*)d_ws + WS_CTL, 0, CTL_ZERO_BYTES, stream);
    Args a{};
    for (int i = 0; i < 25; ++i) a.in[i] = (const float*)d_in[i];
    a.out = (float*)d_out; a.ws = (unsigned char*)d_ws;
#if MK_PER_PHASE
    for (int p = 0; p < NPHASE; ++p) { a.ph_lo = p; a.ph_hi = p + 1; hipLaunchKernelGGL(fwd_kernel, dim3(grid), dim3(NWAVES * 64), LDS_BYTES, stream, a); }
#else
    a.ph_lo = 0; a.ph_hi = NPHASE; hipLaunchKernelGGL(fwd_kernel, dim3(grid), dim3(NWAVES * 64), LDS_BYTES, stream, a);
#endif
}
```

```cpp
#include <hip/hip_runtime.h>
#include <cstdio>
#include <cstdint>

#ifndef MK_PER_PHASE
#define MK_PER_PHASE 0
#endif

namespace pg8 {
#define PG8_LAS __attribute__((address_space(3)))
typedef unsigned short bf16_t;
typedef short bf16x8 __attribute__((ext_vector_type(8)));
typedef float f32x4 __attribute__((ext_vector_type(4)));
typedef unsigned u32x4 __attribute__((ext_vector_type(4)));
constexpr int BM = 256, BK = 64, HALF = 128, HTB = HALF * BK * 2, STAGE_BYTES = 8 * HTB, NXCD = 8, WGM = 8;

__host__ __device__ __forceinline__ int lds_byte(int r, int c) { const int st = (r >> 4) * 2 + (c >> 5), rr = r & 15, cc = c & 31, ob = rr * 64 + cc * 2; return st * 1024 + (ob ^ (((ob >> 9) & 1) << 5)); }
__host__ __device__ __forceinline__ void stage_rc(int b, int& R, int& C) { const int st = b / 1024, sb = b % 1024, swz = sb ^ (((sb >> 9) & 1) << 5); R = (st >> 1) * 16 + swz / 64; C = (st & 1) * 32 + (swz % 64) / 2; }
__host__ __device__ __forceinline__ int perm32(int rho) { const int n = rho >> 4, i = rho & 15; return 8 * (i >> 2) + 4 * n + (i & 3); }

struct Unit { int pm, pn; };
struct Gemm { const bf16_t* A; const bf16_t* Bt; int M, N, K; };

struct StaticOrder {
    int nM, nN, nwg, G, c;
    __host__ __device__ void init(int M, int N, int G_, int c_) { nM = M / BM; nN = N / BM; nwg = nM * nN; G = G_; c = c_; }
    __host__ __device__ bool next(int i, Unit& u) const {
        const long L = (long)i * G + c; if (L >= nwg) return false;
        int wgid = (int)L; { const int q = nwg / NXCD, r = nwg % NXCD, xcd = wgid % NXCD, off = wgid / NXCD; wgid = (xcd < r ? xcd * (q + 1) : r * (q + 1) + (xcd - r) * q) + off; }
        const int nig = WGM * nN, gid = wgid / nig, fm = gid * WGM, gsz = (nM - fm) < WGM ? (nM - fm) : WGM;
        u.pm = fm + ((wgid % nig) % gsz); u.pn = (wgid % nig) / gsz; return true;
    }
    __device__ __forceinline__ void a_ready(const Unit&) const {}
    __device__ __forceinline__ void done(const Unit&) const {}
};

__device__ __forceinline__ unsigned cvt_pk_bf16(float lo, float hi) { unsigned r; asm volatile("v_cvt_pk_bf16_f32 %0, %1, %2" : "=v"(r) : "v"(lo), "v"(hi)); return r; }


struct EpiIn {
    static constexpr bool PERM = true, AFTER_DRAIN = false;
    bf16_t* Z; const float* rope; float* ck_out; float* cv_out; int layer;
    __device__ __forceinline__ void operator()(const f32x4 (&acc)[2][2][4][2], const Unit& u, int wr, int wc, int fr, int fq) const {
        const int pn = u.pn; const bool lat = u.pm >= 32; const bool dorope = lat && pn <= 1;
        const int row0 = u.pm * BM + wr * 64 + fr; const int colw = wc * 32 + 8 * fq;
        const float qs = (pn == 0) ? 0.25503486f : 1.0f;
#pragma unroll
        for (int ai = 0; ai < 2; ++ai)
#pragma unroll
            for (int m = 0; m < 4; ++m) {
                const int row = row0 + ai * HALF + m * 16;
                f32x4 cs[4];
                if (dorope) { const int t = (row - 8192) & 2047; const int pos = (fq >> 1) ? (t & 63) : (t >> 6); const f32x4* rp = (const f32x4*)(rope + pos * 16);
#pragma unroll
                    for (int e = 0; e < 4; ++e) cs[e] = rp[e]; }
#pragma unroll
                for (int bj = 0; bj < 2; ++bj) {
                    float v[8];
#pragma unroll
                    for (int e = 0; e < 4; ++e) { v[e] = acc[ai][bj][m][0][e]; v[4 + e] = acc[ai][bj][m][1][e]; }
                    if (dorope) {
#pragma unroll
                        for (int e = 0; e < 8; ++e) { const float pr = __shfl_xor(v[e], 16); const float c = cs[e >> 1][(e & 1) * 2], s = cs[e >> 1][(e & 1) * 2 + 1];
                            v[e] = (fq & 1) ? (v[e] * c + pr * s) : (v[e] * c - pr * s); }
                    }
                    if (!lat && (pn == 1 || pn == 2)) {
                        float* co = (pn == 1) ? ck_out : cv_out; const int b = row >> 8, t = row & 255; const int cc = bj * HALF + colw; const int hd = cc >> 6, d = cc & 63;
                        float* op = co + ((size_t)((b * 2 + layer) * 4 + hd) * 256 + t) * 64 + d;
                        *(f32x4*)op = (f32x4){v[0], v[1], v[2], v[3]}; *(f32x4*)(op + 4) = (f32x4){v[4], v[5], v[6], v[7]};
                    }
                    u32x4 w; w.x = cvt_pk_bf16(v[0] * qs, v[1] * qs); w.y = cvt_pk_bf16(v[2] * qs, v[3] * qs); w.z = cvt_pk_bf16(v[4] * qs, v[5] * qs); w.w = cvt_pk_bf16(v[6] * qs, v[7] * qs);
                    *(u32x4*)(Z + (size_t)row * 2304 + pn * BM + bj * HALF + colw) = w;
                }
            }
    }
};
struct EpiGateRes {
    static constexpr bool PERM = false, AFTER_DRAIN = false;
    const float* res_c; const float* res_l; float* out; const float* gate; int rowbase;
    __device__ __forceinline__ void operator()(const f32x4 (&acc)[2][2][4][2], const Unit& u, int wr, int wc, int fr, int fq) const {
        const int grow0 = rowbase + u.pm * BM; const int mi = grow0 < 8192 ? 0 : 1 + ((grow0 - 8192) >> 11);
        const float* res = grow0 < 8192 ? res_c : res_l;
        const int row0 = grow0 + wr * 64 + fr, col0 = u.pn * BM + wc * 32 + 4 * fq;
        f32x4 gv[2][2];
#pragma unroll
        for (int bj = 0; bj < 2; ++bj)
#pragma unroll
            for (int n = 0; n < 2; ++n) gv[bj][n] = *(const f32x4*)(gate + (size_t)mi * 6144 + col0 + bj * HALF + n * 16);
#pragma unroll
        for (int ai = 0; ai < 2; ++ai)
#pragma unroll
            for (int m = 0; m < 4; ++m) { const size_t off = (size_t)(row0 + ai * HALF + m * 16) * 1024 + col0;
#pragma unroll
                for (int bj = 0; bj < 2; ++bj)
#pragma unroll
                    for (int n = 0; n < 2; ++n) { const f32x4 r = *(const f32x4*)(res + off + bj * HALF + n * 16); *(f32x4*)(out + off + bj * HALF + n * 16) = r + gv[bj][n] * acc[ai][bj][m][n]; } }
    }
};
struct EpiRelu2 {
    static constexpr bool PERM = true, AFTER_DRAIN = false;
    bf16_t* H;
    __device__ __forceinline__ void operator()(const f32x4 (&acc)[2][2][4][2], const Unit& u, int wr, int wc, int fr, int fq) const {
        const int row0 = u.pm * BM + wr * 64 + fr; const int col0 = u.pn * BM + wc * 32 + 8 * fq;
#pragma unroll
        for (int ai = 0; ai < 2; ++ai)
#pragma unroll
            for (int m = 0; m < 4; ++m) { bf16_t* rowp = H + (size_t)(row0 + ai * HALF + m * 16) * 4096 + col0;
#pragma unroll
                for (int bj = 0; bj < 2; ++bj) { f32x4 v0 = acc[ai][bj][m][0], v1 = acc[ai][bj][m][1];
#pragma unroll
                    for (int e = 0; e < 4; ++e) { const float a = fmaxf(v0[e], 0.f), b = fmaxf(v1[e], 0.f); v0[e] = a * a; v1[e] = b * b; }
                    u32x4 w; w.x = cvt_pk_bf16(v0[0], v0[1]); w.y = cvt_pk_bf16(v0[2], v0[3]); w.z = cvt_pk_bf16(v1[0], v1[1]); w.w = cvt_pk_bf16(v1[2], v1[3]);
                    *(u32x4*)(rowp + bj * HALF) = w; } }
    }
};

template <class Epi, class Sched, bool ALIGN_EPI = false, bool SP2 = false>
__device__ __forceinline__ void gemm_phase(PG8_LAS unsigned char* lds, const Gemm g, const Sched& S, const Epi& E) {
    int tid = threadIdx.x; asm volatile("" : "+v"(tid));
    const int wid = __builtin_amdgcn_readfirstlane(tid >> 6), lane = tid & 63, wr = wid >> 2, wc = wid & 3, fr = lane & 15, fq = lane >> 4;
    const int K = g.K, nt = K / BK;
    unsigned voffA[2], voffB[2];
#pragma unroll
    for (int i = 0; i < 2; ++i) { int R, C; stage_rc(tid * 16 + i * 8192, R, C); const int Rb = Epi::PERM ? ((R & ~31) + perm32(R & 31)) : R;
        voffA[i] = (unsigned)(R * K + C) * 2u; voffB[i] = (unsigned)(Rb * K + C) * 2u; }
    const size_t kstep = (size_t)(BK * 2);
    const size_t hstep = (size_t)HALF * K * 2;
    const size_t tstep = 2 * hstep;
    const unsigned ldsw = (unsigned)wid * 1024u;
    const int aoff = lds_byte(wr * 64 + fr, fq * 8), boff = lds_byte(wc * 32 + fr, fq * 8);
#define PG8_SA(b, h) (((b) * 2 + (h)) * HTB)
#define PG8_SB(b, h) ((4 + (b) * 2 + (h)) * HTB)
#define PG8_STAGE(bufoff, gbase, voff) do { _Pragma("unroll") for (int _i = 0; _i < 2; ++_i) \
        __builtin_amdgcn_global_load_lds((const unsigned*)((const char*)(gbase) + (voff)[_i]), (PG8_LAS unsigned*)(lds + (bufoff) + ldsw + _i * 8192), 16, 0, 0); } while (0)
#define PG8_LDA(dst, b, h) do { _Pragma("unroll") for (int m = 0; m < 4; ++m) _Pragma("unroll") for (int k = 0; k < 2; ++k) dst[m][k] = *(const PG8_LAS bf16x8*)(lds + PG8_SA(b, h) + aoff + m * 2048 + k * 1024); } while (0)
#define PG8_LDB(dst, b, h) do { _Pragma("unroll") for (int n = 0; n < 2; ++n) _Pragma("unroll") for (int k = 0; k < 2; ++k) dst[n][k] = *(const PG8_LAS bf16x8*)(lds + PG8_SB(b, h) + boff + n * 2048 + k * 1024); } while (0)
#define PG8_MMA(ai, bj, At, Bt) do { __builtin_amdgcn_s_setprio(1); _Pragma("unroll") for (int m = 0; m < 4; ++m) _Pragma("unroll") for (int n = 0; n < 2; ++n) _Pragma("unroll") for (int k = 0; k < 2; ++k) \
        acc[ai][bj][m][n] = __builtin_amdgcn_mfma_f32_16x16x32_bf16(Bt[n][k], At[m][k], acc[ai][bj][m][n], 0, 0, 0); __builtin_amdgcn_s_setprio(0); } while (0)
#define PG8_WAIT_V(n) asm volatile("s_waitcnt vmcnt(" #n ")" ::: "memory")
#define PG8_WAIT_L(n) asm volatile("s_waitcnt lgkmcnt(" #n ")" ::: "memory")
#define PG8_BAR __builtin_amdgcn_s_barrier()
#define PG8_SCHED __builtin_amdgcn_sched_barrier(0)
    Unit cur, nxt; int ui = 0;
    if (!S.next(0, cur)) return;
    f32x4 acc[2][2][4][2];
#pragma unroll
    for (int a = 0; a < 2; ++a)
#pragma unroll
        for (int b = 0; b < 2; ++b)
#pragma unroll
            for (int m = 0; m < 4; ++m)
#pragma unroll
                for (int n = 0; n < 2; ++n) acc[a][b][m][n] = (f32x4){0.f, 0.f, 0.f, 0.f};
    bf16x8 At[4][2], B0[2][2], B1[2][2];
    const char* cA = (const char*)g.A + (size_t)cur.pm * tstep; const char* cB = (const char*)g.Bt + (size_t)cur.pn * tstep;
    S.a_ready(cur);
    if constexpr (SP2) {
        PG8_STAGE(PG8_SB(0, 0), cB, voffB); PG8_STAGE(PG8_SB(0, 1), cB + hstep, voffB); PG8_STAGE(PG8_SA(0, 0), cA, voffA); PG8_STAGE(PG8_SA(0, 1), cA + hstep, voffA);
        if (wr == 1) PG8_BAR;
        PG8_WAIT_V(2); PG8_BAR;
        PG8_STAGE(PG8_SB(1, 0), cB + kstep, voffB); PG8_STAGE(PG8_SA(1, 0), cA + kstep, voffA); PG8_STAGE(PG8_SB(1, 1), cB + hstep + kstep, voffB);
        PG8_WAIT_V(6); PG8_BAR;
    } else {
        PG8_STAGE(PG8_SB(0, 0), cB, voffB); PG8_STAGE(PG8_SA(0, 0), cA, voffA); PG8_STAGE(PG8_SB(0, 1), cB + hstep, voffB); PG8_STAGE(PG8_SA(0, 1), cA + hstep, voffA);
        if (wr == 1) PG8_BAR;
        PG8_WAIT_V(4); PG8_BAR;
        PG8_STAGE(PG8_SB(1, 0), cB + kstep, voffB); PG8_STAGE(PG8_SA(1, 0), cA + kstep, voffA); PG8_STAGE(PG8_SB(1, 1), cB + hstep + kstep, voffB);
        PG8_WAIT_V(6); PG8_BAR;
    }
    for (;;) {
        const bool has_next = S.next(ui + 1, nxt);
        const char* nA = has_next ? (const char*)g.A + (size_t)nxt.pm * tstep : cA; const char* nB = has_next ? (const char*)g.Bt + (size_t)nxt.pn * tstep : cB;
        for (int t = 0; t < nt; t += 2) {
            const bool last = (t == nt - 2);
            const char* a1 = cA + (size_t)(t + 1) * kstep;
            const char* a2 = last ? nA : cA + (size_t)(t + 2) * kstep; const char* b2 = last ? nB : cB + (size_t)(t + 2) * kstep;
            const char* a3 = a2 + kstep; const char* b3 = b2 + kstep;
            if (last && has_next) S.a_ready(nxt);
            if constexpr (SP2) {
            PG8_LDB(B0, 0, 0); PG8_LDB(B1, 0, 1); PG8_SCHED; PG8_LDA(At, 0, 0); PG8_STAGE(PG8_SA(1, 1), a1 + hstep, voffA);
            PG8_WAIT_V(8); PG8_WAIT_L(0); PG8_BAR; PG8_MMA(0, 0, At, B0); PG8_MMA(0, 1, At, B1); PG8_BAR; PG8_SCHED;
            PG8_LDA(At, 0, 1); PG8_STAGE(PG8_SB(0, 0), b2, voffB); PG8_STAGE(PG8_SB(0, 1), b2 + hstep, voffB); PG8_STAGE(PG8_SA(0, 0), a2, voffA);
            PG8_WAIT_V(8); PG8_WAIT_L(0); PG8_BAR; PG8_MMA(1, 0, At, B0); PG8_MMA(1, 1, At, B1); PG8_BAR; PG8_SCHED;
            PG8_LDB(B0, 1, 0); PG8_LDB(B1, 1, 1); PG8_SCHED; PG8_LDA(At, 1, 0); PG8_STAGE(PG8_SA(0, 1), a2 + hstep, voffA);
            PG8_WAIT_V(8); PG8_WAIT_L(0); PG8_BAR; PG8_MMA(0, 0, At, B0); PG8_MMA(0, 1, At, B1); PG8_BAR; PG8_SCHED;
            PG8_LDA(At, 1, 1); PG8_STAGE(PG8_SB(1, 0), b3, voffB); PG8_STAGE(PG8_SB(1, 1), b3 + hstep, voffB); PG8_STAGE(PG8_SA(1, 0), a3, voffA);
            PG8_WAIT_V(8); PG8_WAIT_L(0); PG8_BAR; PG8_MMA(1, 0, At, B0); PG8_MMA(1, 1, At, B1); PG8_BAR; PG8_SCHED;
            } else {
            PG8_LDB(B0, 0, 0); PG8_SCHED; PG8_LDA(At, 0, 0); PG8_STAGE(PG8_SA(1, 1), a1 + hstep, voffA);
            PG8_WAIT_L(8); PG8_BAR; PG8_WAIT_L(0); PG8_MMA(0, 0, At, B0); PG8_BAR; PG8_SCHED;
            PG8_LDB(B1, 0, 1); PG8_STAGE(PG8_SB(0, 0), b2, voffB);
            PG8_BAR; PG8_WAIT_L(0); PG8_MMA(0, 1, At, B1); PG8_BAR;
            PG8_LDA(At, 0, 1); PG8_STAGE(PG8_SA(0, 0), a2, voffA);
            PG8_BAR; PG8_WAIT_L(0); PG8_MMA(1, 0, At, B0); PG8_BAR; PG8_SCHED;
            PG8_STAGE(PG8_SB(0, 1), b2 + hstep, voffB);
            PG8_WAIT_V(6); PG8_BAR; PG8_MMA(1, 1, At, B1); PG8_BAR;
            PG8_LDB(B0, 1, 0); PG8_SCHED; PG8_LDA(At, 1, 0); PG8_STAGE(PG8_SA(0, 1), a2 + hstep, voffA);
            PG8_WAIT_L(8); PG8_BAR; PG8_WAIT_L(0); PG8_MMA(0, 0, At, B0); PG8_BAR; PG8_SCHED;
            PG8_LDB(B1, 1, 1); PG8_STAGE(PG8_SB(1, 0), b3, voffB);
            PG8_BAR; PG8_WAIT_L(0); PG8_MMA(0, 1, At, B1); PG8_BAR;
            PG8_LDA(At, 1, 1); PG8_STAGE(PG8_SA(1, 0), a3, voffA);
            PG8_BAR; PG8_WAIT_L(0); PG8_MMA(1, 0, At, B0); PG8_BAR; PG8_SCHED;
            PG8_STAGE(PG8_SB(1, 1), b3 + hstep, voffB);
            PG8_WAIT_V(6); PG8_BAR; PG8_MMA(1, 1, At, B1); PG8_BAR;
            }
        }
        if constexpr (ALIGN_EPI) { if (wr == 0) PG8_BAR; }
        if constexpr (!Epi::AFTER_DRAIN) { E(acc, cur, wr, wc, fr, fq); S.done(cur); }
        if (!has_next) break;
#pragma unroll
        for (int a = 0; a < 2; ++a)
#pragma unroll
            for (int b = 0; b < 2; ++b)
#pragma unroll
                for (int m = 0; m < 4; ++m)
#pragma unroll
                    for (int n = 0; n < 2; ++n) acc[a][b][m][n] = (f32x4){0.f, 0.f, 0.f, 0.f};
        cur = nxt; cA = nA; cB = nB; ++ui;
        if constexpr (ALIGN_EPI) { if (wr == 1) PG8_BAR; }
    }
    PG8_WAIT_V(0);
    if constexpr (!ALIGN_EPI) { if (wr == 0) PG8_BAR; }
    PG8_BAR;
#undef PG8_SA
#undef PG8_SB
#undef PG8_STAGE
#undef PG8_LDA
#undef PG8_LDB
#undef PG8_MMA
#undef PG8_WAIT_V
#undef PG8_WAIT_L
#undef PG8_BAR
#undef PG8_SCHED
}
}

constexpr int NWAVES = 8;
constexpr int D = 1024, MC = 8192, ML = 16384, M = MC + ML, DIN = 2304, DFF = 4096, DG = 256, MH = M / 2;
constexpr float EPS = 1e-6f;
constexpr size_t MiB = 1u << 20;
constexpr size_t WS_CTL = 0, CTL_ZERO_BYTES = 1 * MiB;
constexpr size_t WS_MOD = 1 * MiB;
constexpr size_t WS_ROPE = WS_MOD + 2 * 9 * 6144 * 4;
constexpr size_t WS_LAM = WS_ROPE + 64 * 16 * 4;
constexpr size_t WS_RGWT = WS_LAM + 256;
constexpr size_t WS_POOLT = WS_RGWT + 32 * 4096 * 2;
constexpr size_t WS_WIN = 2 * MiB;
constexpr size_t WS_WOUT = WS_WIN + 2ull * 2304 * 1024 * 2;
constexpr size_t WS_W1 = WS_WOUT + 2ull * 1024 * 1024 * 2;
constexpr size_t WS_W2 = WS_W1 + 2ull * 4096 * 1024 * 2;
constexpr size_t WS_CK = WS_W2 + 2ull * 4096 * 1024 * 2;
constexpr size_t WS_CV = WS_CK + 2 * MiB;
constexpr size_t WS_XN = 52 * MiB;
constexpr size_t WS_Y = 100 * MiB;
constexpr size_t WS_Z = 148 * MiB;
constexpr size_t WS_END = 256 * MiB;
static_assert(WS_POOLT + 8 * 4096 * 2 <= WS_WIN && WS_CV + 2 * MiB <= WS_XN && WS_Z + (size_t)M * DIN * 2 <= WS_END, "d_ws map");
constexpr int CW_BAR = 4096;
constexpr size_t OUT_Y = 0, OUT_CK = (size_t)M * D, OUT_CV = OUT_CK + 32ull * 2 * 4 * 256 * 64, OUT_ST = OUT_CV + 32ull * 2 * 4 * 256 * 64;
constexpr int RING_BYTES = 131072, LDSCTL_OFF = RING_BYTES, MISC_OFF = LDSCTL_OFF + 320, LDS_BYTES = 147456;

#define GAS __attribute__((address_space(1)))
#define LAS __attribute__((address_space(3)))
typedef unsigned short bf16;
typedef unsigned v4u __attribute__((ext_vector_type(4)));
typedef unsigned v2u __attribute__((ext_vector_type(2)));
typedef float f32x4 __attribute__((ext_vector_type(4)));
typedef GAS unsigned gu32;
#define RLX_AGENT __ATOMIC_RELAXED, __HIP_MEMORY_SCOPE_AGENT
#define LDS_WAIT() asm volatile("s_waitcnt lgkmcnt(0)" ::: "memory")
__device__ __forceinline__ unsigned f2bf(float f) { unsigned u = __builtin_bit_cast(unsigned, f); return (u + 0x7fffu + ((u >> 16) & 1u)) >> 16; }
__device__ __forceinline__ unsigned pk2(float lo, float hi) { return f2bf(lo) | (f2bf(hi) << 16); }
__device__ __forceinline__ float bf2f(unsigned h) { return __uint_as_float(h << 16); }
__device__ __forceinline__ float bflo(unsigned w) { return __uint_as_float(w << 16); }
__device__ __forceinline__ float bfhi(unsigned w) { return __uint_as_float(w & 0xffff0000u); }

#define XB_TMO      128
#define XB_XCNT(j)  (256  + 64 * (j))
#define XB_XSUB(j)  (1280 + 64 * (j))
#define XB_XGEN(j)  (2304 + 64 * (j))
#define XB_TOP      3328
#define XB_TOPGEN   3392
#define XCD_BAR_WORDS 3456
#define XB_SPIN_CAP (1u << 18)
__device__ __forceinline__ unsigned xb_ld(unsigned* p)              { return __hip_atomic_load(p, __ATOMIC_RELAXED, __HIP_MEMORY_SCOPE_AGENT); }
__device__ __forceinline__ unsigned xb_add(unsigned* p, unsigned v) { return __hip_atomic_fetch_add(p, v, __ATOMIC_RELAXED, __HIP_MEMORY_SCOPE_AGENT); }
__device__ __forceinline__ unsigned xb_xcc_id() { return (unsigned)__builtin_amdgcn_s_getreg((3 << 11) | 20) & 0xFu; }
#define XB_SPIN(cond, bar) do { unsigned _sp = 0; while (cond) { __builtin_amdgcn_s_sleep(1); \
    if ((++_sp & 255u) == 0u) { if (xb_ld(&(bar)[XB_TMO])) break; if (_sp > XB_SPIN_CAP) { atomicAdd(&(bar)[XB_TMO], 1u); break; } } } } while (0)
struct XcdBarrier { unsigned* bar; unsigned x; volatile LAS unsigned* st; };
__device__ __forceinline__ XcdBarrier xcd_barrier_post(unsigned* bar, volatile LAS unsigned* st) {
    XcdBarrier b; b.bar = bar; b.x = xb_xcc_id(); b.st = st;
    if (threadIdx.x == 0) (void)xb_add(&bar[XB_XCNT(b.x)], 1u);
    return b;
}
__device__ __forceinline__ void xcd_barrier_complete(unsigned* bar, unsigned x, unsigned& nloc, unsigned& nx) {
    const unsigned G = gridDim.x * gridDim.y * gridDim.z;
    unsigned sum, cnt, mine, sp = 0u;
    for (;;) {
        sum = 0u; cnt = 0u; mine = 0u;
#pragma unroll
        for (unsigned j = 0; j < 16; ++j) { const unsigned c = xb_ld(&bar[XB_XCNT(j)]); sum += c; cnt += (c > 0u) ? 1u : 0u; mine = (j == x) ? c : mine; }
        if (sum == G) break;
        __builtin_amdgcn_s_sleep(1);
        if ((++sp & 255u) == 0u) { if (xb_ld(&bar[XB_TMO])) break; if (sp > XB_SPIN_CAP) { atomicAdd(&bar[XB_TMO], 1u); break; } }
    }
    nloc = mine > 0u ? mine : 1u; nx = cnt > 0u ? cnt : 1u;
}
__device__ __forceinline__ void xcd_barrier(const XcdBarrier& b) {
    asm volatile("s_waitcnt vmcnt(0)" ::: "memory");
    __syncthreads();
    if (threadIdx.x == 0) {
        unsigned* bar = b.bar;
        __builtin_amdgcn_s_waitcnt(0);
        unsigned nloc = b.st[0], nx = b.st[1];
        if (nloc == 0u) { xcd_barrier_complete(bar, b.x, nloc, nx); b.st[0] = nloc; b.st[1] = nx; }
        const unsigned old = xb_add(&bar[XB_XSUB(b.x)], 1u);
        const unsigned gen = old / nloc;
        if (old + 1u == (gen + 1u) * nloc) {
            __builtin_amdgcn_fence(__ATOMIC_RELEASE, "agent");
            asm volatile("s_waitcnt vmcnt(0)" ::: "memory");
            const unsigned og = xb_add(&bar[XB_TOP], 1u);
            const unsigned tg = og / nx;
            if (og + 1u == (tg + 1u) * nx) xb_add(&bar[XB_TOPGEN], 1u);
            else XB_SPIN(xb_ld(&bar[XB_TOPGEN]) == tg, bar);
            __builtin_amdgcn_fence(__ATOMIC_ACQUIRE, "agent");
            xb_add(&bar[XB_XGEN(b.x)], 1u);
            asm volatile("s_waitcnt vmcnt(0)" ::: "memory");
        } else {
            XB_SPIN(xb_ld(&bar[XB_XGEN(b.x)]) == gen, bar);
            __builtin_amdgcn_fence(__ATOMIC_ACQUIRE, "agent");
            asm volatile("s_waitcnt vmcnt(0)" ::: "memory");
        }
    }
    __syncthreads();
}

struct Args { const float* in[25]; float* out; unsigned char* ws; int ph_lo, ph_hi; };
#define INP(A_, i) ((A_).in[i])
struct Frame {
    LAS unsigned char* lds; int tid, lane, wave, vcu, G;
    float* out; unsigned char* ws;
};
#define PHASE_IDS(F) do { int t_ = threadIdx.x; asm volatile("" : "+v"(t_)); (F).tid = t_; (F).lane = t_ & 63; (F).wave = __builtin_amdgcn_readfirstlane(t_ >> 6); } while (0)
enum { I_XP = 0, I_XS, I_CK, I_CV, I_ST, I_C, I_CCTX, I_WADA, I_BADA, I_NORMW, I_WIN, I_DLAM, I_SUBLN, I_CBW, I_CCW, I_CCB, I_RGW, I_RGB, I_RGLAM, I_POOLW, I_POOLS, I_WOUT, I_W1, I_W2, I_FNW };

__device__ __forceinline__ float wave_sum(float v) {
#pragma unroll
    for (int o = 1; o < 64; o <<= 1) v += __shfl_xor(v, o);
    return v;
}
__device__ __forceinline__ float wave_max(float v) {
#pragma unroll
    for (int o = 1; o < 64; o <<= 1) v = fmaxf(v, __shfl_xor(v, o));
    return v;
}
__device__ __forceinline__ float gelu_tanh(float x) { const float u = 0.7978845608028654f * (x + 0.044715f * x * x * x); return 0.5f * x * (1.0f + tanhf(u)); }

__device__ __forceinline__ void p0_transpose_item(const float* W, int K, int N, bf16* WT, LAS float* scr, int item, int lane) {
    const int nblk = N / 32, kb = item / nblk, nb = item % nblk, k0 = 64 * kb, n0 = 32 * nb;
#pragma unroll 8
    for (int i = 0; i < 32; ++i) { const int kk = 2 * i + (lane >> 5); scr[kk * 33 + (lane & 31)] = W[(size_t)(k0 + kk) * N + n0 + (lane & 31)]; }
    LDS_WAIT(); asm volatile("" ::: "memory");
    const int c = lane & 7;
#pragma unroll
    for (int j = 0; j < 4; ++j) { const int n = (lane >> 3) + 8 * j; const LAS float* s = scr + (8 * c) * 33 + n;
        v4u o; o.x = pk2(s[0 * 33], s[1 * 33]); o.y = pk2(s[2 * 33], s[3 * 33]); o.z = pk2(s[4 * 33], s[5 * 33]); o.w = pk2(s[6 * 33], s[7 * 33]);
        *(GAS v4u*)(WT + (size_t)(n0 + n) * K + k0 + 8 * c) = o; }
    LDS_WAIT(); asm volatile("" ::: "memory");
}
__device__ __forceinline__ void p0_mod_item(Frame& F, const Args& A, int item) {
    const int l = item / 48, n0 = (item % 48) * 128;
    LAS float* sv = (LAS float*)F.lds;
    LAS float* red = sv + 9 * 1024;
    const float* c = INP(A, I_C); const float* cctx = INP(A, I_CCTX);
    for (int i = F.tid; i < 9 * 1024; i += 512) { const int mi = i >> 10, k = i & 1023; const float v = mi == 0 ? cctx[k] : c[(mi - 1) * 1024 + k]; sv[i] = v / (1.0f + expf(-v)); }
    __syncthreads();
    const int cg = F.tid & 31, rg = F.tid >> 5;
    float acc[9][4];
#pragma unroll
    for (int a = 0; a < 9; ++a)
#pragma unroll
        for (int j = 0; j < 4; ++j) acc[a][j] = 0.f;
    const float* wp = INP(A, I_WADA) + (size_t)l * 1024 * 6144 + n0 + cg * 4;
#pragma unroll 4
    for (int i = 0; i < 64; ++i) { const int k = rg + 16 * i; const f32x4 w = *(const f32x4*)(wp + (size_t)k * 6144);
#pragma unroll
        for (int a = 0; a < 9; ++a) { const float s = sv[a * 1024 + k];
#pragma unroll
            for (int j = 0; j < 4; ++j) acc[a][j] += s * w[j]; } }
#pragma unroll
    for (int a = 0; a < 9; ++a)
#pragma unroll
        for (int j = 0; j < 4; ++j) red[(rg * 9 + a) * 128 + cg * 4 + j] = acc[a][j];
    __syncthreads();
    float* mod = (float*)(F.ws + WS_MOD);
    for (int o = F.tid; o < 9 * 128; o += 512) { const int mi = o >> 7, n = o & 127; float s = INP(A, I_BADA)[l * 6144 + n0 + n];
        for (int r = 0; r < 16; ++r) s += red[(r * 9 + mi) * 128 + n];
        mod[(size_t)(l * 9 + mi) * 6144 + n0 + n] = s; }
    __syncthreads();
}
__device__ __forceinline__ void sincos_d(double a, float& co, float& si) {
    const double TWO_PI = 6.283185307179586476925286766559;
    const double n = (double)(long long)(a / TWO_PI + 0.5);
    const double r = a - n * TWO_PI;
    const double r2 = r * r; double ts = r, tc = 1.0, ss = r, sc = 1.0;
    for (int k = 1; k <= 14; ++k) { tc = -tc * r2 / (double)((2 * k - 1) * (2 * k)); sc += tc; ts = -ts * r2 / (double)((2 * k) * (2 * k + 1)); ss += ts; }
    co = (float)sc; si = (float)ss;
}
__device__ __forceinline__ void p0_prologue(Frame& F, const Args& A) {
    PHASE_IDS(F);
    if (blockIdx.x < 96) p0_mod_item(F, A, blockIdx.x);
    LAS float* scr = (LAS float*)(F.lds + F.wave * 16384);
    const int gw = F.vcu * NWAVES + F.wave, NGW = F.G * NWAVES;
    constexpr int I_IN = 16 * 72, I_OUT = 16 * 32, I_1 = 16 * 128, I_2 = 64 * 32, I_L = I_IN + I_OUT + I_1 + I_2, I_RG = 32 * 2, I_PW = 8 * 2;
    constexpr int NITEMS = 2 * I_L + I_RG + I_PW;
    for (int it = gw; it < NITEMS; it += NGW) {
        int r = it;
        if (r < 2 * I_L) { const int l = r / I_L; r -= l * I_L;
            if (r < I_IN) { p0_transpose_item(INP(A, I_WIN) + (size_t)l * 1024 * 2304, 1024, 2304, (bf16*)(F.ws + WS_WIN) + (size_t)l * 2304 * 1024, scr, r, F.lane); continue; } r -= I_IN;
            if (r < I_OUT) { p0_transpose_item(INP(A, I_WOUT) + (size_t)l * 1024 * 1024, 1024, 1024, (bf16*)(F.ws + WS_WOUT) + (size_t)l * 1024 * 1024, scr, r, F.lane); continue; } r -= I_OUT;
            if (r < I_1) { p0_transpose_item(INP(A, I_W1) + (size_t)l * 1024 * 4096, 1024, 4096, (bf16*)(F.ws + WS_W1) + (size_t)l * 4096 * 1024, scr, r, F.lane); continue; } r -= I_1;
            p0_transpose_item(INP(A, I_W2) + (size_t)l * 4096 * 1024, 4096, 1024, (bf16*)(F.ws + WS_W2) + (size_t)l * 1024 * 4096, scr, r, F.lane); continue; }
        r -= 2 * I_L;
        if (r < I_RG) { const int mi = r >> 1; p0_transpose_item(INP(A, I_RGW) + (size_t)mi * 4096, 64, 64, (bf16*)(F.ws + WS_RGWT) + (size_t)mi * 4096, scr, r & 1, F.lane); continue; } r -= I_RG;
        { const int mi = r >> 1; p0_transpose_item(INP(A, I_POOLW) + (size_t)mi * 4096, 64, 64, (bf16*)(F.ws + WS_POOLT) + (size_t)mi * 4096, scr, r & 1, F.lane); }
    }
    { const int gt = F.vcu * 512 + F.tid, NGT = F.G * 512;
      for (int i = gt; i < 2 * 262144; i += NGT) { const int which = i >= 262144; const int j = which ? i - 262144 : i;
          const float* srcp = which ? INP(A, I_CV) : INP(A, I_CK); const f32x4 v = *(const f32x4*)(srcp + (size_t)j * 4); v2u o; o.x = pk2(v[0], v[1]); o.y = pk2(v[2], v[3]);
          *(GAS v2u*)((bf16*)(F.ws + (which ? WS_CV : WS_CK)) + (size_t)j * 4) = o; } }
    if (blockIdx.x == 100 % F.G) {
        const double fr[8] = {1.0, 0.31622776601683794, 0.1, 0.031622776601683794, 0.01, 0.0031622776601683794, 0.001, 0.00031622776601683794};
        float* rope = (float*)(F.ws + WS_ROPE);
        { const int pos = F.tid >> 3, j = F.tid & 7; double f = fr[0];
#pragma unroll
          for (int q = 1; q < 8; ++q) f = (j == q) ? fr[q] : f;
          float co, si; sincos_d((double)pos * f, co, si); rope[pos * 16 + j * 2] = co; rope[pos * 16 + j * 2 + 1] = si; }
        if (F.tid < 2) { const int l = F.tid; const float* dl = INP(A, I_DLAM) + l * 128; float s1 = 0.f, s2 = 0.f;
            for (int i = 0; i < 32; ++i) { s1 += dl[i] * dl[32 + i]; s2 += dl[64 + i] * dl[96 + i]; }
            const float lam_init = 0.8f - 0.6f * expf(-0.3f * (float)l);
            ((float*)(F.ws + WS_LAM))[l] = expf(s1) - expf(s2) + lam_init; }
    }
}
__device__ __forceinline__ void norm_mod_phase(Frame& F, const float* src_c, const float* src_l, const float* nw, const float* modl, int shift_off, int scale_off) {
    PHASE_IDS(F);
    bf16* XN = (bf16*)(F.ws + WS_XN);
    const int gw = F.vcu * NWAVES + F.wave, NGW = F.G * NWAVES;
    for (int r = gw; r < M; r += NGW) {
        const float* xr = (r < MC ? src_c : src_l) + (size_t)r * D; const int mi = r < MC ? 0 : 1 + ((r - MC) >> 11);
        const float* mp = modl + (size_t)mi * 6144;
        f32x4 v[4]; float s = 0.f;
#pragma unroll
        for (int j = 0; j < 4; ++j) { v[j] = *(const f32x4*)(xr + 256 * j + 4 * F.lane); s += (v[j][0] * v[j][0] + v[j][1] * v[j][1]) + (v[j][2] * v[j][2] + v[j][3] * v[j][3]); }
        const float rstd = 1.0f / sqrtf(wave_sum(s) * (1.0f / D) + EPS);
#pragma unroll
        for (int j = 0; j < 4; ++j) { const int c = 256 * j + 4 * F.lane; const f32x4 w = *(const f32x4*)(nw + c), sc = *(const f32x4*)(mp + scale_off + c), sh = *(const f32x4*)(mp + shift_off + c);
            f32x4 o;
#pragma unroll
            for (int e = 0; e < 4; ++e) o[e] = v[j][e] * rstd * w[e] * (1.0f + sc[e]) + sh[e];
            v2u pk; pk.x = pk2(o[0], o[1]); pk.y = pk2(o[2], o[3]); *(GAS v2u*)(XN + (size_t)r * D + c) = pk; }
    }
}
__device__ __forceinline__ void final_norm_phase(Frame& F, const Args& A) {
    PHASE_IDS(F);
    const int gw = F.vcu * NWAVES + F.wave, NGW = F.G * NWAVES; const float* fw = INP(A, I_FNW);
    for (int r = gw; r < M; r += NGW) {
        float* xr = F.out + (size_t)r * D; f32x4 v[4]; float s = 0.f;
#pragma unroll
        for (int j = 0; j < 4; ++j) { v[j] = *(const f32x4*)(xr + 256 * j + 4 * F.lane); s += (v[j][0] * v[j][0] + v[j][1] * v[j][1]) + (v[j][2] * v[j][2] + v[j][3] * v[j][3]); }
        const float rstd = 1.0f / sqrtf(wave_sum(s) * (1.0f / D) + EPS);
#pragma unroll
        for (int j = 0; j < 4; ++j) { const int c = 256 * j + 4 * F.lane; const f32x4 w = *(const f32x4*)(fw + c); *(f32x4*)(xr + c) = v[j] * rstd * w; }
    }
}

__device__ __forceinline__ void mix_attn_naive(Frame& F, const Args& A, int l) {
    PHASE_IDS(F);
    const bf16* Z = (const bf16*)(F.ws + WS_Z); bf16* Y = (bf16*)(F.ws + WS_Y);
    const bf16* CK = (const bf16*)(F.ws + WS_CK); const bf16* CV = (const bf16*)(F.ws + WS_CV);
    const float lam = ((const float*)(F.ws + WS_LAM))[l]; const float lam_init = 0.8f - 0.6f * expf(-0.3f * (float)l);
    const float sub = INP(A, I_SUBLN)[l * 64 + F.lane] * (1.0f - lam_init);
    const int gw = F.vcu * NWAVES + F.wave, NGW = F.G * NWAVES; const int lane = F.lane;
    for (int it = gw; it < M * 4; it += NGW) {
        const int r = it >> 2, hd = it & 3; const bool lat = r >= MC;
        const int seq0 = lat ? MC + ((r - MC) & ~2047) : (r & ~255); const int nkb = lat ? 36 : 4; const int b = lat ? (r - MC) >> 11 : 0;
        const bf16* ckp = CK + (size_t)((b * 2 + l) * 4 + hd) * 256 * 64; const bf16* cvp = CV + (size_t)((b * 2 + l) * 4 + hd) * 256 * 64;
        float q[64];
        { const v4u* qp = (const v4u*)(Z + (size_t)r * DIN + hd * 64);
#pragma unroll
          for (int c = 0; c < 8; ++c) { const v4u w = qp[c]; q[c * 8 + 0] = bflo(w.x); q[c * 8 + 1] = bfhi(w.x); q[c * 8 + 2] = bflo(w.y); q[c * 8 + 3] = bfhi(w.y); q[c * 8 + 4] = bflo(w.z); q[c * 8 + 5] = bfhi(w.z); q[c * 8 + 6] = bflo(w.w); q[c * 8 + 7] = bfhi(w.w); } }
        float m1 = -1e30f, m2 = -1e30f;
        for (int kb = 0; kb < nkb; ++kb) {
            const bool cached = lat && kb < 4; const int key = kb * 64 + lane;
            const bf16* kp = cached ? ckp + (size_t)key * 64 : Z + (size_t)(seq0 + key - (lat ? 256 : 0)) * DIN + 256 + hd * 64;
            float s1 = 0.f, s2 = 0.f;
#pragma unroll
            for (int c = 0; c < 8; ++c) { const v4u w = ((const v4u*)kp)[c];
                const float d = q[c * 8 + 0] * bflo(w.x) + q[c * 8 + 1] * bfhi(w.x) + q[c * 8 + 2] * bflo(w.y) + q[c * 8 + 3] * bfhi(w.y) + q[c * 8 + 4] * bflo(w.z) + q[c * 8 + 5] * bfhi(w.z) + q[c * 8 + 6] * bflo(w.w) + q[c * 8 + 7] * bfhi(w.w);
                if (c < 4) s1 += d; else s2 += d; }
            m1 = fmaxf(m1, s1); m2 = fmaxf(m2, s2);
        }
        m1 = wave_max(m1); m2 = wave_max(m2);
        float l1 = 0.f, l2 = 0.f, o1 = 0.f, o2 = 0.f;
        for (int kb = 0; kb < nkb; ++kb) {
            const bool cached = lat && kb < 4; const int key = kb * 64 + lane;
            const bf16* kp = cached ? ckp + (size_t)key * 64 : Z + (size_t)(seq0 + key - (lat ? 256 : 0)) * DIN + 256 + hd * 64;
            float s1 = 0.f, s2 = 0.f;
#pragma unroll
            for (int c = 0; c < 8; ++c) { const v4u w = ((const v4u*)kp)[c];
                const float d = q[c * 8 + 0] * bflo(w.x) + q[c * 8 + 1] * bfhi(w.x) + q[c * 8 + 2] * bflo(w.y) + q[c * 8 + 3] * bfhi(w.y) + q[c * 8 + 4] * bflo(w.z) + q[c * 8 + 5] * bfhi(w.z) + q[c * 8 + 6] * bflo(w.w) + q[c * 8 + 7] * bfhi(w.w);
                if (c < 4) s1 += d; else s2 += d; }
            const float p1 = __builtin_amdgcn_exp2f(s1 - m1), p2 = __builtin_amdgcn_exp2f(s2 - m2); l1 += p1; l2 += p2;
            const bf16* vp = cached ? cvp + (size_t)(kb * 64) * 64 + lane : Z + (size_t)(seq0 + kb * 64 - (lat ? 256 : 0)) * DIN + 512 + hd * 64 + lane;
            const int vstride = cached ? 64 : DIN;
#pragma unroll 8
            for (int j = 0; j < 64; ++j) { const float v = bf2f(vp[(size_t)j * vstride]); o1 += __shfl(p1, j) * v; o2 += __shfl(p2, j) * v; }
        }
        l1 = wave_sum(l1); l2 = wave_sum(l2);
        const float o = o1 / l1 - lam * (o2 / l2);
        const float ss = wave_sum(o * o);
        Y[(size_t)r * D + hd * 64 + lane] = (bf16)f2bf(o * (1.0f / sqrtf(ss * (1.0f / 64.0f) + EPS)) * sub);
    }
}
__device__ __forceinline__ void mix_conv_naive(Frame& F, const Args& A, int l) {
    PHASE_IDS(F);
    const bf16* Z = (const bf16*)(F.ws + WS_Z); bf16* Y = (bf16*)(F.ws + WS_Y); const float* cw = INP(A, I_CBW) + l * 3 * 256;
    const int gt = F.vcu * 512 + F.tid, NGT = F.G * 512;
    for (int i = gt; i < M * 256; i += NGT) {
        const int r = i >> 8, c = i & 255; const bool lat = r >= MC; const int T = lat ? 2048 : 256; const int t = lat ? ((r - MC) & 2047) : (r & 255);
        float acc = 0.f;
#pragma unroll
        for (int j = 0; j < 3; ++j) { const int tt = t + j - 1; if (tt >= 0 && tt < T) { const bf16* zp = Z + (size_t)(r + j - 1) * DIN; acc += cw[j * 256 + c] * bf2f(zp[1024 + c]) * bf2f(zp[1280 + c]); } }
        Y[(size_t)r * D + 256 + c] = (bf16)f2bf(bf2f(Z[(size_t)r * DIN + 768 + c]) * acc);
    }
}
__device__ __forceinline__ void mix_rglru_naive(Frame& F, const Args& A, int l) {
    PHASE_IDS(F);
    const bf16* Z = (const bf16*)(F.ws + WS_Z); bf16* Y = (bf16*)(F.ws + WS_Y); float* HF = (float*)(F.ws + WS_XN);
    const int gw = F.vcu * NWAVES + F.wave, NGW = F.G * NWAVES; const int lane = F.lane;
    for (int it = gw; it < 160; it += NGW) {
        const int s = it >> 2, n = it & 3; const bool lat = s >= 32; const int T = lat ? 2048 : 256; const int row0 = lat ? MC + (s - 32) * 2048 : s * 256;
        const int c = n * 64 + lane;
        float cw[4];
#pragma unroll
        for (int j = 0; j < 4; ++j) cw[j] = INP(A, I_CCW)[(l * 4 + j) * 256 + c];
        const float cb = INP(A, I_CCB)[l * 256 + c];
        for (int dir = 0; dir < 2; ++dir) {
            float Wr[64], Wi[64];
            const float* wr_ = INP(A, I_RGW) + ((size_t)(((l * 2 + dir) * 2 + 0) * 4 + n) * 64) * 64 + lane; const float* wi_ = INP(A, I_RGW) + ((size_t)(((l * 2 + dir) * 2 + 1) * 4 + n) * 64) * 64 + lane;
#pragma unroll
            for (int j = 0; j < 64; ++j) { Wr[j] = wr_[j * 64]; Wi[j] = wi_[j * 64]; }
            const float br = INP(A, I_RGB)[((l * 2 + dir) * 2 + 0) * 256 + c], bi = INP(A, I_RGB)[((l * 2 + dir) * 2 + 1) * 256 + c];
            const float lamv = INP(A, I_RGLAM)[(l * 2 + dir) * 256 + c]; const float sp = log1pf(expf(-lamv));
            float h = lat ? INP(A, I_ST)[(((s - 32) * 2 + l) * 2 + dir) * 256 + c] : 0.f;
            for (int step = 0; step < T; ++step) {
                const int t = dir ? T - 1 - step : step;
                float xc = cb;
#pragma unroll
                for (int j = 0; j < 4; ++j) { const int tt = t + j - 2; if (tt >= 0 && tt < T) xc += cw[j] * bf2f(Z[(size_t)(row0 + tt) * DIN + 1536 + c]); }
                float g0 = br, g1 = bi;
#pragma unroll
                for (int j = 0; j < 64; ++j) { const float xj = __shfl(xc, j); g0 += xj * Wr[j]; g1 += xj * Wi[j]; }
                const float rr = 1.0f / (1.0f + expf(-g0)), ii = 1.0f / (1.0f + expf(-g1));
                const float la = -8.0f * rr * sp; const float a = expf(la); const float bb = sqrtf(-expm1f(2.0f * la)) * ii * xc;
                h = a * h + bb;
                const size_t hidx = (size_t)(row0 + t) * 256 + c;
                if (dir == 0) HF[hidx] = h;
                else { const float hf = HF[hidx]; const float gr = bf2f(Z[(size_t)(row0 + t) * DIN + 1792 + c]); Y[(size_t)(row0 + t) * D + 512 + c] = (bf16)f2bf((hf + h) * gelu_tanh(gr)); }
            }
            if (!lat) F.out[OUT_ST + (size_t)((s * 2 + l) * 2 + dir) * 256 + c] = h;
        }
    }
}
__device__ __forceinline__ void mix_pool_naive(Frame& F, const Args& A, int l) {
    PHASE_IDS(F);
    const bf16* Z = (const bf16*)(F.ws + WS_Z); bf16* Y = (bf16*)(F.ws + WS_Y);
    const int gw = F.vcu * NWAVES + F.wave, NGW = F.G * NWAVES; const int lane = F.lane;
    for (int it = gw; it < M * 4; it += NGW) {
        const int r = it >> 2, g = it & 3; const bool lat = r >= MC; const int T = lat ? 2048 : 256; const int t = lat ? ((r - MC) & 2047) : (r & 255);
        const int win = 2 << g, left = win >> 1, right = win - 1 - left; const int lo = max(t - left, 0), hi = min(t + right, T - 1);
        const bf16* zc = Z + (size_t)(r - t) * DIN + 2048 + g * 64 + lane;
        float s = 0.f; for (int tt = lo; tt <= hi; ++tt) s += bf2f(zc[(size_t)tt * DIN]);
        const float p = s / (float)(hi - lo + 1) - bf2f(zc[(size_t)t * DIN]);
        const float* pw = INP(A, I_POOLW) + (size_t)(l * 4 + g) * 4096 + lane; float acc = 0.f;
#pragma unroll 8
        for (int j = 0; j < 64; ++j) acc += __shfl(p, j) * pw[j * 64];
        Y[(size_t)r * D + 768 + g * 64 + lane] = (bf16)f2bf(acc * INP(A, I_POOLS)[l * 256 + g * 64 + lane]);
    }
}

constexpr int PH_PER_LAYER = 9, NPHASE = 1 + 2 * PH_PER_LAYER + 1;
__global__ void __launch_bounds__(NWAVES * 64, 2) fwd_kernel(Args args) {
    extern __shared__ __attribute__((aligned(16))) unsigned char lds[];
    Frame F;
    F.lds = (LAS unsigned char*)lds; F.tid = threadIdx.x; F.lane = F.tid & 63; F.wave = __builtin_amdgcn_readfirstlane(F.tid >> 6);
    F.G = gridDim.x; { const int bx = blockIdx.x; F.vcu = (F.G % 8 == 0) ? (bx % 8) * (F.G / 8) + bx / 8 : bx; }
    F.out = args.out; F.ws = args.ws;
    volatile LAS unsigned* MISC = (volatile LAS unsigned*)(F.lds + MISC_OFF);
    for (int u = F.tid; u < (LDS_BYTES - LDSCTL_OFF) / 4; u += NWAVES * 64) ((LAS unsigned*)(F.lds + LDSCTL_OFF))[u] = 0u;
    __syncthreads();
    XcdBarrier bar; bar.bar = (unsigned*)(args.ws + WS_CTL) + CW_BAR; bar.x = 0; bar.st = nullptr;
#if !MK_PER_PHASE
    bar = xcd_barrier_post((unsigned*)(args.ws + WS_CTL) + CW_BAR, MISC + 8);
#endif
    const int lo = args.ph_lo, hi = args.ph_hi;
#define IN(k) (lo <= (k) && (k) < hi)
#define SEAM(k) do { if (IN(k) && IN((k) + 1)) xcd_barrier(bar); } while (0)
    float* mod = (float*)(args.ws + WS_MOD);
    bf16* XN = (bf16*)(args.ws + WS_XN); bf16* Yb = (bf16*)(args.ws + WS_Y); bf16* Zb = (bf16*)(args.ws + WS_Z);

    if (IN(0)) { p0_prologue(F, args); } SEAM(0);

    for (int l = 0; l < 2; ++l) {
        const int pb = 1 + l * PH_PER_LAYER;
        const float* modl = mod + (size_t)l * 9 * 6144;
        const float* xin_c = l == 0 ? INP(args, I_XP) : F.out; const float* xin_l = l == 0 ? INP(args, I_XS) - (size_t)MC * D : F.out;
        if (IN(pb + 0)) { norm_mod_phase(F, xin_c, xin_l, INP(args, I_NORMW) + (size_t)(l * 2 + 0) * D, modl, 0, 1024); } SEAM(pb + 0);
        if (IN(pb + 1)) {
            pg8::Gemm g{XN, (const bf16*)(args.ws + WS_WIN) + (size_t)l * DIN * D, M, DIN, D}; pg8::StaticOrder S; S.init(M, DIN, F.G, (int)blockIdx.x);
            pg8::EpiIn E{Zb, (const float*)(args.ws + WS_ROPE), F.out + OUT_CK, F.out + OUT_CV, l};
            pg8::gemm_phase<pg8::EpiIn, pg8::StaticOrder, true, true>(F.lds, g, S, E);
        } SEAM(pb + 1);
        if (IN(pb + 2)) { mix_rglru_naive(F, args, l); mix_attn_naive(F, args, l); mix_conv_naive(F, args, l); mix_pool_naive(F, args, l); } SEAM(pb + 2);
        if (IN(pb + 3)) {
            pg8::Gemm g{Yb, (const bf16*)(args.ws + WS_WOUT) + (size_t)l * D * D, M, D, D}; pg8::StaticOrder S; S.init(M, D, F.G, (int)blockIdx.x);
            pg8::EpiGateRes E{xin_c, xin_l, F.out, modl + 2048, 0};
            pg8::gemm_phase<pg8::EpiGateRes, pg8::StaticOrder, true, true>(F.lds, g, S, E);
        } SEAM(pb + 3);
        if (IN(pb + 4)) { norm_mod_phase(F, F.out, F.out, INP(args, I_NORMW) + (size_t)(l * 2 + 1) * D, modl, 3072, 4096); } SEAM(pb + 4);
        for (int hf = 0; hf < 2; ++hf) {
            if (IN(pb + 5 + 2 * hf)) {
                pg8::Gemm g{XN + (size_t)hf * MH * D, (const bf16*)(args.ws + WS_W1) + (size_t)l * DFF * D, MH, DFF, D}; pg8::StaticOrder S; S.init(MH, DFF, F.G, (int)blockIdx.x);
                pg8::EpiRelu2 E{Zb};
                pg8::gemm_phase<pg8::EpiRelu2, pg8::StaticOrder, true, true>(F.lds, g, S, E);
            } SEAM(pb + 5 + 2 * hf);
            if (IN(pb + 6 + 2 * hf)) {
                pg8::Gemm g{Zb, (const bf16*)(args.ws + WS_W2) + (size_t)l * D * DFF, MH, D, DFF}; pg8::StaticOrder S; S.init(MH, D, F.G, (int)blockIdx.x);
                pg8::EpiGateRes E{F.out, F.out, F.out, modl + 5120, hf * MH};
                pg8::gemm_phase<pg8::EpiGateRes, pg8::StaticOrder, true, true>(F.lds, g, S, E);
            } SEAM(pb + 6 + 2 * hf);
        }
    }
    if (IN(NPHASE - 1)) { final_norm_phase(F, args); }
#undef IN
#undef SEAM
}

extern "C" void kernel_launch(void* const* d_in, const int* in_sizes, int n_in, void* d_out, int out_size, void* d_ws, size_t ws_size, hipStream_t stream) {
    static int grid = 0;
    if (grid == 0) {
        if (n_in != 25 || out_size != (int)(OUT_ST + 32 * 2 * 2 * 256) || ws_size < WS_END) { fprintf(stderr, "kernel_launch: unexpected shapes (n_in %d out %d ws %zu)\n", n_in, out_size, ws_size); grid = -1; return; }
        int dev = 0, cus = 0;
        if (hipGetDevice(&dev) != hipSuccess || hipDeviceGetAttribute(&cus, hipDeviceAttributeMultiprocessorCount, dev) != hipSuccess) { grid = -1; return; }
        if (hipFuncSetAttribute((const void*)fwd_kernel, hipFuncAttributeMaxDynamicSharedMemorySize, LDS_BYTES) != hipSuccess) { fprintf(stderr, "kernel_launch: hipFuncSetAttribute failed\n"); grid = -1; return; }
        int per_cu = 0;
        if (hipOccupancyMaxActiveBlocksPerMultiprocessor(&per_cu, (const void*)fwd_kernel, NWAVES * 64, LDS_BYTES) != hipSuccess || per_cu < 1) fprintf(stderr, "kernel_launch: occupancy query says %d\n", per_cu);
        (void)hipGetLastError();
        grid = cus;
    }
    if (grid < 0) return;
    (void)hipMemsetAsync((char*)d_ws + WS_CTL, 0, CTL_ZERO_BYTES, stream);
    Args a{};
    for (int i = 0; i < 25; ++i) a.in[i] = (const float*)d_in[i];
    a.out = (float*)d_out; a.ws = (unsigned char*)d_ws;
#if MK_PER_PHASE
    for (int p = 0; p < NPHASE; ++p) { a.ph_lo = p; a.ph_hi = p + 1; hipLaunchKernelGGL(fwd_kernel, dim3(grid), dim3(NWAVES * 64), LDS_BYTES, stream, a); }
#else
    a.ph_lo = 0; a.ph_hi = NPHASE; hipLaunchKernelGGL(fwd_kernel, dim3(grid), dim3(NWAVES * 64), LDS_BYTES, stream, a);
#endif
}
```

```cpp
#include <hip/hip_runtime.h>
#include <cstdio>
#include <cstdint>

#ifndef MK_PER_PHASE
#define MK_PER_PHASE 0
#endif


__device__ __forceinline__ float shx(float v, int mask, int lane) { return __builtin_bit_cast(float, __builtin_amdgcn_ds_bpermute((lane ^ mask) << 2, __builtin_bit_cast(int, v))); }
__device__ __forceinline__ float shidx(float v, int src) { return __builtin_bit_cast(float, __builtin_amdgcn_ds_bpermute(src << 2, __builtin_bit_cast(int, v))); }

namespace pg8 {
#define PG8_LAS __attribute__((address_space(3)))
typedef unsigned short bf16_t;
typedef short bf16x8 __attribute__((ext_vector_type(8)));
typedef float f32x4 __attribute__((ext_vector_type(4)));
typedef unsigned u32x4 __attribute__((ext_vector_type(4)));
constexpr int BM = 256, BK = 64, HALF = 128, HTB = HALF * BK * 2, STAGE_BYTES = 8 * HTB, NXCD = 8, WGM = 8;

__host__ __device__ __forceinline__ int lds_byte(int r, int c) { const int st = (r >> 4) * 2 + (c >> 5), rr = r & 15, cc = c & 31, ob = rr * 64 + cc * 2; return st * 1024 + (ob ^ (((ob >> 9) & 1) << 5)); }
__host__ __device__ __forceinline__ void stage_rc(int b, int& R, int& C) { const int st = b / 1024, sb = b % 1024, swz = sb ^ (((sb >> 9) & 1) << 5); R = (st >> 1) * 16 + swz / 64; C = (st & 1) * 32 + (swz % 64) / 2; }
__host__ __device__ __forceinline__ int perm32(int rho) { const int n = rho >> 4, i = rho & 15; return 8 * (i >> 2) + 4 * n + (i & 3); }

struct Unit { int pm, pn; };
struct Gemm { const bf16_t* A; const bf16_t* Bt; int M, N, K; };

struct StaticOrder {
    int nM, nN, nwg, G, c;
    __host__ __device__ void init(int M, int N, int G_, int c_) { nM = M / BM; nN = N / BM; nwg = nM * nN; G = G_; c = c_; }
    __host__ __device__ bool next(int i, Unit& u) const {
        const long L = (long)i * G + c; if (L >= nwg) return false;
        int wgid = (int)L; { const int q = nwg / NXCD, r = nwg % NXCD, xcd = wgid % NXCD, off = wgid / NXCD; wgid = (xcd < r ? xcd * (q + 1) : r * (q + 1) + (xcd - r) * q) + off; }
        const int nig = WGM * nN, gid = wgid / nig, fm = gid * WGM, gsz = (nM - fm) < WGM ? (nM - fm) : WGM;
        u.pm = fm + ((wgid % nig) % gsz); u.pn = (wgid % nig) / gsz; return true;
    }
    __device__ __forceinline__ void a_ready(const Unit&) const {}
    __device__ __forceinline__ void done(const Unit&) const {}
};

__device__ __forceinline__ unsigned cvt_pk_bf16(float lo, float hi) { unsigned r; asm volatile("v_cvt_pk_bf16_f32 %0, %1, %2" : "=v"(r) : "v"(lo), "v"(hi)); return r; }


struct EpiIn {
    static constexpr bool PERM = true, AFTER_DRAIN = false;
    bf16_t* Z; const float* rope; float* ck_out; float* cv_out; int layer;
    __device__ __forceinline__ void operator()(const f32x4 (&acc)[2][2][4][2], const Unit& u, int wr, int wc, int fr, int fq) const {
        const int pn = u.pn; const bool lat = u.pm >= 32; const bool dorope = lat && pn <= 1;
        const int row0 = u.pm * BM + wr * 64 + fr; const int colw = wc * 32 + 8 * fq;
        const float qs = (pn == 0) ? 0.25503486f : 1.0f;
#pragma unroll
        for (int ai = 0; ai < 2; ++ai)
#pragma unroll
            for (int m = 0; m < 4; ++m) {
                const int row = row0 + ai * HALF + m * 16;
                f32x4 cs[4];
                if (dorope) { const int t = (row - 8192) & 2047; const int pos = (fq >> 1) ? (t & 63) : (t >> 6); const f32x4* rp = (const f32x4*)(rope + pos * 16);
#pragma unroll
                    for (int e = 0; e < 4; ++e) cs[e] = rp[e]; }
#pragma unroll
                for (int bj = 0; bj < 2; ++bj) {
                    float v[8];
#pragma unroll
                    for (int e = 0; e < 4; ++e) { v[e] = acc[ai][bj][m][0][e]; v[4 + e] = acc[ai][bj][m][1][e]; }
                    if (dorope) {
#pragma unroll
                        for (int e = 0; e < 8; ++e) { const float pr = shx(v[e], 16, fr + 16 * fq); const float c = cs[e >> 1][(e & 1) * 2], s = cs[e >> 1][(e & 1) * 2 + 1];
                            v[e] = (fq & 1) ? (v[e] * c + pr * s) : (v[e] * c - pr * s); }
                    }
                    if (!lat && (pn == 1 || pn == 2)) {
                        float* co = (pn == 1) ? ck_out : cv_out; const int b = row >> 8, t = row & 255; const int cc = bj * HALF + colw; const int hd = cc >> 6, d = cc & 63;
                        float* op = co + ((size_t)((b * 2 + layer) * 4 + hd) * 256 + t) * 64 + d;
                        *(f32x4*)op = (f32x4){v[0], v[1], v[2], v[3]}; *(f32x4*)(op + 4) = (f32x4){v[4], v[5], v[6], v[7]};
                    }
                    u32x4 w; w.x = cvt_pk_bf16(v[0] * qs, v[1] * qs); w.y = cvt_pk_bf16(v[2] * qs, v[3] * qs); w.z = cvt_pk_bf16(v[4] * qs, v[5] * qs); w.w = cvt_pk_bf16(v[6] * qs, v[7] * qs);
                    *(u32x4*)(Z + (size_t)row * 2304 + pn * BM + bj * HALF + colw) = w;
                }
            }
    }
};
struct EpiGateRes {
    static constexpr bool PERM = false, AFTER_DRAIN = false;
    const float* res_c; const float* res_l; float* out; const float* gate; int rowbase;
    __device__ __forceinline__ void operator()(const f32x4 (&acc)[2][2][4][2], const Unit& u, int wr, int wc, int fr, int fq) const {
        const int grow0 = rowbase + u.pm * BM; const int mi = grow0 < 8192 ? 0 : 1 + ((grow0 - 8192) >> 11);
        const float* res = grow0 < 8192 ? res_c : res_l;
        const int row0 = grow0 + wr * 64 + fr, col0 = u.pn * BM + wc * 32 + 4 * fq;
        f32x4 gv[2][2];
#pragma unroll
        for (int bj = 0; bj < 2; ++bj)
#pragma unroll
            for (int n = 0; n < 2; ++n) gv[bj][n] = *(const f32x4*)(gate + (size_t)mi * 6144 + col0 + bj * HALF + n * 16);
#pragma unroll
        for (int ai = 0; ai < 2; ++ai)
#pragma unroll
            for (int m = 0; m < 4; ++m) { const size_t off = (size_t)(row0 + ai * HALF + m * 16) * 1024 + col0;
#pragma unroll
                for (int bj = 0; bj < 2; ++bj)
#pragma unroll
                    for (int n = 0; n < 2; ++n) { const f32x4 r = *(const f32x4*)(res + off + bj * HALF + n * 16); *(f32x4*)(out + off + bj * HALF + n * 16) = r + gv[bj][n] * acc[ai][bj][m][n]; } }
    }
};
struct EpiRelu2 {
    static constexpr bool PERM = true, AFTER_DRAIN = false;
    bf16_t* H;
    __device__ __forceinline__ void operator()(const f32x4 (&acc)[2][2][4][2], const Unit& u, int wr, int wc, int fr, int fq) const {
        const int row0 = u.pm * BM + wr * 64 + fr; const int col0 = u.pn * BM + wc * 32 + 8 * fq;
#pragma unroll
        for (int ai = 0; ai < 2; ++ai)
#pragma unroll
            for (int m = 0; m < 4; ++m) { bf16_t* rowp = H + (size_t)(row0 + ai * HALF + m * 16) * 4096 + col0;
#pragma unroll
                for (int bj = 0; bj < 2; ++bj) { f32x4 v0 = acc[ai][bj][m][0], v1 = acc[ai][bj][m][1];
#pragma unroll
                    for (int e = 0; e < 4; ++e) { const float a = fmaxf(v0[e], 0.f), b = fmaxf(v1[e], 0.f); v0[e] = a * a; v1[e] = b * b; }
                    u32x4 w; w.x = cvt_pk_bf16(v0[0], v0[1]); w.y = cvt_pk_bf16(v0[2], v0[3]); w.z = cvt_pk_bf16(v1[0], v1[1]); w.w = cvt_pk_bf16(v1[2], v1[3]);
                    *(u32x4*)(rowp + bj * HALF) = w; } }
    }
};

template <class Epi, class Sched, bool ALIGN_EPI = false, bool SP2 = false>
__device__ __forceinline__ void gemm_phase(PG8_LAS unsigned char* lds, const Gemm g, const Sched& S, const Epi& E) {
    int tid = threadIdx.x; asm volatile("" : "+v"(tid));
    const int wid = __builtin_amdgcn_readfirstlane(tid >> 6), lane = tid & 63, wr = wid >> 2, wc = wid & 3, fr = lane & 15, fq = lane >> 4;
    const int K = g.K, nt = K / BK;
    unsigned voffA[2], voffB[2];
#pragma unroll
    for (int i = 0; i < 2; ++i) { int R, C; stage_rc(tid * 16 + i * 8192, R, C); const int Rb = Epi::PERM ? ((R & ~31) + perm32(R & 31)) : R;
        voffA[i] = (unsigned)(R * K + C) * 2u; voffB[i] = (unsigned)(Rb * K + C) * 2u; }
    const size_t kstep = (size_t)(BK * 2);
    const size_t hstep = (size_t)HALF * K * 2;
    const size_t tstep = 2 * hstep;
    const unsigned ldsw = (unsigned)wid * 1024u;
    const int aoff = lds_byte(wr * 64 + fr, fq * 8), boff = lds_byte(wc * 32 + fr, fq * 8);
#define PG8_SA(b, h) (((b) * 2 + (h)) * HTB)
#define PG8_SB(b, h) ((4 + (b) * 2 + (h)) * HTB)
#define PG8_STAGE(bufoff, gbase, voff) do { _Pragma("unroll") for (int _i = 0; _i < 2; ++_i) \
        __builtin_amdgcn_global_load_lds((const unsigned*)((const char*)(gbase) + (voff)[_i]), (PG8_LAS unsigned*)(lds + (bufoff) + ldsw + _i * 8192), 16, 0, 0); } while (0)
#define PG8_LDA(dst, b, h) do { _Pragma("unroll") for (int m = 0; m < 4; ++m) _Pragma("unroll") for (int k = 0; k < 2; ++k) dst[m][k] = *(const PG8_LAS bf16x8*)(lds + PG8_SA(b, h) + aoff + m * 2048 + k * 1024); } while (0)
#define PG8_LDB(dst, b, h) do { _Pragma("unroll") for (int n = 0; n < 2; ++n) _Pragma("unroll") for (int k = 0; k < 2; ++k) dst[n][k] = *(const PG8_LAS bf16x8*)(lds + PG8_SB(b, h) + boff + n * 2048 + k * 1024); } while (0)
#define PG8_MMA(ai, bj, At, Bt) do { __builtin_amdgcn_s_setprio(1); _Pragma("unroll") for (int m = 0; m < 4; ++m) _Pragma("unroll") for (int n = 0; n < 2; ++n) _Pragma("unroll") for (int k = 0; k < 2; ++k) \
        acc[ai][bj][m][n] = __builtin_amdgcn_mfma_f32_16x16x32_bf16(Bt[n][k], At[m][k], acc[ai][bj][m][n], 0, 0, 0); __builtin_amdgcn_s_setprio(0); } while (0)
#define PG8_WAIT_V(n) asm volatile("s_waitcnt vmcnt(" #n ")" ::: "memory")
#define PG8_WAIT_L(n) asm volatile("s_waitcnt lgkmcnt(" #n ")" ::: "memory")
#define PG8_BAR __builtin_amdgcn_s_barrier()
#define PG8_SCHED __builtin_amdgcn_sched_barrier(0)
    Unit cur, nxt; int ui = 0;
    if (!S.next(0, cur)) return;
    f32x4 acc[2][2][4][2];
#pragma unroll
    for (int a = 0; a < 2; ++a)
#pragma unroll
        for (int b = 0; b < 2; ++b)
#pragma unroll
            for (int m = 0; m < 4; ++m)
#pragma unroll
                for (int n = 0; n < 2; ++n) acc[a][b][m][n] = (f32x4){0.f, 0.f, 0.f, 0.f};
    bf16x8 At[4][2], B0[2][2], B1[2][2];
    const char* cA = (const char*)g.A + (size_t)cur.pm * tstep; const char* cB = (const char*)g.Bt + (size_t)cur.pn * tstep;
    S.a_ready(cur);
    if constexpr (SP2) {
        PG8_STAGE(PG8_SB(0, 0), cB, voffB); PG8_STAGE(PG8_SB(0, 1), cB + hstep, voffB); PG8_STAGE(PG8_SA(0, 0), cA, voffA); PG8_STAGE(PG8_SA(0, 1), cA + hstep, voffA);
        if (wr == 1) PG8_BAR;
        PG8_WAIT_V(2); PG8_BAR;
        PG8_STAGE(PG8_SB(1, 0), cB + kstep, voffB); PG8_STAGE(PG8_SA(1, 0), cA + kstep, voffA); PG8_STAGE(PG8_SB(1, 1), cB + hstep + kstep, voffB);
        PG8_WAIT_V(6); PG8_BAR;
    } else {
        PG8_STAGE(PG8_SB(0, 0), cB, voffB); PG8_STAGE(PG8_SA(0, 0), cA, voffA); PG8_STAGE(PG8_SB(0, 1), cB + hstep, voffB); PG8_STAGE(PG8_SA(0, 1), cA + hstep, voffA);
        if (wr == 1) PG8_BAR;
        PG8_WAIT_V(4); PG8_BAR;
        PG8_STAGE(PG8_SB(1, 0), cB + kstep, voffB); PG8_STAGE(PG8_SA(1, 0), cA + kstep, voffA); PG8_STAGE(PG8_SB(1, 1), cB + hstep + kstep, voffB);
        PG8_WAIT_V(6); PG8_BAR;
    }
    for (;;) {
        const bool has_next = S.next(ui + 1, nxt);
        const char* nA = has_next ? (const char*)g.A + (size_t)nxt.pm * tstep : cA; const char* nB = has_next ? (const char*)g.Bt + (size_t)nxt.pn * tstep : cB;
        for (int t = 0; t < nt; t += 2) {
            const bool last = (t == nt - 2);
            const char* a1 = cA + (size_t)(t + 1) * kstep;
            const char* a2 = last ? nA : cA + (size_t)(t + 2) * kstep; const char* b2 = last ? nB : cB + (size_t)(t + 2) * kstep;
            const char* a3 = a2 + kstep; const char* b3 = b2 + kstep;
            if (last && has_next) S.a_ready(nxt);
            if constexpr (SP2) {
            PG8_LDB(B0, 0, 0); PG8_LDB(B1, 0, 1); PG8_SCHED; PG8_LDA(At, 0, 0); PG8_STAGE(PG8_SA(1, 1), a1 + hstep, voffA);
            PG8_WAIT_V(8); PG8_WAIT_L(0); PG8_BAR; PG8_MMA(0, 0, At, B0); PG8_MMA(0, 1, At, B1); PG8_BAR; PG8_SCHED;
            PG8_LDA(At, 0, 1); PG8_STAGE(PG8_SB(0, 0), b2, voffB); PG8_STAGE(PG8_SB(0, 1), b2 + hstep, voffB); PG8_STAGE(PG8_SA(0, 0), a2, voffA);
            PG8_WAIT_V(8); PG8_WAIT_L(0); PG8_BAR; PG8_MMA(1, 0, At, B0); PG8_MMA(1, 1, At, B1); PG8_BAR; PG8_SCHED;
            PG8_LDB(B0, 1, 0); PG8_LDB(B1, 1, 1); PG8_SCHED; PG8_LDA(At, 1, 0); PG8_STAGE(PG8_SA(0, 1), a2 + hstep, voffA);
            PG8_WAIT_V(8); PG8_WAIT_L(0); PG8_BAR; PG8_MMA(0, 0, At, B0); PG8_MMA(0, 1, At, B1); PG8_BAR; PG8_SCHED;
            PG8_LDA(At, 1, 1); PG8_STAGE(PG8_SB(1, 0), b3, voffB); PG8_STAGE(PG8_SB(1, 1), b3 + hstep, voffB); PG8_STAGE(PG8_SA(1, 0), a3, voffA);
            PG8_WAIT_V(8); PG8_WAIT_L(0); PG8_BAR; PG8_MMA(1, 0, At, B0); PG8_MMA(1, 1, At, B1); PG8_BAR; PG8_SCHED;
            } else {
            PG8_LDB(B0, 0, 0); PG8_SCHED; PG8_LDA(At, 0, 0); PG8_STAGE(PG8_SA(1, 1), a1 + hstep, voffA);
            PG8_WAIT_L(8); PG8_BAR; PG8_WAIT_L(0); PG8_MMA(0, 0, At, B0); PG8_BAR; PG8_SCHED;
            PG8_LDB(B1, 0, 1); PG8_STAGE(PG8_SB(0, 0), b2, voffB);
            PG8_BAR; PG8_WAIT_L(0); PG8_MMA(0, 1, At, B1); PG8_BAR;
            PG8_LDA(At, 0, 1); PG8_STAGE(PG8_SA(0, 0), a2, voffA);
            PG8_BAR; PG8_WAIT_L(0); PG8_MMA(1, 0, At, B0); PG8_BAR; PG8_SCHED;
            PG8_STAGE(PG8_SB(0, 1), b2 + hstep, voffB);
            PG8_WAIT_V(6); PG8_BAR; PG8_MMA(1, 1, At, B1); PG8_BAR;
            PG8_LDB(B0, 1, 0); PG8_SCHED; PG8_LDA(At, 1, 0); PG8_STAGE(PG8_SA(0, 1), a2 + hstep, voffA);
            PG8_WAIT_L(8); PG8_BAR; PG8_WAIT_L(0); PG8_MMA(0, 0, At, B0); PG8_BAR; PG8_SCHED;
            PG8_LDB(B1, 1, 1); PG8_STAGE(PG8_SB(1, 0), b3, voffB);
            PG8_BAR; PG8_WAIT_L(0); PG8_MMA(0, 1, At, B1); PG8_BAR;
            PG8_LDA(At, 1, 1); PG8_STAGE(PG8_SA(1, 0), a3, voffA);
            PG8_BAR; PG8_WAIT_L(0); PG8_MMA(1, 0, At, B0); PG8_BAR; PG8_SCHED;
            PG8_STAGE(PG8_SB(1, 1), b3 + hstep, voffB);
            PG8_WAIT_V(6); PG8_BAR; PG8_MMA(1, 1, At, B1); PG8_BAR;
            }
        }
        if constexpr (ALIGN_EPI) { if (wr == 0) PG8_BAR; }
        if constexpr (!Epi::AFTER_DRAIN) { E(acc, cur, wr, wc, fr, fq); S.done(cur); }
        if (!has_next) break;
#pragma unroll
        for (int a = 0; a < 2; ++a)
#pragma unroll
            for (int b = 0; b < 2; ++b)
#pragma unroll
                for (int m = 0; m < 4; ++m)
#pragma unroll
                    for (int n = 0; n < 2; ++n) acc[a][b][m][n] = (f32x4){0.f, 0.f, 0.f, 0.f};
        cur = nxt; cA = nA; cB = nB; ++ui;
        if constexpr (ALIGN_EPI) { if (wr == 1) PG8_BAR; }
    }
    PG8_WAIT_V(0);
    if constexpr (!ALIGN_EPI) { if (wr == 0) PG8_BAR; }
    PG8_BAR;
#undef PG8_SA
#undef PG8_SB
#undef PG8_STAGE
#undef PG8_LDA
#undef PG8_LDB
#undef PG8_MMA
#undef PG8_WAIT_V
#undef PG8_WAIT_L
#undef PG8_BAR
#undef PG8_SCHED
}
}

constexpr int NWAVES = 8;
constexpr int D = 1024, MC = 8192, ML = 16384, M = MC + ML, DIN = 2304, DFF = 4096, DG = 256, MH = M / 2;
constexpr float EPS = 1e-6f;
constexpr size_t MiB = 1u << 20;
constexpr size_t WS_CTL = 0, CTL_ZERO_BYTES = 1 * MiB;
constexpr size_t WS_MOD = 1 * MiB;
constexpr size_t WS_ROPE = WS_MOD + 2 * 9 * 6144 * 4;
constexpr size_t WS_LAM = WS_ROPE + 64 * 16 * 4;
constexpr size_t WS_RGWT = WS_LAM + 256;
constexpr size_t WS_POOLT = WS_RGWT + 32 * 4096 * 2;
constexpr size_t WS_CARRY = WS_POOLT + 8 * 4096 * 2;
constexpr size_t WS_WIN = 2 * MiB;
constexpr size_t WS_WOUT = WS_WIN + 2ull * 2304 * 1024 * 2;
constexpr size_t WS_W1 = WS_WOUT + 2ull * 1024 * 1024 * 2;
constexpr size_t WS_W2 = WS_W1 + 2ull * 4096 * 1024 * 2;
constexpr size_t WS_CK = WS_W2 + 2ull * 4096 * 1024 * 2;
constexpr size_t WS_CV = WS_CK + 2 * MiB;
constexpr size_t WS_XN = 52 * MiB;
constexpr size_t WS_Y = 100 * MiB;
constexpr size_t WS_Z = 148 * MiB;
constexpr size_t WS_END = 256 * MiB;
static_assert(WS_CARRY + 8 * 8 * 4 * 2 * 64 * 2 * 4 <= WS_WIN && WS_CV + 2 * MiB <= WS_XN && WS_Z + (size_t)M * DIN * 2 <= WS_END, "d_ws map");
constexpr int CW_BAR = 4096;
constexpr size_t OUT_Y = 0, OUT_CK = (size_t)M * D, OUT_CV = OUT_CK + 32ull * 2 * 4 * 256 * 64, OUT_ST = OUT_CV + 32ull * 2 * 4 * 256 * 64;
constexpr int RING_BYTES = 131072, LDSCTL_OFF = RING_BYTES, MISC_OFF = LDSCTL_OFF + 320, LDS_BYTES = 147456;

#define GAS __attribute__((address_space(1)))
#define LAS __attribute__((address_space(3)))
typedef unsigned short bf16;
typedef unsigned v4u __attribute__((ext_vector_type(4)));
typedef unsigned v2u __attribute__((ext_vector_type(2)));
typedef float f32x4 __attribute__((ext_vector_type(4)));
typedef GAS unsigned gu32;
#define RLX_AGENT __ATOMIC_RELAXED, __HIP_MEMORY_SCOPE_AGENT
#define LDS_WAIT() asm volatile("s_waitcnt lgkmcnt(0)" ::: "memory")
__device__ __forceinline__ unsigned f2bf(float f) { unsigned u = __builtin_bit_cast(unsigned, f); return (u + 0x7fffu + ((u >> 16) & 1u)) >> 16; }
__device__ __forceinline__ unsigned pk2(float lo, float hi) { return f2bf(lo) | (f2bf(hi) << 16); }
__device__ __forceinline__ float bf2f(unsigned h) { return __uint_as_float(h << 16); }
__device__ __forceinline__ float bflo(unsigned w) { return __uint_as_float(w << 16); }
__device__ __forceinline__ float bfhi(unsigned w) { return __uint_as_float(w & 0xffff0000u); }

#define XB_TMO      128
#define XB_XCNT(j)  (256  + 64 * (j))
#define XB_XSUB(j)  (1280 + 64 * (j))
#define XB_XGEN(j)  (2304 + 64 * (j))
#define XB_TOP      3328
#define XB_TOPGEN   3392
#define XCD_BAR_WORDS 3456
#define XB_SPIN_CAP (1u << 18)
__device__ __forceinline__ unsigned xb_ld(unsigned* p)              { return __hip_atomic_load(p, __ATOMIC_RELAXED, __HIP_MEMORY_SCOPE_AGENT); }
__device__ __forceinline__ unsigned xb_add(unsigned* p, unsigned v) { return __hip_atomic_fetch_add(p, v, __ATOMIC_RELAXED, __HIP_MEMORY_SCOPE_AGENT); }
__device__ __forceinline__ unsigned xb_xcc_id() { return (unsigned)__builtin_amdgcn_s_getreg((3 << 11) | 20) & 0xFu; }
#define XB_SPIN(cond, bar) do { unsigned _sp = 0; while (cond) { __builtin_amdgcn_s_sleep(1); \
    if ((++_sp & 255u) == 0u) { if (xb_ld(&(bar)[XB_TMO])) break; if (_sp > XB_SPIN_CAP) { atomicAdd(&(bar)[XB_TMO], 1u); break; } } } } while (0)
struct XcdBarrier { unsigned* bar; unsigned x; volatile LAS unsigned* st; };
__device__ __forceinline__ XcdBarrier xcd_barrier_post(unsigned* bar, volatile LAS unsigned* st) {
    XcdBarrier b; b.bar = bar; b.x = xb_xcc_id(); b.st = st;
    if (threadIdx.x == 0) (void)xb_add(&bar[XB_XCNT(b.x)], 1u);
    return b;
}
__device__ __forceinline__ void xcd_barrier_complete(unsigned* bar, unsigned x, unsigned& nloc, unsigned& nx) {
    const unsigned G = gridDim.x * gridDim.y * gridDim.z;
    unsigned sum, cnt, mine, sp = 0u;
    for (;;) {
        sum = 0u; cnt = 0u;
        for (unsigned j = 0; j < 16; ++j) { const unsigned c = xb_ld(&bar[XB_XCNT(j)]); sum += c; cnt += (c > 0u) ? 1u : 0u; }
        mine = xb_ld(&bar[XB_XCNT(x)]);
        if (sum == G) break;
        __builtin_amdgcn_s_sleep(1);
        if ((++sp & 255u) == 0u) { if (xb_ld(&bar[XB_TMO])) break; if (sp > XB_SPIN_CAP) { atomicAdd(&bar[XB_TMO], 1u); break; } }
    }
    nloc = mine > 0u ? mine : 1u; nx = cnt > 0u ? cnt : 1u;
}
__device__ __forceinline__ void xcd_barrier(const XcdBarrier& b) {
    asm volatile("s_waitcnt vmcnt(0)" ::: "memory");
    __syncthreads();
    if (threadIdx.x == 0) {
        unsigned* bar = b.bar; asm volatile("" : "+s"(bar)); unsigned bx_ = b.x; asm volatile("" : "+s"(bx_));
        __builtin_amdgcn_s_waitcnt(0);
        unsigned nloc = b.st[0], nx = b.st[1];
        if (nloc == 0u) { xcd_barrier_complete(bar, bx_, nloc, nx); b.st[0] = nloc; b.st[1] = nx; }
        const unsigned old = xb_add(&bar[XB_XSUB(bx_)], 1u);
        const unsigned gen = old / nloc;
        if (old + 1u == (gen + 1u) * nloc) {
            __builtin_amdgcn_fence(__ATOMIC_RELEASE, "agent");
            asm volatile("s_waitcnt vmcnt(0)" ::: "memory");
            const unsigned og = xb_add(&bar[XB_TOP], 1u);
            const unsigned tg = og / nx;
            if (og + 1u == (tg + 1u) * nx) xb_add(&bar[XB_TOPGEN], 1u);
            else XB_SPIN(xb_ld(&bar[XB_TOPGEN]) == tg, bar);
            __builtin_amdgcn_fence(__ATOMIC_ACQUIRE, "agent");
            xb_add(&bar[XB_XGEN(bx_)], 1u);
            asm volatile("s_waitcnt vmcnt(0)" ::: "memory");
        } else {
            XB_SPIN(xb_ld(&bar[XB_XGEN(bx_)]) == gen, bar);
            __builtin_amdgcn_fence(__ATOMIC_ACQUIRE, "agent");
            asm volatile("s_waitcnt vmcnt(0)" ::: "memory");
        }
    }
    __syncthreads();
}

struct Args { const float* in[25]; float* out; unsigned char* ws; int ph_lo, ph_hi; };
#define INP(A_, i) inp_ptr(F, (i))
struct Frame {
    LAS unsigned char* lds; LAS unsigned char* lds0; int tid, lane, wave, vcu, G;
    float* out; unsigned char* ws; float* out0; unsigned char* ws0;
};
__device__ __forceinline__ const float* inp_ptr(const Frame& F, int i) {
    const volatile LAS unsigned* t = (const volatile LAS unsigned*)(F.lds + 131072) + 2 * i;
    const unsigned lo = __builtin_amdgcn_readfirstlane(t[0]), hi = __builtin_amdgcn_readfirstlane(t[1]);
    return (const float*)(((unsigned long long)hi << 32) | lo);
}
#define PHASE_IDS(F) do { int t_ = threadIdx.x; asm volatile("" : "+v"(t_)); (F).tid = t_; (F).lane = t_ & 63; (F).wave = __builtin_amdgcn_readfirstlane(t_ >> 6); \
    unsigned l_ = (unsigned)(uintptr_t)(F).lds0; asm volatile("" : "+s"(l_)); (F).lds = (LAS unsigned char*)(uintptr_t)l_; unsigned char* w_ = (F).ws0; asm volatile("" : "+s"(w_)); (F).ws = w_; float* o_ = (F).out0; asm volatile("" : "+s"(o_)); (F).out = o_; } while (0)
enum { I_XP = 0, I_XS, I_CK, I_CV, I_ST, I_C, I_CCTX, I_WADA, I_BADA, I_NORMW, I_WIN, I_DLAM, I_SUBLN, I_CBW, I_CCW, I_CCB, I_RGW, I_RGB, I_RGLAM, I_POOLW, I_POOLS, I_WOUT, I_W1, I_W2, I_FNW };

__device__ __forceinline__ float wave_sum(float v, int lane) {
#pragma unroll
    for (int o = 1; o < 64; o <<= 1) v += shx(v, o, lane);
    return v;
}
__device__ __forceinline__ float wave_max(float v, int lane) {
#pragma unroll
    for (int o = 1; o < 64; o <<= 1) v = fmaxf(v, shx(v, o, lane));
    return v;
}
__device__ __forceinline__ float gelu_tanh(float x) { const float u = 0.7978845608028654f * (x + 0.044715f * x * x * x); return 0.5f * x * (1.0f + tanhf(u)); }

__device__ __forceinline__ void p0_transpose_item(const float* W, int K, int N, bf16* WT, LAS float* scr, int item, int lane) {
    const int nblk = N / 32, kb = item / nblk, nb = item % nblk, k0 = 64 * kb, n0 = 32 * nb;
#pragma unroll 8
    for (int i = 0; i < 32; ++i) { const int kk = 2 * i + (lane >> 5); scr[kk * 33 + (lane & 31)] = W[(size_t)(k0 + kk) * N + n0 + (lane & 31)]; }
    LDS_WAIT(); asm volatile("" ::: "memory");
    const int c = lane & 7;
#pragma unroll
    for (int j = 0; j < 4; ++j) { const int n = (lane >> 3) + 8 * j; const LAS float* s = scr + (8 * c) * 33 + n;
        v4u o; o.x = pk2(s[0 * 33], s[1 * 33]); o.y = pk2(s[2 * 33], s[3 * 33]); o.z = pk2(s[4 * 33], s[5 * 33]); o.w = pk2(s[6 * 33], s[7 * 33]);
        *(GAS v4u*)(WT + (size_t)(n0 + n) * K + k0 + 8 * c) = o; }
    LDS_WAIT(); asm volatile("" ::: "memory");
}
__device__ __forceinline__ void p0_mod_item(Frame& F, const Args& A, int item) {
    const int l = item / 48, n0 = (item % 48) * 128;
    LAS float* sv = (LAS float*)F.lds;
    LAS float* red = sv + 9 * 1024;
    const float* c = INP(A, I_C); const float* cctx = INP(A, I_CCTX);
    for (int i = F.tid; i < 9 * 1024; i += 512) { const int mi = i >> 10, k = i & 1023; const float v = mi == 0 ? cctx[k] : c[(mi - 1) * 1024 + k]; sv[i] = v / (1.0f + expf(-v)); }
    __syncthreads();
    const int cg = F.tid & 31, rg = F.tid >> 5;
    float acc[9][4];
#pragma unroll
    for (int a = 0; a < 9; ++a)
#pragma unroll
        for (int j = 0; j < 4; ++j) acc[a][j] = 0.f;
    const float* wp = INP(A, I_WADA) + (size_t)l * 1024 * 6144 + n0 + cg * 4;
#pragma unroll 4
    for (int i = 0; i < 64; ++i) { const int k = rg + 16 * i; const f32x4 w = *(const f32x4*)(wp + (size_t)k * 6144);
#pragma unroll
        for (int a = 0; a < 9; ++a) { const float s = sv[a * 1024 + k];
#pragma unroll
            for (int j = 0; j < 4; ++j) acc[a][j] += s * w[j]; } }
#pragma unroll
    for (int a = 0; a < 9; ++a)
#pragma unroll
        for (int j = 0; j < 4; ++j) red[(rg * 9 + a) * 128 + cg * 4 + j] = acc[a][j];
    __syncthreads();
    float* mod = (float*)(F.ws + WS_MOD);
    for (int o = F.tid; o < 9 * 128; o += 512) { const int mi = o >> 7, n = o & 127; float s = INP(A, I_BADA)[l * 6144 + n0 + n];
        for (int r = 0; r < 16; ++r) s += red[(r * 9 + mi) * 128 + n];
        mod[(size_t)(l * 9 + mi) * 6144 + n0 + n] = s; }
    __syncthreads();
}
__device__ __forceinline__ void sincos_d(double a, float& co, float& si) {
    const double TWO_PI = 6.283185307179586476925286766559;
    const double n = (double)(long long)(a / TWO_PI + 0.5);
    const double r = a - n * TWO_PI;
    const double r2 = r * r; double ts = r, tc = 1.0, ss = r, sc = 1.0;
    for (int k = 1; k <= 14; ++k) { tc = -tc * r2 / (double)((2 * k - 1) * (2 * k)); sc += tc; ts = -ts * r2 / (double)((2 * k) * (2 * k + 1)); ss += ts; }
    co = (float)sc; si = (float)ss;
}
__device__ __forceinline__ void p0_prologue(Frame& F, const Args& A) {
    PHASE_IDS(F);
    if (blockIdx.x < 96) p0_mod_item(F, A, blockIdx.x);
    LAS float* scr = (LAS float*)(F.lds + F.wave * 16384);
    const int gw = F.vcu * NWAVES + F.wave, NGW = F.G * NWAVES;
    constexpr int I_IN = 16 * 72, I_OUT = 16 * 32, I_1 = 16 * 128, I_2 = 64 * 32, I_L = I_IN + I_OUT + I_1 + I_2, I_RG = 32 * 2, I_PW = 8 * 2;
    constexpr int NITEMS = 2 * I_L + I_RG + I_PW;
    for (int it = gw; it < NITEMS; it += NGW) {
        int r = it;
        if (r < 2 * I_L) { const int l = r / I_L; r -= l * I_L;
            if (r < I_IN) { p0_transpose_item(INP(A, I_WIN) + (size_t)l * 1024 * 2304, 1024, 2304, (bf16*)(F.ws + WS_WIN) + (size_t)l * 2304 * 1024, scr, r, F.lane); continue; } r -= I_IN;
            if (r < I_OUT) { p0_transpose_item(INP(A, I_WOUT) + (size_t)l * 1024 * 1024, 1024, 1024, (bf16*)(F.ws + WS_WOUT) + (size_t)l * 1024 * 1024, scr, r, F.lane); continue; } r -= I_OUT;
            if (r < I_1) { p0_transpose_item(INP(A, I_W1) + (size_t)l * 1024 * 4096, 1024, 4096, (bf16*)(F.ws + WS_W1) + (size_t)l * 4096 * 1024, scr, r, F.lane); continue; } r -= I_1;
            p0_transpose_item(INP(A, I_W2) + (size_t)l * 4096 * 1024, 4096, 1024, (bf16*)(F.ws + WS_W2) + (size_t)l * 1024 * 4096, scr, r, F.lane); continue; }
        r -= 2 * I_L;
        if (r < I_RG) { const int mi = r >> 1; p0_transpose_item(INP(A, I_RGW) + (size_t)mi * 4096, 64, 64, (bf16*)(F.ws + WS_RGWT) + (size_t)mi * 4096, scr, r & 1, F.lane); continue; } r -= I_RG;
        { const int mi = r >> 1; p0_transpose_item(INP(A, I_POOLW) + (size_t)mi * 4096, 64, 64, (bf16*)(F.ws + WS_POOLT) + (size_t)mi * 4096, scr, r & 1, F.lane); }
    }
    { const int gt = F.vcu * 512 + F.tid, NGT = F.G * 512;
      for (int i = gt; i < 2 * 262144; i += NGT) { const int which = i >= 262144; const int j = which ? i - 262144 : i;
          const float* srcp = which ? INP(A, I_CV) : INP(A, I_CK); const f32x4 v = *(const f32x4*)(srcp + (size_t)j * 4); v2u o; o.x = pk2(v[0], v[1]); o.y = pk2(v[2], v[3]);
          *(GAS v2u*)((bf16*)(F.ws + (which ? WS_CV : WS_CK)) + (size_t)j * 4) = o; } }
    if (blockIdx.x == 100 % F.G) {
        const double fr[8] = {1.0, 0.31622776601683794, 0.1, 0.031622776601683794, 0.01, 0.0031622776601683794, 0.001, 0.00031622776601683794};
        float* rope = (float*)(F.ws + WS_ROPE);
        { const int pos = F.tid >> 3, j = F.tid & 7; double f = fr[0];
#pragma unroll
          for (int q = 1; q < 8; ++q) f = (j == q) ? fr[q] : f;
          float co, si; sincos_d((double)pos * f, co, si); rope[pos * 16 + j * 2] = co; rope[pos * 16 + j * 2 + 1] = si; }
        if (F.tid < 2) { const int l = F.tid; const float* dl = INP(A, I_DLAM) + l * 128; float s1 = 0.f, s2 = 0.f;
            for (int i = 0; i < 32; ++i) { s1 += dl[i] * dl[32 + i]; s2 += dl[64 + i] * dl[96 + i]; }
            const float lam_init = 0.8f - 0.6f * expf(-0.3f * (float)l);
            ((float*)(F.ws + WS_LAM))[l] = expf(s1) - expf(s2) + lam_init; }
    }
}
__device__ __forceinline__ void norm_mod_phase(Frame& F, const float* src_c, const float* src_l, const float* nw, const float* modl, int shift_off, int scale_off) {
    PHASE_IDS(F);
    bf16* XN = (bf16*)(F.ws + WS_XN);
    const int gw = F.vcu * NWAVES + F.wave, NGW = F.G * NWAVES;
    for (int r = gw; r < M; r += NGW) {
        const float* xr = (r < MC ? src_c : src_l) + (size_t)r * D; const int mi = r < MC ? 0 : 1 + ((r - MC) >> 11);
        const float* mp = modl + (size_t)mi * 6144;
        f32x4 v[4]; float s = 0.f;
#pragma unroll
        for (int j = 0; j < 4; ++j) { v[j] = *(const f32x4*)(xr + 256 * j + 4 * F.lane); s += (v[j][0] * v[j][0] + v[j][1] * v[j][1]) + (v[j][2] * v[j][2] + v[j][3] * v[j][3]); }
        const float rstd = 1.0f / sqrtf(wave_sum(s, F.lane) * (1.0f / D) + EPS);
#pragma unroll
        for (int j = 0; j < 4; ++j) { const int c = 256 * j + 4 * F.lane; const f32x4 w = *(const f32x4*)(nw + c), sc = *(const f32x4*)(mp + scale_off + c), sh = *(const f32x4*)(mp + shift_off + c);
            f32x4 o;
#pragma unroll
            for (int e = 0; e < 4; ++e) o[e] = v[j][e] * rstd * w[e] * (1.0f + sc[e]) + sh[e];
            v2u pk; pk.x = pk2(o[0], o[1]); pk.y = pk2(o[2], o[3]); *(GAS v2u*)(XN + (size_t)r * D + c) = pk; }
    }
}
__device__ __forceinline__ void final_norm_phase(Frame& F, const Args& A) {
    PHASE_IDS(F);
    const int gw = F.vcu * NWAVES + F.wave, NGW = F.G * NWAVES; const float* fw = INP(A, I_FNW);
    for (int r = gw; r < M; r += NGW) {
        float* xr = F.out + (size_t)r * D; f32x4 v[4]; float s = 0.f;
#pragma unroll
        for (int j = 0; j < 4; ++j) { v[j] = *(const f32x4*)(xr + 256 * j + 4 * F.lane); s += (v[j][0] * v[j][0] + v[j][1] * v[j][1]) + (v[j][2] * v[j][2] + v[j][3] * v[j][3]); }
        const float rstd = 1.0f / sqrtf(wave_sum(s, F.lane) * (1.0f / D) + EPS);
#pragma unroll
        for (int j = 0; j < 4; ++j) { const int c = 256 * j + 4 * F.lane; const f32x4 w = *(const f32x4*)(fw + c); *(f32x4*)(xr + c) = v[j] * rstd * w; }
    }
}

__device__ __forceinline__ void mix_attn_naive(Frame& F, const Args& A, int l) {
    PHASE_IDS(F);
    const bf16* Z = (const bf16*)(F.ws + WS_Z); bf16* Y = (bf16*)(F.ws + WS_Y);
    const bf16* CK = (const bf16*)(F.ws + WS_CK); const bf16* CV = (const bf16*)(F.ws + WS_CV);
    const float lam = ((const float*)(F.ws + WS_LAM))[l]; const float lam_init = 0.8f - 0.6f * expf(-0.3f * (float)l);
    const float sub = INP(A, I_SUBLN)[l * 64 + F.lane] * (1.0f - lam_init);
    const int gw = F.vcu * NWAVES + F.wave, NGW = F.G * NWAVES; const int lane = F.lane;
    for (int it = gw; it < M * 4; it += NGW) {
        const int r = it >> 2, hd = it & 3; const bool lat = r >= MC;
        const int seq0 = lat ? MC + ((r - MC) & ~2047) : (r & ~255); const int nkb = lat ? 36 : 4; const int b = lat ? (r - MC) >> 11 : 0;
        const bf16* ckp = CK + (size_t)((b * 2 + l) * 4 + hd) * 256 * 64; const bf16* cvp = CV + (size_t)((b * 2 + l) * 4 + hd) * 256 * 64;
        float q[64];
        { const v4u* qp = (const v4u*)(Z + (size_t)r * DIN + hd * 64);
#pragma unroll
          for (int c = 0; c < 8; ++c) { const v4u w = qp[c]; q[c * 8 + 0] = bflo(w.x); q[c * 8 + 1] = bfhi(w.x); q[c * 8 + 2] = bflo(w.y); q[c * 8 + 3] = bfhi(w.y); q[c * 8 + 4] = bflo(w.z); q[c * 8 + 5] = bfhi(w.z); q[c * 8 + 6] = bflo(w.w); q[c * 8 + 7] = bfhi(w.w); } }
        float m1 = -1e30f, m2 = -1e30f;
        for (int kb = 0; kb < nkb; ++kb) {
            const bool cached = lat && kb < 4; const int key = kb * 64 + lane;
            const bf16* kp = cached ? ckp + (size_t)key * 64 : Z + (size_t)(seq0 + key - (lat ? 256 : 0)) * DIN + 256 + hd * 64;
            float s1 = 0.f, s2 = 0.f;
#pragma unroll
            for (int c = 0; c < 8; ++c) { const v4u w = ((const v4u*)kp)[c];
                const float d = q[c * 8 + 0] * bflo(w.x) + q[c * 8 + 1] * bfhi(w.x) + q[c * 8 + 2] * bflo(w.y) + q[c * 8 + 3] * bfhi(w.y) + q[c * 8 + 4] * bflo(w.z) + q[c * 8 + 5] * bfhi(w.z) + q[c * 8 + 6] * bflo(w.w) + q[c * 8 + 7] * bfhi(w.w);
                if (c < 4) s1 += d; else s2 += d; }
            m1 = fmaxf(m1, s1); m2 = fmaxf(m2, s2);
        }
        m1 = wave_max(m1, lane); m2 = wave_max(m2, lane);
        float l1 = 0.f, l2 = 0.f, o1 = 0.f, o2 = 0.f;
        for (int kb = 0; kb < nkb; ++kb) {
            const bool cached = lat && kb < 4; const int key = kb * 64 + lane;
            const bf16* kp = cached ? ckp + (size_t)key * 64 : Z + (size_t)(seq0 + key - (lat ? 256 : 0)) * DIN + 256 + hd * 64;
            float s1 = 0.f, s2 = 0.f;
#pragma unroll
            for (int c = 0; c < 8; ++c) { const v4u w = ((const v4u*)kp)[c];
                const float d = q[c * 8 + 0] * bflo(w.x) + q[c * 8 + 1] * bfhi(w.x) + q[c * 8 + 2] * bflo(w.y) + q[c * 8 + 3] * bfhi(w.y) + q[c * 8 + 4] * bflo(w.z) + q[c * 8 + 5] * bfhi(w.z) + q[c * 8 + 6] * bflo(w.w) + q[c * 8 + 7] * bfhi(w.w);
                if (c < 4) s1 += d; else s2 += d; }
            const float p1 = __builtin_amdgcn_exp2f(s1 - m1), p2 = __builtin_amdgcn_exp2f(s2 - m2); l1 += p1; l2 += p2;
            const bf16* vp = cached ? cvp + (size_t)(kb * 64) * 64 + lane : Z + (size_t)(seq0 + kb * 64 - (lat ? 256 : 0)) * DIN + 512 + hd * 64 + lane;
            const int vstride = cached ? 64 : DIN;
#pragma unroll 8
            for (int j = 0; j < 64; ++j) { const float v = bf2f(vp[(size_t)j * vstride]); o1 += shidx(p1, j) * v; o2 += shidx(p2, j) * v; }
        }
        l1 = wave_sum(l1, lane); l2 = wave_sum(l2, lane);
        const float o = o1 / l1 - lam * (o2 / l2);
        const float ss = wave_sum(o * o, lane);
        Y[(size_t)r * D + hd * 64 + lane] = (bf16)f2bf(o * (1.0f / sqrtf(ss * (1.0f / 64.0f) + EPS)) * sub);
    }
}
__device__ __forceinline__ void mix_conv_naive(Frame& F, const Args& A, int l) {
    PHASE_IDS(F);
    const bf16* Z = (const bf16*)(F.ws + WS_Z); bf16* Y = (bf16*)(F.ws + WS_Y); const float* cw = INP(A, I_CBW) + l * 3 * 256;
    const int gt = F.vcu * 512 + F.tid, NGT = F.G * 512;
    for (int i = gt; i < M * 256; i += NGT) {
        const int r = i >> 8, c = i & 255; const bool lat = r >= MC; const int T = lat ? 2048 : 256; const int t = lat ? ((r - MC) & 2047) : (r & 255);
        float acc = 0.f;
#pragma unroll
        for (int j = 0; j < 3; ++j) { const int tt = t + j - 1; if (tt >= 0 && tt < T) { const bf16* zp = Z + (size_t)(r + j - 1) * DIN; acc += cw[j * 256 + c] * bf2f(zp[1024 + c]) * bf2f(zp[1280 + c]); } }
        Y[(size_t)r * D + 256 + c] = (bf16)f2bf(bf2f(Z[(size_t)r * DIN + 768 + c]) * acc);
    }
}
__device__ __forceinline__ void mix_rglru_naive(Frame& F, const Args& A, int l) {
    PHASE_IDS(F);
    const bf16* Z = (const bf16*)(F.ws + WS_Z); bf16* Y = (bf16*)(F.ws + WS_Y); float* HF = (float*)(F.ws + WS_XN);
    const int gw = F.vcu * NWAVES + F.wave, NGW = F.G * NWAVES; const int lane = F.lane;
    for (int it = gw; it < 160; it += NGW) {
        const int s = it >> 2, n = it & 3; const bool lat = s >= 32; const int T = lat ? 2048 : 256; const int row0 = lat ? MC + (s - 32) * 2048 : s * 256;
        const int c = n * 64 + lane;
        float cw[4];
#pragma unroll
        for (int j = 0; j < 4; ++j) cw[j] = INP(A, I_CCW)[(l * 4 + j) * 256 + c];
        const float cb = INP(A, I_CCB)[l * 256 + c];
        for (int dir = 0; dir < 2; ++dir) {
            float Wr[64], Wi[64];
            const float* wr_ = INP(A, I_RGW) + ((size_t)(((l * 2 + dir) * 2 + 0) * 4 + n) * 64) * 64 + lane; const float* wi_ = INP(A, I_RGW) + ((size_t)(((l * 2 + dir) * 2 + 1) * 4 + n) * 64) * 64 + lane;
#pragma unroll
            for (int j = 0; j < 64; ++j) { Wr[j] = wr_[j * 64]; Wi[j] = wi_[j * 64]; }
            const float br = INP(A, I_RGB)[((l * 2 + dir) * 2 + 0) * 256 + c], bi = INP(A, I_RGB)[((l * 2 + dir) * 2 + 1) * 256 + c];
            const float lamv = INP(A, I_RGLAM)[(l * 2 + dir) * 256 + c]; const float sp = log1pf(expf(-lamv));
            float h = lat ? INP(A, I_ST)[(((s - 32) * 2 + l) * 2 + dir) * 256 + c] : 0.f;
            for (int step = 0; step < T; ++step) {
                const int t = dir ? T - 1 - step : step;
                float xc = cb;
#pragma unroll
                for (int j = 0; j < 4; ++j) { const int tt = t + j - 2; if (tt >= 0 && tt < T) xc += cw[j] * bf2f(Z[(size_t)(row0 + tt) * DIN + 1536 + c]); }
                float g0 = br, g1 = bi;
#pragma unroll
                for (int j = 0; j < 64; ++j) { const float xj = shidx(xc, j); g0 += xj * Wr[j]; g1 += xj * Wi[j]; }
                const float rr = 1.0f / (1.0f + expf(-g0)), ii = 1.0f / (1.0f + expf(-g1));
                const float la = -8.0f * rr * sp; const float a = expf(la); const float bb = sqrtf(-expm1f(2.0f * la)) * ii * xc;
                h = a * h + bb;
                const size_t hidx = (size_t)(row0 + t) * 256 + c;
                if (dir == 0) HF[hidx] = h;
                else { const float hf = HF[hidx]; const float gr = bf2f(Z[(size_t)(row0 + t) * DIN + 1792 + c]); Y[(size_t)(row0 + t) * D + 512 + c] = (bf16)f2bf((hf + h) * gelu_tanh(gr)); }
            }
            if (!lat) F.out[OUT_ST + (size_t)((s * 2 + l) * 2 + dir) * 256 + c] = h;
        }
    }
}
__device__ __forceinline__ void mix_pool_naive(Frame& F, const Args& A, int l) {
    PHASE_IDS(F);
    const bf16* Z = (const bf16*)(F.ws + WS_Z); bf16* Y = (bf16*)(F.ws + WS_Y);
    const int gw = F.vcu * NWAVES + F.wave, NGW = F.G * NWAVES; const int lane = F.lane;
    for (int it = gw; it < M * 4; it += NGW) {
        const int r = it >> 2, g = it & 3; const bool lat = r >= MC; const int T = lat ? 2048 : 256; const int t = lat ? ((r - MC) & 2047) : (r & 255);
        const int win = 2 << g, left = win >> 1, right = win - 1 - left; const int lo = max(t - left, 0), hi = min(t + right, T - 1);
        const bf16* zc = Z + (size_t)(r - t) * DIN + 2048 + g * 64 + lane;
        float s = 0.f; for (int tt = lo; tt <= hi; ++tt) s += bf2f(zc[(size_t)tt * DIN]);
        const float p = s / (float)(hi - lo + 1) - bf2f(zc[(size_t)t * DIN]);
        const float* pw = INP(A, I_POOLW) + (size_t)(l * 4 + g) * 4096 + lane; float acc = 0.f;
#pragma unroll 8
        for (int j = 0; j < 64; ++j) acc += shidx(p, j) * pw[j * 64];
        Y[(size_t)r * D + 768 + g * 64 + lane] = (bf16)f2bf(acc * INP(A, I_POOLS)[l * 256 + g * 64 + lane]);
    }
}


typedef short bf16x8_t __attribute__((ext_vector_type(8)));
typedef float f32x16 __attribute__((ext_vector_type(16)));
typedef short v4i16_t __attribute__((ext_vector_type(4)));
__device__ __forceinline__ unsigned cvtpk(float lo, float hi) { unsigned r; asm volatile("v_cvt_pk_bf16_f32 %0, %1, %2" : "=v"(r) : "v"(lo), "v"(hi)); return r; }
__device__ __forceinline__ bf16x8_t pack8(float a0, float a1, float a2, float a3, float a4, float a5, float a6, float a7) {
    v4u w; w.x = cvtpk(a0, a1); w.y = cvtpk(a2, a3); w.z = cvtpk(a4, a5); w.w = cvtpk(a6, a7); return __builtin_bit_cast(bf16x8_t, w); }
__device__ __forceinline__ v4i16_t lds_tr(LAS unsigned char* p) { return __builtin_amdgcn_ds_read_tr16_b64_v4i16((LAS v4i16_t*)p); }
#define MFMA32(a, b, c) __builtin_amdgcn_mfma_f32_32x32x16_bf16((a), (b), (c), 0, 0, 0)

__device__ __forceinline__ void attn_unit(Frame& F, const Args& A, int l, bool lat, int seq, int hd, int qb, float lam, float sub_mul) {
    LAS unsigned char* L = F.lds;
    const bf16* Z = (const bf16*)(F.ws + WS_Z); bf16* Y = (bf16*)(F.ws + WS_Y);
    const bf16* CK = (const bf16*)(F.ws + WS_CK); const bf16* CV = (const bf16*)(F.ws + WS_CV);
    const int tid = F.tid, lane = F.lane, w = F.wave, r32 = lane & 31, h = lane >> 5;
    const int zrow0 = lat ? MC + seq * 2048 : seq * 256;
    const int qrow = zrow0 + qb * 256 + w * 32 + r32;
    bf16x8_t qf[2][2];
#pragma unroll
    for (int s = 0; s < 2; ++s)
#pragma unroll
        for (int ks = 0; ks < 2; ++ks) qf[s][ks] = *(const bf16x8_t*)(Z + (size_t)qrow * DIN + hd * 64 + s * 32 + ks * 16 + h * 8);
    const int NT = lat ? 36 : 4;
    const int srow = tid >> 3, sch = tid & 7;
    const size_t cbase = ((size_t)((seq * 2 + l) * 4 + hd) * 256 + srow) * 64 + sch * 8;
    const size_t zbase = (size_t)(zrow0 + srow) * DIN + 256 + hd * 64 + sch * 8;
    const unsigned kdst = srow * 128 + ((sch ^ ((srow >> 1) & 7)) << 4), vdst = 16384 + srow * 128 + ((sch ^ (((srow >> 1) & 1) << 2)) << 4);
    unsigned koff[2][2];
#pragma unroll
    for (int s = 0; s < 2; ++s)
#pragma unroll
        for (int ks = 0; ks < 2; ++ks) koff[s][ks] = r32 * 128 + (((s * 4 + ks * 2 + h) ^ ((r32 >> 1) & 7)) << 4);
    const int q_ = (lane & 15) >> 2, p_ = lane & 3, g1 = (lane >> 4) & 1, sw = (lane >> 3) & 1;
    const unsigned vb0 = 16384 + (4 * h + q_) * 128 + (((2 * g1 + (p_ >> 1)) ^ (sw << 2)) << 4) + (p_ & 1) * 8;
    const unsigned vb1 = 16384 + (4 * h + q_) * 128 + (((4 + 2 * g1 + (p_ >> 1)) ^ (sw << 2)) << 4) + (p_ & 1) * 8;
    v4u kreg, vreg;
    { const bool c0 = lat; kreg = c0 ? *(const v4u*)(CK + cbase) : *(const v4u*)(Z + zbase); vreg = c0 ? *(const v4u*)(CV + cbase) : *(const v4u*)(Z + zbase + 256); }
    float m[2] = {-1e30f, -1e30f}, ls[2] = {0.f, 0.f};
    f32x16 o[2][2];
#pragma unroll
    for (int s = 0; s < 2; ++s)
#pragma unroll
        for (int db = 0; db < 2; ++db)
#pragma unroll
            for (int r = 0; r < 16; ++r) o[s][db][r] = 0.f;
    for (int t = 0; t < NT; ++t) {
        const unsigned bo = (t & 1) * 8192;
        *(LAS v4u*)(L + bo + kdst) = kreg; *(LAS v4u*)(L + bo + vdst) = vreg;
        __syncthreads();
        if (t + 1 < NT) { const int tn = t + 1;
            if (lat && tn < 4) { kreg = *(const v4u*)(CK + cbase + (size_t)tn * 4096); vreg = *(const v4u*)(CV + cbase + (size_t)tn * 4096); }
            else { const size_t zo = zbase + (size_t)(tn - (lat ? 4 : 0)) * 64 * DIN; kreg = *(const v4u*)(Z + zo); vreg = *(const v4u*)(Z + zo + 256); } }
#pragma unroll
        for (int s = 0; s < 2; ++s) {
            f32x16 p0, p1;
#pragma unroll
            for (int r = 0; r < 16; ++r) { p0[r] = 0.f; p1[r] = 0.f; }
#pragma unroll
            for (int ks = 0; ks < 2; ++ks) { const bf16x8_t k0 = *(const LAS bf16x8_t*)(L + bo + koff[s][ks]); const bf16x8_t k1 = *(const LAS bf16x8_t*)(L + bo + koff[s][ks] + 4096);
                p0 = MFMA32(k0, qf[s][ks], p0); p1 = MFMA32(k1, qf[s][ks], p1); }
            float mt = fmaxf(p0[0], p1[0]);
#pragma unroll
            for (int r = 1; r < 16; ++r) mt = fmaxf(mt, fmaxf(p0[r], p1[r]));
            mt = fmaxf(mt, shx(mt, 32, lane));
            const float mn = fmaxf(m[s], mt); const float al = __builtin_amdgcn_exp2f(m[s] - mn); m[s] = mn;
            float rs = 0.f;
#pragma unroll
            for (int r = 0; r < 16; ++r) { p0[r] = __builtin_amdgcn_exp2f(p0[r] - mn); p1[r] = __builtin_amdgcn_exp2f(p1[r] - mn); rs += p0[r] + p1[r]; }
            ls[s] = ls[s] * al + rs;
#pragma unroll
            for (int db = 0; db < 2; ++db)
#pragma unroll
                for (int r = 0; r < 16; ++r) o[s][db][r] *= al;
            bf16x8_t pb[4];
            pb[0] = pack8(p0[0], p0[1], p0[2], p0[3], p0[4], p0[5], p0[6], p0[7]); pb[1] = pack8(p0[8], p0[9], p0[10], p0[11], p0[12], p0[13], p0[14], p0[15]);
            pb[2] = pack8(p1[0], p1[1], p1[2], p1[3], p1[4], p1[5], p1[6], p1[7]); pb[3] = pack8(p1[8], p1[9], p1[10], p1[11], p1[12], p1[13], p1[14], p1[15]);
#pragma unroll
            for (int db = 0; db < 2; ++db)
#pragma unroll
                for (int sp = 0; sp < 4; ++sp) { LAS unsigned char* vp = L + bo + (db ? vb1 : vb0) + sp * 2048;
                    const v4i16_t lo = lds_tr(vp), hi = lds_tr(vp + 1024);
                    const bf16x8_t vf = (bf16x8_t){lo[0], lo[1], lo[2], lo[3], hi[0], hi[1], hi[2], hi[3]};
                    o[s][db] = MFMA32(vf, pb[sp], o[s][db]); }
        }
    }
    const float l0 = ls[0] + shx(ls[0], 32, lane), l1 = ls[1] + shx(ls[1], 32, lane);
    const float i0 = 1.0f / l0, i1 = lam / l1;
    float ss = 0.f;
#pragma unroll
    for (int db = 0; db < 2; ++db)
#pragma unroll
        for (int r = 0; r < 16; ++r) { const float v = o[0][db][r] * i0 - o[1][db][r] * i1; o[0][db][r] = v; ss += v * v; }
    ss += shx(ss, 32, lane);
    const float rn = sub_mul / sqrtf(ss * (1.0f / 64.0f) + EPS);
    const float* subw = INP(A, I_SUBLN) + l * 64;
    bf16* yrow = Y + (size_t)qrow * D + hd * 64;
#pragma unroll
    for (int db = 0; db < 2; ++db)
#pragma unroll
        for (int g = 0; g < 4; ++g) { const int d0 = 32 * db + 8 * g + 4 * h; const f32x4 sw4 = *(const f32x4*)(subw + d0);
            v2u pk; pk.x = cvtpk(o[0][db][4 * g] * rn * sw4[0], o[0][db][4 * g + 1] * rn * sw4[1]); pk.y = cvtpk(o[0][db][4 * g + 2] * rn * sw4[2], o[0][db][4 * g + 3] * rn * sw4[3]);
            *(GAS v2u*)(yrow + d0) = pk; }
    __syncthreads();
}


__device__ __forceinline__ float sigm(float x) { return __builtin_amdgcn_rcpf(1.0f + __builtin_amdgcn_exp2f(-1.4426950408889634f * x)); }
template <int DIRB> __device__ __forceinline__ void grp_comp(const f32x16& a, const f32x16& b, int g, float& Ag, float& Bg) {
    const float a0 = a[4 * g], a1 = a[4 * g + 1], a2 = a[4 * g + 2], a3 = a[4 * g + 3], b0 = b[4 * g], b1 = b[4 * g + 1], b2 = b[4 * g + 2], b3 = b[4 * g + 3];
    Ag = (a0 * a1) * (a2 * a3);
    if (!DIRB) { float t = b0; t = a1 * t + b1; t = a2 * t + b2; t = a3 * t + b3; Bg = t; }
    else { float t = b3; t = a2 * t + b2; t = a1 * t + b1; t = a0 * t + b0; Bg = t; }
}
template <int DIRB> __device__ __forceinline__ void wave_comp(const f32x16& a, const f32x16& b, int h, int lane, float& Aw, float& Bw) {
    Aw = 1.f; Bw = 0.f;
#pragma unroll
    for (int gi = 0; gi < 4; ++gi) { const int g = DIRB ? 3 - gi : gi;
        float Ag, Bg; grp_comp<DIRB>(a, b, g, Ag, Bg);
        const float Ao = shx(Ag, 32, lane), Bo = shx(Bg, 32, lane);
        const float A0 = h ? Ao : Ag, B0 = h ? Bo : Bg, A1 = h ? Ag : Ao, B1 = h ? Bg : Bo;
        float Ap, Bp;
        if (!DIRB) { Ap = A0 * A1; Bp = A1 * B0 + B1; } else { Ap = A0 * A1; Bp = A0 * B1 + B0; }
        Bw = Ap * Bw + Bp; Aw *= Ap; }
}
template <int DIRB> __device__ __forceinline__ void scan_final(const f32x16& a, const f32x16& b, int h, int lane, float X, f32x16& hout) {
    float S = X;
#pragma unroll
    for (int gi = 0; gi < 4; ++gi) { const int g = DIRB ? 3 - gi : gi;
        float Ag, Bg; grp_comp<DIRB>(a, b, g, Ag, Bg);
        const float Ao = shx(Ag, 32, lane), Bo = shx(Bg, 32, lane);
        const float A0 = h ? Ao : Ag, B0 = h ? Bo : Bg, A1 = h ? Ag : Ao, B1 = h ? Bg : Bo;
        if (!DIRB) { float st = h ? (Ao * S + Bo) : S;
#pragma unroll
            for (int e = 0; e < 4; ++e) { st = a[4 * g + e] * st + b[4 * g + e]; hout[4 * g + e] = st; }
            S = A1 * (A0 * S + B0) + B1; }
        else { float st = h ? S : (Ao * S + Bo);
#pragma unroll
            for (int e = 3; e >= 0; --e) { st = a[4 * g + e] * st + b[4 * g + e]; hout[4 * g + e] = st; }
            S = A0 * (A1 * S + B1) + B0; } }
}
__device__ __forceinline__ void rglru_unit(Frame& F, const Args& A, int l, int mode, int seq, int n, int chunk) {
    const bf16* Z = (const bf16*)(F.ws + WS_Z); bf16* Y = (bf16*)(F.ws + WS_Y); const bf16* RGWT = (const bf16*)(F.ws + WS_RGWT);
    float* CARRY = (float*)(F.ws + WS_CARRY);
    const int lane = F.lane, w = F.wave, r32 = lane & 31, h = lane >> 5;
    const bool lat = mode != 0; const int T = lat ? 2048 : 256; const int row0 = lat ? MC + seq * 2048 : seq * 256; const int t0 = chunk * 256 + w * 32;
    LAS float* comp = (LAS float*)F.lds;
    bf16x8_t xa[4];
    { const int tk = t0 + r32; const float* cw = INP(A, I_CCW) + l * 4 * 256; const float* cb = INP(A, I_CCB) + l * 256;
#pragma unroll
      for (int ks = 0; ks < 4; ++ks) { const int c8 = n * 64 + 16 * ks + 8 * h;
          const f32x4 b0 = *(const f32x4*)(cb + c8), b1 = *(const f32x4*)(cb + c8 + 4);
          float x[8] = {b0[0], b0[1], b0[2], b0[3], b1[0], b1[1], b1[2], b1[3]};
#pragma unroll
          for (int j = 0; j < 4; ++j) { const int tt = tk + j - 2; const bool ok = tt >= 0 && tt < T; const int tc = ok ? tt : tk;
              const v4u z = *(const v4u*)(Z + (size_t)(row0 + tc) * DIN + 1536 + c8); const f32x4 w0 = *(const f32x4*)(cw + j * 256 + c8), w1 = *(const f32x4*)(cw + j * 256 + c8 + 4);
              const float k = ok ? 1.f : 0.f;
              x[0] += k * w0[0] * bflo(z.x); x[1] += k * w0[1] * bfhi(z.x); x[2] += k * w0[2] * bflo(z.y); x[3] += k * w0[3] * bfhi(z.y);
              x[4] += k * w1[0] * bflo(z.z); x[5] += k * w1[1] * bfhi(z.z); x[6] += k * w1[2] * bflo(z.w); x[7] += k * w1[3] * bfhi(z.w); }
          xa[ks] = pack8(x[0], x[1], x[2], x[3], x[4], x[5], x[6], x[7]); } }
    const int rwave0 = t0;
#pragma unroll 1
    for (int cb2 = 0; cb2 < 2; ++cb2) {
        const int cl = 32 * cb2 + r32, c = n * 64 + cl;
        f32x16 xcD;
#pragma unroll
        for (int r = 0; r < 16; ++r) xcD[r] = 0.f;
#pragma unroll
        for (int ks = 0; ks < 4; ++ks) { const bool hit = (cl >> 3) == (2 * ks + h); const int e = r32 & 7;
            bf16x8_t idf;
#pragma unroll
            for (int q = 0; q < 8; ++q) idf[q] = (hit && e == q) ? (short)0x3F80 : (short)0;
            xcD = MFMA32(xa[ks], idf, xcD); }
        f32x16 av[2], bv[2];
#pragma unroll
        for (int dir = 0; dir < 2; ++dir) {
            const bf16* wr_ = RGWT + (size_t)((((l * 2 + dir) * 2 + 0) * 4 + n) * 4096) + cl * 64 + 8 * h;
            const bf16* wi_ = wr_ + 4 * 4096;
            f32x16 gr, gi;
#pragma unroll
            for (int r = 0; r < 16; ++r) { gr[r] = 0.f; gi[r] = 0.f; }
#pragma unroll
            for (int ks = 0; ks < 4; ++ks) { const bf16x8_t br = *(const bf16x8_t*)(wr_ + 16 * ks), bi = *(const bf16x8_t*)(wi_ + 16 * ks);
                gr = MFMA32(xa[ks], br, gr); gi = MFMA32(xa[ks], bi, gi); }
            const float biasr = INP(A, I_RGB)[((l * 2 + dir) * 2 + 0) * 256 + c], biasi = INP(A, I_RGB)[((l * 2 + dir) * 2 + 1) * 256 + c];
            const float sp8 = 8.0f * 1.4426950408889634f * log1pf(expf(-INP(A, I_RGLAM)[(l * 2 + dir) * 256 + c]));
#pragma unroll
            for (int r = 0; r < 16; ++r) { const float rr = sigm(gr[r] + biasr), ii = sigm(gi[r] + biasi);
                const float a = __builtin_amdgcn_exp2f(-rr * sp8);
                av[dir][r] = a; bv[dir][r] = __builtin_amdgcn_sqrtf(fmaxf(1.0f - a * a, 0.f)) * ii * xcD[r]; }
        }
        { float Aw, Bw;
          wave_comp<0>(av[0], bv[0], h, lane, Aw, Bw); if (h == 0) { comp[((0 * 8 + w) * 32 + r32) * 2] = Aw; comp[((0 * 8 + w) * 32 + r32) * 2 + 1] = Bw; }
          wave_comp<1>(av[1], bv[1], h, lane, Aw, Bw); if (h == 0) { comp[((1 * 8 + w) * 32 + r32) * 2] = Aw; comp[((1 * 8 + w) * 32 + r32) * 2 + 1] = Bw; } }
        __syncthreads();
        if (w == 0 && mode != 2 && h == 0) {
            float Af = 1.f, Bf = 0.f, Ab = 1.f, Bb = 0.f;
            for (int ww = 0; ww < 8; ++ww) { const float a0 = comp[((0 * 8 + ww) * 32 + r32) * 2], b0 = comp[((0 * 8 + ww) * 32 + r32) * 2 + 1]; Bf = a0 * Bf + b0; Af *= a0; }
            for (int ww = 7; ww >= 0; --ww) { const float a1 = comp[((1 * 8 + ww) * 32 + r32) * 2], b1 = comp[((1 * 8 + ww) * 32 + r32) * 2 + 1]; Bb = a1 * Bb + b1; Ab *= a1; }
            if (mode == 1) { float* cp = CARRY + ((size_t)(((seq * 8 + chunk) * 4 + n) * 2) * 64 + cl) * 2; cp[0] = Af; cp[1] = Bf; cp[128] = Ab; cp[129] = Bb; }
            else { F.out[OUT_ST + (size_t)((seq * 2 + l) * 2 + 0) * 256 + c] = Bf; F.out[OUT_ST + (size_t)((seq * 2 + l) * 2 + 1) * 256 + c] = Bb; }
        }
        if (mode != 1) {
            float Xf = 0.f, Xb = 0.f;
            if (mode == 2) { Xf = INP(A, I_ST)[(size_t)((seq * 2 + l) * 2 + 0) * 256 + c]; Xb = INP(A, I_ST)[(size_t)((seq * 2 + l) * 2 + 1) * 256 + c];
                for (int cc = 0; cc < chunk; ++cc) { const float* cp = CARRY + ((size_t)(((seq * 8 + cc) * 4 + n) * 2) * 64 + cl) * 2; Xf = cp[0] * Xf + cp[1]; }
                for (int cc = 7; cc > chunk; --cc) { const float* cp = CARRY + ((size_t)(((seq * 8 + cc) * 4 + n) * 2 + 1) * 64 + cl) * 2; Xb = cp[0] * Xb + cp[1]; } }
            for (int ww = 0; ww < w; ++ww) Xf = comp[((0 * 8 + ww) * 32 + r32) * 2] * Xf + comp[((0 * 8 + ww) * 32 + r32) * 2 + 1];
            for (int ww = 7; ww > w; --ww) Xb = comp[((1 * 8 + ww) * 32 + r32) * 2] * Xb + comp[((1 * 8 + ww) * 32 + r32) * 2 + 1];
            f32x16 hf, hb;
            scan_final<0>(av[0], bv[0], h, lane, Xf, hf); scan_final<1>(av[1], bv[1], h, lane, Xb, hb);
#pragma unroll
            for (int r = 0; r < 16; ++r) { const int tok = rwave0 + (r & 3) + 8 * (r >> 2) + 4 * h; const size_t row = (size_t)(row0 + tok);
                const float g = bf2f(Z[row * DIN + 1792 + c]); const float u2 = 2.0f * 0.7978845608028654f * (g + 0.044715f * g * g * g);
                Y[row * D + 512 + c] = (bf16)f2bf((hf[r] + hb[r]) * g * sigm(u2)); }
        }
        __syncthreads();
    }
}

constexpr int PH_PER_LAYER = 10, NPHASE = 1 + 2 * PH_PER_LAYER + 1;
__global__ void __launch_bounds__(NWAVES * 64, 2) fwd_kernel(Args args) {
    extern __shared__ __attribute__((aligned(16))) unsigned char lds[];
    Frame F;
    F.lds = (LAS unsigned char*)lds; F.lds0 = F.lds; F.tid = threadIdx.x; F.lane = F.tid & 63; F.wave = __builtin_amdgcn_readfirstlane(F.tid >> 6);
    F.G = gridDim.x; { const int bx = blockIdx.x; F.vcu = (F.G % 8 == 0) ? (bx % 8) * (F.G / 8) + bx / 8 : bx; }
    F.out = args.out; F.ws = args.ws; F.out0 = args.out; F.ws0 = args.ws;
    volatile LAS unsigned* MISC = (volatile LAS unsigned*)(F.lds + MISC_OFF);
    for (int u = F.tid; u < (LDS_BYTES - LDSCTL_OFF) / 4; u += NWAVES * 64) ((LAS unsigned*)(F.lds + LDSCTL_OFF))[u] = 0u;
    __syncthreads();
    if (F.tid < 25) { const unsigned long long pv = (unsigned long long)args.in[F.tid]; ((LAS unsigned*)(F.lds + LDSCTL_OFF))[2 * F.tid] = (unsigned)pv; ((LAS unsigned*)(F.lds + LDSCTL_OFF))[2 * F.tid + 1] = (unsigned)(pv >> 32); }
    __syncthreads();
    XcdBarrier bar; bar.bar = (unsigned*)(args.ws + WS_CTL) + CW_BAR; bar.x = 0; bar.st = nullptr;
#if !MK_PER_PHASE
    bar = xcd_barrier_post((unsigned*)(args.ws + WS_CTL) + CW_BAR, MISC + 8);
#endif
#if MK_PER_PHASE
    const int lo = args.ph_lo, hi = args.ph_hi;
#define IN(k) (lo <= (k) && (k) < hi)
#define SEAM(k) do { } while (0)
#else
#define IN(k) true
#define SEAM(k) xcd_barrier(bar)
#endif
    if (IN(0)) { p0_prologue(F, args); } SEAM(0);

    for (int l = 0; l < 2; ++l) {
        const int pb = 1 + l * PH_PER_LAYER;
        if (IN(pb + 0)) { PHASE_IDS(F); const float* modl = (const float*)(F.ws + WS_MOD) + (size_t)l * 9 * 6144;
            const float* xin_c = l == 0 ? INP(args, I_XP) : F.out; const float* xin_l = l == 0 ? INP(args, I_XS) - (size_t)MC * D : F.out;
            norm_mod_phase(F, xin_c, xin_l, INP(args, I_NORMW) + (size_t)(l * 2 + 0) * D, modl, 0, 1024); } SEAM(pb + 0);
        if (IN(pb + 1)) { PHASE_IDS(F);
            pg8::Gemm g{(const bf16*)(F.ws + WS_XN), (const bf16*)(F.ws + WS_WIN) + (size_t)l * DIN * D, M, DIN, D}; pg8::StaticOrder S; S.init(M, DIN, F.G, (int)blockIdx.x);
            pg8::EpiIn E{(bf16*)(F.ws + WS_Z), (const float*)(F.ws + WS_ROPE), F.out + OUT_CK, F.out + OUT_CV, l};
            pg8::gemm_phase<pg8::EpiIn, pg8::StaticOrder, true, true>(F.lds, g, S, E);
        } SEAM(pb + 1);
        for (int sp = 0; sp < 2; ++sp) {
            if (IN(pb + 2 + sp)) {
                PHASE_IDS(F); const float lam = ((const float*)(F.ws + WS_LAM))[l]; const float sub_mul = 1.0f - (0.8f - 0.6f * expf(-0.3f * (float)l));
                for (int u = F.vcu; u < 512; u += F.G) {
                    const bool is_attn = sp == 0 ? (u >= 384) : (u < 256);
                    if (is_attn) { const bool ulat = sp == 1; const int v = ulat ? u : u - 384;
                        attn_unit(F, args, l, ulat, ulat ? (v >> 5) : (v >> 2), ulat ? ((v >> 3) & 3) : (v & 3), ulat ? (v & 7) : 0, lam, sub_mul); }
                    else { const int mode = sp == 1 ? 2 : (u < 256 ? 1 : 0); const int v = sp == 1 ? u - 256 : (u < 256 ? u : u - 256);
                        rglru_unit(F, args, l, mode, mode == 0 ? (v >> 2) : (v >> 5), mode == 0 ? (v & 3) : ((v >> 3) & 3), mode == 0 ? 0 : (v & 7)); } }
                if (sp == 0) { mix_conv_naive(F, args, l); mix_pool_naive(F, args, l); }
            } SEAM(pb + 2 + sp);
        }
        if (IN(pb + 4)) { PHASE_IDS(F); const float* modl = (const float*)(F.ws + WS_MOD) + (size_t)l * 9 * 6144;
            const float* xin_c = l == 0 ? INP(args, I_XP) : F.out; const float* xin_l = l == 0 ? INP(args, I_XS) - (size_t)MC * D : F.out;
            pg8::Gemm g{(const bf16*)(F.ws + WS_Y), (const bf16*)(F.ws + WS_WOUT) + (size_t)l * D * D, M, D, D}; pg8::StaticOrder S; S.init(M, D, F.G, (int)blockIdx.x);
            pg8::EpiGateRes E{xin_c, xin_l, F.out, modl + 2048, 0};
            pg8::gemm_phase<pg8::EpiGateRes, pg8::StaticOrder, true, true>(F.lds, g, S, E);
        } SEAM(pb + 4);
        if (IN(pb + 5)) { PHASE_IDS(F); const float* modl = (const float*)(F.ws + WS_MOD) + (size_t)l * 9 * 6144;
            norm_mod_phase(F, F.out, F.out, INP(args, I_NORMW) + (size_t)(l * 2 + 1) * D, modl, 3072, 4096); } SEAM(pb + 5);
        for (int hf = 0; hf < 2; ++hf) {
            if (IN(pb + 6 + 2 * hf)) { PHASE_IDS(F);
                pg8::Gemm g{(const bf16*)(F.ws + WS_XN) + (size_t)hf * MH * D, (const bf16*)(F.ws + WS_W1) + (size_t)l * DFF * D, MH, DFF, D}; pg8::StaticOrder S; S.init(MH, DFF, F.G, (int)blockIdx.x);
                pg8::EpiRelu2 E{(bf16*)(F.ws + WS_Z)};
                pg8::gemm_phase<pg8::EpiRelu2, pg8::StaticOrder, true, true>(F.lds, g, S, E);
            } SEAM(pb + 6 + 2 * hf);
            if (IN(pb + 7 + 2 * hf)) { PHASE_IDS(F); const float* modl = (const float*)(F.ws + WS_MOD) + (size_t)l * 9 * 6144;
                pg8::Gemm g{(const bf16*)(F.ws + WS_Z), (const bf16*)(F.ws + WS_W2) + (size_t)l * D * DFF, MH, D, DFF}; pg8::StaticOrder S; S.init(MH, D, F.G, (int)blockIdx.x);
                pg8::EpiGateRes E{F.out, F.out, F.out, modl + 5120, hf * MH};
                pg8::gemm_phase<pg8::EpiGateRes, pg8::StaticOrder, true, true>(F.lds, g, S, E);
            } SEAM(pb + 7 + 2 * hf);
        }
    }
    if (IN(NPHASE - 1)) { final_norm_phase(F, args); }
#undef IN
#undef SEAM
}

extern "C" void kernel_launch(void* const* d_in, const int* in_sizes, int n_in, void* d_out, int out_size, void* d_ws, size_t ws_size, hipStream_t stream) {
    static int grid = 0;
    if (grid == 0) {
        if (n_in != 25 || out_size != (int)(OUT_ST + 32 * 2 * 2 * 256) || ws_size < WS_END) { fprintf(stderr, "kernel_launch: unexpected shapes (n_in %d out %d ws %zu)\n", n_in, out_size, ws_size); grid = -1; return; }
        int dev = 0, cus = 0;
        if (hipGetDevice(&dev) != hipSuccess || hipDeviceGetAttribute(&cus, hipDeviceAttributeMultiprocessorCount, dev) != hipSuccess) { grid = -1; return; }
        if (hipFuncSetAttribute((const void*)fwd_kernel, hipFuncAttributeMaxDynamicSharedMemorySize, LDS_BYTES) != hipSuccess) { fprintf(stderr, "kernel_launch: hipFuncSetAttribute failed\n"); grid = -1; return; }
        int per_cu = 0;
        if (hipOccupancyMaxActiveBlocksPerMultiprocessor(&per_cu, (const void*)fwd_kernel, NWAVES * 64, LDS_BYTES) != hipSuccess || per_cu < 1) fprintf(stderr, "kernel_launch: occupancy query says %d\n", per_cu);
        (void)hipGetLastError();
        grid = cus;
    }
    if (grid < 0) return;
    (void)hipMemsetAsync((char*)d_ws + WS_CTL, 0, CTL_ZERO_BYTES, stream);
    Args a{};
    for (int i = 0; i < 25; ++i) a.in[i] = (const float*)d_in[i];
    a.out = (float*)d_out; a.ws = (unsigned char*)d_ws;
#if MK_PER_PHASE
    for (int p = 0; p < NPHASE; ++p) { a.ph_lo = p; a.ph_hi = p + 1; hipLaunchKernelGGL(fwd_kernel, dim3(grid), dim3(NWAVES * 64), LDS_BYTES, stream, a); }
#else
    a.ph_lo = 0; a.ph_hi = NPHASE; hipLaunchKernelGGL(fwd_kernel, dim3(grid), dim3(NWAVES * 64), LDS_BYTES, stream, a);
#endif
}
```

```cpp
#include <hip/hip_runtime.h>
#include <cstdio>
#include <cstdint>

#ifndef MK_PER_PHASE
#define MK_PER_PHASE 0
#endif


__device__ __forceinline__ float shx(float v, int mask, int lane) { return __builtin_bit_cast(float, __builtin_amdgcn_ds_bpermute((lane ^ mask) << 2, __builtin_bit_cast(int, v))); }
__device__ __forceinline__ float shidx(float v, int src) { return __builtin_bit_cast(float, __builtin_amdgcn_ds_bpermute(src << 2, __builtin_bit_cast(int, v))); }

namespace pg8 {
#define PG8_LAS __attribute__((address_space(3)))
typedef unsigned short bf16_t;
typedef short bf16x8 __attribute__((ext_vector_type(8)));
typedef float f32x4 __attribute__((ext_vector_type(4)));
typedef unsigned u32x4 __attribute__((ext_vector_type(4)));
constexpr int BM = 256, BK = 64, HALF = 128, HTB = HALF * BK * 2, STAGE_BYTES = 8 * HTB, NXCD = 8, WGM = 8;

__host__ __device__ __forceinline__ int lds_byte(int r, int c) { const int st = (r >> 4) * 2 + (c >> 5), rr = r & 15, cc = c & 31, ob = rr * 64 + cc * 2; return st * 1024 + (ob ^ (((ob >> 9) & 1) << 5)); }
__host__ __device__ __forceinline__ void stage_rc(int b, int& R, int& C) { const int st = b / 1024, sb = b % 1024, swz = sb ^ (((sb >> 9) & 1) << 5); R = (st >> 1) * 16 + swz / 64; C = (st & 1) * 32 + (swz % 64) / 2; }
__host__ __device__ __forceinline__ int perm32(int rho) { const int n = rho >> 4, i = rho & 15; return 8 * (i >> 2) + 4 * n + (i & 3); }

struct Unit { int pm, pn; };
struct Gemm { const bf16_t* A; const bf16_t* Bt; int M, N, K; };

struct StaticOrder {
    int nM, nN, nwg, G, c;
    __host__ __device__ void init(int M, int N, int G_, int c_) { nM = M / BM; nN = N / BM; nwg = nM * nN; G = G_; c = c_; }
    __host__ __device__ bool next(int i, Unit& u) const {
        const long L = (long)i * G + c; if (L >= nwg) return false;
        int wgid = (int)L; { const int q = nwg / NXCD, r = nwg % NXCD, xcd = wgid % NXCD, off = wgid / NXCD; wgid = (xcd < r ? xcd * (q + 1) : r * (q + 1) + (xcd - r) * q) + off; }
        const int nig = WGM * nN, gid = wgid / nig, fm = gid * WGM, gsz = (nM - fm) < WGM ? (nM - fm) : WGM;
        u.pm = fm + ((wgid % nig) % gsz); u.pn = (wgid % nig) / gsz; return true;
    }
    __device__ __forceinline__ void a_ready(const Unit&) const {}
    __device__ __forceinline__ void done(const Unit&) const {}
};

__device__ __forceinline__ unsigned cvt_pk_bf16(float lo, float hi) { unsigned r; asm volatile("v_cvt_pk_bf16_f32 %0, %1, %2" : "=v"(r) : "v"(lo), "v"(hi)); return r; }


struct EpiIn {
    static constexpr bool PERM = true, AFTER_DRAIN = false;
    bf16_t* Z; const float* rope; float* ck_out; float* cv_out; int layer;
    __device__ __forceinline__ void operator()(const f32x4 (&acc)[2][2][4][2], const Unit& u, int wr, int wc, int fr, int fq) const {
        const int pn = u.pn; const bool lat = u.pm >= 32; const bool dorope = lat && pn <= 1;
        const int row0 = u.pm * BM + wr * 64 + fr; const int colw = wc * 32 + 8 * fq;
        const float qs = (pn == 0) ? 0.25503486f : 1.0f;
#pragma unroll
        for (int ai = 0; ai < 2; ++ai)
#pragma unroll
            for (int m = 0; m < 4; ++m) {
                const int row = row0 + ai * HALF + m * 16;
                f32x4 cs[4];
                if (dorope) { const int t = (row - 8192) & 2047; const int pos = (fq >> 1) ? (t & 63) : (t >> 6); const f32x4* rp = (const f32x4*)(rope + pos * 16);
#pragma unroll
                    for (int e = 0; e < 4; ++e) cs[e] = rp[e]; }
#pragma unroll
                for (int bj = 0; bj < 2; ++bj) {
                    float v[8];
#pragma unroll
                    for (int e = 0; e < 4; ++e) { v[e] = acc[ai][bj][m][0][e]; v[4 + e] = acc[ai][bj][m][1][e]; }
                    if (dorope) {
#pragma unroll
                        for (int e = 0; e < 8; ++e) { const float pr = shx(v[e], 16, fr + 16 * fq); const float c = cs[e >> 1][(e & 1) * 2], s = cs[e >> 1][(e & 1) * 2 + 1];
                            v[e] = (fq & 1) ? (v[e] * c + pr * s) : (v[e] * c - pr * s); }
                    }
                    if (!lat && (pn == 1 || pn == 2)) {
                        float* co = (pn == 1) ? ck_out : cv_out; const int b = row >> 8, t = row & 255; const int cc = bj * HALF + colw; const int hd = cc >> 6, d = cc & 63;
                        float* op = co + ((size_t)((b * 2 + layer) * 4 + hd) * 256 + t) * 64 + d;
                        *(f32x4*)op = (f32x4){v[0], v[1], v[2], v[3]}; *(f32x4*)(op + 4) = (f32x4){v[4], v[5], v[6], v[7]};
                    }
                    u32x4 w; w.x = cvt_pk_bf16(v[0] * qs, v[1] * qs); w.y = cvt_pk_bf16(v[2] * qs, v[3] * qs); w.z = cvt_pk_bf16(v[4] * qs, v[5] * qs); w.w = cvt_pk_bf16(v[6] * qs, v[7] * qs);
                    *(u32x4*)(Z + (size_t)row * 2304 + pn * BM + bj * HALF + colw) = w;
                }
            }
    }
};
struct EpiGateRes {
    static constexpr bool PERM = false, AFTER_DRAIN = false;
    const float* res_c; const float* res_l; float* out; const float* gate; int rowbase;
    __device__ __forceinline__ void operator()(const f32x4 (&acc)[2][2][4][2], const Unit& u, int wr, int wc, int fr, int fq) const {
        const int grow0 = rowbase + u.pm * BM; const int mi = grow0 < 8192 ? 0 : 1 + ((grow0 - 8192) >> 11);
        const float* res = grow0 < 8192 ? res_c : res_l;
        const int row0 = grow0 + wr * 64 + fr, col0 = u.pn * BM + wc * 32 + 4 * fq;
        f32x4 gv[2][2];
#pragma unroll
        for (int bj = 0; bj < 2; ++bj)
#pragma unroll
            for (int n = 0; n < 2; ++n) gv[bj][n] = *(const f32x4*)(gate + (size_t)mi * 6144 + col0 + bj * HALF + n * 16);
#pragma unroll
        for (int ai = 0; ai < 2; ++ai)
#pragma unroll
            for (int m = 0; m < 4; ++m) { const size_t off = (size_t)(row0 + ai * HALF + m * 16) * 1024 + col0;
#pragma unroll
                for (int bj = 0; bj < 2; ++bj)
#pragma unroll
                    for (int n = 0; n < 2; ++n) { const f32x4 r = *(const f32x4*)(res + off + bj * HALF + n * 16); *(f32x4*)(out + off + bj * HALF + n * 16) = r + gv[bj][n] * acc[ai][bj][m][n]; } }
    }
};
struct EpiRelu2 {
    static constexpr bool PERM = true, AFTER_DRAIN = false;
    bf16_t* H;
    __device__ __forceinline__ void operator()(const f32x4 (&acc)[2][2][4][2], const Unit& u, int wr, int wc, int fr, int fq) const {
        const int row0 = u.pm * BM + wr * 64 + fr; const int col0 = u.pn * BM + wc * 32 + 8 * fq;
#pragma unroll
        for (int ai = 0; ai < 2; ++ai)
#pragma unroll
            for (int m = 0; m < 4; ++m) { bf16_t* rowp = H + (size_t)(row0 + ai * HALF + m * 16) * 4096 + col0;
#pragma unroll
                for (int bj = 0; bj < 2; ++bj) { f32x4 v0 = acc[ai][bj][m][0], v1 = acc[ai][bj][m][1];
#pragma unroll
                    for (int e = 0; e < 4; ++e) { const float a = fmaxf(v0[e], 0.f), b = fmaxf(v1[e], 0.f); v0[e] = a * a; v1[e] = b * b; }
                    u32x4 w; w.x = cvt_pk_bf16(v0[0], v0[1]); w.y = cvt_pk_bf16(v0[2], v0[3]); w.z = cvt_pk_bf16(v1[0], v1[1]); w.w = cvt_pk_bf16(v1[2], v1[3]);
                    *(u32x4*)(rowp + bj * HALF) = w; } }
    }
};

template <class Epi, class Sched, bool ALIGN_EPI = false, bool SP2 = false>
__device__ __forceinline__ void gemm_phase(PG8_LAS unsigned char* lds, const Gemm g, const Sched& S, const Epi& E, int wave_id) {
    int tid; asm volatile("v_mbcnt_lo_u32_b32 %0, -1, 0\n\tv_mbcnt_hi_u32_b32 %0, -1, %0" : "=v"(tid)); tid += wave_id * 64;
    const int wid = __builtin_amdgcn_readfirstlane(tid >> 6), lane = tid & 63, wr = wid >> 2, wc = wid & 3, fr = lane & 15, fq = lane >> 4;
    const int K = g.K, nt = K / BK;
    unsigned voffA[2], voffB[2];
#pragma unroll
    for (int i = 0; i < 2; ++i) { int R, C; stage_rc(tid * 16 + i * 8192, R, C); const int Rb = Epi::PERM ? ((R & ~31) + perm32(R & 31)) : R;
        voffA[i] = (unsigned)(R * K + C) * 2u; voffB[i] = (unsigned)(Rb * K + C) * 2u; }
    const size_t kstep = (size_t)(BK * 2);
    const size_t hstep = (size_t)HALF * K * 2;
    const size_t tstep = 2 * hstep;
    const unsigned ldsw = (unsigned)wid * 1024u;
    const int aoff = lds_byte(wr * 64 + fr, fq * 8), boff = lds_byte(wc * 32 + fr, fq * 8);
#define PG8_SA(b, h) (((b) * 2 + (h)) * HTB)
#define PG8_SB(b, h) ((4 + (b) * 2 + (h)) * HTB)
#define PG8_STAGE(bufoff, gbase, voff) do { _Pragma("unroll") for (int _i = 0; _i < 2; ++_i) \
        __builtin_amdgcn_global_load_lds((const unsigned*)((const char*)(gbase) + (voff)[_i]), (PG8_LAS unsigned*)(lds + (bufoff) + ldsw + _i * 8192), 16, 0, 0); } while (0)
#define PG8_LDA(dst, b, h) do { _Pragma("unroll") for (int m = 0; m < 4; ++m) _Pragma("unroll") for (int k = 0; k < 2; ++k) dst[m][k] = *(const PG8_LAS bf16x8*)(lds + PG8_SA(b, h) + aoff + m * 2048 + k * 1024); } while (0)
#define PG8_LDB(dst, b, h) do { _Pragma("unroll") for (int n = 0; n < 2; ++n) _Pragma("unroll") for (int k = 0; k < 2; ++k) dst[n][k] = *(const PG8_LAS bf16x8*)(lds + PG8_SB(b, h) + boff + n * 2048 + k * 1024); } while (0)
#define PG8_MMA(ai, bj, At, Bt) do { __builtin_amdgcn_s_setprio(1); _Pragma("unroll") for (int m = 0; m < 4; ++m) _Pragma("unroll") for (int n = 0; n < 2; ++n) _Pragma("unroll") for (int k = 0; k < 2; ++k) \
        acc[ai][bj][m][n] = __builtin_amdgcn_mfma_f32_16x16x32_bf16(Bt[n][k], At[m][k], acc[ai][bj][m][n], 0, 0, 0); __builtin_amdgcn_s_setprio(0); } while (0)
#define PG8_WAIT_V(n) asm volatile("s_waitcnt vmcnt(" #n ")" ::: "memory")
#define PG8_WAIT_L(n) asm volatile("s_waitcnt lgkmcnt(" #n ")" ::: "memory")
#define PG8_BAR __builtin_amdgcn_s_barrier()
#define PG8_SCHED __builtin_amdgcn_sched_barrier(0)
    Unit cur, nxt; int ui = 0;
    if (!S.next(0, cur)) return;
    f32x4 acc[2][2][4][2];
#pragma unroll
    for (int a = 0; a < 2; ++a)
#pragma unroll
        for (int b = 0; b < 2; ++b)
#pragma unroll
            for (int m = 0; m < 4; ++m)
#pragma unroll
                for (int n = 0; n < 2; ++n) acc[a][b][m][n] = (f32x4){0.f, 0.f, 0.f, 0.f};
    bf16x8 At[4][2], B0[2][2], B1[2][2];
    const char* cA = (const char*)g.A + (size_t)cur.pm * tstep; const char* cB = (const char*)g.Bt + (size_t)cur.pn * tstep;
    S.a_ready(cur);
    if constexpr (SP2) {
        PG8_STAGE(PG8_SB(0, 0), cB, voffB); PG8_STAGE(PG8_SB(0, 1), cB + hstep, voffB); PG8_STAGE(PG8_SA(0, 0), cA, voffA); PG8_STAGE(PG8_SA(0, 1), cA + hstep, voffA);
        if (wr == 1) PG8_BAR;
        PG8_WAIT_V(2); PG8_BAR;
        PG8_STAGE(PG8_SB(1, 0), cB + kstep, voffB); PG8_STAGE(PG8_SA(1, 0), cA + kstep, voffA); PG8_STAGE(PG8_SB(1, 1), cB + hstep + kstep, voffB);
        PG8_WAIT_V(6); PG8_BAR;
    } else {
        PG8_STAGE(PG8_SB(0, 0), cB, voffB); PG8_STAGE(PG8_SA(0, 0), cA, voffA); PG8_STAGE(PG8_SB(0, 1), cB + hstep, voffB); PG8_STAGE(PG8_SA(0, 1), cA + hstep, voffA);
        if (wr == 1) PG8_BAR;
        PG8_WAIT_V(4); PG8_BAR;
        PG8_STAGE(PG8_SB(1, 0), cB + kstep, voffB); PG8_STAGE(PG8_SA(1, 0), cA + kstep, voffA); PG8_STAGE(PG8_SB(1, 1), cB + hstep + kstep, voffB);
        PG8_WAIT_V(6); PG8_BAR;
    }
    for (;;) {
        const bool has_next = S.next(ui + 1, nxt);
        const char* nA = has_next ? (const char*)g.A + (size_t)nxt.pm * tstep : cA; const char* nB = has_next ? (const char*)g.Bt + (size_t)nxt.pn * tstep : cB;
        for (int t = 0; t < nt; t += 2) {
            const bool last = (t == nt - 2);
            const char* a1 = cA + (size_t)(t + 1) * kstep;
            const char* a2 = last ? nA : cA + (size_t)(t + 2) * kstep; const char* b2 = last ? nB : cB + (size_t)(t + 2) * kstep;
            const char* a3 = a2 + kstep; const char* b3 = b2 + kstep;
            if (last && has_next) S.a_ready(nxt);
            if constexpr (SP2) {
            PG8_LDB(B0, 0, 0); PG8_LDB(B1, 0, 1); PG8_SCHED; PG8_LDA(At, 0, 0); PG8_STAGE(PG8_SA(1, 1), a1 + hstep, voffA);
            PG8_WAIT_V(8); PG8_WAIT_L(0); PG8_BAR; PG8_MMA(0, 0, At, B0); PG8_MMA(0, 1, At, B1); PG8_BAR; PG8_SCHED;
            PG8_LDA(At, 0, 1); PG8_STAGE(PG8_SB(0, 0), b2, voffB); PG8_STAGE(PG8_SB(0, 1), b2 + hstep, voffB); PG8_STAGE(PG8_SA(0, 0), a2, voffA);
            PG8_WAIT_V(8); PG8_WAIT_L(0); PG8_BAR; PG8_MMA(1, 0, At, B0); PG8_MMA(1, 1, At, B1); PG8_BAR; PG8_SCHED;
            PG8_LDB(B0, 1, 0); PG8_LDB(B1, 1, 1); PG8_SCHED; PG8_LDA(At, 1, 0); PG8_STAGE(PG8_SA(0, 1), a2 + hstep, voffA);
            PG8_WAIT_V(8); PG8_WAIT_L(0); PG8_BAR; PG8_MMA(0, 0, At, B0); PG8_MMA(0, 1, At, B1); PG8_BAR; PG8_SCHED;
            PG8_LDA(At, 1, 1); PG8_STAGE(PG8_SB(1, 0), b3, voffB); PG8_STAGE(PG8_SB(1, 1), b3 + hstep, voffB); PG8_STAGE(PG8_SA(1, 0), a3, voffA);
            PG8_WAIT_V(8); PG8_WAIT_L(0); PG8_BAR; PG8_MMA(1, 0, At, B0); PG8_MMA(1, 1, At, B1); PG8_BAR; PG8_SCHED;
            } else {
            PG8_LDB(B0, 0, 0); PG8_SCHED; PG8_LDA(At, 0, 0); PG8_STAGE(PG8_SA(1, 1), a1 + hstep, voffA);
            PG8_WAIT_L(8); PG8_BAR; PG8_WAIT_L(0); PG8_MMA(0, 0, At, B0); PG8_BAR; PG8_SCHED;
            PG8_LDB(B1, 0, 1); PG8_STAGE(PG8_SB(0, 0), b2, voffB);
            PG8_BAR; PG8_WAIT_L(0); PG8_MMA(0, 1, At, B1); PG8_BAR;
            PG8_LDA(At, 0, 1); PG8_STAGE(PG8_SA(0, 0), a2, voffA);
            PG8_BAR; PG8_WAIT_L(0); PG8_MMA(1, 0, At, B0); PG8_BAR; PG8_SCHED;
            PG8_STAGE(PG8_SB(0, 1), b2 + hstep, voffB);
            PG8_WAIT_V(6); PG8_BAR; PG8_MMA(1, 1, At, B1); PG8_BAR;
            PG8_LDB(B0, 1, 0); PG8_SCHED; PG8_LDA(At, 1, 0); PG8_STAGE(PG8_SA(0, 1), a2 + hstep, voffA);
            PG8_WAIT_L(8); PG8_BAR; PG8_WAIT_L(0); PG8_MMA(0, 0, At, B0); PG8_BAR; PG8_SCHED;
            PG8_LDB(B1, 1, 1); PG8_STAGE(PG8_SB(1, 0), b3, voffB);
            PG8_BAR; PG8_WAIT_L(0); PG8_MMA(0, 1, At, B1); PG8_BAR;
            PG8_LDA(At, 1, 1); PG8_STAGE(PG8_SA(1, 0), a3, voffA);
            PG8_BAR; PG8_WAIT_L(0); PG8_MMA(1, 0, At, B0); PG8_BAR; PG8_SCHED;
            PG8_STAGE(PG8_SB(1, 1), b3 + hstep, voffB);
            PG8_WAIT_V(6); PG8_BAR; PG8_MMA(1, 1, At, B1); PG8_BAR;
            }
        }
        if constexpr (ALIGN_EPI) { if (wr == 0) PG8_BAR; }
        if constexpr (!Epi::AFTER_DRAIN) { E(acc, cur, wr, wc, fr, fq); S.done(cur); }
        if (!has_next) break;
#pragma unroll
        for (int a = 0; a < 2; ++a)
#pragma unroll
            for (int b = 0; b < 2; ++b)
#pragma unroll
                for (int m = 0; m < 4; ++m)
#pragma unroll
                    for (int n = 0; n < 2; ++n) acc[a][b][m][n] = (f32x4){0.f, 0.f, 0.f, 0.f};
        cur = nxt; cA = nA; cB = nB; ++ui;
        if constexpr (ALIGN_EPI) { if (wr == 1) PG8_BAR; }
    }
    PG8_WAIT_V(0);
    if constexpr (!ALIGN_EPI) { if (wr == 0) PG8_BAR; }
    PG8_BAR;
#undef PG8_SA
#undef PG8_SB
#undef PG8_STAGE
#undef PG8_LDA
#undef PG8_LDB
#undef PG8_MMA
#undef PG8_WAIT_V
#undef PG8_WAIT_L
#undef PG8_BAR
#undef PG8_SCHED
}
}

constexpr int NWAVES = 8;
constexpr int D = 1024, MC = 8192, ML = 16384, M = MC + ML, DIN = 2304, DFF = 4096, DG = 256, MH = M / 2;
constexpr float EPS = 1e-6f;
constexpr size_t MiB = 1u << 20;
constexpr size_t WS_CTL = 0, CTL_ZERO_BYTES = 1 * MiB;
constexpr size_t WS_MOD = 1 * MiB;
constexpr size_t WS_ROPE = WS_MOD + 2 * 9 * 6144 * 4;
constexpr size_t WS_LAM = WS_ROPE + 64 * 16 * 4;
constexpr size_t WS_RGWT = WS_LAM + 256;
constexpr size_t WS_POOLT = WS_RGWT + 32 * 4096 * 2;
constexpr size_t WS_CARRY = WS_POOLT + 8 * 4096 * 2;
constexpr size_t WS_WIN = 2 * MiB;
constexpr size_t WS_WOUT = WS_WIN + 2ull * 2304 * 1024 * 2;
constexpr size_t WS_W1 = WS_WOUT + 2ull * 1024 * 1024 * 2;
constexpr size_t WS_W2 = WS_W1 + 2ull * 4096 * 1024 * 2;
constexpr size_t WS_CK = WS_W2 + 2ull * 4096 * 1024 * 2;
constexpr size_t WS_CV = WS_CK + 2 * MiB;
constexpr size_t WS_XN = 52 * MiB;
constexpr size_t WS_Y = 100 * MiB;
constexpr size_t WS_Z = 148 * MiB;
constexpr size_t WS_END = 256 * MiB;
static_assert(WS_CARRY + 8 * 8 * 4 * 2 * 64 * 2 * 4 <= WS_WIN && WS_CV + 2 * MiB <= WS_XN && WS_Z + (size_t)M * DIN * 2 <= WS_END, "d_ws map");
constexpr int CW_BAR = 4096;
constexpr size_t OUT_Y = 0, OUT_CK = (size_t)M * D, OUT_CV = OUT_CK + 32ull * 2 * 4 * 256 * 64, OUT_ST = OUT_CV + 32ull * 2 * 4 * 256 * 64;
constexpr int RING_BYTES = 131072, LDSCTL_OFF = RING_BYTES, MISC_OFF = LDSCTL_OFF + 320, LDS_BYTES = 147456;

#define GAS __attribute__((address_space(1)))
#define LAS __attribute__((address_space(3)))
typedef unsigned short bf16;
typedef unsigned v4u __attribute__((ext_vector_type(4)));
typedef unsigned v2u __attribute__((ext_vector_type(2)));
typedef float f32x4 __attribute__((ext_vector_type(4)));
typedef GAS unsigned gu32;
#define RLX_AGENT __ATOMIC_RELAXED, __HIP_MEMORY_SCOPE_AGENT
#define LDS_WAIT() asm volatile("s_waitcnt lgkmcnt(0)" ::: "memory")
__device__ __forceinline__ unsigned f2bf(float f) { unsigned u = __builtin_bit_cast(unsigned, f); return (u + 0x7fffu + ((u >> 16) & 1u)) >> 16; }
__device__ __forceinline__ unsigned pk2(float lo, float hi) { return f2bf(lo) | (f2bf(hi) << 16); }
__device__ __forceinline__ float bf2f(unsigned h) { return __uint_as_float(h << 16); }
__device__ __forceinline__ float bflo(unsigned w) { return __uint_as_float(w << 16); }
__device__ __forceinline__ float bfhi(unsigned w) { return __uint_as_float(w & 0xffff0000u); }

#define XB_TMO      128
#define XB_XCNT(j)  (256  + 64 * (j))
#define XB_XSUB(j)  (1280 + 64 * (j))
#define XB_XGEN(j)  (2304 + 64 * (j))
#define XB_TOP      3328
#define XB_TOPGEN   3392
#define XCD_BAR_WORDS 3456
#define XB_SPIN_CAP (1u << 18)
__device__ __forceinline__ unsigned xb_ld(unsigned* p)              { return __hip_atomic_load(p, __ATOMIC_RELAXED, __HIP_MEMORY_SCOPE_AGENT); }
__device__ __forceinline__ unsigned xb_add(unsigned* p, unsigned v) { return __hip_atomic_fetch_add(p, v, __ATOMIC_RELAXED, __HIP_MEMORY_SCOPE_AGENT); }
__device__ __forceinline__ unsigned xb_xcc_id() { return (unsigned)__builtin_amdgcn_s_getreg((3 << 11) | 20) & 0xFu; }
#define XB_SPIN(cond, bar) do { unsigned _sp = 0; while (cond) { __builtin_amdgcn_s_sleep(1); \
    if ((++_sp & 255u) == 0u) { if (xb_ld(&(bar)[XB_TMO])) break; if (_sp > XB_SPIN_CAP) { atomicAdd(&(bar)[XB_TMO], 1u); break; } } } } while (0)
struct XcdBarrier { unsigned* bar; unsigned x; volatile LAS unsigned* st; };
__device__ __forceinline__ XcdBarrier xcd_barrier_post(unsigned* bar, volatile LAS unsigned* st) {
    XcdBarrier b; b.bar = bar; b.x = xb_xcc_id(); b.st = st;
    if (threadIdx.x == 0) (void)xb_add(&bar[XB_XCNT(b.x)], 1u);
    return b;
}
__device__ __forceinline__ void xcd_barrier_complete(unsigned* bar, unsigned x, unsigned& nloc, unsigned& nx) {
    const unsigned G = gridDim.x * gridDim.y * gridDim.z;
    unsigned sum, cnt, mine, sp = 0u;
    for (;;) {
        sum = 0u; cnt = 0u;
        for (unsigned j = 0; j < 16; ++j) { const unsigned c = xb_ld(&bar[XB_XCNT(j)]); sum += c; cnt += (c > 0u) ? 1u : 0u; }
        mine = xb_ld(&bar[XB_XCNT(x)]);
        if (sum == G) break;
        __builtin_amdgcn_s_sleep(1);
        if ((++sp & 255u) == 0u) { if (xb_ld(&bar[XB_TMO])) break; if (sp > XB_SPIN_CAP) { atomicAdd(&bar[XB_TMO], 1u); break; } }
    }
    nloc = mine > 0u ? mine : 1u; nx = cnt > 0u ? cnt : 1u;
}
__device__ __forceinline__ void xcd_barrier(const XcdBarrier& b) {
    asm volatile("s_waitcnt vmcnt(0)" ::: "memory");
    __syncthreads();
    if (threadIdx.x == 0) {
        unsigned* bar = b.bar; asm volatile("" : "+s"(bar)); unsigned bx_ = b.x; asm volatile("" : "+s"(bx_));
        __builtin_amdgcn_s_waitcnt(0);
        unsigned nloc = b.st[0], nx = b.st[1];
        if (nloc == 0u) { xcd_barrier_complete(bar, bx_, nloc, nx); b.st[0] = nloc; b.st[1] = nx; }
        const unsigned old = xb_add(&bar[XB_XSUB(bx_)], 1u);
        const unsigned gen = old / nloc;
        if (old + 1u == (gen + 1u) * nloc) {
            __builtin_amdgcn_fence(__ATOMIC_RELEASE, "agent");
            asm volatile("s_waitcnt vmcnt(0)" ::: "memory");
            const unsigned og = xb_add(&bar[XB_TOP], 1u);
            const unsigned tg = og / nx;
            if (og + 1u == (tg + 1u) * nx) xb_add(&bar[XB_TOPGEN], 1u);
            else XB_SPIN(xb_ld(&bar[XB_TOPGEN]) == tg, bar);
            __builtin_amdgcn_fence(__ATOMIC_ACQUIRE, "agent");
            xb_add(&bar[XB_XGEN(bx_)], 1u);
            asm volatile("s_waitcnt vmcnt(0)" ::: "memory");
        } else {
            XB_SPIN(xb_ld(&bar[XB_XGEN(bx_)]) == gen, bar);
            __builtin_amdgcn_fence(__ATOMIC_ACQUIRE, "agent");
            asm volatile("s_waitcnt vmcnt(0)" ::: "memory");
        }
    }
    __syncthreads();
}

struct Args { const float* in[25]; float* out; unsigned char* ws; int ph_lo, ph_hi; };
#define INP(A_, i) inp_ptr(F, (i))
struct Frame {
    LAS unsigned char* lds; LAS unsigned char* lds0; int tid, lane, wave, wave0, vcu, vcu0, G;
    float* out; unsigned char* ws; float* out0; unsigned char* ws0;
};
__device__ __forceinline__ const float* inp_ptr(const Frame& F, int i) {
    const volatile LAS unsigned* t = (const volatile LAS unsigned*)(F.lds + 131072) + 2 * i;
    const unsigned lo = __builtin_amdgcn_readfirstlane(t[0]), hi = __builtin_amdgcn_readfirstlane(t[1]);
    return (const float*)(((unsigned long long)hi << 32) | lo);
}
#define PHASE_IDS(F) do { int t_; asm volatile("v_mbcnt_lo_u32_b32 %0, -1, 0\n\tv_mbcnt_hi_u32_b32 %0, -1, %0" : "=v"(t_)); int wv_ = (F).wave0; asm volatile("" : "+s"(wv_)); int vc_ = (F).vcu0; asm volatile("" : "+s"(vc_)); (F).vcu = vc_; (F).lane = t_; (F).wave = wv_; (F).tid = wv_ * 64 + t_; \
    unsigned l_ = (unsigned)(uintptr_t)(F).lds0; asm volatile("" : "+s"(l_)); (F).lds = (LAS unsigned char*)(uintptr_t)l_; unsigned char* w_ = (F).ws0; asm volatile("" : "+s"(w_)); (F).ws = w_; float* o_ = (F).out0; asm volatile("" : "+s"(o_)); (F).out = o_; } while (0)
enum { I_XP = 0, I_XS, I_CK, I_CV, I_ST, I_C, I_CCTX, I_WADA, I_BADA, I_NORMW, I_WIN, I_DLAM, I_SUBLN, I_CBW, I_CCW, I_CCB, I_RGW, I_RGB, I_RGLAM, I_POOLW, I_POOLS, I_WOUT, I_W1, I_W2, I_FNW };

__device__ __forceinline__ float wave_sum(float v, int lane) {
#pragma unroll
    for (int o = 1; o < 64; o <<= 1) v += shx(v, o, lane);
    return v;
}
__device__ __forceinline__ float wave_max(float v, int lane) {
#pragma unroll
    for (int o = 1; o < 64; o <<= 1) v = fmaxf(v, shx(v, o, lane));
    return v;
}
__device__ __forceinline__ float gelu_tanh(float x) { const float u = 0.7978845608028654f * (x + 0.044715f * x * x * x); return 0.5f * x * (1.0f + tanhf(u)); }

__device__ __forceinline__ void p0_transpose_item(const float* W, int K, int N, bf16* WT, LAS float* scr, int item, int lane) {
    const int nblk = N / 32, kb = item / nblk, nb = item % nblk, k0 = 64 * kb, n0 = 32 * nb;
#pragma unroll 8
    for (int i = 0; i < 32; ++i) { const int kk = 2 * i + (lane >> 5); scr[kk * 33 + (lane & 31)] = W[(size_t)(k0 + kk) * N + n0 + (lane & 31)]; }
    LDS_WAIT(); asm volatile("" ::: "memory");
    const int c = lane & 7;
#pragma unroll
    for (int j = 0; j < 4; ++j) { const int n = (lane >> 3) + 8 * j; const LAS float* s = scr + (8 * c) * 33 + n;
        v4u o; o.x = pk2(s[0 * 33], s[1 * 33]); o.y = pk2(s[2 * 33], s[3 * 33]); o.z = pk2(s[4 * 33], s[5 * 33]); o.w = pk2(s[6 * 33], s[7 * 33]);
        *(GAS v4u*)(WT + (size_t)(n0 + n) * K + k0 + 8 * c) = o; }
    LDS_WAIT(); asm volatile("" ::: "memory");
}
__device__ __forceinline__ void p0_mod_item(Frame& F, const Args& A, int item) {
    const int l = item / 48, n0 = (item % 48) * 128;
    LAS float* sv = (LAS float*)F.lds;
    LAS float* red = sv + 9 * 1024;
    const float* c = INP(A, I_C); const float* cctx = INP(A, I_CCTX);
    for (int i = F.tid; i < 9 * 1024; i += 512) { const int mi = i >> 10, k = i & 1023; const float v = mi == 0 ? cctx[k] : c[(mi - 1) * 1024 + k]; sv[i] = v / (1.0f + expf(-v)); }
    __syncthreads();
    const int cg = F.tid & 31, rg = F.tid >> 5;
    float acc[9][4];
#pragma unroll
    for (int a = 0; a < 9; ++a)
#pragma unroll
        for (int j = 0; j < 4; ++j) acc[a][j] = 0.f;
    const float* wp = INP(A, I_WADA) + (size_t)l * 1024 * 6144 + n0 + cg * 4;
#pragma unroll 4
    for (int i = 0; i < 64; ++i) { const int k = rg + 16 * i; const f32x4 w = *(const f32x4*)(wp + (size_t)k * 6144);
#pragma unroll
        for (int a = 0; a < 9; ++a) { const float s = sv[a * 1024 + k];
#pragma unroll
            for (int j = 0; j < 4; ++j) acc[a][j] += s * w[j]; } }
#pragma unroll
    for (int a = 0; a < 9; ++a)
#pragma unroll
        for (int j = 0; j < 4; ++j) red[(rg * 9 + a) * 128 + cg * 4 + j] = acc[a][j];
    __syncthreads();
    float* mod = (float*)(F.ws + WS_MOD);
    for (int o = F.tid; o < 9 * 128; o += 512) { const int mi = o >> 7, n = o & 127; float s = INP(A, I_BADA)[l * 6144 + n0 + n];
        for (int r = 0; r < 16; ++r) s += red[(r * 9 + mi) * 128 + n];
        mod[(size_t)(l * 9 + mi) * 6144 + n0 + n] = s; }
    __syncthreads();
}
__device__ __forceinline__ void sincos_d(double a, float& co, float& si) {
    const double TWO_PI = 6.283185307179586476925286766559;
    const double n = (double)(long long)(a / TWO_PI + 0.5);
    const double r = a - n * TWO_PI;
    const double r2 = r * r; double ts = r, tc = 1.0, ss = r, sc = 1.0;
    for (int k = 1; k <= 14; ++k) { tc = -tc * r2 / (double)((2 * k - 1) * (2 * k)); sc += tc; ts = -ts * r2 / (double)((2 * k) * (2 * k + 1)); ss += ts; }
    co = (float)sc; si = (float)ss;
}
__device__ __forceinline__ void p0_prologue(Frame& F, const Args& A) {
    PHASE_IDS(F);
    if (blockIdx.x < 96) p0_mod_item(F, A, blockIdx.x);
    LAS float* scr = (LAS float*)(F.lds + F.wave * 16384);
    const int gw = F.vcu * NWAVES + F.wave, NGW = F.G * NWAVES;
    constexpr int I_IN = 16 * 72, I_OUT = 16 * 32, I_1 = 16 * 128, I_2 = 64 * 32, I_L = I_IN + I_OUT + I_1 + I_2, I_RG = 32 * 2, I_PW = 8 * 2;
    constexpr int NITEMS = 2 * I_L + I_RG + I_PW;
    for (int it = gw; it < NITEMS; it += NGW) {
        int r = it;
        if (r < 2 * I_L) { const int l = r / I_L; r -= l * I_L;
            if (r < I_IN) { p0_transpose_item(INP(A, I_WIN) + (size_t)l * 1024 * 2304, 1024, 2304, (bf16*)(F.ws + WS_WIN) + (size_t)l * 2304 * 1024, scr, r, F.lane); continue; } r -= I_IN;
            if (r < I_OUT) { p0_transpose_item(INP(A, I_WOUT) + (size_t)l * 1024 * 1024, 1024, 1024, (bf16*)(F.ws + WS_WOUT) + (size_t)l * 1024 * 1024, scr, r, F.lane); continue; } r -= I_OUT;
            if (r < I_1) { p0_transpose_item(INP(A, I_W1) + (size_t)l * 1024 * 4096, 1024, 4096, (bf16*)(F.ws + WS_W1) + (size_t)l * 4096 * 1024, scr, r, F.lane); continue; } r -= I_1;
            p0_transpose_item(INP(A, I_W2) + (size_t)l * 4096 * 1024, 4096, 1024, (bf16*)(F.ws + WS_W2) + (size_t)l * 1024 * 4096, scr, r, F.lane); continue; }
        r -= 2 * I_L;
        if (r < I_RG) { const int mi = r >> 1; p0_transpose_item(INP(A, I_RGW) + (size_t)mi * 4096, 64, 64, (bf16*)(F.ws + WS_RGWT) + (size_t)mi * 4096, scr, r & 1, F.lane); continue; } r -= I_RG;
        { const int mi = r >> 1; p0_transpose_item(INP(A, I_POOLW) + (size_t)mi * 4096, 64, 64, (bf16*)(F.ws + WS_POOLT) + (size_t)mi * 4096, scr, r & 1, F.lane); }
    }
    { const int gt = F.vcu * 512 + F.tid, NGT = F.G * 512;
      for (int i = gt; i < 2 * 262144; i += NGT) { const int which = i >= 262144; const int j = which ? i - 262144 : i;
          const float* srcp = which ? INP(A, I_CV) : INP(A, I_CK); const f32x4 v = *(const f32x4*)(srcp + (size_t)j * 4); v2u o; o.x = pk2(v[0], v[1]); o.y = pk2(v[2], v[3]);
          *(GAS v2u*)((bf16*)(F.ws + (which ? WS_CV : WS_CK)) + (size_t)j * 4) = o; } }
    if (blockIdx.x == 100 % F.G) {
        const double fr[8] = {1.0, 0.31622776601683794, 0.1, 0.031622776601683794, 0.01, 0.0031622776601683794, 0.001, 0.00031622776601683794};
        float* rope = (float*)(F.ws + WS_ROPE);
        { const int pos = F.tid >> 3, j = F.tid & 7; double f = fr[0];
#pragma unroll
          for (int q = 1; q < 8; ++q) f = (j == q) ? fr[q] : f;
          float co, si; sincos_d((double)pos * f, co, si); rope[pos * 16 + j * 2] = co; rope[pos * 16 + j * 2 + 1] = si; }
        if (F.tid < 2) { const int l = F.tid; const float* dl = INP(A, I_DLAM) + l * 128; float s1 = 0.f, s2 = 0.f;
            for (int i = 0; i < 32; ++i) { s1 += dl[i] * dl[32 + i]; s2 += dl[64 + i] * dl[96 + i]; }
            const float lam_init = 0.8f - 0.6f * expf(-0.3f * (float)l);
            ((float*)(F.ws + WS_LAM))[l] = expf(s1) - expf(s2) + lam_init; }
    }
}
__device__ __forceinline__ void norm_mod_phase(Frame& F, const float* src_c, const float* src_l, const float* nw, const float* modl, int shift_off, int scale_off) {
    PHASE_IDS(F);
    bf16* XN = (bf16*)(F.ws + WS_XN);
    const int gw = F.vcu * NWAVES + F.wave, NGW = F.G * NWAVES;
    for (int r = gw; r < M; r += NGW) {
        const float* xr = (r < MC ? src_c : src_l) + (size_t)r * D; const int mi = r < MC ? 0 : 1 + ((r - MC) >> 11);
        const float* mp = modl + (size_t)mi * 6144;
        f32x4 v[4]; float s = 0.f;
#pragma unroll
        for (int j = 0; j < 4; ++j) { v[j] = *(const f32x4*)(xr + 256 * j + 4 * F.lane); s += (v[j][0] * v[j][0] + v[j][1] * v[j][1]) + (v[j][2] * v[j][2] + v[j][3] * v[j][3]); }
        const float rstd = 1.0f / sqrtf(wave_sum(s, F.lane) * (1.0f / D) + EPS);
#pragma unroll
        for (int j = 0; j < 4; ++j) { const int c = 256 * j + 4 * F.lane; const f32x4 w = *(const f32x4*)(nw + c), sc = *(const f32x4*)(mp + scale_off + c), sh = *(const f32x4*)(mp + shift_off + c);
            f32x4 o;
#pragma unroll
            for (int e = 0; e < 4; ++e) o[e] = v[j][e] * rstd * w[e] * (1.0f + sc[e]) + sh[e];
            v2u pk; pk.x = pk2(o[0], o[1]); pk.y = pk2(o[2], o[3]); *(GAS v2u*)(XN + (size_t)r * D + c) = pk; }
    }
}
__device__ __forceinline__ void final_norm_phase(Frame& F, const Args& A) {
    PHASE_IDS(F);
    const int gw = F.vcu * NWAVES + F.wave, NGW = F.G * NWAVES; const float* fw = INP(A, I_FNW);
    for (int r = gw; r < M; r += NGW) {
        float* xr = F.out + (size_t)r * D; f32x4 v[4]; float s = 0.f;
#pragma unroll
        for (int j = 0; j < 4; ++j) { v[j] = *(const f32x4*)(xr + 256 * j + 4 * F.lane); s += (v[j][0] * v[j][0] + v[j][1] * v[j][1]) + (v[j][2] * v[j][2] + v[j][3] * v[j][3]); }
        const float rstd = 1.0f / sqrtf(wave_sum(s, F.lane) * (1.0f / D) + EPS);
#pragma unroll
        for (int j = 0; j < 4; ++j) { const int c = 256 * j + 4 * F.lane; const f32x4 w = *(const f32x4*)(fw + c); *(f32x4*)(xr + c) = v[j] * rstd * w; }
    }
}

__device__ __forceinline__ void mix_attn_naive(Frame& F, const Args& A, int l) {
    PHASE_IDS(F);
    const bf16* Z = (const bf16*)(F.ws + WS_Z); bf16* Y = (bf16*)(F.ws + WS_Y);
    const bf16* CK = (const bf16*)(F.ws + WS_CK); const bf16* CV = (const bf16*)(F.ws + WS_CV);
    const float lam = ((const float*)(F.ws + WS_LAM))[l]; const float lam_init = 0.8f - 0.6f * expf(-0.3f * (float)l);
    const float sub = INP(A, I_SUBLN)[l * 64 + F.lane] * (1.0f - lam_init);
    const int gw = F.vcu * NWAVES + F.wave, NGW = F.G * NWAVES; const int lane = F.lane;
    for (int it = gw; it < M * 4; it += NGW) {
        const int r = it >> 2, hd = it & 3; const bool lat = r >= MC;
        const int seq0 = lat ? MC + ((r - MC) & ~2047) : (r & ~255); const int nkb = lat ? 36 : 4; const int b = lat ? (r - MC) >> 11 : 0;
        const bf16* ckp = CK + (size_t)((b * 2 + l) * 4 + hd) * 256 * 64; const bf16* cvp = CV + (size_t)((b * 2 + l) * 4 + hd) * 256 * 64;
        float q[64];
        { const v4u* qp = (const v4u*)(Z + (size_t)r * DIN + hd * 64);
#pragma unroll
          for (int c = 0; c < 8; ++c) { const v4u w = qp[c]; q[c * 8 + 0] = bflo(w.x); q[c * 8 + 1] = bfhi(w.x); q[c * 8 + 2] = bflo(w.y); q[c * 8 + 3] = bfhi(w.y); q[c * 8 + 4] = bflo(w.z); q[c * 8 + 5] = bfhi(w.z); q[c * 8 + 6] = bflo(w.w); q[c * 8 + 7] = bfhi(w.w); } }
        float m1 = -1e30f, m2 = -1e30f;
        for (int kb = 0; kb < nkb; ++kb) {
            const bool cached = lat && kb < 4; const int key = kb * 64 + lane;
            const bf16* kp = cached ? ckp + (size_t)key * 64 : Z + (size_t)(seq0 + key - (lat ? 256 : 0)) * DIN + 256 + hd * 64;
            float s1 = 0.f, s2 = 0.f;
#pragma unroll
            for (int c = 0; c < 8; ++c) { const v4u w = ((const v4u*)kp)[c];
                const float d = q[c * 8 + 0] * bflo(w.x) + q[c * 8 + 1] * bfhi(w.x) + q[c * 8 + 2] * bflo(w.y) + q[c * 8 + 3] * bfhi(w.y) + q[c * 8 + 4] * bflo(w.z) + q[c * 8 + 5] * bfhi(w.z) + q[c * 8 + 6] * bflo(w.w) + q[c * 8 + 7] * bfhi(w.w);
                if (c < 4) s1 += d; else s2 += d; }
            m1 = fmaxf(m1, s1); m2 = fmaxf(m2, s2);
        }
        m1 = wave_max(m1, lane); m2 = wave_max(m2, lane);
        float l1 = 0.f, l2 = 0.f, o1 = 0.f, o2 = 0.f;
        for (int kb = 0; kb < nkb; ++kb) {
            const bool cached = lat && kb < 4; const int key = kb * 64 + lane;
            const bf16* kp = cached ? ckp + (size_t)key * 64 : Z + (size_t)(seq0 + key - (lat ? 256 : 0)) * DIN + 256 + hd * 64;
            float s1 = 0.f, s2 = 0.f;
#pragma unroll
            for (int c = 0; c < 8; ++c) { const v4u w = ((const v4u*)kp)[c];
                const float d = q[c * 8 + 0] * bflo(w.x) + q[c * 8 + 1] * bfhi(w.x) + q[c * 8 + 2] * bflo(w.y) + q[c * 8 + 3] * bfhi(w.y) + q[c * 8 + 4] * bflo(w.z) + q[c * 8 + 5] * bfhi(w.z) + q[c * 8 + 6] * bflo(w.w) + q[c * 8 + 7] * bfhi(w.w);
                if (c < 4) s1 += d; else s2 += d; }
            const float p1 = __builtin_amdgcn_exp2f(s1 - m1), p2 = __builtin_amdgcn_exp2f(s2 - m2); l1 += p1; l2 += p2;
            const bf16* vp = cached ? cvp + (size_t)(kb * 64) * 64 + lane : Z + (size_t)(seq0 + kb * 64 - (lat ? 256 : 0)) * DIN + 512 + hd * 64 + lane;
            const int vstride = cached ? 64 : DIN;
#pragma unroll 8
            for (int j = 0; j < 64; ++j) { const float v = bf2f(vp[(size_t)j * vstride]); o1 += shidx(p1, j) * v; o2 += shidx(p2, j) * v; }
        }
        l1 = wave_sum(l1, lane); l2 = wave_sum(l2, lane);
        const float o = o1 / l1 - lam * (o2 / l2);
        const float ss = wave_sum(o * o, lane);
        Y[(size_t)r * D + hd * 64 + lane] = (bf16)f2bf(o * (1.0f / sqrtf(ss * (1.0f / 64.0f) + EPS)) * sub);
    }
}
__device__ __forceinline__ void mix_conv_naive(Frame& F, const Args& A, int l) {
    PHASE_IDS(F);
    const bf16* Z = (const bf16*)(F.ws + WS_Z); bf16* Y = (bf16*)(F.ws + WS_Y); const float* cw = INP(A, I_CBW) + l * 3 * 256;
    const int gt = F.vcu * 512 + F.tid, NGT = F.G * 512;
    for (int i = gt; i < M * 256; i += NGT) {
        const int r = i >> 8, c = i & 255; const bool lat = r >= MC; const int T = lat ? 2048 : 256; const int t = lat ? ((r - MC) & 2047) : (r & 255);
        float acc = 0.f;
#pragma unroll
        for (int j = 0; j < 3; ++j) { const int tt = t + j - 1; if (tt >= 0 && tt < T) { const bf16* zp = Z + (size_t)(r + j - 1) * DIN; acc += cw[j * 256 + c] * bf2f(zp[1024 + c]) * bf2f(zp[1280 + c]); } }
        Y[(size_t)r * D + 256 + c] = (bf16)f2bf(bf2f(Z[(size_t)r * DIN + 768 + c]) * acc);
    }
}
__device__ __forceinline__ void mix_rglru_naive(Frame& F, const Args& A, int l) {
    PHASE_IDS(F);
    const bf16* Z = (const bf16*)(F.ws + WS_Z); bf16* Y = (bf16*)(F.ws + WS_Y); float* HF = (float*)(F.ws + WS_XN);
    const int gw = F.vcu * NWAVES + F.wave, NGW = F.G * NWAVES; const int lane = F.lane;
    for (int it = gw; it < 160; it += NGW) {
        const int s = it >> 2, n = it & 3; const bool lat = s >= 32; const int T = lat ? 2048 : 256; const int row0 = lat ? MC + (s - 32) * 2048 : s * 256;
        const int c = n * 64 + lane;
        float cw[4];
#pragma unroll
        for (int j = 0; j < 4; ++j) cw[j] = INP(A, I_CCW)[(l * 4 + j) * 256 + c];
        const float cb = INP(A, I_CCB)[l * 256 + c];
        for (int dir = 0; dir < 2; ++dir) {
            float Wr[64], Wi[64];
            const float* wr_ = INP(A, I_RGW) + ((size_t)(((l * 2 + dir) * 2 + 0) * 4 + n) * 64) * 64 + lane; const float* wi_ = INP(A, I_RGW) + ((size_t)(((l * 2 + dir) * 2 + 1) * 4 + n) * 64) * 64 + lane;
#pragma unroll
            for (int j = 0; j < 64; ++j) { Wr[j] = wr_[j * 64]; Wi[j] = wi_[j * 64]; }
            const float br = INP(A, I_RGB)[((l * 2 + dir) * 2 + 0) * 256 + c], bi = INP(A, I_RGB)[((l * 2 + dir) * 2 + 1) * 256 + c];
            const float lamv = INP(A, I_RGLAM)[(l * 2 + dir) * 256 + c]; const float sp = log1pf(expf(-lamv));
            float h = lat ? INP(A, I_ST)[(((s - 32) * 2 + l) * 2 + dir) * 256 + c] : 0.f;
            for (int step = 0; step < T; ++step) {
                const int t = dir ? T - 1 - step : step;
                float xc = cb;
#pragma unroll
                for (int j = 0; j < 4; ++j) { const int tt = t + j - 2; if (tt >= 0 && tt < T) xc += cw[j] * bf2f(Z[(size_t)(row0 + tt) * DIN + 1536 + c]); }
                float g0 = br, g1 = bi;
#pragma unroll
                for (int j = 0; j < 64; ++j) { const float xj = shidx(xc, j); g0 += xj * Wr[j]; g1 += xj * Wi[j]; }
                const float rr = 1.0f / (1.0f + expf(-g0)), ii = 1.0f / (1.0f + expf(-g1));
                const float la = -8.0f * rr * sp; const float a = expf(la); const float bb = sqrtf(-expm1f(2.0f * la)) * ii * xc;
                h = a * h + bb;
                const size_t hidx = (size_t)(row0 + t) * 256 + c;
                if (dir == 0) HF[hidx] = h;
                else { const float hf = HF[hidx]; const float gr = bf2f(Z[(size_t)(row0 + t) * DIN + 1792 + c]); Y[(size_t)(row0 + t) * D + 512 + c] = (bf16)f2bf((hf + h) * gelu_tanh(gr)); }
            }
            if (!lat) F.out[OUT_ST + (size_t)((s * 2 + l) * 2 + dir) * 256 + c] = h;
        }
    }
}
__device__ __forceinline__ void mix_pool_naive(Frame& F, const Args& A, int l) {
    PHASE_IDS(F);
    const bf16* Z = (const bf16*)(F.ws + WS_Z); bf16* Y = (bf16*)(F.ws + WS_Y);
    const int gw = F.vcu * NWAVES + F.wave, NGW = F.G * NWAVES; const int lane = F.lane;
    for (int it = gw; it < M * 4; it += NGW) {
        const int r = it >> 2, g = it & 3; const bool lat = r >= MC; const int T = lat ? 2048 : 256; const int t = lat ? ((r - MC) & 2047) : (r & 255);
        const int win = 2 << g, left = win >> 1, right = win - 1 - left; const int lo = max(t - left, 0), hi = min(t + right, T - 1);
        const bf16* zc = Z + (size_t)(r - t) * DIN + 2048 + g * 64 + lane;
        float s = 0.f; for (int tt = lo; tt <= hi; ++tt) s += bf2f(zc[(size_t)tt * DIN]);
        const float p = s / (float)(hi - lo + 1) - bf2f(zc[(size_t)t * DIN]);
        const float* pw = INP(A, I_POOLW) + (size_t)(l * 4 + g) * 4096 + lane; float acc = 0.f;
#pragma unroll 8
        for (int j = 0; j < 64; ++j) acc += shidx(p, j) * pw[j * 64];
        Y[(size_t)r * D + 768 + g * 64 + lane] = (bf16)f2bf(acc * INP(A, I_POOLS)[l * 256 + g * 64 + lane]);
    }
}


typedef short bf16x8_t __attribute__((ext_vector_type(8)));
typedef float f32x16 __attribute__((ext_vector_type(16)));
typedef short v4i16_t __attribute__((ext_vector_type(4)));
__device__ __forceinline__ unsigned cvtpk(float lo, float hi) { unsigned r; asm volatile("v_cvt_pk_bf16_f32 %0, %1, %2" : "=v"(r) : "v"(lo), "v"(hi)); return r; }
__device__ __forceinline__ bf16x8_t pack8(float a0, float a1, float a2, float a3, float a4, float a5, float a6, float a7) {
    v4u w; w.x = cvtpk(a0, a1); w.y = cvtpk(a2, a3); w.z = cvtpk(a4, a5); w.w = cvtpk(a6, a7); return __builtin_bit_cast(bf16x8_t, w); }
__device__ __forceinline__ v4i16_t lds_tr(LAS unsigned char* p) { return __builtin_amdgcn_ds_read_tr16_b64_v4i16((LAS v4i16_t*)p); }
#define MFMA32(a, b, c) __builtin_amdgcn_mfma_f32_32x32x16_bf16((a), (b), (c), 0, 0, 0)

__device__ __forceinline__ void attn_unit(Frame& F, const Args& A, int l, bool lat, int seq, int hd, int qb, float lam, float sub_mul) {
    LAS unsigned char* L = F.lds;
    const bf16* Z = (const bf16*)(F.ws + WS_Z); bf16* Y = (bf16*)(F.ws + WS_Y);
    const bf16* CK = (const bf16*)(F.ws + WS_CK); const bf16* CV = (const bf16*)(F.ws + WS_CV);
    const int tid = F.tid, lane = F.lane, w = F.wave, r32 = lane & 31, h = lane >> 5;
    const int zrow0 = lat ? MC + seq * 2048 : seq * 256;
    const int qrow = zrow0 + qb * 256 + w * 32 + r32;
    bf16x8_t qf[2][2];
#pragma unroll
    for (int s = 0; s < 2; ++s)
#pragma unroll
        for (int ks = 0; ks < 2; ++ks) qf[s][ks] = *(const bf16x8_t*)(Z + (size_t)qrow * DIN + hd * 64 + s * 32 + ks * 16 + h * 8);
    const int NT = lat ? 36 : 4;
    const int srow = tid >> 3, sch = tid & 7;
    const size_t cbase = ((size_t)((seq * 2 + l) * 4 + hd) * 256 + srow) * 64 + sch * 8;
    const size_t zbase = (size_t)(zrow0 + srow) * DIN + 256 + hd * 64 + sch * 8;
    const unsigned kdst = srow * 128 + ((sch ^ ((srow >> 1) & 7)) << 4), vdst = 16384 + srow * 128 + ((sch ^ (((srow >> 1) & 1) << 2)) << 4);
    unsigned koff[2][2];
#pragma unroll
    for (int s = 0; s < 2; ++s)
#pragma unroll
        for (int ks = 0; ks < 2; ++ks) koff[s][ks] = r32 * 128 + (((s * 4 + ks * 2 + h) ^ ((r32 >> 1) & 7)) << 4);
    const int q_ = (lane & 15) >> 2, p_ = lane & 3, g1 = (lane >> 4) & 1, sw = (lane >> 3) & 1;
    const unsigned vb0 = 16384 + (4 * h + q_) * 128 + (((2 * g1 + (p_ >> 1)) ^ (sw << 2)) << 4) + (p_ & 1) * 8;
    const unsigned vb1 = 16384 + (4 * h + q_) * 128 + (((4 + 2 * g1 + (p_ >> 1)) ^ (sw << 2)) << 4) + (p_ & 1) * 8;
    v4u kreg, vreg;
    { const bool c0 = lat; kreg = c0 ? *(const v4u*)(CK + cbase) : *(const v4u*)(Z + zbase); vreg = c0 ? *(const v4u*)(CV + cbase) : *(const v4u*)(Z + zbase + 256); }
    float m[2] = {-1e30f, -1e30f}, ls[2] = {0.f, 0.f};
    f32x16 o[2][2];
#pragma unroll
    for (int s = 0; s < 2; ++s)
#pragma unroll
        for (int db = 0; db < 2; ++db)
#pragma unroll
            for (int r = 0; r < 16; ++r) o[s][db][r] = 0.f;
    for (int t = 0; t < NT; ++t) {
        const unsigned bo = (t & 1) * 8192;
        *(LAS v4u*)(L + bo + kdst) = kreg; *(LAS v4u*)(L + bo + vdst) = vreg;
        __syncthreads();
        if (t + 1 < NT) { const int tn = t + 1;
            if (lat && tn < 4) { kreg = *(const v4u*)(CK + cbase + (size_t)tn * 4096); vreg = *(const v4u*)(CV + cbase + (size_t)tn * 4096); }
            else { const size_t zo = zbase + (size_t)(tn - (lat ? 4 : 0)) * 64 * DIN; kreg = *(const v4u*)(Z + zo); vreg = *(const v4u*)(Z + zo + 256); } }
#pragma unroll
        for (int s = 0; s < 2; ++s) {
            f32x16 p0, p1;
#pragma unroll
            for (int r = 0; r < 16; ++r) { p0[r] = 0.f; p1[r] = 0.f; }
#pragma unroll
            for (int ks = 0; ks < 2; ++ks) { const bf16x8_t k0 = *(const LAS bf16x8_t*)(L + bo + koff[s][ks]); const bf16x8_t k1 = *(const LAS bf16x8_t*)(L + bo + koff[s][ks] + 4096);
                p0 = MFMA32(k0, qf[s][ks], p0); p1 = MFMA32(k1, qf[s][ks], p1); }
            float mt = fmaxf(p0[0], p1[0]);
#pragma unroll
            for (int r = 1; r < 16; ++r) mt = fmaxf(mt, fmaxf(p0[r], p1[r]));
            mt = fmaxf(mt, shx(mt, 32, lane));
            const float mn = fmaxf(m[s], mt); const float al = __builtin_amdgcn_exp2f(m[s] - mn); m[s] = mn;
            float rs = 0.f;
#pragma unroll
            for (int r = 0; r < 16; ++r) { p0[r] = __builtin_amdgcn_exp2f(p0[r] - mn); p1[r] = __builtin_amdgcn_exp2f(p1[r] - mn); rs += p0[r] + p1[r]; }
            ls[s] = ls[s] * al + rs;
#pragma unroll
            for (int db = 0; db < 2; ++db)
#pragma unroll
                for (int r = 0; r < 16; ++r) o[s][db][r] *= al;
            bf16x8_t pb[4];
            pb[0] = pack8(p0[0], p0[1], p0[2], p0[3], p0[4], p0[5], p0[6], p0[7]); pb[1] = pack8(p0[8], p0[9], p0[10], p0[11], p0[12], p0[13], p0[14], p0[15]);
            pb[2] = pack8(p1[0], p1[1], p1[2], p1[3], p1[4], p1[5], p1[6], p1[7]); pb[3] = pack8(p1[8], p1[9], p1[10], p1[11], p1[12], p1[13], p1[14], p1[15]);
#pragma unroll
            for (int db = 0; db < 2; ++db)
#pragma unroll
                for (int sp = 0; sp < 4; ++sp) { LAS unsigned char* vp = L + bo + (db ? vb1 : vb0) + sp * 2048;
                    const v4i16_t lo = lds_tr(vp), hi = lds_tr(vp + 1024);
                    const bf16x8_t vf = (bf16x8_t){lo[0], lo[1], lo[2], lo[3], hi[0], hi[1], hi[2], hi[3]};
                    o[s][db] = MFMA32(vf, pb[sp], o[s][db]); }
            __builtin_amdgcn_sched_barrier(0);
        }
    }
    const float l0 = ls[0] + shx(ls[0], 32, lane), l1 = ls[1] + shx(ls[1], 32, lane);
    const float i0 = 1.0f / l0, i1 = lam / l1;
    float ss = 0.f;
#pragma unroll
    for (int db = 0; db < 2; ++db)
#pragma unroll
        for (int r = 0; r < 16; ++r) { const float v = o[0][db][r] * i0 - o[1][db][r] * i1; o[0][db][r] = v; ss += v * v; }
    ss += shx(ss, 32, lane);
    const float rn = sub_mul / sqrtf(ss * (1.0f / 64.0f) + EPS);
    const float* subw = INP(A, I_SUBLN) + l * 64;
    bf16* yrow = Y + (size_t)qrow * D + hd * 64;
#pragma unroll
    for (int db = 0; db < 2; ++db)
#pragma unroll
        for (int g = 0; g < 4; ++g) { const int d0 = 32 * db + 8 * g + 4 * h; const f32x4 sw4 = *(const f32x4*)(subw + d0);
            v2u pk; pk.x = cvtpk(o[0][db][4 * g] * rn * sw4[0], o[0][db][4 * g + 1] * rn * sw4[1]); pk.y = cvtpk(o[0][db][4 * g + 2] * rn * sw4[2], o[0][db][4 * g + 3] * rn * sw4[3]);
            *(GAS v2u*)(yrow + d0) = pk; }
    __syncthreads();
}


__device__ __forceinline__ float sigm(float x) { return __builtin_amdgcn_rcpf(1.0f + __builtin_amdgcn_exp2f(-1.4426950408889634f * x)); }
template <int DIRB> __device__ __forceinline__ void grp_comp(const f32x16& a, const f32x16& b, int g, float& Ag, float& Bg) {
    const float a0 = a[4 * g], a1 = a[4 * g + 1], a2 = a[4 * g + 2], a3 = a[4 * g + 3], b0 = b[4 * g], b1 = b[4 * g + 1], b2 = b[4 * g + 2], b3 = b[4 * g + 3];
    Ag = (a0 * a1) * (a2 * a3);
    if (!DIRB) { float t = b0; t = a1 * t + b1; t = a2 * t + b2; t = a3 * t + b3; Bg = t; }
    else { float t = b3; t = a2 * t + b2; t = a1 * t + b1; t = a0 * t + b0; Bg = t; }
}
template <int DIRB> __device__ __forceinline__ void wave_comp(const f32x16& a, const f32x16& b, int h, int lane, float& Aw, float& Bw) {
    Aw = 1.f; Bw = 0.f;
#pragma unroll
    for (int gi = 0; gi < 4; ++gi) { const int g = DIRB ? 3 - gi : gi;
        float Ag, Bg; grp_comp<DIRB>(a, b, g, Ag, Bg);
        const float Ao = shx(Ag, 32, lane), Bo = shx(Bg, 32, lane);
        const float A0 = h ? Ao : Ag, B0 = h ? Bo : Bg, A1 = h ? Ag : Ao, B1 = h ? Bg : Bo;
        float Ap, Bp;
        if (!DIRB) { Ap = A0 * A1; Bp = A1 * B0 + B1; } else { Ap = A0 * A1; Bp = A0 * B1 + B0; }
        Bw = Ap * Bw + Bp; Aw *= Ap; }
}
template <int DIRB> __device__ __forceinline__ void scan_final(const f32x16& a, const f32x16& b, int h, int lane, float X, f32x16& hout) {
    float S = X;
#pragma unroll
    for (int gi = 0; gi < 4; ++gi) { const int g = DIRB ? 3 - gi : gi;
        float Ag, Bg; grp_comp<DIRB>(a, b, g, Ag, Bg);
        const float Ao = shx(Ag, 32, lane), Bo = shx(Bg, 32, lane);
        const float A0 = h ? Ao : Ag, B0 = h ? Bo : Bg, A1 = h ? Ag : Ao, B1 = h ? Bg : Bo;
        if (!DIRB) { float st = h ? (Ao * S + Bo) : S;
#pragma unroll
            for (int e = 0; e < 4; ++e) { st = a[4 * g + e] * st + b[4 * g + e]; hout[4 * g + e] = st; }
            S = A1 * (A0 * S + B0) + B1; }
        else { float st = h ? S : (Ao * S + Bo);
#pragma unroll
            for (int e = 3; e >= 0; --e) { st = a[4 * g + e] * st + b[4 * g + e]; hout[4 * g + e] = st; }
            S = A0 * (A1 * S + B1) + B0; } }
}
__device__ __forceinline__ void rglru_unit(Frame& F, const Args& A, int l, int mode, int seq, int n, int chunk) {
    const bf16* Z = (const bf16*)(F.ws + WS_Z); bf16* Y = (bf16*)(F.ws + WS_Y); const bf16* RGWT = (const bf16*)(F.ws + WS_RGWT);
    float* CARRY = (float*)(F.ws + WS_CARRY);
    const int lane = F.lane, w = F.wave, r32 = lane & 31, h = lane >> 5;
    const bool lat = mode != 0; const int T = lat ? 2048 : 256; const int row0 = lat ? MC + seq * 2048 : seq * 256; const int t0 = chunk * 256 + w * 32;
    LAS float* comp = (LAS float*)F.lds;
    bf16x8_t xa[4];
    { const int tk = t0 + r32; const float* cw = INP(A, I_CCW) + l * 4 * 256; const float* cb = INP(A, I_CCB) + l * 256;
#pragma unroll
      for (int ks = 0; ks < 4; ++ks) { const int c8 = n * 64 + 16 * ks + 8 * h;
          const f32x4 b0 = *(const f32x4*)(cb + c8), b1 = *(const f32x4*)(cb + c8 + 4);
          float x[8] = {b0[0], b0[1], b0[2], b0[3], b1[0], b1[1], b1[2], b1[3]};
#pragma unroll
          for (int j = 0; j < 4; ++j) { const int tt = tk + j - 2; const bool ok = tt >= 0 && tt < T; const int tc = ok ? tt : tk;
              const v4u z = *(const v4u*)(Z + (size_t)(row0 + tc) * DIN + 1536 + c8); const f32x4 w0 = *(const f32x4*)(cw + j * 256 + c8), w1 = *(const f32x4*)(cw + j * 256 + c8 + 4);
              const float k = ok ? 1.f : 0.f;
              x[0] += k * w0[0] * bflo(z.x); x[1] += k * w0[1] * bfhi(z.x); x[2] += k * w0[2] * bflo(z.y); x[3] += k * w0[3] * bfhi(z.y);
              x[4] += k * w1[0] * bflo(z.z); x[5] += k * w1[1] * bfhi(z.z); x[6] += k * w1[2] * bflo(z.w); x[7] += k * w1[3] * bfhi(z.w); }
          xa[ks] = pack8(x[0], x[1], x[2], x[3], x[4], x[5], x[6], x[7]); } }
    const int rwave0 = t0;
#pragma unroll 1
    for (int cb2 = 0; cb2 < 2; ++cb2) {
        const int cl = 32 * cb2 + r32, c = n * 64 + cl;
        f32x16 xcD;
#pragma unroll
        for (int r = 0; r < 16; ++r) xcD[r] = 0.f;
#pragma unroll
        for (int ks = 0; ks < 4; ++ks) { const bool hit = (cl >> 3) == (2 * ks + h); const int e = r32 & 7;
            bf16x8_t idf;
#pragma unroll
            for (int q = 0; q < 8; ++q) idf[q] = (hit && e == q) ? (short)0x3F80 : (short)0;
            xcD = MFMA32(xa[ks], idf, xcD); }
        f32x16 av[2], bv[2];
#pragma unroll
        for (int dir = 0; dir < 2; ++dir) {
            const bf16* wr_ = RGWT + (size_t)((((l * 2 + dir) * 2 + 0) * 4 + n) * 4096) + cl * 64 + 8 * h;
            const bf16* wi_ = wr_ + 4 * 4096;
            f32x16 gr, gi;
#pragma unroll
            for (int r = 0; r < 16; ++r) { gr[r] = 0.f; gi[r] = 0.f; }
#pragma unroll
            for (int ks = 0; ks < 4; ++ks) { const bf16x8_t br = *(const bf16x8_t*)(wr_ + 16 * ks), bi = *(const bf16x8_t*)(wi_ + 16 * ks);
                gr = MFMA32(xa[ks], br, gr); gi = MFMA32(xa[ks], bi, gi); }
            const float biasr = INP(A, I_RGB)[((l * 2 + dir) * 2 + 0) * 256 + c], biasi = INP(A, I_RGB)[((l * 2 + dir) * 2 + 1) * 256 + c];
            const float sp8 = 8.0f * 1.4426950408889634f * log1pf(expf(-INP(A, I_RGLAM)[(l * 2 + dir) * 256 + c]));
#pragma unroll
            for (int r = 0; r < 16; ++r) { const float rr = sigm(gr[r] + biasr), ii = sigm(gi[r] + biasi);
                const float a = __builtin_amdgcn_exp2f(-rr * sp8);
                av[dir][r] = a; bv[dir][r] = __builtin_amdgcn_sqrtf(fmaxf(1.0f - a * a, 0.f)) * ii * xcD[r]; }
        }
        { float Aw, Bw;
          wave_comp<0>(av[0], bv[0], h, lane, Aw, Bw); if (h == 0) { comp[((0 * 8 + w) * 32 + r32) * 2] = Aw; comp[((0 * 8 + w) * 32 + r32) * 2 + 1] = Bw; }
          wave_comp<1>(av[1], bv[1], h, lane, Aw, Bw); if (h == 0) { comp[((1 * 8 + w) * 32 + r32) * 2] = Aw; comp[((1 * 8 + w) * 32 + r32) * 2 + 1] = Bw; } }
        __syncthreads();
        if (w == 0 && mode != 2 && h == 0) {
            float Af = 1.f, Bf = 0.f, Ab = 1.f, Bb = 0.f;
            for (int ww = 0; ww < 8; ++ww) { const float a0 = comp[((0 * 8 + ww) * 32 + r32) * 2], b0 = comp[((0 * 8 + ww) * 32 + r32) * 2 + 1]; Bf = a0 * Bf + b0; Af *= a0; }
            for (int ww = 7; ww >= 0; --ww) { const float a1 = comp[((1 * 8 + ww) * 32 + r32) * 2], b1 = comp[((1 * 8 + ww) * 32 + r32) * 2 + 1]; Bb = a1 * Bb + b1; Ab *= a1; }
            if (mode == 1) { float* cp = CARRY + ((size_t)(((seq * 8 + chunk) * 4 + n) * 2) * 64 + cl) * 2; cp[0] = Af; cp[1] = Bf; cp[128] = Ab; cp[129] = Bb; }
            else { F.out[OUT_ST + (size_t)((seq * 2 + l) * 2 + 0) * 256 + c] = Bf; F.out[OUT_ST + (size_t)((seq * 2 + l) * 2 + 1) * 256 + c] = Bb; }
        }
        if (mode != 1) {
            float Xf = 0.f, Xb = 0.f;
            if (mode == 2) { Xf = INP(A, I_ST)[(size_t)((seq * 2 + l) * 2 + 0) * 256 + c]; Xb = INP(A, I_ST)[(size_t)((seq * 2 + l) * 2 + 1) * 256 + c];
                for (int cc = 0; cc < chunk; ++cc) { const float* cp = CARRY + ((size_t)(((seq * 8 + cc) * 4 + n) * 2) * 64 + cl) * 2; Xf = cp[0] * Xf + cp[1]; }
                for (int cc = 7; cc > chunk; --cc) { const float* cp = CARRY + ((size_t)(((seq * 8 + cc) * 4 + n) * 2 + 1) * 64 + cl) * 2; Xb = cp[0] * Xb + cp[1]; } }
            for (int ww = 0; ww < w; ++ww) Xf = comp[((0 * 8 + ww) * 32 + r32) * 2] * Xf + comp[((0 * 8 + ww) * 32 + r32) * 2 + 1];
            for (int ww = 7; ww > w; --ww) Xb = comp[((1 * 8 + ww) * 32 + r32) * 2] * Xb + comp[((1 * 8 + ww) * 32 + r32) * 2 + 1];
            f32x16 hf, hb;
            scan_final<0>(av[0], bv[0], h, lane, Xf, hf); scan_final<1>(av[1], bv[1], h, lane, Xb, hb);
#pragma unroll
            for (int r = 0; r < 16; ++r) { const int tok = rwave0 + (r & 3) + 8 * (r >> 2) + 4 * h; const size_t row = (size_t)(row0 + tok);
                const float g = bf2f(Z[row * DIN + 1792 + c]); const float u2 = 2.0f * 0.7978845608028654f * (g + 0.044715f * g * g * g);
                Y[row * D + 512 + c] = (bf16)f2bf((hf[r] + hb[r]) * g * sigm(u2)); }
        }
        __syncthreads();
    }
}


__device__ __forceinline__ void mix_pool(Frame& F, const Args& A, int l) {
    PHASE_IDS(F);
    const bf16* Z = (const bf16*)(F.ws + WS_Z); bf16* Y = (bf16*)(F.ws + WS_Y); const bf16* PT = (const bf16*)(F.ws + WS_POOLT);
    const int gw = F.vcu * NWAVES + F.wave, NGW = F.G * NWAVES; const int lane = F.lane, r32 = lane & 31, h = lane >> 5;
    for (int it = gw; it < (M / 32) * 4; it += NGW) {
        const int tt = it >> 2, g = it & 3; const int rowt0 = tt * 32; const bool lat = rowt0 >= MC; const int T = lat ? 2048 : 256;
        const int seq0 = lat ? MC + ((rowt0 - MC) & ~2047) : (rowt0 & ~255); const int tpos = rowt0 - seq0 + r32;
        const int win = 2 << g, left = win >> 1; const int lo = max(tpos - left, 0), hi = min(tpos + win - 1 - left, T - 1); const float inv = 1.0f / (float)(hi - lo + 1);
        bf16x8_t pa[4];
#pragma unroll
        for (int ks = 0; ks < 4; ++ks) { const bf16* zc = Z + (size_t)seq0 * DIN + 2048 + g * 64 + 16 * ks + 8 * h;
            float sm[8] = {0.f, 0.f, 0.f, 0.f, 0.f, 0.f, 0.f, 0.f};
            for (int j = 0; j < win; ++j) { const int t2 = tpos - left + j; const bool ok = t2 >= 0 && t2 < T; const int tc = ok ? t2 : tpos; const float k = ok ? 1.f : 0.f;
                const v4u z = *(const v4u*)(zc + (size_t)tc * DIN);
                sm[0] += k * bflo(z.x); sm[1] += k * bfhi(z.x); sm[2] += k * bflo(z.y); sm[3] += k * bfhi(z.y); sm[4] += k * bflo(z.z); sm[5] += k * bfhi(z.z); sm[6] += k * bflo(z.w); sm[7] += k * bfhi(z.w); }
            const v4u z0 = *(const v4u*)(zc + (size_t)tpos * DIN);
            pa[ks] = pack8(sm[0] * inv - bflo(z0.x), sm[1] * inv - bfhi(z0.x), sm[2] * inv - bflo(z0.y), sm[3] * inv - bfhi(z0.y), sm[4] * inv - bflo(z0.z), sm[5] * inv - bfhi(z0.z), sm[6] * inv - bflo(z0.w), sm[7] * inv - bfhi(z0.w)); }
#pragma unroll
        for (int cb2 = 0; cb2 < 2; ++cb2) { const int d = 32 * cb2 + r32; const bf16* wt = PT + (size_t)(l * 4 + g) * 4096 + d * 64 + 8 * h;
            f32x16 acc;
#pragma unroll
            for (int r = 0; r < 16; ++r) acc[r] = 0.f;
#pragma unroll
            for (int ks = 0; ks < 4; ++ks) acc = MFMA32(pa[ks], *(const bf16x8_t*)(wt + 16 * ks), acc);
            const float sc = INP(A, I_POOLS)[l * 256 + g * 64 + d];
#pragma unroll
            for (int r = 0; r < 16; ++r) { const int row = rowt0 + (r & 3) + 8 * (r >> 2) + 4 * h; Y[(size_t)row * D + 768 + g * 64 + d] = (bf16)f2bf(acc[r] * sc); } }
    }
}
__device__ __forceinline__ void mix_conv(Frame& F, const Args& A, int l) {
    PHASE_IDS(F);
    const bf16* Z = (const bf16*)(F.ws + WS_Z); bf16* Y = (bf16*)(F.ws + WS_Y); const float* cw = INP(A, I_CBW) + l * 3 * 256;
    const int gt = F.vcu * 512 + F.tid, NGT = F.G * 512;
    for (int i = gt; i < (M / 8) * 32; i += NGT) {
        const int tg = i >> 5, c8 = (i & 31) * 8; const int r0 = tg * 8; const bool lat = r0 >= MC; const int T = lat ? 2048 : 256; const int t0 = lat ? ((r0 - MC) & 2047) : (r0 & 255);
        float w[3][8];
#pragma unroll
        for (int j = 0; j < 3; ++j) { const f32x4 a = *(const f32x4*)(cw + j * 256 + c8), b = *(const f32x4*)(cw + j * 256 + c8 + 4); w[j][0] = a[0]; w[j][1] = a[1]; w[j][2] = a[2]; w[j][3] = a[3]; w[j][4] = b[0]; w[j][5] = b[1]; w[j][6] = b[2]; w[j][7] = b[3]; }
        float pm[8], pc[8], pn[8];
        auto prod = [&](int t, float (&o)[8]) { const bool ok = t >= 0 && t < T; const int tc = ok ? t : t0; const float k = ok ? 1.f : 0.f; const bf16* zp = Z + (size_t)(r0 - t0 + tc) * DIN + c8;
            const v4u a = *(const v4u*)(zp + 1024), b = *(const v4u*)(zp + 1280);
            o[0] = k * bflo(a.x) * bflo(b.x); o[1] = k * bfhi(a.x) * bfhi(b.x); o[2] = k * bflo(a.y) * bflo(b.y); o[3] = k * bfhi(a.y) * bfhi(b.y);
            o[4] = k * bflo(a.z) * bflo(b.z); o[5] = k * bfhi(a.z) * bfhi(b.z); o[6] = k * bflo(a.w) * bflo(b.w); o[7] = k * bfhi(a.w) * bfhi(b.w); };
        prod(t0 - 1, pm); prod(t0, pc);
#pragma unroll
        for (int q = 0; q < 8; ++q) { prod(t0 + q + 1, pn);
            const v4u gb = *(const v4u*)(Z + (size_t)(r0 + q) * DIN + 768 + c8);
            const float g[8] = {bflo(gb.x), bfhi(gb.x), bflo(gb.y), bfhi(gb.y), bflo(gb.z), bfhi(gb.z), bflo(gb.w), bfhi(gb.w)};
            float o[8];
#pragma unroll
            for (int e = 0; e < 8; ++e) { o[e] = g[e] * (w[0][e] * pm[e] + w[1][e] * pc[e] + w[2][e] * pn[e]); pm[e] = pc[e]; pc[e] = pn[e]; }
            v4u ov; ov.x = cvtpk(o[0], o[1]); ov.y = cvtpk(o[2], o[3]); ov.z = cvtpk(o[4], o[5]); ov.w = cvtpk(o[6], o[7]);
            *(GAS v4u*)(Y + (size_t)(r0 + q) * D + 256 + c8) = ov; }
    }
}

constexpr int PH_PER_LAYER = 10, NPHASE = 1 + 2 * PH_PER_LAYER + 1;
__global__ void __launch_bounds__(NWAVES * 64, 2) fwd_kernel(Args args) {
    extern __shared__ __attribute__((aligned(16))) unsigned char lds[];
    Frame F;
    F.lds = (LAS unsigned char*)lds; F.lds0 = F.lds; F.tid = threadIdx.x; F.lane = F.tid & 63; F.wave = __builtin_amdgcn_readfirstlane(F.tid >> 6); F.wave0 = F.wave;
    F.G = gridDim.x; { const int bx = blockIdx.x; F.vcu = (F.G % 8 == 0) ? (bx % 8) * (F.G / 8) + bx / 8 : bx; F.vcu0 = F.vcu; }
    F.out = args.out; F.ws = args.ws; F.out0 = args.out; F.ws0 = args.ws;
    volatile LAS unsigned* MISC = (volatile LAS unsigned*)(F.lds + MISC_OFF);
    for (int u = F.tid; u < (LDS_BYTES - LDSCTL_OFF) / 4; u += NWAVES * 64) ((LAS unsigned*)(F.lds + LDSCTL_OFF))[u] = 0u;
    __syncthreads();
    if (F.tid < 25) { const unsigned long long pv = (unsigned long long)args.in[F.tid]; ((LAS unsigned*)(F.lds + LDSCTL_OFF))[2 * F.tid] = (unsigned)pv; ((LAS unsigned*)(F.lds + LDSCTL_OFF))[2 * F.tid + 1] = (unsigned)(pv >> 32); }
    __syncthreads();
    XcdBarrier bar; bar.bar = (unsigned*)(args.ws + WS_CTL) + CW_BAR; bar.x = 0; bar.st = nullptr;
#if !MK_PER_PHASE
    bar = xcd_barrier_post((unsigned*)(args.ws + WS_CTL) + CW_BAR, MISC + 8);
#endif
#if MK_PER_PHASE
    const int lo = args.ph_lo, hi = args.ph_hi;
#define IN(k) (lo <= (k) && (k) < hi)
#define SEAM(k) do { } while (0)
#else
#define IN(k) true
#define SEAM(k) xcd_barrier(bar)
#endif
    if (IN(0)) { p0_prologue(F, args); } SEAM(0);

    for (int l = 0; l < 2; ++l) {
        const int pb = 1 + l * PH_PER_LAYER;
        if (IN(pb + 0)) { PHASE_IDS(F); const float* modl = (const float*)(F.ws + WS_MOD) + (size_t)l * 9 * 6144;
            const float* xin_c = l == 0 ? INP(args, I_XP) : F.out; const float* xin_l = l == 0 ? INP(args, I_XS) - (size_t)MC * D : F.out;
            norm_mod_phase(F, xin_c, xin_l, INP(args, I_NORMW) + (size_t)(l * 2 + 0) * D, modl, 0, 1024); } SEAM(pb + 0);
        if (IN(pb + 1)) { PHASE_IDS(F);
            pg8::Gemm g{(const bf16*)(F.ws + WS_XN), (const bf16*)(F.ws + WS_WIN) + (size_t)l * DIN * D, M, DIN, D}; pg8::StaticOrder S; S.init(M, DIN, F.G, (int)blockIdx.x);
            pg8::EpiIn E{(bf16*)(F.ws + WS_Z), (const float*)(F.ws + WS_ROPE), F.out + OUT_CK, F.out + OUT_CV, l};
            pg8::gemm_phase<pg8::EpiIn, pg8::StaticOrder, true, true>(F.lds, g, S, E, F.wave0);
        } SEAM(pb + 1);
        for (int sp = 0; sp < 2; ++sp) {
            if (IN(pb + 2 + sp)) {
                PHASE_IDS(F); const float lam = ((const float*)(F.ws + WS_LAM))[l]; const float sub_mul = 1.0f - (0.8f - 0.6f * expf(-0.3f * (float)l));
                for (int u = F.vcu; u < 512; u += F.G) {
                    const bool is_attn = sp == 0 ? (u >= 384) : (u < 256);
                    if (is_attn) { const bool ulat = sp == 1; const int v = ulat ? u : u - 384;
                        attn_unit(F, args, l, ulat, ulat ? (v >> 5) : (v >> 2), ulat ? ((v >> 3) & 3) : (v & 3), ulat ? (v & 7) : 0, lam, sub_mul); }
                    else { const int mode = sp == 1 ? 2 : (u < 256 ? 1 : 0); const int v = sp == 1 ? u - 256 : (u < 256 ? u : u - 256);
                        rglru_unit(F, args, l, mode, mode == 0 ? (v >> 2) : (v >> 5), mode == 0 ? (v & 3) : ((v >> 3) & 3), mode == 0 ? 0 : (v & 7)); } }
                if (sp == 0) { mix_conv(F, args, l); mix_pool(F, args, l); }
            } SEAM(pb + 2 + sp);
        }
        if (IN(pb + 4)) { PHASE_IDS(F); const float* modl = (const float*)(F.ws + WS_MOD) + (size_t)l * 9 * 6144;
            const float* xin_c = l == 0 ? INP(args, I_XP) : F.out; const float* xin_l = l == 0 ? INP(args, I_XS) - (size_t)MC * D : F.out;
            pg8::Gemm g{(const bf16*)(F.ws + WS_Y), (const bf16*)(F.ws + WS_WOUT) + (size_t)l * D * D, M, D, D}; pg8::StaticOrder S; S.init(M, D, F.G, (int)blockIdx.x);
            pg8::EpiGateRes E{xin_c, xin_l, F.out, modl + 2048, 0};
            pg8::gemm_phase<pg8::EpiGateRes, pg8::StaticOrder, true, true>(F.lds, g, S, E, F.wave0);
        } SEAM(pb + 4);
        if (IN(pb + 5)) { PHASE_IDS(F); const float* modl = (const float*)(F.ws + WS_MOD) + (size_t)l * 9 * 6144;
            norm_mod_phase(F, F.out, F.out, INP(args, I_NORMW) + (size_t)(l * 2 + 1) * D, modl, 3072, 4096); } SEAM(pb + 5);
        for (int hf = 0; hf < 2; ++hf) {
            if (IN(pb + 6 + 2 * hf)) { PHASE_IDS(F);
                pg8::Gemm g{(const bf16*)(F.ws + WS_XN) + (size_t)hf * MH * D, (const bf16*)(F.ws + WS_W1) + (size_t)l * DFF * D, MH, DFF, D}; pg8::StaticOrder S; S.init(MH, DFF, F.G, (int)blockIdx.x);
                pg8::EpiRelu2 E{(bf16*)(F.ws + WS_Z)};
                pg8::gemm_phase<pg8::EpiRelu2, pg8::StaticOrder, true, true>(F.lds, g, S, E, F.wave0);
            } SEAM(pb + 6 + 2 * hf);
            if (IN(pb + 7 + 2 * hf)) { PHASE_IDS(F); const float* modl = (const float*)(F.ws + WS_MOD) + (size_t)l * 9 * 6144;
                pg8::Gemm g{(const bf16*)(F.ws + WS_Z), (const bf16*)(F.ws + WS_W2) + (size_t)l * D * DFF, MH, D, DFF}; pg8::StaticOrder S; S.init(MH, D, F.G, (int)blockIdx.x);
                pg8::EpiGateRes E{F.out, F.out, F.out, modl + 5120, hf * MH};
                pg8::gemm_phase<pg8::EpiGateRes, pg8::StaticOrder, true, true>(F.lds, g, S, E, F.wave0);
            } SEAM(pb + 7 + 2 * hf);
        }
    }
    if (IN(NPHASE - 1)) { final_norm_phase(F, args); }
#undef IN
#undef SEAM
}

extern "C" void kernel_launch(void* const* d_in, const int* in_sizes, int n_in, void* d_out, int out_size, void* d_ws, size_t ws_size, hipStream_t stream) {
    static int grid = 0;
    if (grid == 0) {
        if (n_in != 25 || out_size != (int)(OUT_ST + 32 * 2 * 2 * 256) || ws_size < WS_END) { fprintf(stderr, "kernel_launch: unexpected shapes (n_in %d out %d ws %zu)\n", n_in, out_size, ws_size); grid = -1; return; }
        int dev = 0, cus = 0;
        if (hipGetDevice(&dev) != hipSuccess || hipDeviceGetAttribute(&cus, hipDeviceAttributeMultiprocessorCount, dev) != hipSuccess) { grid = -1; return; }
        if (hipFuncSetAttribute((const void*)fwd_kernel, hipFuncAttributeMaxDynamicSharedMemorySize, LDS_BYTES) != hipSuccess) { fprintf(stderr, "kernel_launch: hipFuncSetAttribute failed\n"); grid = -1; return; }
        int per_cu = 0;
        if (hipOccupancyMaxActiveBlocksPerMultiprocessor(&per_cu, (const void*)fwd_kernel, NWAVES * 64, LDS_BYTES) != hipSuccess || per_cu < 1) fprintf(stderr, "kernel_launch: occupancy query says %d\n", per_cu);
        (void)hipGetLastError();
        grid = cus;
    }
    if (grid < 0) return;
    (void)hipMemsetAsync((char*)d_ws + WS_CTL, 0, CTL_ZERO_BYTES, stream);
    Args a{};
    for (int i = 0; i < 25; ++i) a.in[i] = (const float*)d_in[i];
    a.out = (float*)d_out; a.ws = (unsigned char*)d_ws;
#if MK_PER_PHASE
    for (int p = 0; p < NPHASE; ++p) { a.ph_lo = p; a.ph_hi = p + 1; hipLaunchKernelGGL(fwd_kernel, dim3(grid), dim3(NWAVES * 64), LDS_BYTES, stream, a); }
#else
    a.ph_lo = 0; a.ph_hi = NPHASE; hipLaunchKernelGGL(fwd_kernel, dim3(grid), dim3(NWAVES * 64), LDS_BYTES, stream, a);
#endif
}
```

```cpp
#include <hip/hip_runtime.h>
#include <cstdio>
#include <cstdint>

#ifndef PROBE_REP
#define PROBE_REP 0
#endif
#ifndef PROBE_VAR
#define PROBE_VAR 0
#endif
#define REP(bit) for (int rep_ = 0; rep_ < (((PROBE_REP) >> (bit)) & 1) + 1; ++rep_)
#ifndef MK_PER_PHASE
#define MK_PER_PHASE 0
#endif


#define LANE_ID(v) asm volatile("v_mbcnt_lo_u32_b32 %0, -1, 0\n\tv_mbcnt_hi_u32_b32 %0, -1, %0" : "=v"(v))
__device__ __forceinline__ float shx(float v, int mask, int lane) { return __builtin_bit_cast(float, __builtin_amdgcn_ds_bpermute((lane ^ mask) << 2, __builtin_bit_cast(int, v))); }
__device__ __forceinline__ float shidx(float v, int src) { return __builtin_bit_cast(float, __builtin_amdgcn_ds_bpermute(src << 2, __builtin_bit_cast(int, v))); }

namespace pg8 {
#define PG8_LAS __attribute__((address_space(3)))
typedef unsigned short bf16_t;
typedef short bf16x8 __attribute__((ext_vector_type(8)));
typedef float f32x4 __attribute__((ext_vector_type(4)));
typedef unsigned u32x4 __attribute__((ext_vector_type(4)));
constexpr int BM = 256, BK = 64, HALF = 128, HTB = HALF * BK * 2, STAGE_BYTES = 8 * HTB, NXCD = 8, WGM = 8;

__host__ __device__ __forceinline__ int lds_byte(int r, int c) { const int st = (r >> 4) * 2 + (c >> 5), rr = r & 15, cc = c & 31, ob = rr * 64 + cc * 2; return st * 1024 + (ob ^ (((ob >> 9) & 1) << 5)); }
__host__ __device__ __forceinline__ void stage_rc(int b, int& R, int& C) { const int st = b / 1024, sb = b % 1024, swz = sb ^ (((sb >> 9) & 1) << 5); R = (st >> 1) * 16 + swz / 64; C = (st & 1) * 32 + (swz % 64) / 2; }
__host__ __device__ __forceinline__ int perm32(int rho) { const int n = rho >> 4, i = rho & 15; return 8 * (i >> 2) + 4 * n + (i & 3); }

struct Unit { int pm, pn, single, sub; };
struct Gemm { const bf16_t* A; const bf16_t* Bt; int M, N, K; };

struct StaticOrder {
    int nM, nN, nwg, G, c, R, rem, part;
    __host__ __device__ __forceinline__ void init(int M, int N, int G_, int c_, int part_ = 0) { nM = M / BM; nN = N / BM; nwg = nM * nN; G = G_; c = c_; R = nwg / G; rem = nwg - R * G; part = part_; }
    __host__ __device__ __forceinline__ bool splits() const { return rem > 0 && 2 * rem <= G; }
    __host__ __device__ __forceinline__ bool next(int i, Unit& u) const {
        long L; u.single = 0; u.sub = 0;
        if (part == 0) { if (i < R) L = (long)i * G + c; else if (i == R && rem > 0 && !splits()) { L = (long)R * G + c; if (L >= nwg) return false; } else return false; }
        else { if (i != 0 || !splits() || c >= 2 * rem) return false; L = (long)R * G + (c >> 1); u.single = 1; u.sub = c & 1; }
        int wgid = (int)L; { const int q = nwg / NXCD, r = nwg % NXCD, xcd = wgid % NXCD, off = wgid / NXCD; wgid = (xcd < r ? xcd * (q + 1) : r * (q + 1) + (xcd - r) * q) + off; }
        const int nig = WGM * nN, gid = wgid / nig, fm = gid * WGM, gsz = (nM - fm) < WGM ? (nM - fm) : WGM;
        u.pm = fm + ((wgid % nig) % gsz); u.pn = (wgid % nig) / gsz; return true;
    }
    __device__ __forceinline__ void a_ready(const Unit&) const {}
    __device__ __forceinline__ void done(const Unit&) const {}
};

__device__ __forceinline__ unsigned cvt_pk_bf16(float lo, float hi) { unsigned r; asm volatile("v_cvt_pk_bf16_f32 %0, %1, %2" : "=v"(r) : "v"(lo), "v"(hi)); return r; }

template <bool WT> __device__ __forceinline__ void st16(void* p, u32x4 v) {
    if constexpr (WT) asm volatile("global_store_dwordx4 %0, %1, off sc1\n\ts_nop 1" :: "v"(p), "v"(v) : "memory");     else *(__attribute__((address_space(1))) u32x4*)p = v; }
template <bool WT> __device__ __forceinline__ void st16(void* p, f32x4 v) { st16<WT>(p, __builtin_bit_cast(u32x4, v)); }


struct EpiIn {
    static constexpr bool PERM = true, AFTER_DRAIN = false;
    bf16_t* Z; const float* rope; float* ck_out; float* cv_out; int layer; const float* ss; const float* sw;
    template <bool WT> __device__ __forceinline__ void run(const f32x4 (&acc)[2][2][4][2], const Unit& u, int wr, int wc, int fr, int fq) const {
        asm volatile("" : "+v"(fr), "+v"(fq));
        int pn = u.pn; asm volatile("" : "+s"(pn)); const bool lat = u.pm >= 32; const bool dorope = lat && pn <= 1;
        const int row0 = u.pm * BM + (u.single ? u.sub * HALF : 0) + wr * 64 + fr; const int colw = wc * 32 + 8 * fq;
        const float qs = (pn == 0) ? 0.25503486f : 1.0f;
        const int mi = u.pm < 32 ? 0 : 1 + ((u.pm - 32) >> 3);
        f32x4 swv[2][2];
#pragma unroll
        for (int bj = 0; bj < 2; ++bj)
#pragma unroll
            for (int n = 0; n < 2; ++n) swv[bj][n] = *(const f32x4*)(sw + (size_t)mi * 2304 + pn * BM + bj * HALF + colw + 4 * n);
        float ssv[2][4];
#pragma unroll
        for (int ai = 0; ai < 2; ++ai)
#pragma unroll
            for (int m = 0; m < 4; ++m) ssv[ai][m] = ss[row0 + (u.single ? 0 : ai) * HALF + m * 16];
        f32x4 cs[4], csn[4];
        if (dorope) { const int t = (row0 - 8192) & 2047; const int pos = (fq >> 1) ? (t & 63) : (t >> 6); const f32x4* rp = (const f32x4*)(rope + pos * 16);
#pragma unroll
            for (int e = 0; e < 4; ++e) cs[e] = rp[e]; }
#pragma unroll
        for (int ai = 0; ai < 2; ++ai) { if (ai == 1 && u.single) break;
#pragma unroll
            for (int m = 0; m < 4; ++m) {
                const int row = row0 + ai * HALF + m * 16;
                const float rs = 1.0f / sqrtf(ssv[ai][m] * (1.0f / 1024.0f) + 1e-6f);
                if (dorope && !(ai == 1 && m == 3)) { const int rown = row0 + (m == 3 ? HALF : ai * HALF + (m + 1) * 16); const int t = (rown - 8192) & 2047; const int pos = (fq >> 1) ? (t & 63) : (t >> 6);
                    const f32x4* rp = (const f32x4*)(rope + pos * 16);
#pragma unroll
                    for (int e = 0; e < 4; ++e) csn[e] = rp[e]; }
#pragma unroll
                for (int bj = 0; bj < 2; ++bj) {
                    float v[8];
#pragma unroll
                    for (int e = 0; e < 4; ++e) { v[e] = acc[ai][bj][m][0][e] * rs + swv[bj][0][e]; v[4 + e] = acc[ai][bj][m][1][e] * rs + swv[bj][1][e]; }
                    if (dorope) {
#pragma unroll
                        for (int e = 0; e < 8; ++e) { const float pr = shx(v[e], 16, fr + 16 * fq); const float c = cs[e >> 1][(e & 1) * 2], s = cs[e >> 1][(e & 1) * 2 + 1];
                            v[e] = (fq & 1) ? (v[e] * c + pr * s) : (v[e] * c - pr * s); }
                    }
                    if (!lat && (pn == 1 || pn == 2)) {
                        float* co = (pn == 1) ? ck_out : cv_out; const int b = row >> 8, t = row & 255; const int cc = bj * HALF + colw; const int hd = cc >> 6, d = cc & 63;
                        float* op = co + ((size_t)((b * 2 + layer) * 4 + hd) * 256 + t) * 64 + d;
                        st16<WT>(op, (f32x4){v[0], v[1], v[2], v[3]}); st16<WT>(op + 4, (f32x4){v[4], v[5], v[6], v[7]});
                    }
                    u32x4 w; w.x = cvt_pk_bf16(v[0] * qs, v[1] * qs); w.y = cvt_pk_bf16(v[2] * qs, v[3] * qs); w.z = cvt_pk_bf16(v[4] * qs, v[5] * qs); w.w = cvt_pk_bf16(v[6] * qs, v[7] * qs);
                    st16<WT>(Z + (size_t)row * 2304 + pn * BM + bj * HALF + colw, w);
                }
                if (dorope && !(ai == 1 && m == 3)) {
#pragma unroll
                    for (int e = 0; e < 4; ++e) cs[e] = csn[e]; }
            } }
    }
};
__device__ __forceinline__ void unpack8(const u32x4 w, float (&o)[8]) {
    o[0] = __uint_as_float(w.x << 16); o[1] = __uint_as_float(w.x & 0xffff0000u); o[2] = __uint_as_float(w.y << 16); o[3] = __uint_as_float(w.y & 0xffff0000u);
    o[4] = __uint_as_float(w.z << 16); o[5] = __uint_as_float(w.z & 0xffff0000u); o[6] = __uint_as_float(w.w << 16); o[7] = __uint_as_float(w.w & 0xffff0000u); }
template <bool RES_BF16> struct EpiGateRes {
    static constexpr bool PERM = true, AFTER_DRAIN = false;
    const void* res_c; const void* res_l; bf16_t* xr; const float* gate; int rowbase;
    bf16_t* xs; const float* nw; const float* nscale; float* ssq;
    template <bool WT> __device__ __forceinline__ void run(const f32x4 (&acc)[2][2][4][2], const Unit& u, int wr, int wc, int fr, int fq) const {
        asm volatile("" : "+v"(fr), "+v"(fq));
        const int grow0 = rowbase + u.pm * BM; const int mi = grow0 < 8192 ? 0 : 1 + ((grow0 - 8192) >> 11);
        const void* res = grow0 < 8192 ? res_c : res_l;
        const int row0 = grow0 + (u.single ? u.sub * HALF : 0) + wr * 64 + fr, col0 = u.pn * BM + wc * 32 + 8 * fq;
        f32x4 gv[2][2], fv[2][2];
#pragma unroll
        for (int bj = 0; bj < 2; ++bj)
#pragma unroll
            for (int n = 0; n < 2; ++n) { gv[bj][n] = *(const f32x4*)(gate + (size_t)mi * 6144 + col0 + bj * HALF + 4 * n);
                if (xs) { const f32x4 w = *(const f32x4*)(nw + col0 + bj * HALF + 4 * n); f32x4 f = w;
                    if (nscale) { const f32x4 sc = *(const f32x4*)(nscale + (size_t)mi * 6144 + col0 + bj * HALF + 4 * n); f = w * (sc + 1.0f); }
                    fv[bj][n] = f; } }
        constexpr int RD = RES_BF16 ? 3 : 2;
        u32x4 rb[8][2]; f32x4 rf[8][4];
#define EGR_FETCH(c) do { const size_t o_ = (size_t)(row0 + (u.single ? 0 : ((c) >> 2)) * HALF + ((c) & 3) * 16) * 1024 + col0; _Pragma("unroll") for (int bj = 0; bj < 2; ++bj) { \
            if (RES_BF16) rb[c][bj] = *(const u32x4*)((const bf16_t*)res + o_ + bj * HALF); \
            else { rf[c][2 * bj] = *(const f32x4*)((const float*)res + o_ + bj * HALF); rf[c][2 * bj + 1] = *(const f32x4*)((const float*)res + o_ + bj * HALF + 4); } } } while (0)
#pragma unroll
        for (int c = 0; c < RD; ++c) EGR_FETCH(c);
#pragma unroll
        for (int ai = 0; ai < 2; ++ai) { if (ai == 1 && u.single) break;
#pragma unroll
            for (int m = 0; m < 4; ++m) { const size_t off = (size_t)(row0 + ai * HALF + m * 16) * 1024 + col0; const int c = ai * 4 + m;
                if (c + RD < 8) EGR_FETCH(c + RD);
                float sq = 0.f;
#pragma unroll
                for (int bj = 0; bj < 2; ++bj) { float r[8];
                    if (RES_BF16) unpack8(rb[c][bj], r);
                    else { const f32x4 r0 = rf[c][2 * bj], r1 = rf[c][2 * bj + 1];
                        r[0] = r0[0]; r[1] = r0[1]; r[2] = r0[2]; r[3] = r0[3]; r[4] = r1[0]; r[5] = r1[1]; r[6] = r1[2]; r[7] = r1[3]; }
                    float x[8];
#pragma unroll
                    for (int e = 0; e < 4; ++e) { x[e] = r[e] + gv[bj][0][e] * acc[ai][bj][m][0][e]; x[4 + e] = r[4 + e] + gv[bj][1][e] * acc[ai][bj][m][1][e]; }
#pragma unroll
                    for (int e = 0; e < 8; ++e) sq += x[e] * x[e];
                    u32x4 w; w.x = cvt_pk_bf16(x[0], x[1]); w.y = cvt_pk_bf16(x[2], x[3]); w.z = cvt_pk_bf16(x[4], x[5]); w.w = cvt_pk_bf16(x[6], x[7]);
                    st16<WT>(xr + off + bj * HALF, w);
                    if (xs) { u32x4 v; v.x = cvt_pk_bf16(x[0] * fv[bj][0][0], x[1] * fv[bj][0][1]); v.y = cvt_pk_bf16(x[2] * fv[bj][0][2], x[3] * fv[bj][0][3]);
                        v.z = cvt_pk_bf16(x[4] * fv[bj][1][0], x[5] * fv[bj][1][1]); v.w = cvt_pk_bf16(x[6] * fv[bj][1][2], x[7] * fv[bj][1][3]); st16<WT>(xs + off + bj * HALF, v); } }
                if (ssq) { const int ln = fr + 16 * fq; sq += shx(sq, 16, ln); sq += shx(sq, 32, ln); if (fq == 0) atomicAdd(ssq + row0 + ai * HALF + m * 16, sq); } } }
#undef EGR_FETCH
    }
};
struct EpiFinal {
    static constexpr bool PERM = true, AFTER_DRAIN = false;
    const bf16_t* res; float* out; const float* gate; int rowbase; const float* nw; float* ssq; unsigned* fin_cnt;
    template <bool WT> __device__ __forceinline__ void run(const f32x4 (&acc_c)[2][2][4][2], const Unit& u, int wr, int wc, int fr, int fq) const {
        asm volatile("" : "+v"(fr), "+v"(fq));
        f32x4 (&acc)[2][2][4][2] = const_cast<f32x4 (&)[2][2][4][2]>(acc_c);
        const int grow0 = rowbase + u.pm * BM; const int mi = grow0 < 8192 ? 0 : 1 + ((grow0 - 8192) >> 11);
        const int row0 = grow0 + (u.single ? u.sub * HALF : 0) + wr * 64 + fr, col0 = u.pn * BM + wc * 32 + 8 * fq; const int ln = fr + 16 * fq;
        f32x4 gv[2][2];
#pragma unroll
        for (int bj = 0; bj < 2; ++bj)
#pragma unroll
            for (int n = 0; n < 2; ++n) gv[bj][n] = *(const f32x4*)(gate + (size_t)mi * 6144 + col0 + bj * HALF + 4 * n);
        u32x4 rb[8][2];
#define EFN_FETCH(c) do { const size_t o_ = (size_t)(row0 + (u.single ? 0 : ((c) >> 2)) * HALF + ((c) & 3) * 16) * 1024 + col0; _Pragma("unroll") for (int bj = 0; bj < 2; ++bj) rb[c][bj] = *(const u32x4*)(res + o_ + bj * HALF); } while (0)
#pragma unroll
        for (int c = 0; c < 3; ++c) EFN_FETCH(c);
#pragma unroll
        for (int ai = 0; ai < 2; ++ai) { if (ai == 1 && u.single) break;
#pragma unroll
            for (int m = 0; m < 4; ++m) { const int c = ai * 4 + m; float sq = 0.f;
                if (c + 3 < 8) EFN_FETCH(c + 3);
#pragma unroll
                for (int bj = 0; bj < 2; ++bj) { float r[8]; unpack8(rb[c][bj], r);
#pragma unroll
                    for (int e = 0; e < 4; ++e) { const float x0 = r[e] + gv[bj][0][e] * acc[ai][bj][m][0][e], x1 = r[4 + e] + gv[bj][1][e] * acc[ai][bj][m][1][e];
                        acc[ai][bj][m][0][e] = x0; acc[ai][bj][m][1][e] = x1; sq += x0 * x0 + x1 * x1; } }
                sq += shx(sq, 16, ln); sq += shx(sq, 32, ln); if (fq == 0) atomicAdd(ssq + row0 + ai * HALF + m * 16, sq); } }
#undef EFN_FETCH
        asm volatile("s_waitcnt vmcnt(0)" ::: "memory");
        const int hp0 = (grow0 >> 7) + (u.single ? u.sub : 0);
        if (ln == 0) { __hip_atomic_fetch_add(fin_cnt + 16 * hp0, 1u, __ATOMIC_RELAXED, __HIP_MEMORY_SCOPE_AGENT); if (!u.single) __hip_atomic_fetch_add(fin_cnt + 16 * (hp0 + 1), 1u, __ATOMIC_RELAXED, __HIP_MEMORY_SCOPE_AGENT); }
        for (unsigned spins = 0; spins < (1u << 20); ++spins) {
            unsigned c0 = __hip_atomic_load(fin_cnt + 16 * hp0, __ATOMIC_RELAXED, __HIP_MEMORY_SCOPE_AGENT); unsigned c1 = u.single ? 32u : __hip_atomic_load(fin_cnt + 16 * (hp0 + 1), __ATOMIC_RELAXED, __HIP_MEMORY_SCOPE_AGENT);
            c0 = (unsigned)__builtin_amdgcn_readfirstlane((int)c0); c1 = (unsigned)__builtin_amdgcn_readfirstlane((int)c1);
            if (c0 >= 32u && c1 >= 32u) break;
            __builtin_amdgcn_s_sleep(2); }
        f32x4 wv[2][2];
#pragma unroll
        for (int bj = 0; bj < 2; ++bj)
#pragma unroll
            for (int n = 0; n < 2; ++n) wv[bj][n] = *(const f32x4*)(nw + col0 + bj * HALF + 4 * n);
        float sstv[2][4];
#pragma unroll
        for (int ai = 0; ai < 2; ++ai)
#pragma unroll
            for (int m = 0; m < 4; ++m) sstv[ai][m] = __hip_atomic_load(ssq + row0 + (u.single ? 0 : ai) * HALF + m * 16, __ATOMIC_RELAXED, __HIP_MEMORY_SCOPE_AGENT);
#pragma unroll
        for (int ai = 0; ai < 2; ++ai) { if (ai == 1 && u.single) break;
#pragma unroll
            for (int m = 0; m < 4; ++m) { const int row = row0 + ai * HALF + m * 16; const size_t off = (size_t)row * 1024 + col0;
                const float sst = sstv[ai][m]; const float rs = 1.0f / sqrtf(sst * (1.0f / 1024.0f) + 1e-6f);
#pragma unroll
                for (int bj = 0; bj < 2; ++bj)
#pragma unroll
                    for (int n = 0; n < 2; ++n) *(f32x4*)(out + off + bj * HALF + 4 * n) = acc[ai][bj][m][n] * rs * wv[bj][n]; } }
    }
};
struct EpiRelu2 {
    static constexpr bool PERM = true, AFTER_DRAIN = false;
    bf16_t* H; const float* ss; const float* sw; int rowbase;
    template <bool WT> __device__ __forceinline__ void run(const f32x4 (&acc)[2][2][4][2], const Unit& u, int wr, int wc, int fr, int fq) const {
        asm volatile("" : "+v"(fr), "+v"(fq));
        const int row0 = u.pm * BM + (u.single ? u.sub * HALF : 0) + wr * 64 + fr; const int col0 = u.pn * BM + wc * 32 + 8 * fq;
        const int grow0 = rowbase + u.pm * BM; const int mi = grow0 < 8192 ? 0 : 1 + ((grow0 - 8192) >> 11);
        f32x4 swv[2][2];
#pragma unroll
        for (int bj = 0; bj < 2; ++bj)
#pragma unroll
            for (int n = 0; n < 2; ++n) swv[bj][n] = *(const f32x4*)(sw + (size_t)mi * 4096 + col0 + bj * HALF + 4 * n);
        float ssv[2][4];
#pragma unroll
        for (int ai = 0; ai < 2; ++ai)
#pragma unroll
            for (int m = 0; m < 4; ++m) ssv[ai][m] = ss[rowbase + row0 + (u.single ? 0 : ai) * HALF + m * 16];
#pragma unroll
        for (int ai = 0; ai < 2; ++ai) { if (ai == 1 && u.single) break;
#pragma unroll
            for (int m = 0; m < 4; ++m) { bf16_t* rowp = H + (size_t)(row0 + ai * HALF + m * 16) * 4096 + col0;
                const float rs = 1.0f / sqrtf(ssv[ai][m] * (1.0f / 1024.0f) + 1e-6f);
#pragma unroll
                for (int bj = 0; bj < 2; ++bj) { f32x4 v0 = acc[ai][bj][m][0] * rs + swv[bj][0], v1 = acc[ai][bj][m][1] * rs + swv[bj][1];
#pragma unroll
                    for (int e = 0; e < 4; ++e) { const float a = fmaxf(v0[e], 0.f), b = fmaxf(v1[e], 0.f); v0[e] = a * a; v1[e] = b * b; }
                    u32x4 w; w.x = cvt_pk_bf16(v0[0], v0[1]); w.y = cvt_pk_bf16(v0[2], v0[3]); w.z = cvt_pk_bf16(v1[0], v1[1]); w.w = cvt_pk_bf16(v1[2], v1[3]);
                    st16<WT>(rowp + bj * HALF, w); } } }
    }
};

template <class Epi, class Sched, bool ALIGN_EPI = false, bool SP2 = false, bool SINGLE = false>
__device__ __forceinline__ void gemm_phase(PG8_LAS unsigned char* lds, const Gemm g, const Sched& S, const Epi& E, int wave_id, bool bpre) {
    int tid; asm volatile("v_mbcnt_lo_u32_b32 %0, -1, 0\n\tv_mbcnt_hi_u32_b32 %0, -1, %0" : "=v"(tid)); tid += wave_id * 64;
    const int wid = __builtin_amdgcn_readfirstlane(tid >> 6), lane = tid & 63, wr = wid >> 2, wc = wid & 3, fr = lane & 15, fq = lane >> 4;
    const int K = g.K, nt = K / BK;
    unsigned voffA[2], voffB[2];
#pragma unroll
    for (int i = 0; i < 2; ++i) { int R, C; stage_rc(tid * 16 + i * 8192, R, C); const int Rb = Epi::PERM ? ((R & ~31) + perm32(R & 31)) : R;
        voffA[i] = (unsigned)(R * K + C) * 2u; voffB[i] = (unsigned)(Rb * K + C) * 2u; }
    const size_t kstep = (size_t)(BK * 2);
    const size_t hstep = (size_t)HALF * K * 2;
    const size_t tstep = 2 * hstep;
    const unsigned ldsw = (unsigned)wid * 1024u;
    const int aoff = lds_byte(wr * 64 + fr, fq * 8), boff = lds_byte(wc * 32 + fr, fq * 8);
#define PG8_SA(b, h) (((b) * 2 + (h)) * HTB)
#define PG8_SB(b, h) ((4 + (b) * 2 + (h)) * HTB)
#define PG8_STAGE(bufoff, gbase, voff) do { _Pragma("unroll") for (int _i = 0; _i < 2; ++_i) \
        __builtin_amdgcn_global_load_lds((const unsigned*)((const char*)(gbase) + (voff)[_i]), (PG8_LAS unsigned*)(lds + (bufoff) + ldsw + _i * 8192), 16, 0, 0); } while (0)
#define PG8_LDA(dst, b, h) do { _Pragma("unroll") for (int m = 0; m < 4; ++m) _Pragma("unroll") for (int k = 0; k < 2; ++k) dst[m][k] = *(const PG8_LAS bf16x8*)(lds + PG8_SA(b, h) + aoff + m * 2048 + k * 1024); } while (0)
#define PG8_LDB(dst, b, h) do { _Pragma("unroll") for (int n = 0; n < 2; ++n) _Pragma("unroll") for (int k = 0; k < 2; ++k) dst[n][k] = *(const PG8_LAS bf16x8*)(lds + PG8_SB(b, h) + boff + n * 2048 + k * 1024); } while (0)
#define PG8_MMA(ai, bj, At, Bt) do { __builtin_amdgcn_s_setprio(1); _Pragma("unroll") for (int m = 0; m < 4; ++m) _Pragma("unroll") for (int n = 0; n < 2; ++n) _Pragma("unroll") for (int k = 0; k < 2; ++k) \
        acc[ai][bj][m][n] = __builtin_amdgcn_mfma_f32_16x16x32_bf16(Bt[n][k], At[m][k], acc[ai][bj][m][n], 0, 0, 0); __builtin_amdgcn_s_setprio(0); } while (0)
#define PG8_WAIT_V(n) asm volatile("s_waitcnt vmcnt(" #n ")" ::: "memory")
#define PG8_WAIT_L(n) asm volatile("s_waitcnt lgkmcnt(" #n ")" ::: "memory")
#define PG8_BAR __builtin_amdgcn_s_barrier()
#define PG8_SCHED __builtin_amdgcn_sched_barrier(0)
    Unit cur, nxt; int ui = 0;
    if (!S.next(0, cur)) return;
    f32x4 acc[2][2][4][2];
#pragma unroll
    for (int a = 0; a < 2; ++a)
#pragma unroll
        for (int b = 0; b < 2; ++b)
#pragma unroll
            for (int m = 0; m < 4; ++m)
#pragma unroll
                for (int n = 0; n < 2; ++n) acc[a][b][m][n] = (f32x4){0.f, 0.f, 0.f, 0.f};
    bf16x8 At[4][2], B0[2][2], B1[2][2];
    const char* cA = (const char*)g.A + (size_t)cur.pm * tstep + (cur.single ? (size_t)cur.sub * hstep : (size_t)0); const char* cB = (const char*)g.Bt + (size_t)cur.pn * tstep;
    constexpr bool full = !SINGLE; const unsigned hA = SINGLE ? 0u : (unsigned)hstep;
    S.a_ready(cur);
    if constexpr (SP2) {
        if (!bpre) { PG8_STAGE(PG8_SB(0, 0), cB, voffB); PG8_STAGE(PG8_SB(0, 1), cB + hstep, voffB); } PG8_STAGE(PG8_SA(0, 0), cA, voffA); PG8_STAGE(PG8_SA(0, 1), cA + hA, voffA);
        if (wr == 1) PG8_BAR;
        PG8_WAIT_V(2); PG8_BAR;
        if (!bpre) PG8_STAGE(PG8_SB(1, 0), cB + kstep, voffB); PG8_STAGE(PG8_SA(1, 0), cA + kstep, voffA); if (!bpre) PG8_STAGE(PG8_SB(1, 1), cB + hstep + kstep, voffB);
        if (bpre) PG8_WAIT_V(2); else PG8_WAIT_V(6); PG8_BAR;
    } else {
        PG8_STAGE(PG8_SB(0, 0), cB, voffB); PG8_STAGE(PG8_SA(0, 0), cA, voffA); PG8_STAGE(PG8_SB(0, 1), cB + hstep, voffB); PG8_STAGE(PG8_SA(0, 1), cA + hA, voffA);
        if (wr == 1) PG8_BAR;
        PG8_WAIT_V(4); PG8_BAR;
        PG8_STAGE(PG8_SB(1, 0), cB + kstep, voffB); PG8_STAGE(PG8_SA(1, 0), cA + kstep, voffA); PG8_STAGE(PG8_SB(1, 1), cB + hstep + kstep, voffB);
        PG8_WAIT_V(6); PG8_BAR;
    }
    for (;;) {
        const bool has_next = S.next(ui + 1, nxt);
        const char* nA = has_next ? (const char*)g.A + (size_t)nxt.pm * tstep + (nxt.single ? (size_t)nxt.sub * hstep : (size_t)0) : cA; const char* nB = has_next ? (const char*)g.Bt + (size_t)nxt.pn * tstep : cB;

        for (int t = 0; t < nt; t += 2) {
            const bool last = (t == nt - 2);
            const char* a1 = cA + (size_t)(t + 1) * kstep;
            const char* a2 = last ? nA : cA + (size_t)(t + 2) * kstep; const char* b2 = last ? nB : cB + (size_t)(t + 2) * kstep;
            const char* a3 = a2 + kstep; const char* b3 = b2 + kstep; const unsigned h2 = hA;
            if (last && has_next) S.a_ready(nxt);
            if constexpr (SP2) {
            PG8_LDB(B0, 0, 0); PG8_LDB(B1, 0, 1); PG8_SCHED; PG8_LDA(At, 0, 0); PG8_STAGE(PG8_SA(1, 1), a1 + hA, voffA);
            PG8_WAIT_V(8); PG8_WAIT_L(0); PG8_BAR; PG8_MMA(0, 0, At, B0); PG8_MMA(0, 1, At, B1); PG8_BAR; PG8_SCHED;
            if constexpr (full) PG8_LDA(At, 0, 1); PG8_STAGE(PG8_SB(0, 0), b2, voffB); PG8_STAGE(PG8_SB(0, 1), b2 + hstep, voffB); PG8_STAGE(PG8_SA(0, 0), a2, voffA);
            PG8_WAIT_V(8); PG8_WAIT_L(0); PG8_BAR; if constexpr (full) { PG8_MMA(1, 0, At, B0); PG8_MMA(1, 1, At, B1); } PG8_BAR; PG8_SCHED;
            PG8_LDB(B0, 1, 0); PG8_LDB(B1, 1, 1); PG8_SCHED; PG8_LDA(At, 1, 0); PG8_STAGE(PG8_SA(0, 1), a2 + h2, voffA);
            PG8_WAIT_V(8); PG8_WAIT_L(0); PG8_BAR; PG8_MMA(0, 0, At, B0); PG8_MMA(0, 1, At, B1); PG8_BAR; PG8_SCHED;
            if constexpr (full) PG8_LDA(At, 1, 1); PG8_STAGE(PG8_SB(1, 0), b3, voffB); PG8_STAGE(PG8_SB(1, 1), b3 + hstep, voffB); PG8_STAGE(PG8_SA(1, 0), a3, voffA);
            PG8_WAIT_V(8); PG8_WAIT_L(0); PG8_BAR; if constexpr (full) { PG8_MMA(1, 0, At, B0); PG8_MMA(1, 1, At, B1); } PG8_BAR; PG8_SCHED;
            } else {
            PG8_LDB(B0, 0, 0); PG8_SCHED; PG8_LDA(At, 0, 0); PG8_STAGE(PG8_SA(1, 1), a1 + hA, voffA);
            PG8_WAIT_L(8); PG8_BAR; PG8_WAIT_L(0); PG8_MMA(0, 0, At, B0); PG8_BAR; PG8_SCHED;
            PG8_LDB(B1, 0, 1); PG8_STAGE(PG8_SB(0, 0), b2, voffB);
            PG8_BAR; PG8_WAIT_L(0); PG8_MMA(0, 1, At, B1); PG8_BAR;
            PG8_LDA(At, 0, 1); PG8_STAGE(PG8_SA(0, 0), a2, voffA);
            PG8_BAR; PG8_WAIT_L(0); if constexpr (full) PG8_MMA(1, 0, At, B0); PG8_BAR; PG8_SCHED;
            PG8_STAGE(PG8_SB(0, 1), b2 + hstep, voffB);
            PG8_WAIT_V(6); PG8_BAR; if constexpr (full) PG8_MMA(1, 1, At, B1); PG8_BAR;
            PG8_LDB(B0, 1, 0); PG8_SCHED; PG8_LDA(At, 1, 0); PG8_STAGE(PG8_SA(0, 1), a2 + h2, voffA);
            PG8_WAIT_L(8); PG8_BAR; PG8_WAIT_L(0); PG8_MMA(0, 0, At, B0); PG8_BAR; PG8_SCHED;
            PG8_LDB(B1, 1, 1); PG8_STAGE(PG8_SB(1, 0), b3, voffB);
            PG8_BAR; PG8_WAIT_L(0); PG8_MMA(0, 1, At, B1); PG8_BAR;
            PG8_LDA(At, 1, 1); PG8_STAGE(PG8_SA(1, 0), a3, voffA);
            PG8_BAR; PG8_WAIT_L(0); if constexpr (full) PG8_MMA(1, 0, At, B0); PG8_BAR; PG8_SCHED;
            PG8_STAGE(PG8_SB(1, 1), b3 + hstep, voffB);
            PG8_WAIT_V(6); PG8_BAR; if constexpr (full) PG8_MMA(1, 1, At, B1); PG8_BAR;
            }
        }
        if constexpr (ALIGN_EPI) { if (wr == 0) PG8_BAR; }
        if constexpr (!Epi::AFTER_DRAIN) { int ln_; LANE_ID(ln_); E.template run<SINGLE>(acc, cur, wr, wc, ln_ & 15, ln_ >> 4); S.done(cur); }
        if (!has_next) break;
#pragma unroll
        for (int a = 0; a < 2; ++a)
#pragma unroll
            for (int b = 0; b < 2; ++b)
#pragma unroll
                for (int m = 0; m < 4; ++m)
#pragma unroll
                    for (int n = 0; n < 2; ++n) acc[a][b][m][n] = (f32x4){0.f, 0.f, 0.f, 0.f};
        cur = nxt; cA = nA; cB = nB; ++ui;
        if constexpr (ALIGN_EPI) { if (wr == 1) PG8_BAR; }
    }
    PG8_WAIT_V(0);
    if constexpr (!ALIGN_EPI) { if (wr == 0) PG8_BAR; }
    PG8_BAR;
#undef PG8_SA
#undef PG8_SB
#undef PG8_STAGE
#undef PG8_LDA
#undef PG8_LDB
#undef PG8_MMA
#undef PG8_WAIT_V
#undef PG8_WAIT_L
#undef PG8_BAR
#undef PG8_SCHED
}
__device__ __forceinline__ bool gemm_prefetch_b(PG8_LAS unsigned char* lds, const bf16_t* Bt, int M, int N, int K, int G, int c, int wave_id) {
    StaticOrder S0; S0.init(M, N, G, c, 0); Unit u; bool in0 = S0.next(0, u);
    if (!in0) { StaticOrder S1; S1.init(M, N, G, c, 1); if (!S1.next(0, u)) return false; }
    int tid; asm volatile("v_mbcnt_lo_u32_b32 %0, -1, 0\n\tv_mbcnt_hi_u32_b32 %0, -1, %0" : "=v"(tid)); tid += wave_id * 64;
    const int wid = __builtin_amdgcn_readfirstlane(tid >> 6);
    const unsigned ldsw = (unsigned)wid * 1024u;
    const size_t kstep = (size_t)(BK * 2), hstep = (size_t)HALF * K * 2, tstep = 2 * hstep;
    const char* cB = (const char*)Bt + (size_t)u.pn * tstep;
#pragma unroll
    for (int i = 0; i < 2; ++i) { int R, C; stage_rc(tid * 16 + i * 8192, R, C); const int Rb = (R & ~31) + perm32(R & 31); const unsigned vo = (unsigned)(Rb * K + C) * 2u;
#pragma unroll
        for (int b = 0; b < 2; ++b)
#pragma unroll
            for (int h = 0; h < 2; ++h)
                __builtin_amdgcn_global_load_lds((const unsigned*)(cB + (size_t)b * kstep + (size_t)h * hstep + vo), (PG8_LAS unsigned*)(lds + (4 + b * 2 + h) * HTB + ldsw + i * 8192), 16, 0, 0); }
    return in0;
}
}

constexpr int NWAVES = 8;
constexpr int D = 1024, MC = 8192, ML = 16384, M = MC + ML, DIN = 2304, DFF = 4096, DG = 256, MP0 = 16384;
constexpr float EPS = 1e-6f;
constexpr size_t MiB = 1u << 20;
constexpr size_t WS_CTL = 0, CTL_ZERO_BYTES = 1 * MiB;
constexpr size_t WS_MOD = 1 * MiB;
constexpr size_t WS_ROPE = WS_MOD + 2 * 9 * 6144 * 4;
constexpr size_t WS_LAM = WS_ROPE + 64 * 16 * 4;
constexpr size_t WS_RGWT = WS_LAM + 256;
constexpr size_t WS_POOLT = WS_RGWT + 32 * 4096 * 2;
constexpr size_t WS_CARRY = WS_POOLT + 8 * 4096 * 2;
constexpr size_t WS_WIN = 2 * MiB;
constexpr size_t WS_WOUT = WS_WIN + 2ull * 2304 * 1024 * 2;
constexpr size_t WS_W1 = WS_WOUT + 2ull * 1024 * 1024 * 2;
constexpr size_t WS_W2 = WS_W1 + 2ull * 4096 * 1024 * 2;
constexpr size_t WS_CK = WS_W2 + 2ull * 4096 * 1024 * 2;
constexpr size_t WS_CV = WS_CK + 2 * MiB;
constexpr size_t WS_SW = 51 * MiB;
constexpr size_t WS_SS = 512 * 1024;
constexpr size_t WS_CARRY1 = 51 * MiB + 512 * 1024;
constexpr size_t WS_SP8 = WS_CARRY1 + 256 * 1024;
constexpr size_t WS_XN = 52 * MiB;
constexpr size_t WS_XR = 52 * MiB;
constexpr size_t OUT_XN_BYTES = 48 * MiB;
constexpr size_t WS_Y = 100 * MiB;
constexpr size_t WS_Z = 148 * MiB;
constexpr size_t WS_END = 256 * MiB;
static_assert(WS_SS + 5ull * 24576 * 4 <= CTL_ZERO_BYTES && WS_SW + 2ull * 9 * 6400 * 4 <= WS_XN, "ss/sw map");
static_assert(WS_CARRY + 8 * 8 * 4 * 2 * 64 * 2 * 4 <= WS_WIN && WS_CV + 2 * MiB <= WS_XN && WS_Z + (size_t)M * DIN * 2 <= WS_END, "d_ws map");
constexpr int CW_BAR = 4096, CW_FIN = 8192, CW_RG = 12288;
constexpr size_t OUT_Y = 0, OUT_CK = (size_t)M * D, OUT_CV = OUT_CK + 32ull * 2 * 4 * 256 * 64, OUT_ST = OUT_CV + 32ull * 2 * 4 * 256 * 64;
constexpr int RING_BYTES = 131072, LDSCTL_OFF = RING_BYTES, MISC_OFF = LDSCTL_OFF + 320, LDS_BYTES = 147456;

#define GAS __attribute__((address_space(1)))
#define LAS __attribute__((address_space(3)))
typedef unsigned short bf16;
typedef unsigned v4u __attribute__((ext_vector_type(4)));
typedef unsigned v2u __attribute__((ext_vector_type(2)));
typedef float f32x4 __attribute__((ext_vector_type(4)));
typedef GAS unsigned gu32;
#define RLX_AGENT __ATOMIC_RELAXED, __HIP_MEMORY_SCOPE_AGENT
#define LDS_WAIT() asm volatile("s_waitcnt lgkmcnt(0)" ::: "memory")
__device__ __forceinline__ unsigned f2bf(float f) { unsigned u = __builtin_bit_cast(unsigned, f); return (u + 0x7fffu + ((u >> 16) & 1u)) >> 16; }
__device__ __forceinline__ unsigned pk2(float lo, float hi) { return f2bf(lo) | (f2bf(hi) << 16); }
__device__ __forceinline__ float bf2f(unsigned h) { return __uint_as_float(h << 16); }
__device__ __forceinline__ float bflo(unsigned w) { return __uint_as_float(w << 16); }
__device__ __forceinline__ float bfhi(unsigned w) { return __uint_as_float(w & 0xffff0000u); }

#define XB_TMO      128
#define XB_XCNT(j)  (256  + 64 * (j))
#define XB_XSUB(j)  (1280 + 64 * (j))
#define XB_XGEN(j)  (2304 + 64 * (j))
#define XB_TOP      3328
#define XB_TOPGEN   3392
#define XCD_BAR_WORDS 3456
#define XB_SPIN_CAP (1u << 18)
__device__ __forceinline__ unsigned xb_ld(unsigned* p)              { return __hip_atomic_load(p, __ATOMIC_RELAXED, __HIP_MEMORY_SCOPE_AGENT); }
__device__ __forceinline__ unsigned xb_add(unsigned* p, unsigned v) { return __hip_atomic_fetch_add(p, v, __ATOMIC_RELAXED, __HIP_MEMORY_SCOPE_AGENT); }
__device__ __forceinline__ unsigned xb_xcc_id() { return (unsigned)__builtin_amdgcn_s_getreg((3 << 11) | 20) & 0xFu; }
#define XB_SPIN(cond, bar) do { unsigned _sp = 0; while (cond) { __builtin_amdgcn_s_sleep(1); \
    if ((++_sp & 255u) == 0u) { if (xb_ld(&(bar)[XB_TMO])) break; if (_sp > XB_SPIN_CAP) { atomicAdd(&(bar)[XB_TMO], 1u); break; } } } } while (0)
struct XcdBarrier { unsigned* bar; unsigned x; volatile LAS unsigned* st; };
__device__ __forceinline__ XcdBarrier xcd_barrier_post(unsigned* bar, volatile LAS unsigned* st) {
    XcdBarrier b; b.bar = bar; b.x = xb_xcc_id(); b.st = st;
    if (threadIdx.x == 0) (void)xb_add(&bar[XB_XCNT(b.x)], 1u);
    return b;
}
__device__ __forceinline__ void xcd_barrier_complete(unsigned* bar, unsigned x, unsigned& nloc, unsigned& nx) {
    const unsigned G = gridDim.x * gridDim.y * gridDim.z;
    unsigned sum, cnt, mine, sp = 0u;
    for (;;) {
        sum = 0u; cnt = 0u;
        for (unsigned j = 0; j < 16; ++j) { const unsigned c = xb_ld(&bar[XB_XCNT(j)]); sum += c; cnt += (c > 0u) ? 1u : 0u; }
        mine = xb_ld(&bar[XB_XCNT(x)]);
        if (sum == G) break;
        __builtin_amdgcn_s_sleep(1);
        if ((++sp & 255u) == 0u) { if (xb_ld(&bar[XB_TMO])) break; if (sp > XB_SPIN_CAP) { atomicAdd(&bar[XB_TMO], 1u); break; } }
    }
    nloc = mine > 0u ? mine : 1u; nx = cnt > 0u ? cnt : 1u;
}
__device__ __forceinline__ void xcd_barrier(const XcdBarrier& b) {
    asm volatile("s_waitcnt vmcnt(0)" ::: "memory");
    __syncthreads();
    if (threadIdx.x == 0) {
        unsigned* bar = b.bar; asm volatile("" : "+s"(bar)); unsigned bx_ = b.x; asm volatile("" : "+s"(bx_));
        __builtin_amdgcn_s_waitcnt(0);
        unsigned nloc = b.st[0], nx = b.st[1];
        if (nloc == 0u) { xcd_barrier_complete(bar, bx_, nloc, nx); b.st[0] = nloc; b.st[1] = nx; }
        const unsigned old = xb_add(&bar[XB_XSUB(bx_)], 1u);
        const unsigned gen = old / nloc;
        if (old + 1u == (gen + 1u) * nloc) {
            __builtin_amdgcn_fence(__ATOMIC_RELEASE, "agent");
            asm volatile("s_waitcnt vmcnt(0)" ::: "memory");
            const unsigned og = xb_add(&bar[XB_TOP], 1u);
            const unsigned tg = og / nx;
            if (og + 1u == (tg + 1u) * nx) xb_add(&bar[XB_TOPGEN], 1u);
            else XB_SPIN(xb_ld(&bar[XB_TOPGEN]) == tg, bar);
            __builtin_amdgcn_fence(__ATOMIC_ACQUIRE, "agent");
            xb_add(&bar[XB_XGEN(bx_)], 1u);
            asm volatile("s_waitcnt vmcnt(0)" ::: "memory");
        } else {
            XB_SPIN(xb_ld(&bar[XB_XGEN(bx_)]) == gen, bar);
            __builtin_amdgcn_fence(__ATOMIC_ACQUIRE, "agent");
            asm volatile("s_waitcnt vmcnt(0)" ::: "memory");
        }
    }
    __syncthreads();
}

struct Args { const float* in[25]; float* out; unsigned char* ws; int ph_lo, ph_hi; };
#define INP(A_, i) inp_ptr(F, (i))
struct Frame {
    LAS unsigned char* lds; LAS unsigned char* lds0; int tid, lane, wave, wave0, vcu, vcu0, G;
    float* out; unsigned char* ws; float* out0; unsigned char* ws0;
};
__device__ __forceinline__ const float* inp_ptr(const Frame& F, int i) {
    const volatile LAS unsigned* t = (const volatile LAS unsigned*)(F.lds + 131072) + 2 * i;
    const unsigned lo = __builtin_amdgcn_readfirstlane(t[0]), hi = __builtin_amdgcn_readfirstlane(t[1]);
    return (const float*)(((unsigned long long)hi << 32) | lo);
}
#define PHASE_IDS(F) do { int t_; asm volatile("v_mbcnt_lo_u32_b32 %0, -1, 0\n\tv_mbcnt_hi_u32_b32 %0, -1, %0" : "=v"(t_)); int wv_ = (F).wave0; asm volatile("" : "+s"(wv_)); int vc_ = (F).vcu0; asm volatile("" : "+s"(vc_)); (F).vcu = vc_; (F).lane = t_; (F).wave = wv_; (F).tid = wv_ * 64 + t_; \
    unsigned l_ = (unsigned)(uintptr_t)(F).lds0; asm volatile("" : "+s"(l_)); (F).lds = (LAS unsigned char*)(uintptr_t)l_; unsigned char* w_ = (F).ws0; asm volatile("" : "+s"(w_)); (F).ws = w_; float* o_ = (F).out0; asm volatile("" : "+s"(o_)); (F).out = o_; } while (0)
enum { I_XP = 0, I_XS, I_CK, I_CV, I_ST, I_C, I_CCTX, I_WADA, I_BADA, I_NORMW, I_WIN, I_DLAM, I_SUBLN, I_CBW, I_CCW, I_CCB, I_RGW, I_RGB, I_RGLAM, I_POOLW, I_POOLS, I_WOUT, I_W1, I_W2, I_FNW };

__device__ __forceinline__ float wave_sum(float v, int lane) {
#pragma unroll
    for (int o = 1; o < 64; o <<= 1) v += shx(v, o, lane);
    return v;
}
__device__ __forceinline__ float wave_max(float v, int lane) {
#pragma unroll
    for (int o = 1; o < 64; o <<= 1) v = fmaxf(v, shx(v, o, lane));
    return v;
}
__device__ __forceinline__ float gelu_tanh(float x) { const float u = 0.7978845608028654f * (x + 0.044715f * x * x * x); return 0.5f * x * (1.0f + tanhf(u)); }

__device__ __forceinline__ void glds16(const void* gsrc, unsigned lds_dst) { unsigned keep;
    asm volatile("s_mov_b32 %0, m0\n\ts_mov_b32 m0, %2\n\ts_nop 0\n\tglobal_load_lds_dwordx4 %1, off\n\ts_mov_b32 m0, %0" : "=&s"(keep) : "v"(gsrc), "s"(lds_dst) : "memory"); }
struct TItem { const float* W; bf16* WT; int K, N, item; };
__device__ __forceinline__ void p0_titem_load(const TItem& t, int lane, unsigned slot) {
    const int nblk = t.N / 32, kb = t.item / nblk, nb = t.item % nblk, k0 = 64 * kb, n0 = 32 * nb;
    const float* src = t.W + (size_t)(k0 + (lane >> 3)) * t.N + n0;
#pragma unroll
    for (int i = 0; i < 8; ++i) glds16(src + (size_t)(8 * i) * t.N + 4 * ((lane & 7) ^ i), slot + 1024u * i);
}
__device__ __forceinline__ void p0_titem_finish(const TItem& t, const LAS float* scr, int lane, bool first) {
    const int nblk = t.N / 32, kb = t.item / nblk, nb = t.item % nblk, k0 = 64 * kb, n0 = 32 * nb;
    if (first) asm volatile("s_waitcnt vmcnt(8)" ::: "memory"); else asm volatile("s_waitcnt vmcnt(12)" ::: "memory");
    const int c = lane & 7;
#pragma unroll
    for (int j = 0; j < 4; ++j) { const int n = (lane >> 3) + 8 * j; const LAS float* sp = scr + (8 * c) * 32 + (((n >> 2) ^ c) << 2) + (n & 3);
        v4u o; o.x = pk2(sp[0 * 32], sp[1 * 32]); o.y = pk2(sp[2 * 32], sp[3 * 32]); o.z = pk2(sp[4 * 32], sp[5 * 32]); o.w = pk2(sp[6 * 32], sp[7 * 32]);
        *(GAS v4u*)(t.WT + (size_t)(n0 + n) * t.K + k0 + 8 * c) = o; }
    LDS_WAIT(); asm volatile("" ::: "memory");
}
__device__ __forceinline__ void p0_mod_item(Frame& F, const Args& A, int item) {
    const int l = item / 96, n0 = (item % 96) * 64;
    LAS float* sv = (LAS float*)F.lds;
    LAS float* red = sv + 9 * 1024;
    const float* c = INP(A, I_C); const float* cctx = INP(A, I_CCTX);
    for (int i = F.tid; i < 9 * 1024; i += 512) { const int mi = i >> 10, k = i & 1023; const float v = mi == 0 ? cctx[k] : c[(mi - 1) * 1024 + k]; sv[i] = v / (1.0f + expf(-v)); }
    __syncthreads();
    const int cg = F.tid & 15, rg = F.tid >> 4;
    float acc[9][4];
#pragma unroll
    for (int a = 0; a < 9; ++a)
#pragma unroll
        for (int j = 0; j < 4; ++j) acc[a][j] = 0.f;
    const float* wp = INP(A, I_WADA) + (size_t)l * 1024 * 6144 + n0 + cg * 4;
#pragma unroll 1
    for (int i0 = 0; i0 < 32; i0 += 8) { f32x4 w[8];
#pragma unroll
        for (int q = 0; q < 8; ++q) w[q] = *(const GAS f32x4*)(wp + (size_t)(rg + 32 * (i0 + q)) * 6144);
#pragma unroll
        for (int q = 0; q < 8; ++q) { const int k = rg + 32 * (i0 + q);
#pragma unroll
            for (int a = 0; a < 9; ++a) { const float sx = sv[a * 1024 + k];
#pragma unroll
                for (int j = 0; j < 4; ++j) acc[a][j] += sx * w[q][j]; } } }
#pragma unroll
    for (int a = 0; a < 9; ++a)
#pragma unroll
        for (int j = 0; j < 4; ++j) red[(rg * 9 + a) * 64 + cg * 4 + j] = acc[a][j];
    __syncthreads();
    float* mod = (float*)(F.ws + WS_MOD);
    for (int o = F.tid; o < 9 * 64; o += 512) { const int mi = o >> 6, n = o & 63; float sm = INP(A, I_BADA)[l * 6144 + n0 + n];
#pragma unroll 8
        for (int r = 0; r < 32; ++r) sm += red[(r * 9 + mi) * 64 + n];
        mod[(size_t)(l * 9 + mi) * 6144 + n0 + n] = sm; }
    __syncthreads();
}
__device__ __forceinline__ void sincos_d(double a, float& co, float& si) {
    const double TWO_PI = 6.283185307179586476925286766559;
    const double n = (double)(long long)(a / TWO_PI + 0.5);
    const double r = a - n * TWO_PI;
    const double r2 = r * r; double ts = r, tc = 1.0, ss = r, sc = 1.0;
    for (int k = 1; k <= 14; ++k) { tc = -tc * r2 / (double)((2 * k - 1) * (2 * k)); sc += tc; ts = -ts * r2 / (double)((2 * k) * (2 * k + 1)); ss += ts; }
    co = (float)sc; si = (float)ss;
}
__device__ __forceinline__ void p0_prologue(Frame& F, const Args& A) {
    PHASE_IDS(F);
    if (blockIdx.x < 192) p0_mod_item(F, A, blockIdx.x);
    const unsigned slot0 = (unsigned)__builtin_amdgcn_readfirstlane((int)(unsigned)(size_t)(F.lds + F.wave * 16384));
    const LAS float* scr0 = (const LAS float*)(F.lds + F.wave * 16384); const LAS float* scr1 = scr0 + 2048;
    const int gw = F.vcu * NWAVES + F.wave, NGW = F.G * NWAVES;
    constexpr int I_IN = 16 * 72, I_OUT = 16 * 32, I_1 = 16 * 128, I_2 = 64 * 32, I_L = I_IN + I_OUT + I_1 + I_2, I_RG = 32 * 2, I_PW = 8 * 2;
    constexpr int NITEMS = 2 * I_L + I_RG + I_PW;
    const float* pw_in = INP(A, I_WIN); const float* pw_out = INP(A, I_WOUT); const float* pw_1 = INP(A, I_W1); const float* pw_2 = INP(A, I_W2); const float* pw_rg = INP(A, I_RGW); const float* pw_pl = INP(A, I_POOLW);
    auto decode = [&](int it, TItem& t) {
        int r = it;
        if (r < 2 * I_L) { const int l = r / I_L; r -= l * I_L;
            if (r < I_IN) { t = TItem{pw_in + (size_t)l * 1024 * 2304, (bf16*)(F.ws + WS_WIN) + (size_t)l * 2304 * 1024, 1024, 2304, r}; return; } r -= I_IN;
            if (r < I_OUT) { t = TItem{pw_out + (size_t)l * 1024 * 1024, (bf16*)(F.ws + WS_WOUT) + (size_t)l * 1024 * 1024, 1024, 1024, r}; return; } r -= I_OUT;
            if (r < I_1) { t = TItem{pw_1 + (size_t)l * 1024 * 4096, (bf16*)(F.ws + WS_W1) + (size_t)l * 4096 * 1024, 1024, 4096, r}; return; } r -= I_1;
            t = TItem{pw_2 + (size_t)l * 4096 * 1024, (bf16*)(F.ws + WS_W2) + (size_t)l * 1024 * 4096, 4096, 1024, r}; return; }
        r -= 2 * I_L;
        if (r < I_RG) { const int mi = r >> 1; t = TItem{pw_rg + (size_t)mi * 4096, (bf16*)(F.ws + WS_RGWT) + (size_t)mi * 4096, 64, 64, r & 1}; return; } r -= I_RG;
        { const int mi = r >> 1; t = TItem{pw_pl + (size_t)mi * 4096, (bf16*)(F.ws + WS_POOLT) + (size_t)mi * 4096, 64, 64, r & 1}; }
    };
    if (gw < NITEMS) {
        const int cnt = (NITEMS - gw + NGW - 1) / NGW;
        TItem ta, tb;
        decode(gw, ta); p0_titem_load(ta, F.lane, slot0);
        for (int j = 0; j < cnt; j += 2) {
            { const int jn = j + 1 < cnt ? j + 1 : cnt - 1; decode(gw + jn * NGW, tb); p0_titem_load(tb, F.lane, slot0 + 8192u); }
            p0_titem_finish(ta, scr0, F.lane, j == 0);
            if (j + 1 >= cnt) break;
            { const int jn = j + 2 < cnt ? j + 2 : cnt - 1; decode(gw + jn * NGW, ta); p0_titem_load(ta, F.lane, slot0); }
            p0_titem_finish(tb, scr1, F.lane, false);
        }
        asm volatile("s_waitcnt vmcnt(0)" ::: "memory");
    }
    { const int gt = F.vcu * 512 + F.tid, NGT = F.G * 512;
      const float* pck = INP(A, I_CK); const float* pcv = INP(A, I_CV);
      for (int i0 = gt; i0 < 2 * 262144; i0 += 4 * NGT) { f32x4 v[4];
#pragma unroll
          for (int q = 0; q < 4; ++q) { const int i = i0 + q * NGT; if (i < 2 * 262144) { const int which = i >= 262144; const int j = which ? i - 262144 : i; v[q] = *(const GAS f32x4*)((which ? pcv : pck) + (size_t)j * 4); } }
#pragma unroll
          for (int q = 0; q < 4; ++q) { const int i = i0 + q * NGT; if (i < 2 * 262144) { const int which = i >= 262144; const int j = which ? i - 262144 : i; v2u o; o.x = pk2(v[q][0], v[q][1]); o.y = pk2(v[q][2], v[q][3]);
              *(GAS v2u*)((bf16*)(F.ws + (which ? WS_CV : WS_CK)) + (size_t)j * 4) = o; } } } }
    if (blockIdx.x == (unsigned)(F.G - 1)) {
        const double fr[8] = {1.0, 0.31622776601683794, 0.1, 0.031622776601683794, 0.01, 0.0031622776601683794, 0.001, 0.00031622776601683794};
        float* rope = (float*)(F.ws + WS_ROPE);
        { const int pos = F.tid >> 3, j = F.tid & 7; double f = fr[0];
#pragma unroll
          for (int q = 1; q < 8; ++q) f = (j == q) ? fr[q] : f;
          float co, si; sincos_d((double)pos * f, co, si); rope[pos * 16 + j * 2] = co; rope[pos * 16 + j * 2 + 1] = si; }
        { const float* rgl = INP(A, I_RGLAM); float* sp8 = (float*)(F.ws + WS_SP8);
          for (int i = F.tid; i < 2 * 2 * 256; i += 512) sp8[i] = 8.0f * 1.4426950408889634f * log1pf(expf(-rgl[i])); }
        if (F.tid < 2) { const int l = F.tid; const float* dl = INP(A, I_DLAM) + l * 128; float s1 = 0.f, s2 = 0.f;
            for (int i = 0; i < 32; ++i) { s1 += dl[i] * dl[32 + i]; s2 += dl[64 + i] * dl[96 + i]; }
            const float lam_init = 0.8f - 0.6f * expf(-0.3f * (float)l);
            ((float*)(F.ws + WS_LAM))[l] = expf(s1) - expf(s2) + lam_init; }
    }
}
__device__ __forceinline__ void prep0_phase(Frame& F, const Args& A) {
    PHASE_IDS(F);
    bf16* XN = (bf16*)((unsigned char*)F.out + OUT_XN_BYTES); float* SS0 = (float*)(F.ws + WS_SS); const float* mod = (const float*)(F.ws + WS_MOD);
    const float* xp = INP(A, I_XP); const float* xsm = INP(A, I_XS) - (size_t)MC * D; const float* nw = INP(A, I_NORMW);
    const int gw = F.vcu * NWAVES + F.wave, NGW = F.G * NWAVES; const int lane = F.lane;
    const int cmb = (int)blockIdx.x & 3, sl = cmb >> 1, which = cmb & 1, slot = (int)blockIdx.x >> 2; const int N = which ? DFF : DIN;
    const int ntile = which ? 4 : 3, ncol = which ? 64 : 48; const bool active = which ? (slot < 64) : (slot < 48);
    const int tile = F.wave & 3, kh = F.wave >> 2; const bool has = active && tile < ntile;
    const int n0 = (active ? slot : 0) * ncol + (tile < ntile ? tile : 0) * 16;
    LAS float* sh = (LAS float*)F.lds;
    LAS float* red = sh + 9 * 1024;
    { const float* shg = mod + (size_t)sl * 9 * 6144 + (which ? 3072 : 0);
      for (int i = F.tid; i < 9 * 256; i += 512) { const int mi = i >> 8, k4 = i & 255; *(LAS f32x4*)(sh + mi * 1024 + 4 * k4) = *(const f32x4*)(shg + (size_t)mi * 6144 + 4 * k4); } }
    const bf16* wbase = which ? (const bf16*)(F.ws + WS_W1) + (size_t)sl * DFF * D : (const bf16*)(F.ws + WS_WIN) + (size_t)sl * DIN * D;
    v4u wf[16];
    { const bf16* wt = wbase + (size_t)(n0 + (lane & 15)) * D + kh * 512 + (lane >> 4) * 8;
#pragma unroll
      for (int st = 0; st < 16; ++st) wf[st] = *(const GAS v4u*)(wt + 32 * st); }
    REP(13) for (int r0 = gw; r0 < M; r0 += 4 * NGW) {
        f32x4 v[4][4];
#pragma unroll
        for (int q = 0; q < 4; ++q) { const int r = r0 + q * NGW; const float* xr = (r < MC ? xp : xsm) + (size_t)r * D;
#pragma unroll
            for (int j = 0; j < 4; ++j) v[q][j] = *(const GAS f32x4*)(xr + 256 * j + 4 * lane); }
#pragma unroll
        for (int q = 0; q < 4; ++q) { const int r = r0 + q * NGW; const int mi = r < MC ? 0 : 1 + ((r - MC) >> 11);
            const float* mp = mod + (size_t)mi * 6144 + 1024;
            float sq = 0.f;
#pragma unroll
            for (int j = 0; j < 4; ++j) sq += (v[q][j][0] * v[q][j][0] + v[q][j][1] * v[q][j][1]) + (v[q][j][2] * v[q][j][2] + v[q][j][3] * v[q][j][3]);
#pragma unroll
            for (int j = 0; j < 4; ++j) { const int c = 256 * j + 4 * lane; const f32x4 w = *(const GAS f32x4*)(nw + c), sc = *(const GAS f32x4*)(mp + c);
                v2u pk; pk.x = pk2(v[q][j][0] * w[0] * (1.0f + sc[0]), v[q][j][1] * w[1] * (1.0f + sc[1])); pk.y = pk2(v[q][j][2] * w[2] * (1.0f + sc[2]), v[q][j][3] * w[3] * (1.0f + sc[3])); *(GAS v2u*)(XN + (size_t)r * D + c) = pk; }
            sq = wave_sum(sq, lane); if (lane == 0) *(GAS float*)(SS0 + r) = sq; }
    }
    __syncthreads();
    { const int mi = lane & 15, kg = lane >> 4; const LAS float* sp = sh + (mi < 9 ? mi : 0) * 1024 + kh * 512 + kg * 8; const float keep = mi < 9 ? 1.0f : 0.0f;
      pg8::f32x4 acc = {0.f, 0.f, 0.f, 0.f};
#pragma unroll
      for (int st = 0; st < 16; ++st) { const f32x4 s0 = *(const LAS f32x4*)(sp + 32 * st), s1 = *(const LAS f32x4*)(sp + 32 * st + 4);
          float x[8] = {s0[0] * keep, s0[1] * keep, s0[2] * keep, s0[3] * keep, s1[0] * keep, s1[1] * keep, s1[2] * keep, s1[3] * keep}; v4u hi, lo;
          hi.x = pg8::cvt_pk_bf16(x[0], x[1]); hi.y = pg8::cvt_pk_bf16(x[2], x[3]); hi.z = pg8::cvt_pk_bf16(x[4], x[5]); hi.w = pg8::cvt_pk_bf16(x[6], x[7]);
          lo.x = pg8::cvt_pk_bf16(x[0] - bflo(hi.x), x[1] - bfhi(hi.x)); lo.y = pg8::cvt_pk_bf16(x[2] - bflo(hi.y), x[3] - bfhi(hi.y));
          lo.z = pg8::cvt_pk_bf16(x[4] - bflo(hi.z), x[5] - bfhi(hi.z)); lo.w = pg8::cvt_pk_bf16(x[6] - bflo(hi.w), x[7] - bfhi(hi.w));
          const pg8::bf16x8 bw = __builtin_bit_cast(pg8::bf16x8, wf[st]);
          acc = __builtin_amdgcn_mfma_f32_16x16x32_bf16(__builtin_bit_cast(pg8::bf16x8, hi), bw, acc, 0, 0, 0);
          acc = __builtin_amdgcn_mfma_f32_16x16x32_bf16(__builtin_bit_cast(pg8::bf16x8, lo), bw, acc, 0, 0, 0); }
      if (kh == 1) *(LAS pg8::f32x4*)(red + (tile * 64 + lane) * 4) = acc;
      __syncthreads();
      if (kh == 0 && has) { const pg8::f32x4 o = *(const LAS pg8::f32x4*)(red + (tile * 64 + lane) * 4);
          float* obase = (float*)(F.ws + WS_SW) + (which ? 2 * 9 * 2304 + (size_t)sl * 9 * 4096 : (size_t)sl * 9 * 2304);
#pragma unroll
          for (int e = 0; e < 4; ++e) { const int m2 = 4 * kg + e; if (m2 < 9) *(GAS float*)(obase + (size_t)m2 * N + n0 + (lane & 15)) = acc[e] + o[e]; } }
      __syncthreads(); }
}
typedef short bf16x8_t __attribute__((ext_vector_type(8)));
typedef float f32x16 __attribute__((ext_vector_type(16)));
typedef short v4i16_t __attribute__((ext_vector_type(4)));
__device__ __forceinline__ unsigned cvtpk(float lo, float hi) { unsigned r; asm volatile("v_cvt_pk_bf16_f32 %0, %1, %2" : "=v"(r) : "v"(lo), "v"(hi)); return r; }
__device__ __forceinline__ bf16x8_t pack8(float a0, float a1, float a2, float a3, float a4, float a5, float a6, float a7) {
    v4u w; w.x = cvtpk(a0, a1); w.y = cvtpk(a2, a3); w.z = cvtpk(a4, a5); w.w = cvtpk(a6, a7); return __builtin_bit_cast(bf16x8_t, w); }
__device__ __forceinline__ v4i16_t lds_tr(LAS unsigned char* p) { return __builtin_amdgcn_ds_read_tr16_b64_v4i16((LAS v4i16_t*)p); }
#define MFMA32(a, b, c) __builtin_amdgcn_mfma_f32_32x32x16_bf16((a), (b), (c), 0, 0, 0)


__device__ __forceinline__ void attn_unit(Frame& F, const Args& A, int l, bool lat, int seq, int hd, int qb, float lam, float sub_mul) {
    LAS unsigned char* L = F.lds;
    const bf16* Z = (const bf16*)(F.ws + WS_Z); bf16* Y = (bf16*)(F.ws + WS_Y);
    const bf16* CK = (const bf16*)(F.ws + WS_CK); const bf16* CV = (const bf16*)(F.ws + WS_CV);
    int lane; LANE_ID(lane); const int w = F.wave, tid = w * 64 + lane, r32 = lane & 31, h = lane >> 5;
    const int zrow0 = lat ? MC + seq * 2048 : seq * 256;
    const int qrow = zrow0 + qb * 256 + w * 32 + r32;
    bf16x8_t qf[2][2];
#pragma unroll
    for (int s = 0; s < 2; ++s)
#pragma unroll
        for (int ks = 0; ks < 2; ++ks) qf[s][ks] = *(const bf16x8_t*)(Z + (size_t)qrow * DIN + hd * 64 + s * 32 + ks * 16 + h * 8);
    const int NT = lat ? 36 : 4;
    const unsigned lds0 = (unsigned)(uintptr_t)L;
    const int srow = 8 * w + (lane >> 3), spc = lane & 7;
    const int kch = spc ^ ((srow >> 1) & 7), vch = spc ^ (((srow >> 1) & 1) << 2);
    const size_t cbk = ((size_t)((seq * 2 + l) * 4 + hd) * 256 + srow) * 64 + kch * 8, cbv = ((size_t)((seq * 2 + l) * 4 + hd) * 256 + srow) * 64 + vch * 8;
    const size_t zbk = (size_t)(zrow0 + srow) * DIN + 256 + hd * 64 + kch * 8, zbv = (size_t)(zrow0 + srow) * DIN + 512 + hd * 64 + vch * 8;
#define ATT_DMA(tn, slot) do { const unsigned sb_ = (unsigned)(slot) * 16384u + (unsigned)w * 1024u; \
        const bf16* ks_ = (lat && (tn) < 4) ? CK + cbk + (size_t)(tn) * 4096 : Z + zbk + (size_t)((tn) - (lat ? 4 : 0)) * 64 * DIN; \
        const bf16* vs_ = (lat && (tn) < 4) ? CV + cbv + (size_t)(tn) * 4096 : Z + zbv + (size_t)((tn) - (lat ? 4 : 0)) * 64 * DIN; \
        glds16(ks_, (unsigned)__builtin_amdgcn_readfirstlane((int)(lds0 + sb_))); glds16(vs_, (unsigned)__builtin_amdgcn_readfirstlane((int)(lds0 + sb_ + 8192u))); } while (0)
    unsigned koff[2][2];
#pragma unroll
    for (int s = 0; s < 2; ++s)
#pragma unroll
        for (int ks = 0; ks < 2; ++ks) koff[s][ks] = r32 * 128 + (((s * 4 + ks * 2 + h) ^ ((r32 >> 1) & 7)) << 4);
    const int q_ = (lane & 15) >> 2, p_ = lane & 3, g1 = (lane >> 4) & 1, sw = (lane >> 3) & 1;
    const unsigned vb0 = 8192 + (4 * h + q_) * 128 + (((2 * g1 + (p_ >> 1)) ^ (sw << 2)) << 4) + (p_ & 1) * 8;
    const unsigned vb1 = 8192 + (4 * h + q_) * 128 + (((4 + 2 * g1 + (p_ >> 1)) ^ (sw << 2)) << 4) + (p_ & 1) * 8;
    ATT_DMA(0, 0); ATT_DMA(1, 1);
    __builtin_amdgcn_s_waitcnt(0x0F70);
    float mref[2] = {0.f, 0.f}, ls[2] = {0.f, 0.f};
    f32x16 o[2][2];
#pragma unroll
    for (int s = 0; s < 2; ++s)
#pragma unroll
        for (int db = 0; db < 2; ++db)
#pragma unroll
            for (int r = 0; r < 16; ++r) o[s][db][r] = 0.f;
    for (int t = 0, par = 0; t < NT; ++t, par = (par == 2 ? 0 : par + 1)) {
        const unsigned bo = (unsigned)par * 16384u;
        if (t + 1 < NT) asm volatile("s_waitcnt vmcnt(2)" ::: "memory"); else asm volatile("s_waitcnt vmcnt(0)" ::: "memory");
        __builtin_amdgcn_s_barrier(); asm volatile("" ::: "memory");
        if (t + 2 < NT) ATT_DMA(t + 2, (par == 0 ? 2 : par - 1));
        bf16x8_t kf[2][2][2], vf[2][4];
#pragma unroll
        for (int s = 0; s < 2; ++s)
#pragma unroll
            for (int ks = 0; ks < 2; ++ks) { kf[s][ks][0] = *(const LAS bf16x8_t*)(L + bo + koff[s][ks]); kf[s][ks][1] = *(const LAS bf16x8_t*)(L + bo + koff[s][ks] + 4096); }
#pragma unroll
        for (int db = 0; db < 2; ++db)
#pragma unroll
            for (int sp = 0; sp < 4; ++sp) { LAS unsigned char* vp = L + bo + (db ? vb1 : vb0) + sp * 2048; const v4i16_t lo = lds_tr(vp), hi = lds_tr(vp + 1024);
                vf[db][sp] = (bf16x8_t){lo[0], lo[1], lo[2], lo[3], hi[0], hi[1], hi[2], hi[3]}; }
        f32x16 p[2][2];
#pragma unroll
        for (int s = 0; s < 2; ++s) { const float nm = -mref[s];
#pragma unroll
            for (int r = 0; r < 16; ++r) { p[s][0][r] = nm; p[s][1][r] = nm; }
#pragma unroll
            for (int ks = 0; ks < 2; ++ks) { p[s][0] = MFMA32(kf[s][ks][0], qf[s][ks], p[s][0]); p[s][1] = MFMA32(kf[s][ks][1], qf[s][ks], p[s][1]); } }
        __builtin_amdgcn_sched_barrier(0);
        bf16x8_t pb[2][4];
#pragma unroll
        for (int s = 0; s < 2; ++s) {
            f32x16& p0 = p[s][0]; f32x16& p1 = p[s][1];
            float ma = fmaxf(fmaxf(p0[0], p0[1]), p1[0]), mb = fmaxf(fmaxf(p0[2], p0[3]), p1[1]); ma = fmaxf(fmaxf(ma, p1[2]), p1[3]);
#pragma unroll
            for (int r = 4; r < 16; r += 4) { ma = fmaxf(fmaxf(ma, p0[r]), p0[r + 1]); mb = fmaxf(fmaxf(mb, p0[r + 2]), p0[r + 3]); ma = fmaxf(fmaxf(ma, p1[r]), p1[r + 1]); mb = fmaxf(fmaxf(mb, p1[r + 2]), p1[r + 3]); }
            float mt = fmaxf(ma, mb); mt = fmaxf(mt, shx(mt, 32, lane));
            if (t == 0 || __any(mt > 8.0f)) {
                const float dl = (t == 0) ? mt : fmaxf(mt, 0.f); mref[s] += dl; const float al = (t == 0) ? 1.0f : __builtin_amdgcn_exp2f(-dl); ls[s] *= al;
#pragma unroll
                for (int r = 0; r < 16; ++r) { p0[r] -= dl; p1[r] -= dl; }
#pragma unroll
                for (int db = 0; db < 2; ++db)
#pragma unroll
                    for (int r = 0; r < 16; ++r) o[s][db][r] *= al; }
            float rs0 = 0.f, rs1 = 0.f;
#pragma unroll
            for (int r = 0; r < 16; ++r) { p0[r] = __builtin_amdgcn_exp2f(p0[r]); p1[r] = __builtin_amdgcn_exp2f(p1[r]); rs0 += p0[r]; asm volatile("" : "+v"(rs0)); rs1 += p1[r]; asm volatile("" : "+v"(rs1)); }
            ls[s] += rs0 + rs1;
            pb[s][0] = pack8(p0[0], p0[1], p0[2], p0[3], p0[4], p0[5], p0[6], p0[7]); pb[s][1] = pack8(p0[8], p0[9], p0[10], p0[11], p0[12], p0[13], p0[14], p0[15]);
            pb[s][2] = pack8(p1[0], p1[1], p1[2], p1[3], p1[4], p1[5], p1[6], p1[7]); pb[s][3] = pack8(p1[8], p1[9], p1[10], p1[11], p1[12], p1[13], p1[14], p1[15]);
            if (s == 0) {
                __builtin_amdgcn_sched_barrier(0);
#pragma unroll
                for (int db = 0; db < 2; ++db)
#pragma unroll
                    for (int sp = 0; sp < 4; ++sp) o[0][db] = MFMA32(vf[db][sp], pb[0][sp], o[0][db]);
            }
        }
        __builtin_amdgcn_sched_barrier(0);
#pragma unroll
        for (int db = 0; db < 2; ++db)
#pragma unroll
            for (int sp = 0; sp < 4; ++sp) o[1][db] = MFMA32(vf[db][sp], pb[1][sp], o[1][db]);
        __builtin_amdgcn_sched_barrier(0);
    }
    const float l0 = ls[0] + shx(ls[0], 32, lane), l1 = ls[1] + shx(ls[1], 32, lane);
    const float i0 = 1.0f / l0, i1 = lam / l1;
    float ss = 0.f;
#pragma unroll
    for (int db = 0; db < 2; ++db)
#pragma unroll
        for (int r = 0; r < 16; ++r) { const float v = o[0][db][r] * i0 - o[1][db][r] * i1; o[0][db][r] = v; ss += v * v; }
    ss += shx(ss, 32, lane);
    const float rn = sub_mul / sqrtf(ss * (1.0f / 64.0f) + EPS);
    const float* subw = INP(A, I_SUBLN) + l * 64;
    bf16* yrow = Y + (size_t)qrow * D + hd * 64;
#pragma unroll
    for (int db = 0; db < 2; ++db)
#pragma unroll
        for (int g = 0; g < 4; ++g) { const int d0 = 32 * db + 8 * g + 4 * h; const f32x4 sw4 = *(const f32x4*)(subw + d0);
            v2u pk; pk.x = cvtpk(o[0][db][4 * g] * rn * sw4[0], o[0][db][4 * g + 1] * rn * sw4[1]); pk.y = cvtpk(o[0][db][4 * g + 2] * rn * sw4[2], o[0][db][4 * g + 3] * rn * sw4[3]);
            *(GAS v2u*)(yrow + d0) = pk; }
    __syncthreads();
}


__device__ __forceinline__ float sigm(float x) { return __builtin_amdgcn_rcpf(1.0f + __builtin_amdgcn_exp2f(-1.4426950408889634f * x)); }
template <int DIRB> __device__ __forceinline__ void grp_comp(const f32x16& a, const f32x16& b, int g, float& Ag, float& Bg) {
    const float a0 = a[4 * g], a1 = a[4 * g + 1], a2 = a[4 * g + 2], a3 = a[4 * g + 3], b0 = b[4 * g], b1 = b[4 * g + 1], b2 = b[4 * g + 2], b3 = b[4 * g + 3];
    Ag = (a0 * a1) * (a2 * a3);
    if (!DIRB) { float t = b0; t = a1 * t + b1; t = a2 * t + b2; t = a3 * t + b3; Bg = t; }
    else { float t = b3; t = a2 * t + b2; t = a1 * t + b1; t = a0 * t + b0; Bg = t; }
}
template <int DIRB> __device__ __forceinline__ void wave_comp(const f32x16& a, const f32x16& b, int h, int lane, float& Aw, float& Bw) {
    Aw = 1.f; Bw = 0.f;
#pragma unroll
    for (int gi = 0; gi < 4; ++gi) { const int g = DIRB ? 3 - gi : gi;
        float Ag, Bg; grp_comp<DIRB>(a, b, g, Ag, Bg);
        const float Ao = shx(Ag, 32, lane), Bo = shx(Bg, 32, lane);
        const float A0 = h ? Ao : Ag, B0 = h ? Bo : Bg, A1 = h ? Ag : Ao, B1 = h ? Bg : Bo;
        float Ap, Bp;
        if (!DIRB) { Ap = A0 * A1; Bp = A1 * B0 + B1; } else { Ap = A0 * A1; Bp = A0 * B1 + B0; }
        Bw = Ap * Bw + Bp; Aw *= Ap; }
}
template <int DIRB> __device__ __forceinline__ void scan_final(const f32x16& a, const f32x16& b, int h, int lane, float X, f32x16& hout) {
    float S = X;
#pragma unroll
    for (int gi = 0; gi < 4; ++gi) { const int g = DIRB ? 3 - gi : gi;
        float Ag, Bg; grp_comp<DIRB>(a, b, g, Ag, Bg);
        const float Ao = shx(Ag, 32, lane), Bo = shx(Bg, 32, lane);
        const float A0 = h ? Ao : Ag, B0 = h ? Bo : Bg, A1 = h ? Ag : Ao, B1 = h ? Bg : Bo;
        if (!DIRB) { float st = h ? (Ao * S + Bo) : S;
#pragma unroll
            for (int e = 0; e < 4; ++e) { st = a[4 * g + e] * st + b[4 * g + e]; hout[4 * g + e] = st; }
            S = A1 * (A0 * S + B0) + B1; }
        else { float st = h ? S : (Ao * S + Bo);
#pragma unroll
            for (int e = 3; e >= 0; --e) { st = a[4 * g + e] * st + b[4 * g + e]; hout[4 * g + e] = st; }
            S = A0 * (A1 * S + B1) + B0; } }
}
__device__ __forceinline__ void rglru_unit(Frame& F, const Args& A, int l, int mode, int seq, int n, int chunk, int pv = 0) {
    const bf16* Z = (const bf16*)(F.ws + WS_Z); bf16* Y = (bf16*)(F.ws + WS_Y); const bf16* RGWT = (const bf16*)(F.ws + WS_RGWT);
    float* CARRY = (float*)(F.ws + (l == 0 ? WS_CARRY : WS_CARRY1));
    unsigned* rg_cnt = (unsigned*)(F.ws + WS_CTL) + CW_RG + 16 * ((l * 8 + seq) * 4 + n);
    int lane; LANE_ID(lane); const int w = F.wave, r32 = lane & 31, h = lane >> 5;
    const bool lat = mode != 0; const int T = lat ? 2048 : 256; const int row0 = lat ? MC + seq * 2048 : seq * 256; const int t0 = chunk * 256 + w * 32;
    LAS float* comp = (LAS float*)F.lds;
    LAS float* xcar = (LAS float*)(F.lds + 8192);
    LAS unsigned char* GR = F.lds + 16384 + w * 4096;
    LAS unsigned char* YO = F.lds + 16384 + 32768 + w * 4096;
    LAS float* CWL = (LAS float*)(F.lds + 81920 + w * 1280);
    const float* p_rgb = INP(A, I_RGB); const float* p_sp8 = (const float*)(F.ws + WS_SP8); const float* p_cw = INP(A, I_CCW) + l * 4 * 256; const float* p_cb = INP(A, I_CCB) + l * 256; const float* p_st = INP(A, I_ST);
    v4u gq[4];
    if (mode != 1) { const bf16* gp = Z + (size_t)(row0 + t0 + r32) * DIN + 1792 + n * 64 + h * 32;
#pragma unroll
        for (int q = 0; q < 4; ++q) gq[q] = *(const v4u*)(gp + 8 * q); }
    const int tk = t0 + r32;
    v4u zq[4][4];
#pragma unroll
    for (int ks = 0; ks < 4; ++ks) { const int c8 = n * 64 + 16 * ks + 8 * h;
#pragma unroll
        for (int j = 0; j < 4; ++j) { const int tt = tk + j - 2; const bool ok = tt >= 0 && tt < T; const int tc = ok ? tt : tk;
            zq[ks][j] = *(const v4u*)(Z + (size_t)(row0 + tc) * DIN + 1536 + c8); } }
    bf16x8_t wf[2][2][4];
#pragma unroll
    for (int dir = 0; dir < 2; ++dir)
#pragma unroll
        for (int gt = 0; gt < 2; ++gt) { const bf16* wp = RGWT + (size_t)((((l * 2 + dir) * 2 + gt) * 4 + n) * 4096) + r32 * 64 + 8 * h;
#pragma unroll
            for (int ks = 0; ks < 4; ++ks) wf[dir][gt][ks] = *(const bf16x8_t*)(wp + 16 * ks); }
    float cwv[5], kbr[2][2], kbi[2][2], ksp[2][2];
#pragma unroll
    for (int j = 0; j < 4; ++j) cwv[j] = ((const GAS float*)p_cw)[j * 256 + n * 64 + lane];
    cwv[4] = ((const GAS float*)p_cb)[n * 64 + lane];
#pragma unroll
    for (int hb = 0; hb < 2; ++hb)
#pragma unroll
        for (int dir = 0; dir < 2; ++dir) { const int c = n * 64 + 32 * hb + r32;
            kbr[hb][dir] = ((const GAS float*)p_rgb)[((l * 2 + dir) * 2 + 0) * 256 + c]; kbi[hb][dir] = ((const GAS float*)p_rgb)[((l * 2 + dir) * 2 + 1) * 256 + c]; ksp[hb][dir] = ((const GAS float*)p_sp8)[(l * 2 + dir) * 256 + c]; }
    if (mode == 2 && w == 0) { const int c = n * 64 + lane;
        for (unsigned spins = 0; spins < (1u << 20); ++spins) { const unsigned cdone = (unsigned)__builtin_amdgcn_readfirstlane((int)__hip_atomic_load(rg_cnt, __ATOMIC_RELAXED, __HIP_MEMORY_SCOPE_AGENT)); if (cdone >= 16u) break; __builtin_amdgcn_s_sleep(2); }
        float Xf = p_st[(size_t)((seq * 2 + l) * 2 + 0) * 256 + c], Xb = p_st[(size_t)((seq * 2 + l) * 2 + 1) * 256 + c];
        unsigned long long cf[8], cbk[8];
#pragma unroll
        for (int cc = 0; cc < 8; ++cc) { cf[cc] = __hip_atomic_load((const unsigned long long*)(CARRY + ((size_t)(((seq * 8 + cc) * 4 + n) * 2) * 64 + lane) * 2), __ATOMIC_RELAXED, __HIP_MEMORY_SCOPE_AGENT);
                                         cbk[cc] = __hip_atomic_load((const unsigned long long*)(CARRY + ((size_t)(((seq * 8 + cc) * 4 + n) * 2 + 1) * 64 + lane) * 2), __ATOMIC_RELAXED, __HIP_MEMORY_SCOPE_AGENT); }
#pragma unroll
        for (int cc = 0; cc < 8; ++cc) if (cc < chunk) Xf = __uint_as_float((unsigned)cf[cc]) * Xf + __uint_as_float((unsigned)(cf[cc] >> 32));
#pragma unroll
        for (int cc = 7; cc >= 0; --cc) if (cc > chunk) Xb = __uint_as_float((unsigned)cbk[cc]) * Xb + __uint_as_float((unsigned)(cbk[cc] >> 32));
        xcar[lane] = Xf; xcar[64 + lane] = Xb; }
    __builtin_amdgcn_sched_barrier(0);
    if (mode != 1) {
#pragma unroll
        for (int q = 0; q < 4; ++q) *(LAS v4u*)(GR + r32 * 128 + (h * 4 + q) * 16) = gq[q]; }
#pragma unroll
    for (int j = 0; j < 5; ++j) CWL[j * 64 + lane] = cwv[j];
    bf16x8_t xa[4];
#pragma unroll
    for (int ks = 0; ks < 4; ++ks) { const int cl8 = 16 * ks + 8 * h; const f32x4 cb0 = *(const LAS f32x4*)(CWL + 4 * 64 + cl8), cb1 = *(const LAS f32x4*)(CWL + 4 * 64 + cl8 + 4);
        float x[8] = {cb0[0], cb0[1], cb0[2], cb0[3], cb1[0], cb1[1], cb1[2], cb1[3]};
#pragma unroll
        for (int j = 0; j < 4; ++j) { const int tt = tk + j - 2; const float k = (tt >= 0 && tt < T) ? 1.f : 0.f; const v4u z = zq[ks][j]; const f32x4 w0 = *(const LAS f32x4*)(CWL + j * 64 + cl8), w1 = *(const LAS f32x4*)(CWL + j * 64 + cl8 + 4);
            x[0] += k * w0[0] * bflo(z.x); x[1] += k * w0[1] * bfhi(z.x); x[2] += k * w0[2] * bflo(z.y); x[3] += k * w0[3] * bfhi(z.y);
            x[4] += k * w1[0] * bflo(z.z); x[5] += k * w1[1] * bfhi(z.z); x[6] += k * w1[2] * bflo(z.w); x[7] += k * w1[3] * bfhi(z.w); }
        xa[ks] = pack8(x[0], x[1], x[2], x[3], x[4], x[5], x[6], x[7]); }
#pragma unroll 1
    for (int cb2 = 0; cb2 < 2; ++cb2) {
        const int cl = 32 * cb2 + r32, c = n * 64 + cl;
        LAS float* cmp = comp + cb2 * 1024;
        float cbr[2], cbi[2], csp[2];
#pragma unroll
        for (int dir = 0; dir < 2; ++dir) { cbr[dir] = cb2 ? kbr[1][dir] : kbr[0][dir]; cbi[dir] = cb2 ? kbi[1][dir] : kbi[0][dir]; csp[dir] = cb2 ? ksp[1][dir] : ksp[0][dir]; }
        f32x16 xcD;
#pragma unroll
        for (int r = 0; r < 16; ++r) xcD[r] = 0.f;
#pragma unroll
        for (int ks = 0; ks < 4; ++ks) { const bool hit = (cl >> 3) == (2 * ks + h); const int e = r32 & 7;
            bf16x8_t idf;
#pragma unroll
            for (int q = 0; q < 8; ++q) idf[q] = (hit && e == q) ? (short)0x3F80 : (short)0;
            xcD = MFMA32(xa[ks], idf, xcD); }
        f32x16 av[2], bv[2];
#pragma unroll
        for (int dir = 0; dir < 2; ++dir) {
            f32x16 gr, gi; const float biasr = cbr[dir], biasi = cbi[dir];
#pragma unroll
            for (int r = 0; r < 16; ++r) { gr[r] = biasr; gi[r] = biasi; }
#pragma unroll
            for (int ks = 0; ks < 4; ++ks) { gr = MFMA32(xa[ks], wf[dir][0][ks], gr); gi = MFMA32(xa[ks], wf[dir][1][ks], gi); }
            if (cb2 == 0) {
#pragma unroll
                for (int gt = 0; gt < 2; ++gt) { const bf16* wp = RGWT + (size_t)((((l * 2 + dir) * 2 + gt) * 4 + n) * 4096) + (32 + r32) * 64 + 8 * h;
#pragma unroll
                    for (int ks = 0; ks < 4; ++ks) wf[dir][gt][ks] = *(const bf16x8_t*)(wp + 16 * ks); } }
            const float sp8 = csp[dir];
#pragma unroll
            for (int r = 0; r < 16; ++r) { const float rr = sigm(gr[r]), ii = sigm(gi[r]);
                const float a = __builtin_amdgcn_exp2f(-rr * sp8);
                av[dir][r] = a; bv[dir][r] = __builtin_amdgcn_sqrtf(fmaxf(1.0f - a * a, 0.f)) * ii * xcD[r]; }
        }
        { float Aw, Bw;
          wave_comp<0>(av[0], bv[0], h, lane, Aw, Bw); if (h == 0) { cmp[((0 * 8 + w) * 32 + r32) * 2] = Aw; cmp[((0 * 8 + w) * 32 + r32) * 2 + 1] = Bw; }
          wave_comp<1>(av[1], bv[1], h, lane, Aw, Bw); if (h == 0) { cmp[((1 * 8 + w) * 32 + r32) * 2] = Aw; cmp[((1 * 8 + w) * 32 + r32) * 2 + 1] = Bw; } }
        __syncthreads();
        if (w == 0 && mode != 2 && h == 0) {
            float Af = 1.f, Bf = 0.f, Ab = 1.f, Bb = 0.f;
#pragma unroll
            for (int ww = 0; ww < 8; ++ww) { const float a0 = cmp[((0 * 8 + ww) * 32 + r32) * 2], b0 = cmp[((0 * 8 + ww) * 32 + r32) * 2 + 1]; Bf = a0 * Bf + b0; Af *= a0; }
#pragma unroll
            for (int ww = 7; ww >= 0; --ww) { const float a1 = cmp[((1 * 8 + ww) * 32 + r32) * 2], b1 = cmp[((1 * 8 + ww) * 32 + r32) * 2 + 1]; Bb = a1 * Bb + b1; Ab *= a1; }
            if (mode == 1) { float* cp = CARRY + ((size_t)(((seq * 8 + chunk) * 4 + n) * 2) * 64 + cl) * 2;
                __hip_atomic_store((unsigned long long*)cp, ((unsigned long long)__float_as_uint(Bf) << 32) | __float_as_uint(Af), __ATOMIC_RELAXED, __HIP_MEMORY_SCOPE_AGENT);
                __hip_atomic_store((unsigned long long*)(cp + 128), ((unsigned long long)__float_as_uint(Bb) << 32) | __float_as_uint(Ab), __ATOMIC_RELAXED, __HIP_MEMORY_SCOPE_AGENT); }
            else { F.out[OUT_ST + (size_t)((seq * 2 + l) * 2 + 0) * 256 + c] = Bf; F.out[OUT_ST + (size_t)((seq * 2 + l) * 2 + 1) * 256 + c] = Bb; }
        }
        if (w == 0 && mode == 1) { asm volatile("s_waitcnt vmcnt(0)" ::: "memory");
            if (lane == 0) __hip_atomic_fetch_add(rg_cnt, 1u, __ATOMIC_RELAXED, __HIP_MEMORY_SCOPE_AGENT); }
        if (mode != 1) {
            float Xf = 0.f, Xb = 0.f; if (mode == 2) { Xf = xcar[cl]; Xb = xcar[64 + cl]; }
#pragma unroll
            for (int ww = 0; ww < 8; ++ww) if (ww < w) Xf = cmp[((0 * 8 + ww) * 32 + r32) * 2] * Xf + cmp[((0 * 8 + ww) * 32 + r32) * 2 + 1];
#pragma unroll
            for (int ww = 7; ww >= 0; --ww) if (ww > w) Xb = cmp[((1 * 8 + ww) * 32 + r32) * 2] * Xb + cmp[((1 * 8 + ww) * 32 + r32) * 2 + 1];
            f32x16 hf, hb;
            scan_final<0>(av[0], bv[0], h, lane, Xf, hf); scan_final<1>(av[1], bv[1], h, lane, Xb, hb);
#pragma unroll
            for (int r = 0; r < 16; r += 2) { const int tl = (r & 3) + 8 * (r >> 2) + 4 * h;
                const float g0 = bf2f(*(const LAS unsigned short*)(GR + tl * 128 + cl * 2)), g1 = bf2f(*(const LAS unsigned short*)(GR + (tl + 1) * 128 + cl * 2));
                const float u0 = 2.0f * 0.7978845608028654f * (g0 + 0.044715f * g0 * g0 * g0), u1 = 2.0f * 0.7978845608028654f * (g1 + 0.044715f * g1 * g1 * g1);
                const unsigned pk = cvtpk((hf[r] + hb[r]) * g0 * sigm(u0), (hf[r + 1] + hb[r + 1]) * g1 * sigm(u1));
                *(LAS unsigned short*)(YO + tl * 128 + cl * 2) = (unsigned short)pk; *(LAS unsigned short*)(YO + (tl + 1) * 128 + cl * 2) = (unsigned short)(pk >> 16); }
        }
        __builtin_amdgcn_sched_barrier(0);
    }
    if (mode != 1) {
        bf16* yp = Y + (size_t)(row0 + t0 + r32) * D + 512 + n * 64 + h * 32;
#pragma unroll
        for (int q = 0; q < 4; ++q) *(GAS v4u*)(yp + 8 * q) = *(const LAS v4u*)(YO + r32 * 128 + (h * 4 + q) * 16);
    }
    __syncthreads();
}

__device__ __forceinline__ void pool_item(int WIN, const bf16* Z, bf16* Y, const bf16* PT, const float* pscale, int l, int tt, int g, int lane, LAS unsigned char* LP) {
    const int r32 = lane & 31, h = lane >> 5;
    const int rowt0 = tt * 32; const bool lat = rowt0 >= MC; const int T = lat ? 2048 : 256;
    const int seq0 = lat ? MC + ((rowt0 - MC) & ~2047) : (rowt0 & ~255); const int tpos0 = rowt0 - seq0, tpos = tpos0 + r32;
    const int left = WIN >> 1; const int lo = max(tpos - left, 0), hi = min(tpos + WIN - 1 - left, T - 1); const float inv = 1.0f / (float)(hi - lo + 1);
    const int NCH = (32 + WIN - 1) * 8;
    LAS unsigned char* TILE = LP; LAS unsigned char* YO = LP + 8192;
    const GAS bf16* zc = (const GAS bf16*)Z + (size_t)seq0 * DIN + 2048 + g * 64;
    bf16x8_t wq[2][4]; float sc[2];
#pragma unroll
    for (int cb2 = 0; cb2 < 2; ++cb2) { const int d = 32 * cb2 + r32; const GAS bf16* wt = (const GAS bf16*)PT + (size_t)(l * 4 + g) * 4096 + d * 64 + 8 * h;
#pragma unroll
        for (int ks = 0; ks < 4; ++ks) wq[cb2][ks] = *(const GAS bf16x8_t*)(wt + 16 * ks);
        sc[cb2] = ((const GAS float*)pscale)[l * 256 + g * 64 + d]; }
    v4u zt[6];
#pragma unroll
    for (int i = 0; i < 6; ++i) { int q = lane + 64 * i; q = q < NCH ? q : NCH - 1; const int row = q >> 3, c = q & 7; const int t2 = tpos0 - left + row; const int tc = (t2 >= 0 && t2 < T) ? t2 : tpos0;
        zt[i] = *(const GAS v4u*)(zc + (size_t)tc * DIN + 8 * c); }
#pragma unroll
    for (int i = 0; i < 6; ++i) { int q = lane + 64 * i; q = q < NCH ? q : NCH - 1; const int row = q >> 3, c = q & 7; *(LAS v4u*)(TILE + row * 144 + c * 16) = zt[i]; }
    float sm[4][8];
#pragma unroll
    for (int ks = 0; ks < 4; ++ks)
#pragma unroll
        for (int e = 0; e < 8; ++e) sm[ks][e] = 0.f;
    const LAS unsigned char* tp = TILE + r32 * 144 + h * 16;
#pragma unroll 1
    for (int j = 0; j < WIN; ++j) { const int t2 = tpos - left + j; const float k = (t2 >= 0 && t2 < T) ? 1.f : 0.f;
#pragma unroll
        for (int ks = 0; ks < 4; ++ks) { const v4u z = *(const LAS v4u*)(tp + j * 144 + ks * 32);
            sm[ks][0] += k * bflo(z.x); sm[ks][1] += k * bfhi(z.x); sm[ks][2] += k * bflo(z.y); sm[ks][3] += k * bfhi(z.y); sm[ks][4] += k * bflo(z.z); sm[ks][5] += k * bfhi(z.z); sm[ks][6] += k * bflo(z.w); sm[ks][7] += k * bfhi(z.w); } }
    bf16x8_t pa[4];
#pragma unroll
    for (int ks = 0; ks < 4; ++ks) { const v4u z0 = *(const LAS v4u*)(tp + left * 144 + ks * 32);
        pa[ks] = pack8(sm[ks][0] * inv - bflo(z0.x), sm[ks][1] * inv - bfhi(z0.x), sm[ks][2] * inv - bflo(z0.y), sm[ks][3] * inv - bfhi(z0.y), sm[ks][4] * inv - bflo(z0.z), sm[ks][5] * inv - bfhi(z0.z), sm[ks][6] * inv - bflo(z0.w), sm[ks][7] * inv - bfhi(z0.w)); }
#pragma unroll
    for (int cb2 = 0; cb2 < 2; ++cb2) { const int d = 32 * cb2 + r32;
        f32x16 acc;
#pragma unroll
        for (int r = 0; r < 16; ++r) acc[r] = 0.f;
#pragma unroll
        for (int ks = 0; ks < 4; ++ks) acc = MFMA32(pa[ks], wq[cb2][ks], acc);
        const float scd = sc[cb2];
#pragma unroll
        for (int r = 0; r < 16; r += 2) { const int row = rowt0 + (r & 3) + 8 * (r >> 2) + 4 * h; const unsigned pk = cvtpk(acc[r] * scd, acc[r + 1] * scd);
            const int tl = row - rowt0; *(LAS unsigned short*)(YO + tl * 128 + d * 2) = (unsigned short)pk; *(LAS unsigned short*)(YO + (tl + 1) * 128 + d * 2) = (unsigned short)(pk >> 16); } }
    { bf16* yp = Y + (size_t)(rowt0 + r32) * D + 768 + g * 64 + h * 32;
#pragma unroll
      for (int q = 0; q < 4; ++q) *(GAS v4u*)(yp + 8 * q) = *(const LAS v4u*)(YO + r32 * 128 + (h * 4 + q) * 16); }
}
__device__ __forceinline__ void mix_pool(Frame& F, const Args& A, int l) {
    PHASE_IDS(F);
    const bf16* Z = (const bf16*)(F.ws + WS_Z); bf16* Y = (bf16*)(F.ws + WS_Y); const bf16* PT = (const bf16*)(F.ws + WS_POOLT); const float* ps = INP(A, I_POOLS);
    const int gw = F.vcu * NWAVES + F.wave, NGW = F.G * NWAVES;
    const int hgw = (F.G >> 1) * NWAVES;
    const bool heavy = F.vcu < (F.G >> 1); const int hw = heavy ? gw : gw - hgw;
    for (int k = 0; k < 3; ++k) { int it;
        if (F.G == 256) { if (heavy) { if (k > 0) break; it = hw; } else { if (k > 1) break; it = hgw + k * hgw + hw; } }
        else { it = gw + k * NGW; }
        if (it >= (M / 32) * 4) break;
        const int g = it / (M / 32), tt = it % (M / 32);
        LAS unsigned char* yo = F.lds + F.wave * 12288;
        pool_item(2 << g, Z, Y, PT, ps, l, tt, g, F.lane, yo); }
    __syncthreads();
}
__device__ __forceinline__ void mix_conv(Frame& F, const Args& A, int l) {
    PHASE_IDS(F);
    const GAS bf16* Z = (const GAS bf16*)(F.ws + WS_Z); bf16* Y = (bf16*)(F.ws + WS_Y); const GAS float* cw = (const GAS float*)(INP(A, I_CBW) + l * 3 * 256);
    const int gt = F.vcu * 512 + F.tid, NGT = F.G * 512;
    for (int i = gt; i < (M / 8) * 32; i += NGT) {
        const int tg = i >> 5, c8 = (i & 31) * 8; const int r0 = tg * 8; const bool lat = r0 >= MC; const int T = lat ? 2048 : 256; const int t0 = lat ? ((r0 - MC) & 2047) : (r0 & 255);
        f32x4 wv[3][2];
#pragma unroll
        for (int j = 0; j < 3; ++j) { wv[j][0] = *(const GAS f32x4*)(cw + j * 256 + c8); wv[j][1] = *(const GAS f32x4*)(cw + j * 256 + c8 + 4); }
        v4u za[10], zb[10], zg[8];
#pragma unroll
        for (int k = 0; k < 10; ++k) { const int t = t0 - 1 + k; const bool ok = t >= 0 && t < T; const int tc = ok ? t : t0; const GAS bf16* zp = Z + (size_t)(r0 - t0 + tc) * DIN + c8;
            za[k] = *(const GAS v4u*)(zp + 1024); zb[k] = *(const GAS v4u*)(zp + 1280); }
#pragma unroll
        for (int q = 0; q < 8; ++q) zg[q] = *(const GAS v4u*)(Z + (size_t)(r0 + q) * DIN + 768 + c8);
        float w[3][8];
#pragma unroll
        for (int j = 0; j < 3; ++j) { w[j][0] = wv[j][0][0]; w[j][1] = wv[j][0][1]; w[j][2] = wv[j][0][2]; w[j][3] = wv[j][0][3]; w[j][4] = wv[j][1][0]; w[j][5] = wv[j][1][1]; w[j][6] = wv[j][1][2]; w[j][7] = wv[j][1][3]; }
        float pm[8], pc[8], pn[8];
        auto prod = [&](int k, float (&o)[8]) { const int t = t0 - 1 + k; const float kk = (t >= 0 && t < T) ? 1.f : 0.f; const v4u a = za[k], b = zb[k];
            o[0] = kk * bflo(a.x) * bflo(b.x); o[1] = kk * bfhi(a.x) * bfhi(b.x); o[2] = kk * bflo(a.y) * bflo(b.y); o[3] = kk * bfhi(a.y) * bfhi(b.y);
            o[4] = kk * bflo(a.z) * bflo(b.z); o[5] = kk * bfhi(a.z) * bfhi(b.z); o[6] = kk * bflo(a.w) * bflo(b.w); o[7] = kk * bfhi(a.w) * bfhi(b.w); };
        prod(0, pm); prod(1, pc);
#pragma unroll
        for (int q = 0; q < 8; ++q) { prod(q + 2, pn);
            const v4u gb = zg[q];
            const float g[8] = {bflo(gb.x), bfhi(gb.x), bflo(gb.y), bfhi(gb.y), bflo(gb.z), bfhi(gb.z), bflo(gb.w), bfhi(gb.w)};
            float o[8];
#pragma unroll
            for (int e = 0; e < 8; ++e) { o[e] = g[e] * (w[0][e] * pm[e] + w[1][e] * pc[e] + w[2][e] * pn[e]); pm[e] = pc[e]; pc[e] = pn[e]; }
            v4u ov; ov.x = cvtpk(o[0], o[1]); ov.y = cvtpk(o[2], o[3]); ov.z = cvtpk(o[4], o[5]); ov.w = cvtpk(o[6], o[7]);
            *(GAS v4u*)(Y + (size_t)(r0 + q) * D + 256 + c8) = ov; }
    }
}

#define GEMM_PHASE(EPI, g, E, MM, NN) do { pg8::StaticOrder S_; S_.init((MM), (NN), F.G, (int)blockIdx.x, 0); pg8::Unit u0_; const bool in0_ = S_.next(0, u0_); \
    pg8::gemm_phase<EPI, pg8::StaticOrder, true, true, false>(F.lds, (g), S_, (E), F.wave0, bpf_ && in0_); \
    if (S_.splits()) { pg8::StaticOrder S1_; S1_.init((MM), (NN), F.G, (int)blockIdx.x, 1); pg8::gemm_phase<EPI, pg8::StaticOrder, true, true, true>(F.lds, (g), S1_, (E), F.wave0, bpf_ && !in0_); } bpf_ = false; } while (0)
#define GEMM_PREFETCH(Bt, MM, NN, KK) do { if (!MK_PER_PHASE) { (void)pg8::gemm_prefetch_b(F.lds, (const pg8::bf16_t*)(Bt), (MM), (NN), (KK), F.G, (int)blockIdx.x, F.wave0); bpf_ = true; } } while (0)

constexpr int PH_PER_LAYER = 8, NPHASE = 2 + 2 * PH_PER_LAYER + 1;
__global__ void __launch_bounds__(NWAVES * 64, 2) fwd_kernel(Args args) {
    extern __shared__ __attribute__((aligned(16))) unsigned char lds[];
    Frame F;
    F.lds = (LAS unsigned char*)lds; F.lds0 = F.lds; F.tid = threadIdx.x; F.lane = F.tid & 63; F.wave = __builtin_amdgcn_readfirstlane(F.tid >> 6); F.wave0 = F.wave;
    F.G = gridDim.x; { const int bx = blockIdx.x; F.vcu = (F.G % 8 == 0) ? (bx % 8) * (F.G / 8) + bx / 8 : bx; F.vcu0 = F.vcu; }
    F.out = args.out; F.ws = args.ws; F.out0 = args.out; F.ws0 = args.ws;
    volatile LAS unsigned* MISC = (volatile LAS unsigned*)(F.lds + MISC_OFF);
    for (int u = F.tid; u < (LDS_BYTES - LDSCTL_OFF) / 4; u += NWAVES * 64) ((LAS unsigned*)(F.lds + LDSCTL_OFF))[u] = 0u;
    __syncthreads();
    if (F.tid < 25) { const unsigned long long pv = (unsigned long long)args.in[F.tid]; ((LAS unsigned*)(F.lds + LDSCTL_OFF))[2 * F.tid] = (unsigned)pv; ((LAS unsigned*)(F.lds + LDSCTL_OFF))[2 * F.tid + 1] = (unsigned)(pv >> 32); }
    __syncthreads();
    XcdBarrier bar; bar.bar = (unsigned*)(args.ws + WS_CTL) + CW_BAR; bar.x = 0; bar.st = nullptr;
#if !MK_PER_PHASE
    bar = xcd_barrier_post((unsigned*)(args.ws + WS_CTL) + CW_BAR, MISC + 8);
#endif
#if MK_PER_PHASE
    const int lo = args.ph_lo, hi = args.ph_hi;
#define IN(k) (lo <= (k) && (k) < hi)
#define SEAM(k) do { } while (0)
#else
#define IN(k) true
#define SEAM(k) xcd_barrier(bar)
#endif
    REP(4) { if (IN(0)) { p0_prologue(F, args); } SEAM(0); }

    bool bpf_ = false;
    REP(3) { if (IN(1)) { prep0_phase(F, args); } if (!((PROBE_REP >> 3) & 1) || rep_ == 1) GEMM_PREFETCH((const bf16*)(F.ws + WS_WIN), M, DIN, D); SEAM(1); }
    for (int l = 0; l < 2; ++l) {
        const int pb = 2 + l * PH_PER_LAYER;
        REP(0) if (IN(pb + 0)) { PHASE_IDS(F);
            pg8::Gemm g{(const bf16*)((const unsigned char*)F.out + OUT_XN_BYTES), (const bf16*)(F.ws + WS_WIN) + (size_t)l * DIN * D, M, DIN, D};
            pg8::EpiIn E{(bf16*)(F.ws + WS_Z), (const float*)(F.ws + WS_ROPE), F.out + OUT_CK, F.out + OUT_CV, l, (const float*)(F.ws + WS_SS) + (size_t)(l == 0 ? 0 : 2) * M, (const float*)(F.ws + WS_SW) + (size_t)l * 9 * 2304};
            GEMM_PHASE(pg8::EpiIn, g, E, M, DIN);
            SEAM(pb + 0); }
        if (IN(pb + 1)) {
            PHASE_IDS(F); const float lam = ((const float*)(F.ws + WS_LAM))[l]; const float sub_mul = 1.0f - (0.8f - 0.6f * expf(-0.3f * (float)l));
            for (int u = F.vcu; u < 512; u += F.G) {
                if (u >= 384) { const int v = u - 384; attn_unit(F, args, l, false, v >> 2, v & 3, 0, lam, sub_mul); }
                else { const int mode = u < 256 ? 1 : 0; const int v = u < 256 ? u : u - 256; rglru_unit(F, args, l, mode, mode == 0 ? (v >> 2) : (v >> 5), mode == 0 ? (v & 3) : ((v >> 3) & 3), mode == 0 ? 0 : (v & 7)); } }
            mix_conv(F, args, l); mix_pool(F, args, l);
            PHASE_IDS(F);
            for (int u = F.vcu; u < 512; u += F.G) {
                if (u < 256) attn_unit(F, args, l, true, u >> 5, (u >> 3) & 3, u & 7, lam, sub_mul);
                else { const int v = u - 256; rglru_unit(F, args, l, 2, v >> 5, (v >> 3) & 3, v & 7); } }
            GEMM_PREFETCH((const bf16*)(F.ws + WS_WOUT) + (size_t)l * D * D, M, D, D);
        } SEAM(pb + 1);
        if (IN(pb + 3)) { PHASE_IDS(F); const float* modl = (const float*)(F.ws + WS_MOD) + (size_t)l * 9 * 6144;
            pg8::Gemm g{(const bf16*)(F.ws + WS_Y), (const bf16*)(F.ws + WS_WOUT) + (size_t)l * D * D, M, D, D};
            bf16* XR = (bf16*)(F.ws + WS_XR); bf16* XNp = (bf16*)((unsigned char*)F.out + OUT_XN_BYTES);
            if (l == 0) { pg8::EpiGateRes<false> E{(const void*)INP(args, I_XP), (const void*)(INP(args, I_XS) - (size_t)MC * D), XR, modl + 2048, 0, XNp, INP(args, I_NORMW) + (size_t)(l * 2 + 1) * D, modl + 4096, (float*)(F.ws + WS_SS) + (size_t)1 * M};
                GEMM_PHASE(pg8::EpiGateRes<false>, g, E, M, D); }
            else { pg8::EpiGateRes<true> E{(const void*)XR, (const void*)XR, XR, modl + 2048, 0, XNp, INP(args, I_NORMW) + (size_t)(l * 2 + 1) * D, modl + 4096, (float*)(F.ws + WS_SS) + (size_t)3 * M};
                GEMM_PHASE(pg8::EpiGateRes<true>, g, E, M, D); }
            GEMM_PREFETCH((const bf16*)(F.ws + WS_W1) + (size_t)l * DFF * D, MP0, DFF, D);
        } SEAM(pb + 3);
        for (int hf = 0; hf < 2; ++hf) {
            const int mrow0 = hf == 0 ? 0 : MP0, mrows = hf == 0 ? MP0 : M - MP0;
            REP(2) if (IN(pb + 4 + 2 * hf)) { PHASE_IDS(F);
                pg8::Gemm g{(const bf16*)((const unsigned char*)F.out + OUT_XN_BYTES) + (size_t)mrow0 * D, (const bf16*)(F.ws + WS_W1) + (size_t)l * DFF * D, mrows, DFF, D};
                pg8::EpiRelu2 E{(bf16*)(F.ws + WS_Y), (const float*)(F.ws + WS_SS) + (size_t)(l == 0 ? 1 : 3) * M, (const float*)(F.ws + WS_SW) + 2 * 9 * 2304 + (size_t)l * 9 * 4096, mrow0};
                GEMM_PHASE(pg8::EpiRelu2, g, E, mrows, DFF);
                if (!((PROBE_REP >> 2) & 1) || rep_ == 1) GEMM_PREFETCH((const bf16*)(F.ws + WS_W2) + (size_t)l * D * DFF, mrows, D, DFF);
                SEAM(pb + 4 + 2 * hf); }
            if (IN(pb + 5 + 2 * hf)) { PHASE_IDS(F); const float* modl = (const float*)(F.ws + WS_MOD) + (size_t)l * 9 * 6144;
                pg8::Gemm g{(const bf16*)(F.ws + WS_Y), (const bf16*)(F.ws + WS_W2) + (size_t)l * D * DFF, mrows, D, DFF};
                bf16* XR = (bf16*)(F.ws + WS_XR);
                if (l == 0) {
                    pg8::EpiGateRes<true> E{(const void*)XR, (const void*)XR, XR, modl + 5120, mrow0, (bf16*)((unsigned char*)F.out + OUT_XN_BYTES), INP(args, I_NORMW) + (size_t)2 * D, modl + 9 * 6144 + 1024, (float*)(F.ws + WS_SS) + (size_t)2 * M};
                    GEMM_PHASE(pg8::EpiGateRes<true>, g, E, mrows, D); }
                else {
                    pg8::EpiFinal E{XR, F.out, modl + 5120, mrow0, INP(args, I_FNW), (float*)(F.ws + WS_SS) + (size_t)4 * M, (unsigned*)(F.ws + WS_CTL) + CW_FIN};
                    GEMM_PHASE(pg8::EpiFinal, g, E, mrows, D); }
                if (hf == 0) GEMM_PREFETCH((const bf16*)(F.ws + WS_W1) + (size_t)l * DFF * D, M - MP0, DFF, D);
                else if (l == 0) GEMM_PREFETCH((const bf16*)(F.ws + WS_WIN) + (size_t)1 * DIN * D, M, DIN, D);
            } if (!(l == 1 && hf == 1)) SEAM(pb + 5 + 2 * hf);
        }
    }
    if ((PROBE_REP >> 12) & 1) { for (int q = 0; q < 20; ++q) xcd_barrier(bar); }

#undef IN
#undef SEAM
}

extern "C" void kernel_launch(void* const* d_in, const int* in_sizes, int n_in, void* d_out, int out_size, void* d_ws, size_t ws_size, hipStream_t stream) {
    static int grid = 0;
    if (grid == 0) {
        if (n_in != 25 || out_size != (int)(OUT_ST + 32 * 2 * 2 * 256) || ws_size < WS_END) { fprintf(stderr, "kernel_launch: unexpected shapes (n_in %d out %d ws %zu)\n", n_in, out_size, ws_size); grid = -1; return; }
        int dev = 0, cus = 0;
        if (hipGetDevice(&dev) != hipSuccess || hipDeviceGetAttribute(&cus, hipDeviceAttributeMultiprocessorCount, dev) != hipSuccess) { grid = -1; return; }
        if (hipFuncSetAttribute((const void*)fwd_kernel, hipFuncAttributeMaxDynamicSharedMemorySize, LDS_BYTES) != hipSuccess) { fprintf(stderr, "kernel_launch: hipFuncSetAttribute failed\n"); grid = -1; return; }
        int per_cu = 0;
        if (hipOccupancyMaxActiveBlocksPerMultiprocessor(&per_cu, (const void*)fwd_kernel, NWAVES * 64, LDS_BYTES) != hipSuccess || per_cu < 1) fprintf(stderr, "kernel_launch: occupancy query says %d\n", per_cu);
        (void)hipGetLastError();
        if (cus != 256) { fprintf(stderr, "kernel_launch: this kernel is laid out for a 256-CU grid (prep0's shift-row slots, the fused final norm's one-unit-per-workgroup phase); the device reports %d CUs\n", cus); grid = -1; return; }
        grid = cus;
    }
    if (grid < 0) return;
    (void)hipMemsetAsync((char*)d_ws + WS_CTL, 0, CTL_ZERO_BYTES, stream);
    Args a{};
    for (int i = 0; i < 25; ++i) a.in[i] = (const float*)d_in[i];
    a.out = (float*)d_out; a.ws = (unsigned char*)d_ws;
#if MK_PER_PHASE
    for (int p = 0; p < NPHASE; ++p) { a.ph_lo = p; a.ph_hi = p + 1; hipLaunchKernelGGL(fwd_kernel, dim3(grid), dim3(NWAVES * 64), LDS_BYTES, stream, a); }
#else
    a.ph_lo = 0; a.ph_hi = NPHASE; hipLaunchKernelGGL(fwd_kernel, dim3(grid), dim3(NWAVES * 64), LDS_BYTES, stream, a);
#endif
}
```

```cpp
#include <hip/hip_runtime.h>
#include <cstdio>
#include <cstdint>

#ifndef PROBE_REP
#define PROBE_REP 0
#endif
#ifndef PROBE_VAR
#define PROBE_VAR 0
#endif
#define REP(bit) for (int rep_ = 0; rep_ < (((PROBE_REP) >> (bit)) & 1) + 1; ++rep_)
#ifndef MK_PER_PHASE
#define MK_PER_PHASE 0
#endif


#define LANE_ID(v) asm volatile("v_mbcnt_lo_u32_b32 %0, -1, 0\n\tv_mbcnt_hi_u32_b32 %0, -1, %0" : "=v"(v))
__device__ __forceinline__ float shx(float v, int mask, int lane) { return __builtin_bit_cast(float, __builtin_amdgcn_ds_bpermute((lane ^ mask) << 2, __builtin_bit_cast(int, v))); }
__device__ __forceinline__ float shidx(float v, int src) { return __builtin_bit_cast(float, __builtin_amdgcn_ds_bpermute(src << 2, __builtin_bit_cast(int, v))); }

namespace pg8 {
#define PG8_LAS __attribute__((address_space(3)))
typedef unsigned short bf16_t;
typedef short bf16x8 __attribute__((ext_vector_type(8)));
typedef float f32x4 __attribute__((ext_vector_type(4)));
typedef unsigned u32x4 __attribute__((ext_vector_type(4)));
constexpr int BM = 256, BK = 64, HALF = 128, HTB = HALF * BK * 2, STAGE_BYTES = 8 * HTB, NXCD = 8, WGM = 8;

__host__ __device__ __forceinline__ int lds_byte(int r, int c) { const int st = (r >> 4) * 2 + (c >> 5), rr = r & 15, cc = c & 31, ob = rr * 64 + cc * 2; return st * 1024 + (ob ^ (((ob >> 9) & 1) << 5)); }
__host__ __device__ __forceinline__ void stage_rc(int b, int& R, int& C) { const int st = b / 1024, sb = b % 1024, swz = sb ^ (((sb >> 9) & 1) << 5); R = (st >> 1) * 16 + swz / 64; C = (st & 1) * 32 + (swz % 64) / 2; }
__host__ __device__ __forceinline__ int perm32(int rho) { const int n = rho >> 4, i = rho & 15; return 8 * (i >> 2) + 4 * n + (i & 3); }

struct Unit { int pm, pn, single, sub; };
struct Gemm { const bf16_t* A; const bf16_t* Bt; int M, N, K; };

struct StaticOrder {
    int nM, nN, nwg, G, c, R, rem, part;
    __host__ __device__ __forceinline__ void init(int M, int N, int G_, int c_, int part_ = 0) { nM = M / BM; nN = N / BM; nwg = nM * nN; G = G_; c = c_; R = nwg / G; rem = nwg - R * G; part = part_; }
    __host__ __device__ __forceinline__ bool splits() const { return rem > 0 && 2 * rem <= G; }
    __host__ __device__ __forceinline__ bool next(int i, Unit& u) const {
        long L; u.single = 0; u.sub = 0;
        if (part == 0) { if (i < R) L = (long)i * G + c; else if (i == R && rem > 0 && !splits()) { L = (long)R * G + c; if (L >= nwg) return false; } else return false; }
        else { if (i != 0 || !splits() || c >= 2 * rem) return false; L = (long)R * G + (c >> 1); u.single = 1; u.sub = c & 1; }
        int wgid = (int)L; { const int q = nwg / NXCD, r = nwg % NXCD, xcd = wgid % NXCD, off = wgid / NXCD; wgid = (xcd < r ? xcd * (q + 1) : r * (q + 1) + (xcd - r) * q) + off; }
        const int nig = WGM * nN, gid = wgid / nig, fm = gid * WGM, gsz = (nM - fm) < WGM ? (nM - fm) : WGM;
        u.pm = fm + ((wgid % nig) % gsz); u.pn = (wgid % nig) / gsz; return true;
    }
    __device__ __forceinline__ void a_ready(const Unit&) const {}
    __device__ __forceinline__ void done(const Unit&) const {}
};

__device__ __forceinline__ unsigned cvt_pk_bf16(float lo, float hi) { unsigned r; asm volatile("v_cvt_pk_bf16_f32 %0, %1, %2" : "=v"(r) : "v"(lo), "v"(hi)); return r; }

template <bool WT> __device__ __forceinline__ void st16(void* p, u32x4 v) {
    if constexpr (WT) asm volatile("global_store_dwordx4 %0, %1, off sc1\n\ts_nop 1" :: "v"(p), "v"(v) : "memory");     else *(__attribute__((address_space(1))) u32x4*)p = v; }
template <bool WT> __device__ __forceinline__ void st16(void* p, f32x4 v) { st16<WT>(p, __builtin_bit_cast(u32x4, v)); }


struct EpiIn {
    static constexpr bool PERM = true, AFTER_DRAIN = false;
    bf16_t* Z; const float* rope; float* ck_out; float* cv_out; int layer; const float* ss; const float* sw;
    template <bool WT> __device__ __forceinline__ void run(const f32x4 (&acc)[2][2][4][2], const Unit& u, int wr, int wc, int fr, int fq) const {
        asm volatile("" : "+v"(fr), "+v"(fq));
        int pn = u.pn; asm volatile("" : "+s"(pn)); const bool lat = u.pm >= 32; const bool dorope = lat && pn <= 1;
        const int row0 = u.pm * BM + (u.single ? u.sub * HALF : 0) + wr * 64 + fr; const int colw = wc * 32 + 8 * fq;
        const float qs = (pn == 0) ? 0.25503486f : 1.0f;
        const int mi = u.pm < 32 ? 0 : 1 + ((u.pm - 32) >> 3);
        f32x4 swv[2][2];
#pragma unroll
        for (int bj = 0; bj < 2; ++bj)
#pragma unroll
            for (int n = 0; n < 2; ++n) swv[bj][n] = *(const f32x4*)(sw + (size_t)mi * 2304 + pn * BM + bj * HALF + colw + 4 * n);
        float ssv[2][4];
#pragma unroll
        for (int ai = 0; ai < 2; ++ai)
#pragma unroll
            for (int m = 0; m < 4; ++m) ssv[ai][m] = ss[row0 + (u.single ? 0 : ai) * HALF + m * 16];
        f32x4 cs[4], csn[4];
        if (dorope) { const int t = (row0 - 8192) & 2047; const int pos = (fq >> 1) ? (t & 63) : (t >> 6); const f32x4* rp = (const f32x4*)(rope + pos * 16);
#pragma unroll
            for (int e = 0; e < 4; ++e) cs[e] = rp[e]; }
#pragma unroll
        for (int ai = 0; ai < 2; ++ai) { if (ai == 1 && u.single) break;
#pragma unroll
            for (int m = 0; m < 4; ++m) {
                const int row = row0 + ai * HALF + m * 16;
                const float rs = 1.0f / sqrtf(ssv[ai][m] * (1.0f / 1024.0f) + 1e-6f);
                if (dorope && !(ai == 1 && m == 3)) { const int rown = row0 + (m == 3 ? HALF : ai * HALF + (m + 1) * 16); const int t = (rown - 8192) & 2047; const int pos = (fq >> 1) ? (t & 63) : (t >> 6);
                    const f32x4* rp = (const f32x4*)(rope + pos * 16);
#pragma unroll
                    for (int e = 0; e < 4; ++e) csn[e] = rp[e]; }
#pragma unroll
                for (int bj = 0; bj < 2; ++bj) {
                    float v[8];
#pragma unroll
                    for (int e = 0; e < 4; ++e) { v[e] = acc[ai][bj][m][0][e] * rs + swv[bj][0][e]; v[4 + e] = acc[ai][bj][m][1][e] * rs + swv[bj][1][e]; }
                    if (dorope) {
#pragma unroll
                        for (int e = 0; e < 8; ++e) { const float pr = shx(v[e], 16, fr + 16 * fq); const float c = cs[e >> 1][(e & 1) * 2], s = cs[e >> 1][(e & 1) * 2 + 1];
                            v[e] = (fq & 1) ? (v[e] * c + pr * s) : (v[e] * c - pr * s); }
                    }
                    if (!lat && (pn == 1 || pn == 2)) {
                        float* co = (pn == 1) ? ck_out : cv_out; const int b = row >> 8, t = row & 255; const int cc = bj * HALF + colw; const int hd = cc >> 6, d = cc & 63;
                        float* op = co + ((size_t)((b * 2 + layer) * 4 + hd) * 256 + t) * 64 + d;
                        st16<WT>(op, (f32x4){v[0], v[1], v[2], v[3]}); st16<WT>(op + 4, (f32x4){v[4], v[5], v[6], v[7]});
                    }
                    u32x4 w; w.x = cvt_pk_bf16(v[0] * qs, v[1] * qs); w.y = cvt_pk_bf16(v[2] * qs, v[3] * qs); w.z = cvt_pk_bf16(v[4] * qs, v[5] * qs); w.w = cvt_pk_bf16(v[6] * qs, v[7] * qs);
                    st16<WT>(Z + (size_t)row * 2304 + pn * BM + bj * HALF + colw, w);
                }
                if (dorope && !(ai == 1 && m == 3)) {
#pragma unroll
                    for (int e = 0; e < 4; ++e) cs[e] = csn[e]; }
            } }
    }
};
__device__ __forceinline__ void unpack8(const u32x4 w, float (&o)[8]) {
    o[0] = __uint_as_float(w.x << 16); o[1] = __uint_as_float(w.x & 0xffff0000u); o[2] = __uint_as_float(w.y << 16); o[3] = __uint_as_float(w.y & 0xffff0000u);
    o[4] = __uint_as_float(w.z << 16); o[5] = __uint_as_float(w.z & 0xffff0000u); o[6] = __uint_as_float(w.w << 16); o[7] = __uint_as_float(w.w & 0xffff0000u); }
template <bool RES_BF16> struct EpiGateRes {
    static constexpr bool PERM = true, AFTER_DRAIN = false;
    const void* res_c; const void* res_l; bf16_t* xr; const float* gate; int rowbase;
    bf16_t* xs; const float* nw; const float* nscale; float* ssq;
    template <bool WT> __device__ __forceinline__ void run(const f32x4 (&acc)[2][2][4][2], const Unit& u, int wr, int wc, int fr, int fq) const {
        asm volatile("" : "+v"(fr), "+v"(fq));
        const int grow0 = rowbase + u.pm * BM; const int mi = grow0 < 8192 ? 0 : 1 + ((grow0 - 8192) >> 11);
        const void* res = grow0 < 8192 ? res_c : res_l;
        const int row0 = grow0 + (u.single ? u.sub * HALF : 0) + wr * 64 + fr, col0 = u.pn * BM + wc * 32 + 8 * fq;
        f32x4 gv[2][2], fv[2][2];
#pragma unroll
        for (int bj = 0; bj < 2; ++bj)
#pragma unroll
            for (int n = 0; n < 2; ++n) { gv[bj][n] = *(const f32x4*)(gate + (size_t)mi * 6144 + col0 + bj * HALF + 4 * n);
                if (xs) { const f32x4 w = *(const f32x4*)(nw + col0 + bj * HALF + 4 * n); f32x4 f = w;
                    if (nscale) { const f32x4 sc = *(const f32x4*)(nscale + (size_t)mi * 6144 + col0 + bj * HALF + 4 * n); f = w * (sc + 1.0f); }
                    fv[bj][n] = f; } }
        constexpr int RD = RES_BF16 ? 3 : 2;
        u32x4 rb[8][2]; f32x4 rf[8][4];
#define EGR_FETCH(c) do { const size_t o_ = (size_t)(row0 + (u.single ? 0 : ((c) >> 2)) * HALF + ((c) & 3) * 16) * 1024 + col0; _Pragma("unroll") for (int bj = 0; bj < 2; ++bj) { \
            if (RES_BF16) rb[c][bj] = *(const u32x4*)((const bf16_t*)res + o_ + bj * HALF); \
            else { rf[c][2 * bj] = *(const f32x4*)((const float*)res + o_ + bj * HALF); rf[c][2 * bj + 1] = *(const f32x4*)((const float*)res + o_ + bj * HALF + 4); } } } while (0)
#pragma unroll
        for (int c = 0; c < RD; ++c) EGR_FETCH(c);
#pragma unroll
        for (int ai = 0; ai < 2; ++ai) { if (ai == 1 && u.single) break;
#pragma unroll
            for (int m = 0; m < 4; ++m) { const size_t off = (size_t)(row0 + ai * HALF + m * 16) * 1024 + col0; const int c = ai * 4 + m;
                if (c + RD < 8) EGR_FETCH(c + RD);
                float sq = 0.f;
#pragma unroll
                for (int bj = 0; bj < 2; ++bj) { float r[8];
                    if (RES_BF16) unpack8(rb[c][bj], r);
                    else { const f32x4 r0 = rf[c][2 * bj], r1 = rf[c][2 * bj + 1];
                        r[0] = r0[0]; r[1] = r0[1]; r[2] = r0[2]; r[3] = r0[3]; r[4] = r1[0]; r[5] = r1[1]; r[6] = r1[2]; r[7] = r1[3]; }
                    float x[8];
#pragma unroll
                    for (int e = 0; e < 4; ++e) { x[e] = r[e] + gv[bj][0][e] * acc[ai][bj][m][0][e]; x[4 + e] = r[4 + e] + gv[bj][1][e] * acc[ai][bj][m][1][e]; }
#pragma unroll
                    for (int e = 0; e < 8; ++e) sq += x[e] * x[e];
                    u32x4 w; w.x = cvt_pk_bf16(x[0], x[1]); w.y = cvt_pk_bf16(x[2], x[3]); w.z = cvt_pk_bf16(x[4], x[5]); w.w = cvt_pk_bf16(x[6], x[7]);
                    st16<WT>(xr + off + bj * HALF, w);
                    if (xs) { u32x4 v; v.x = cvt_pk_bf16(x[0] * fv[bj][0][0], x[1] * fv[bj][0][1]); v.y = cvt_pk_bf16(x[2] * fv[bj][0][2], x[3] * fv[bj][0][3]);
                        v.z = cvt_pk_bf16(x[4] * fv[bj][1][0], x[5] * fv[bj][1][1]); v.w = cvt_pk_bf16(x[6] * fv[bj][1][2], x[7] * fv[bj][1][3]); st16<WT>(xs + off + bj * HALF, v); } }
                if (ssq) { const int ln = fr + 16 * fq; sq += shx(sq, 16, ln); sq += shx(sq, 32, ln); if (fq == 0) atomicAdd(ssq + row0 + ai * HALF + m * 16, sq); } } }
#undef EGR_FETCH
    }
};
struct EpiFinal {
    static constexpr bool PERM = true, AFTER_DRAIN = false;
    const bf16_t* res; float* out; const float* gate; int rowbase; const float* nw; float* ssq; unsigned* fin_cnt;
    template <bool WT> __device__ __forceinline__ void run(const f32x4 (&acc_c)[2][2][4][2], const Unit& u, int wr, int wc, int fr, int fq) const {
        asm volatile("" : "+v"(fr), "+v"(fq));
        f32x4 (&acc)[2][2][4][2] = const_cast<f32x4 (&)[2][2][4][2]>(acc_c);
        const int grow0 = rowbase + u.pm * BM; const int mi = grow0 < 8192 ? 0 : 1 + ((grow0 - 8192) >> 11);
        const int row0 = grow0 + (u.single ? u.sub * HALF : 0) + wr * 64 + fr, col0 = u.pn * BM + wc * 32 + 8 * fq; const int ln = fr + 16 * fq;
        f32x4 gv[2][2];
#pragma unroll
        for (int bj = 0; bj < 2; ++bj)
#pragma unroll
            for (int n = 0; n < 2; ++n) gv[bj][n] = *(const f32x4*)(gate + (size_t)mi * 6144 + col0 + bj * HALF + 4 * n);
        u32x4 rb[8][2];
#define EFN_FETCH(c) do { const size_t o_ = (size_t)(row0 + (u.single ? 0 : ((c) >> 2)) * HALF + ((c) & 3) * 16) * 1024 + col0; _Pragma("unroll") for (int bj = 0; bj < 2; ++bj) rb[c][bj] = *(const u32x4*)(res + o_ + bj * HALF); } while (0)
#pragma unroll
        for (int c = 0; c < 3; ++c) EFN_FETCH(c);
#pragma unroll
        for (int ai = 0; ai < 2; ++ai) { if (ai == 1 && u.single) break;
#pragma unroll
            for (int m = 0; m < 4; ++m) { const int c = ai * 4 + m; float sq = 0.f;
                if (c + 3 < 8) EFN_FETCH(c + 3);
#pragma unroll
                for (int bj = 0; bj < 2; ++bj) { float r[8]; unpack8(rb[c][bj], r);
#pragma unroll
                    for (int e = 0; e < 4; ++e) { const float x0 = r[e] + gv[bj][0][e] * acc[ai][bj][m][0][e], x1 = r[4 + e] + gv[bj][1][e] * acc[ai][bj][m][1][e];
                        acc[ai][bj][m][0][e] = x0; acc[ai][bj][m][1][e] = x1; sq += x0 * x0 + x1 * x1; } }
                sq += shx(sq, 16, ln); sq += shx(sq, 32, ln); if (fq == 0) atomicAdd(ssq + row0 + ai * HALF + m * 16, sq); } }
#undef EFN_FETCH
        asm volatile("s_waitcnt vmcnt(0)" ::: "memory");
        const int hp0 = (grow0 >> 7) + (u.single ? u.sub : 0);
        if (ln == 0) { __hip_atomic_fetch_add(fin_cnt + 16 * hp0, 1u, __ATOMIC_RELAXED, __HIP_MEMORY_SCOPE_AGENT); if (!u.single) __hip_atomic_fetch_add(fin_cnt + 16 * (hp0 + 1), 1u, __ATOMIC_RELAXED, __HIP_MEMORY_SCOPE_AGENT); }
        for (unsigned spins = 0; spins < (1u << 20); ++spins) {
            unsigned c0 = __hip_atomic_load(fin_cnt + 16 * hp0, __ATOMIC_RELAXED, __HIP_MEMORY_SCOPE_AGENT); unsigned c1 = u.single ? 32u : __hip_atomic_load(fin_cnt + 16 * (hp0 + 1), __ATOMIC_RELAXED, __HIP_MEMORY_SCOPE_AGENT);
            c0 = (unsigned)__builtin_amdgcn_readfirstlane((int)c0); c1 = (unsigned)__builtin_amdgcn_readfirstlane((int)c1);
            if (c0 >= 32u && c1 >= 32u) break;
            __builtin_amdgcn_s_sleep(2); }
        f32x4 wv[2][2];
#pragma unroll
        for (int bj = 0; bj < 2; ++bj)
#pragma unroll
            for (int n = 0; n < 2; ++n) wv[bj][n] = *(const f32x4*)(nw + col0 + bj * HALF + 4 * n);
        float sstv[2][4];
#pragma unroll
        for (int ai = 0; ai < 2; ++ai)
#pragma unroll
            for (int m = 0; m < 4; ++m) sstv[ai][m] = __hip_atomic_load(ssq + row0 + (u.single ? 0 : ai) * HALF + m * 16, __ATOMIC_RELAXED, __HIP_MEMORY_SCOPE_AGENT);
#pragma unroll
        for (int ai = 0; ai < 2; ++ai) { if (ai == 1 && u.single) break;
#pragma unroll
            for (int m = 0; m < 4; ++m) { const int row = row0 + ai * HALF + m * 16; const size_t off = (size_t)row * 1024 + col0;
                const float sst = sstv[ai][m]; const float rs = 1.0f / sqrtf(sst * (1.0f / 1024.0f) + 1e-6f);
#pragma unroll
                for (int bj = 0; bj < 2; ++bj)
#pragma unroll
                    for (int n = 0; n < 2; ++n) *(f32x4*)(out + off + bj * HALF + 4 * n) = acc[ai][bj][m][n] * rs * wv[bj][n]; } }
    }
};
struct EpiRelu2 {
    static constexpr bool PERM = true, AFTER_DRAIN = false;
    bf16_t* H; const float* ss; const float* sw; int rowbase;
    template <bool WT> __device__ __forceinline__ void run(const f32x4 (&acc)[2][2][4][2], const Unit& u, int wr, int wc, int fr, int fq) const {
        asm volatile("" : "+v"(fr), "+v"(fq));
        const int row0 = u.pm * BM + (u.single ? u.sub * HALF : 0) + wr * 64 + fr; const int col0 = u.pn * BM + wc * 32 + 8 * fq;
        const int grow0 = rowbase + u.pm * BM; const int mi = grow0 < 8192 ? 0 : 1 + ((grow0 - 8192) >> 11);
        f32x4 swv[2][2];
#pragma unroll
        for (int bj = 0; bj < 2; ++bj)
#pragma unroll
            for (int n = 0; n < 2; ++n) swv[bj][n] = *(const f32x4*)(sw + (size_t)mi * 4096 + col0 + bj * HALF + 4 * n);
        float ssv[2][4];
#pragma unroll
        for (int ai = 0; ai < 2; ++ai)
#pragma unroll
            for (int m = 0; m < 4; ++m) ssv[ai][m] = ss[rowbase + row0 + (u.single ? 0 : ai) * HALF + m * 16];
#pragma unroll
        for (int ai = 0; ai < 2; ++ai) { if (ai == 1 && u.single) break;
#pragma unroll
            for (int m = 0; m < 4; ++m) { bf16_t* rowp = H + (size_t)(row0 + ai * HALF + m * 16) * 4096 + col0;
                const float rs = 1.0f / sqrtf(ssv[ai][m] * (1.0f / 1024.0f) + 1e-6f);
#pragma unroll
                for (int bj = 0; bj < 2; ++bj) { f32x4 v0 = acc[ai][bj][m][0] * rs + swv[bj][0], v1 = acc[ai][bj][m][1] * rs + swv[bj][1];
#pragma unroll
                    for (int e = 0; e < 4; ++e) { const float a = fmaxf(v0[e], 0.f), b = fmaxf(v1[e], 0.f); v0[e] = a * a; v1[e] = b * b; }
                    u32x4 w; w.x = cvt_pk_bf16(v0[0], v0[1]); w.y = cvt_pk_bf16(v0[2], v0[3]); w.z = cvt_pk_bf16(v1[0], v1[1]); w.w = cvt_pk_bf16(v1[2], v1[3]);
                    st16<WT>(rowp + bj * HALF, w); } } }
    }
};

template <class Epi, class Sched, bool ALIGN_EPI = false, bool SP2 = false, bool SINGLE = false>
__device__ __forceinline__ void gemm_phase(PG8_LAS unsigned char* lds, const Gemm g, const Sched& S, const Epi& E, int wave_id, bool bpre) {
    int tid; asm volatile("v_mbcnt_lo_u32_b32 %0, -1, 0\n\tv_mbcnt_hi_u32_b32 %0, -1, %0" : "=v"(tid)); tid += wave_id * 64;
    const int wid = __builtin_amdgcn_readfirstlane(tid >> 6), lane = tid & 63, wr = wid >> 2, wc = wid & 3, fr = lane & 15, fq = lane >> 4;
    const int K = g.K, nt = K / BK;
    unsigned voffA[2], voffB[2];
#pragma unroll
    for (int i = 0; i < 2; ++i) { int R, C; stage_rc(tid * 16 + i * 8192, R, C); const int Rb = Epi::PERM ? ((R & ~31) + perm32(R & 31)) : R;
        voffA[i] = (unsigned)(R * K + C) * 2u; voffB[i] = (unsigned)(Rb * K + C) * 2u; }
    const size_t kstep = (size_t)(BK * 2);
    const size_t hstep = (size_t)HALF * K * 2;
    const size_t tstep = 2 * hstep;
    const unsigned ldsw = (unsigned)wid * 1024u;
    const int aoff = lds_byte(wr * 64 + fr, fq * 8), boff = lds_byte(wc * 32 + fr, fq * 8);
#define PG8_SA(b, h) (((b) * 2 + (h)) * HTB)
#define PG8_SB(b, h) ((4 + (b) * 2 + (h)) * HTB)
#define PG8_STAGE(bufoff, gbase, voff) do { _Pragma("unroll") for (int _i = 0; _i < 2; ++_i) \
        __builtin_amdgcn_global_load_lds((const unsigned*)((const char*)(gbase) + (voff)[_i]), (PG8_LAS unsigned*)(lds + (bufoff) + ldsw + _i * 8192), 16, 0, 0); } while (0)
#define PG8_LDA(dst, b, h) do { _Pragma("unroll") for (int m = 0; m < 4; ++m) _Pragma("unroll") for (int k = 0; k < 2; ++k) dst[m][k] = *(const PG8_LAS bf16x8*)(lds + PG8_SA(b, h) + aoff + m * 2048 + k * 1024); } while (0)
#define PG8_LDB(dst, b, h) do { _Pragma("unroll") for (int n = 0; n < 2; ++n) _Pragma("unroll") for (int k = 0; k < 2; ++k) dst[n][k] = *(const PG8_LAS bf16x8*)(lds + PG8_SB(b, h) + boff + n * 2048 + k * 1024); } while (0)
#define PG8_MMA(ai, bj, At, Bt) do { __builtin_amdgcn_s_setprio(1); _Pragma("unroll") for (int m = 0; m < 4; ++m) _Pragma("unroll") for (int n = 0; n < 2; ++n) _Pragma("unroll") for (int k = 0; k < 2; ++k) \
        acc[ai][bj][m][n] = __builtin_amdgcn_mfma_f32_16x16x32_bf16(Bt[n][k], At[m][k], acc[ai][bj][m][n], 0, 0, 0); __builtin_amdgcn_s_setprio(0); } while (0)
#define PG8_WAIT_V(n) asm volatile("s_waitcnt vmcnt(" #n ")" ::: "memory")
#define PG8_WAIT_L(n) asm volatile("s_waitcnt lgkmcnt(" #n ")" ::: "memory")
#define PG8_BAR __builtin_amdgcn_s_barrier()
#define PG8_SCHED __builtin_amdgcn_sched_barrier(0)
    Unit cur, nxt; int ui = 0;
    if (!S.next(0, cur)) return;
    f32x4 acc[2][2][4][2];
#pragma unroll
    for (int a = 0; a < 2; ++a)
#pragma unroll
        for (int b = 0; b < 2; ++b)
#pragma unroll
            for (int m = 0; m < 4; ++m)
#pragma unroll
                for (int n = 0; n < 2; ++n) acc[a][b][m][n] = (f32x4){0.f, 0.f, 0.f, 0.f};
    bf16x8 At[4][2], B0[2][2], B1[2][2];
    const char* cA = (const char*)g.A + (size_t)cur.pm * tstep + (cur.single ? (size_t)cur.sub * hstep : (size_t)0); const char* cB = (const char*)g.Bt + (size_t)cur.pn * tstep;
    constexpr bool full = !SINGLE; const unsigned hA = SINGLE ? 0u : (unsigned)hstep;
    S.a_ready(cur);
    if constexpr (SP2) {
        if (!bpre) { PG8_STAGE(PG8_SB(0, 0), cB, voffB); PG8_STAGE(PG8_SB(0, 1), cB + hstep, voffB); } PG8_STAGE(PG8_SA(0, 0), cA, voffA); PG8_STAGE(PG8_SA(0, 1), cA + hA, voffA);
        if (wr == 1) PG8_BAR;
        PG8_WAIT_V(2); PG8_BAR;
        if (!bpre) PG8_STAGE(PG8_SB(1, 0), cB + kstep, voffB); PG8_STAGE(PG8_SA(1, 0), cA + kstep, voffA); if (!bpre) PG8_STAGE(PG8_SB(1, 1), cB + hstep + kstep, voffB);
        if (bpre) PG8_WAIT_V(2); else PG8_WAIT_V(6); PG8_BAR;
    } else {
        PG8_STAGE(PG8_SB(0, 0), cB, voffB); PG8_STAGE(PG8_SA(0, 0), cA, voffA); PG8_STAGE(PG8_SB(0, 1), cB + hstep, voffB); PG8_STAGE(PG8_SA(0, 1), cA + hA, voffA);
        if (wr == 1) PG8_BAR;
        PG8_WAIT_V(4); PG8_BAR;
        PG8_STAGE(PG8_SB(1, 0), cB + kstep, voffB); PG8_STAGE(PG8_SA(1, 0), cA + kstep, voffA); PG8_STAGE(PG8_SB(1, 1), cB + hstep + kstep, voffB);
        PG8_WAIT_V(6); PG8_BAR;
    }
    for (;;) {
        const bool has_next = S.next(ui + 1, nxt);
        const char* nA = has_next ? (const char*)g.A + (size_t)nxt.pm * tstep + (nxt.single ? (size_t)nxt.sub * hstep : (size_t)0) : cA; const char* nB = has_next ? (const char*)g.Bt + (size_t)nxt.pn * tstep : cB;

        for (int t = 0; t < nt; t += 2) {
            const bool last = (t == nt - 2);
            const char* a1 = cA + (size_t)(t + 1) * kstep;
            const char* a2 = last ? nA : cA + (size_t)(t + 2) * kstep; const char* b2 = last ? nB : cB + (size_t)(t + 2) * kstep;
            const char* a3 = a2 + kstep; const char* b3 = b2 + kstep; const unsigned h2 = hA;
            if (last && has_next) S.a_ready(nxt);
            if constexpr (SP2) {
            PG8_LDB(B0, 0, 0); PG8_LDB(B1, 0, 1); PG8_SCHED; PG8_LDA(At, 0, 0); PG8_STAGE(PG8_SA(1, 1), a1 + hA, voffA);
            PG8_WAIT_V(8); PG8_WAIT_L(0); PG8_BAR; PG8_MMA(0, 0, At, B0); PG8_MMA(0, 1, At, B1); PG8_BAR; PG8_SCHED;
            if constexpr (full) PG8_LDA(At, 0, 1); PG8_STAGE(PG8_SB(0, 0), b2, voffB); PG8_STAGE(PG8_SB(0, 1), b2 + hstep, voffB); PG8_STAGE(PG8_SA(0, 0), a2, voffA);
            PG8_WAIT_V(8); PG8_WAIT_L(0); PG8_BAR; if constexpr (full) { PG8_MMA(1, 0, At, B0); PG8_MMA(1, 1, At, B1); } PG8_BAR; PG8_SCHED;
            PG8_LDB(B0, 1, 0); PG8_LDB(B1, 1, 1); PG8_SCHED; PG8_LDA(At, 1, 0); PG8_STAGE(PG8_SA(0, 1), a2 + h2, voffA);
            PG8_WAIT_V(8); PG8_WAIT_L(0); PG8_BAR; PG8_MMA(0, 0, At, B0); PG8_MMA(0, 1, At, B1); PG8_BAR; PG8_SCHED;
            if constexpr (full) PG8_LDA(At, 1, 1); PG8_STAGE(PG8_SB(1, 0), b3, voffB); PG8_STAGE(PG8_SB(1, 1), b3 + hstep, voffB); PG8_STAGE(PG8_SA(1, 0), a3, voffA);
            PG8_WAIT_V(8); PG8_WAIT_L(0); PG8_BAR; if constexpr (full) { PG8_MMA(1, 0, At, B0); PG8_MMA(1, 1, At, B1); } PG8_BAR; PG8_SCHED;
            } else {
            PG8_LDB(B0, 0, 0); PG8_SCHED; PG8_LDA(At, 0, 0); PG8_STAGE(PG8_SA(1, 1), a1 + hA, voffA);
            PG8_WAIT_L(8); PG8_BAR; PG8_WAIT_L(0); PG8_MMA(0, 0, At, B0); PG8_BAR; PG8_SCHED;
            PG8_LDB(B1, 0, 1); PG8_STAGE(PG8_SB(0, 0), b2, voffB);
            PG8_BAR; PG8_WAIT_L(0); PG8_MMA(0, 1, At, B1); PG8_BAR;
            PG8_LDA(At, 0, 1); PG8_STAGE(PG8_SA(0, 0), a2, voffA);
            PG8_BAR; PG8_WAIT_L(0); if constexpr (full) PG8_MMA(1, 0, At, B0); PG8_BAR; PG8_SCHED;
            PG8_STAGE(PG8_SB(0, 1), b2 + hstep, voffB);
            PG8_WAIT_V(6); PG8_BAR; if constexpr (full) PG8_MMA(1, 1, At, B1); PG8_BAR;
            PG8_LDB(B0, 1, 0); PG8_SCHED; PG8_LDA(At, 1, 0); PG8_STAGE(PG8_SA(0, 1), a2 + h2, voffA);
            PG8_WAIT_L(8); PG8_BAR; PG8_WAIT_L(0); PG8_MMA(0, 0, At, B0); PG8_BAR; PG8_SCHED;
            PG8_LDB(B1, 1, 1); PG8_STAGE(PG8_SB(1, 0), b3, voffB);
            PG8_BAR; PG8_WAIT_L(0); PG8_MMA(0, 1, At, B1); PG8_BAR;
            PG8_LDA(At, 1, 1); PG8_STAGE(PG8_SA(1, 0), a3, voffA);
            PG8_BAR; PG8_WAIT_L(0); if constexpr (full) PG8_MMA(1, 0, At, B0); PG8_BAR; PG8_SCHED;
            PG8_STAGE(PG8_SB(1, 1), b3 + hstep, voffB);
            PG8_WAIT_V(6); PG8_BAR; if constexpr (full) PG8_MMA(1, 1, At, B1); PG8_BAR;
            }
        }
        if constexpr (ALIGN_EPI) { if (wr == 0) PG8_BAR; }
        if constexpr (!Epi::AFTER_DRAIN) { int ln_; LANE_ID(ln_); E.template run<SINGLE>(acc, cur, wr, wc, ln_ & 15, ln_ >> 4); S.done(cur); }
        if (!has_next) break;
#pragma unroll
        for (int a = 0; a < 2; ++a)
#pragma unroll
            for (int b = 0; b < 2; ++b)
#pragma unroll
                for (int m = 0; m < 4; ++m)
#pragma unroll
                    for (int n = 0; n < 2; ++n) acc[a][b][m][n] = (f32x4){0.f, 0.f, 0.f, 0.f};
        cur = nxt; cA = nA; cB = nB; ++ui;
        if constexpr (ALIGN_EPI) { if (wr == 1) PG8_BAR; }
    }
    PG8_WAIT_V(0);
    if constexpr (!ALIGN_EPI) { if (wr == 0) PG8_BAR; }
    PG8_BAR;
#undef PG8_SA
#undef PG8_SB
#undef PG8_STAGE
#undef PG8_LDA
#undef PG8_LDB
#undef PG8_MMA
#undef PG8_WAIT_V
#undef PG8_WAIT_L
#undef PG8_BAR
#undef PG8_SCHED
}
}

constexpr int NWAVES = 8;
constexpr int D = 1024, MC = 8192, ML = 16384, M = MC + ML, DIN = 2304, DFF = 4096, DG = 256, MP0 = 16384;
constexpr float EPS = 1e-6f;
constexpr size_t MiB = 1u << 20;
constexpr size_t WS_CTL = 0, CTL_ZERO_BYTES = 1 * MiB;
constexpr size_t WS_MOD = 1 * MiB;
constexpr size_t WS_ROPE = WS_MOD + 2 * 9 * 6144 * 4;
constexpr size_t WS_LAM = WS_ROPE + 64 * 16 * 4;
constexpr size_t WS_RGWT = WS_LAM + 256;
constexpr size_t WS_POOLT = WS_RGWT + 32 * 4096 * 2;
constexpr size_t WS_CARRY = WS_POOLT + 8 * 4096 * 2;
constexpr size_t WS_WIN = 2 * MiB;
constexpr size_t WS_WOUT = WS_WIN + 2ull * 2304 * 1024 * 2;
constexpr size_t WS_W1 = WS_WOUT + 2ull * 1024 * 1024 * 2;
constexpr size_t WS_W2 = WS_W1 + 2ull * 4096 * 1024 * 2;
constexpr size_t WS_CK = WS_W2 + 2ull * 4096 * 1024 * 2;
constexpr size_t WS_CV = WS_CK + 2 * MiB;
constexpr size_t WS_SW = 51 * MiB;
constexpr size_t WS_SS = 512 * 1024;
constexpr size_t WS_CARRY1 = 51 * MiB + 512 * 1024;
constexpr size_t WS_SP8 = WS_CARRY1 + 256 * 1024;
constexpr size_t WS_XN = 52 * MiB;
constexpr size_t WS_XR = 52 * MiB;
constexpr size_t OUT_XN_BYTES = 48 * MiB;
constexpr size_t WS_Y = 100 * MiB;
constexpr size_t WS_Z = 148 * MiB;
constexpr size_t WS_END = 256 * MiB;
static_assert(WS_SS + 5ull * 24576 * 4 <= CTL_ZERO_BYTES && WS_SW + 2ull * 9 * 6400 * 4 <= WS_XN, "ss/sw map");
static_assert(WS_CARRY + 8 * 8 * 4 * 2 * 64 * 2 * 4 <= WS_WIN && WS_CV + 2 * MiB <= WS_XN && WS_Z + (size_t)M * DIN * 2 <= WS_END, "d_ws map");
constexpr int CW_BAR = 4096, CW_FIN = 8192, CW_RG = 12288;
constexpr size_t OUT_Y = 0, OUT_CK = (size_t)M * D, OUT_CV = OUT_CK + 32ull * 2 * 4 * 256 * 64, OUT_ST = OUT_CV + 32ull * 2 * 4 * 256 * 64;
constexpr int RING_BYTES = 131072, LDSCTL_OFF = RING_BYTES, MISC_OFF = LDSCTL_OFF + 320, LDS_BYTES = 147456;

#define GAS __attribute__((address_space(1)))
#define LAS __attribute__((address_space(3)))
typedef unsigned short bf16;
typedef unsigned v4u __attribute__((ext_vector_type(4)));
typedef unsigned v2u __attribute__((ext_vector_type(2)));
typedef float f32x4 __attribute__((ext_vector_type(4)));
typedef GAS unsigned gu32;
#define RLX_AGENT __ATOMIC_RELAXED, __HIP_MEMORY_SCOPE_AGENT
#define LDS_WAIT() asm volatile("s_waitcnt lgkmcnt(0)" ::: "memory")
__device__ __forceinline__ unsigned f2bf(float f) { unsigned u = __builtin_bit_cast(unsigned, f); return (u + 0x7fffu + ((u >> 16) & 1u)) >> 16; }
__device__ __forceinline__ unsigned pk2(float lo, float hi) { return f2bf(lo) | (f2bf(hi) << 16); }
__device__ __forceinline__ float bf2f(unsigned h) { return __uint_as_float(h << 16); }
__device__ __forceinline__ float bflo(unsigned w) { return __uint_as_float(w << 16); }
__device__ __forceinline__ float bfhi(unsigned w) { return __uint_as_float(w & 0xffff0000u); }

#define XB_TMO      128
#define XB_XCNT(j)  (256  + 64 * (j))
#define XB_XSUB(j)  (1280 + 64 * (j))
#define XB_XGEN(j)  (2304 + 64 * (j))
#define XB_TOP      3328
#define XB_TOPGEN   3392
#define XCD_BAR_WORDS 3456
#define XB_SPIN_CAP (1u << 18)
__device__ __forceinline__ unsigned xb_ld(unsigned* p)              { return __hip_atomic_load(p, __ATOMIC_RELAXED, __HIP_MEMORY_SCOPE_AGENT); }
__device__ __forceinline__ unsigned xb_add(unsigned* p, unsigned v) { return __hip_atomic_fetch_add(p, v, __ATOMIC_RELAXED, __HIP_MEMORY_SCOPE_AGENT); }
__device__ __forceinline__ unsigned xb_xcc_id() { return (unsigned)__builtin_amdgcn_s_getreg((3 << 11) | 20) & 0xFu; }
#define XB_SPIN(cond, bar) do { unsigned _sp = 0; while (cond) { __builtin_amdgcn_s_sleep(1); \
    if ((++_sp & 255u) == 0u) { if (xb_ld(&(bar)[XB_TMO])) break; if (_sp > XB_SPIN_CAP) { atomicAdd(&(bar)[XB_TMO], 1u); break; } } } } while (0)
struct XcdBarrier { unsigned* bar; unsigned x; volatile LAS unsigned* st; };
__device__ __forceinline__ XcdBarrier xcd_barrier_post(unsigned* bar, volatile LAS unsigned* st) {
    XcdBarrier b; b.bar = bar; b.x = xb_xcc_id(); b.st = st;
    if (threadIdx.x == 0) (void)xb_add(&bar[XB_XCNT(b.x)], 1u);
    return b;
}
__device__ __forceinline__ void xcd_barrier_complete(unsigned* bar, unsigned x, unsigned& nloc, unsigned& nx) {
    const unsigned G = gridDim.x * gridDim.y * gridDim.z;
    unsigned sum, cnt, mine, sp = 0u;
    for (;;) {
        sum = 0u; cnt = 0u;
        for (unsigned j = 0; j < 16; ++j) { const unsigned c = xb_ld(&bar[XB_XCNT(j)]); sum += c; cnt += (c > 0u) ? 1u : 0u; }
        mine = xb_ld(&bar[XB_XCNT(x)]);
        if (sum == G) break;
        __builtin_amdgcn_s_sleep(1);
        if ((++sp & 255u) == 0u) { if (xb_ld(&bar[XB_TMO])) break; if (sp > XB_SPIN_CAP) { atomicAdd(&bar[XB_TMO], 1u); break; } }
    }
    nloc = mine > 0u ? mine : 1u; nx = cnt > 0u ? cnt : 1u;
}
__device__ __forceinline__ void xcd_barrier(const XcdBarrier& b, bool pend, int wave_id) {
    if (!pend || wave_id == 0) asm volatile("s_waitcnt vmcnt(0)" ::: "memory");
    else if (wave_id == 1) asm volatile("s_waitcnt vmcnt(16)" ::: "memory");
    else asm volatile("s_waitcnt vmcnt(8)" ::: "memory");
    __syncthreads();
    if (threadIdx.x == 0) {
        unsigned* bar = b.bar; asm volatile("" : "+s"(bar)); unsigned bx_ = b.x; asm volatile("" : "+s"(bx_));
        __builtin_amdgcn_s_waitcnt(0);
        unsigned nloc = b.st[0], nx = b.st[1];
        if (nloc == 0u) { xcd_barrier_complete(bar, bx_, nloc, nx); b.st[0] = nloc; b.st[1] = nx; }
        const unsigned old = xb_add(&bar[XB_XSUB(bx_)], 1u);
        const unsigned gen = old / nloc;
        if (old + 1u == (gen + 1u) * nloc) {
            __builtin_amdgcn_fence(__ATOMIC_RELEASE, "agent");
            asm volatile("s_waitcnt vmcnt(0)" ::: "memory");
            const unsigned og = xb_add(&bar[XB_TOP], 1u);
            const unsigned tg = og / nx;
            if (og + 1u == (tg + 1u) * nx) xb_add(&bar[XB_TOPGEN], 1u);
            else XB_SPIN(xb_ld(&bar[XB_TOPGEN]) == tg, bar);
            __builtin_amdgcn_fence(__ATOMIC_ACQUIRE, "agent");
            xb_add(&bar[XB_XGEN(bx_)], 1u);
            asm volatile("s_waitcnt vmcnt(0)" ::: "memory");
        } else {
            XB_SPIN(xb_ld(&bar[XB_XGEN(bx_)]) == gen, bar);
            __builtin_amdgcn_fence(__ATOMIC_ACQUIRE, "agent");
            asm volatile("s_waitcnt vmcnt(0)" ::: "memory");
        }
    }
    __syncthreads();
}

struct Args { const float* in[25]; float* out; unsigned char* ws; int ph_lo, ph_hi; };
#define INP(A_, i) inp_ptr(F, (i))
struct Frame {
    LAS unsigned char* lds; LAS unsigned char* lds0; int tid, lane, wave, wave0, vcu, vcu0, G;
    float* out; unsigned char* ws; float* out0; unsigned char* ws0;
};
__device__ __forceinline__ const float* inp_ptr(const Frame& F, int i) {
    const volatile LAS unsigned* t = (const volatile LAS unsigned*)(F.lds + 131072) + 2 * i;
    const unsigned lo = __builtin_amdgcn_readfirstlane(t[0]), hi = __builtin_amdgcn_readfirstlane(t[1]);
    return (const float*)(((unsigned long long)hi << 32) | lo);
}
#define PHASE_IDS(F) do { int t_; asm volatile("v_mbcnt_lo_u32_b32 %0, -1, 0\n\tv_mbcnt_hi_u32_b32 %0, -1, %0" : "=v"(t_)); int wv_ = (F).wave0; asm volatile("" : "+s"(wv_)); int vc_ = (F).vcu0; asm volatile("" : "+s"(vc_)); (F).vcu = vc_; (F).lane = t_; (F).wave = wv_; (F).tid = wv_ * 64 + t_; \
    unsigned l_ = (unsigned)(uintptr_t)(F).lds0; asm volatile("" : "+s"(l_)); (F).lds = (LAS unsigned char*)(uintptr_t)l_; unsigned char* w_ = (F).ws0; asm volatile("" : "+s"(w_)); (F).ws = w_; float* o_ = (F).out0; asm volatile("" : "+s"(o_)); (F).out = o_; } while (0)
enum { I_XP = 0, I_XS, I_CK, I_CV, I_ST, I_C, I_CCTX, I_WADA, I_BADA, I_NORMW, I_WIN, I_DLAM, I_SUBLN, I_CBW, I_CCW, I_CCB, I_RGW, I_RGB, I_RGLAM, I_POOLW, I_POOLS, I_WOUT, I_W1, I_W2, I_FNW };

__device__ __forceinline__ float wave_sum(float v, int lane) {
#pragma unroll
    for (int o = 1; o < 64; o <<= 1) v += shx(v, o, lane);
    return v;
}
__device__ __forceinline__ float wave_max(float v, int lane) {
#pragma unroll
    for (int o = 1; o < 64; o <<= 1) v = fmaxf(v, shx(v, o, lane));
    return v;
}
__device__ __forceinline__ float gelu_tanh(float x) { const float u = 0.7978845608028654f * (x + 0.044715f * x * x * x); return 0.5f * x * (1.0f + tanhf(u)); }

__device__ __forceinline__ void glds16(const void* gsrc, unsigned lds_dst) { unsigned keep;
    asm volatile("s_mov_b32 %0, m0\n\ts_mov_b32 m0, %2\n\ts_nop 0\n\tglobal_load_lds_dwordx4 %1, off\n\ts_mov_b32 m0, %0" : "=&s"(keep) : "v"(gsrc), "s"(lds_dst) : "memory"); }
__device__ __forceinline__ bool gemm_prefetch_b(LAS unsigned char* lds, const pg8::bf16_t* Bt, int M_, int N_, int K, int G, int c, int wave_id) {
    pg8::StaticOrder S0; S0.init(M_, N_, G, c, 0); pg8::Unit u;
    if (!S0.next(0, u)) { pg8::StaticOrder S1; S1.init(M_, N_, G, c, 1); if (!S1.next(0, u)) return false; }
    if (wave_id == 0) return true;
    int lane; LANE_ID(lane);
    const unsigned lds0 = (unsigned)(size_t)lds;
    const size_t kstep = (size_t)(pg8::BK * 2), hstep = (size_t)pg8::HALF * K * 2, tstep = 2 * hstep;
    const char* cB = (const char*)Bt + (size_t)u.pn * tstep;
    for (int sh = (wave_id == 1 ? 0 : wave_id); sh <= wave_id; ++sh) {
        const int tid = sh * 64 + lane;
#pragma unroll
        for (int i = 0; i < 2; ++i) { int R, C; pg8::stage_rc(tid * 16 + i * 8192, R, C); const int Rb = (R & ~31) + pg8::perm32(R & 31); const unsigned vo = (unsigned)(Rb * K + C) * 2u;
#pragma unroll
            for (int b = 0; b < 2; ++b)
#pragma unroll
                for (int h = 0; h < 2; ++h)
                    glds16(cB + (size_t)b * kstep + (size_t)h * hstep + vo, (unsigned)__builtin_amdgcn_readfirstlane((int)(lds0 + (unsigned)((4 + b * 2 + h) * pg8::HTB) + (unsigned)sh * 1024u + (unsigned)i * 8192u))); } }
    return true;
}
struct TItem { const float* W; bf16* WT; int K, N, item; };
__device__ __forceinline__ void p0_titem_load(const TItem& t, int lane, unsigned slot) {
    const int nblk = t.N / 32, kb = t.item / nblk, nb = t.item % nblk, k0 = 64 * kb, n0 = 32 * nb;
    const float* src = t.W + (size_t)(k0 + (lane >> 3)) * t.N + n0;
#pragma unroll
    for (int i = 0; i < 8; ++i) glds16(src + (size_t)(8 * i) * t.N + 4 * ((lane & 7) ^ i), slot + 1024u * i);
}
__device__ __forceinline__ void p0_titem_finish(const TItem& t, const LAS float* scr, int lane, bool first) {
    const int nblk = t.N / 32, kb = t.item / nblk, nb = t.item % nblk, k0 = 64 * kb, n0 = 32 * nb;
    if (first) asm volatile("s_waitcnt vmcnt(8)" ::: "memory"); else asm volatile("s_waitcnt vmcnt(12)" ::: "memory");
    const int c = lane & 7;
#pragma unroll
    for (int j = 0; j < 4; ++j) { const int n = (lane >> 3) + 8 * j; const LAS float* sp = scr + (8 * c) * 32 + (((n >> 2) ^ c) << 2) + (n & 3);
        v4u o; o.x = pk2(sp[0 * 32], sp[1 * 32]); o.y = pk2(sp[2 * 32], sp[3 * 32]); o.z = pk2(sp[4 * 32], sp[5 * 32]); o.w = pk2(sp[6 * 32], sp[7 * 32]);
        *(GAS v4u*)(t.WT + (size_t)(n0 + n) * t.K + k0 + 8 * c) = o; }
    LDS_WAIT(); asm volatile("" ::: "memory");
}
__device__ __forceinline__ void p0_mod_item(Frame& F, const Args& A, int item) {
    const int l = item / 96, n0 = (item % 96) * 64;
    LAS float* sv = (LAS float*)F.lds;
    LAS float* red = sv + 9 * 1024;
    const float* c = INP(A, I_C); const float* cctx = INP(A, I_CCTX);
    for (int i = F.tid; i < 9 * 1024; i += 512) { const int mi = i >> 10, k = i & 1023; const float v = mi == 0 ? cctx[k] : c[(mi - 1) * 1024 + k]; sv[i] = v / (1.0f + expf(-v)); }
    __syncthreads();
    const int cg = F.tid & 15, rg = F.tid >> 4;
    float acc[9][4];
#pragma unroll
    for (int a = 0; a < 9; ++a)
#pragma unroll
        for (int j = 0; j < 4; ++j) acc[a][j] = 0.f;
    const float* wp = INP(A, I_WADA) + (size_t)l * 1024 * 6144 + n0 + cg * 4;
#pragma unroll 1
    for (int i0 = 0; i0 < 32; i0 += 8) { f32x4 w[8];
#pragma unroll
        for (int q = 0; q < 8; ++q) w[q] = *(const GAS f32x4*)(wp + (size_t)(rg + 32 * (i0 + q)) * 6144);
#pragma unroll
        for (int q = 0; q < 8; ++q) { const int k = rg + 32 * (i0 + q);
#pragma unroll
            for (int a = 0; a < 9; ++a) { const float sx = sv[a * 1024 + k];
#pragma unroll
                for (int j = 0; j < 4; ++j) acc[a][j] += sx * w[q][j]; } } }
#pragma unroll
    for (int a = 0; a < 9; ++a)
#pragma unroll
        for (int j = 0; j < 4; ++j) red[(rg * 9 + a) * 64 + cg * 4 + j] = acc[a][j];
    __syncthreads();
    float* mod = (float*)(F.ws + WS_MOD);
    for (int o = F.tid; o < 9 * 64; o += 512) { const int mi = o >> 6, n = o & 63; float sm = INP(A, I_BADA)[l * 6144 + n0 + n];
#pragma unroll 8
        for (int r = 0; r < 32; ++r) sm += red[(r * 9 + mi) * 64 + n];
        mod[(size_t)(l * 9 + mi) * 6144 + n0 + n] = sm; }
    __syncthreads();
}
__device__ __forceinline__ void sincos_d(double a, float& co, float& si) {
    const double TWO_PI = 6.283185307179586476925286766559;
    const double n = (double)(long long)(a / TWO_PI + 0.5);
    const double r = a - n * TWO_PI;
    const double r2 = r * r; double ts = r, tc = 1.0, ss = r, sc = 1.0;
    for (int k = 1; k <= 14; ++k) { tc = -tc * r2 / (double)((2 * k - 1) * (2 * k)); sc += tc; ts = -ts * r2 / (double)((2 * k) * (2 * k + 1)); ss += ts; }
    co = (float)sc; si = (float)ss;
}
__device__ __forceinline__ void p0_prologue(Frame& F, const Args& A) {
    PHASE_IDS(F);
    if (blockIdx.x < 192) p0_mod_item(F, A, blockIdx.x);
    const unsigned slot0 = (unsigned)__builtin_amdgcn_readfirstlane((int)(unsigned)(size_t)(F.lds + F.wave * 16384));
    const LAS float* scr0 = (const LAS float*)(F.lds + F.wave * 16384); const LAS float* scr1 = scr0 + 2048;
    const int gw = F.vcu * NWAVES + F.wave, NGW = F.G * NWAVES;
    constexpr int I_IN = 16 * 72, I_OUT = 16 * 32, I_1 = 16 * 128, I_2 = 64 * 32, I_L = I_IN + I_OUT + I_1 + I_2, I_RG = 32 * 2, I_PW = 8 * 2;
    constexpr int NITEMS = 2 * I_L + I_RG + I_PW;
    const float* pw_in = INP(A, I_WIN); const float* pw_out = INP(A, I_WOUT); const float* pw_1 = INP(A, I_W1); const float* pw_2 = INP(A, I_W2); const float* pw_rg = INP(A, I_RGW); const float* pw_pl = INP(A, I_POOLW);
    auto decode = [&](int it, TItem& t) {
        int r = it;
        if (r < 2 * I_L) { const int l = r / I_L; r -= l * I_L;
            if (r < I_IN) { t = TItem{pw_in + (size_t)l * 1024 * 2304, (bf16*)(F.ws + WS_WIN) + (size_t)l * 2304 * 1024, 1024, 2304, r}; return; } r -= I_IN;
            if (r < I_OUT) { t = TItem{pw_out + (size_t)l * 1024 * 1024, (bf16*)(F.ws + WS_WOUT) + (size_t)l * 1024 * 1024, 1024, 1024, r}; return; } r -= I_OUT;
            if (r < I_1) { t = TItem{pw_1 + (size_t)l * 1024 * 4096, (bf16*)(F.ws + WS_W1) + (size_t)l * 4096 * 1024, 1024, 4096, r}; return; } r -= I_1;
            t = TItem{pw_2 + (size_t)l * 4096 * 1024, (bf16*)(F.ws + WS_W2) + (size_t)l * 1024 * 4096, 4096, 1024, r}; return; }
        r -= 2 * I_L;
        if (r < I_RG) { const int mi = r >> 1; t = TItem{pw_rg + (size_t)mi * 4096, (bf16*)(F.ws + WS_RGWT) + (size_t)mi * 4096, 64, 64, r & 1}; return; } r -= I_RG;
        { const int mi = r >> 1; t = TItem{pw_pl + (size_t)mi * 4096, (bf16*)(F.ws + WS_POOLT) + (size_t)mi * 4096, 64, 64, r & 1}; }
    };
    if (gw < NITEMS) {
        const int cnt = (NITEMS - gw + NGW - 1) / NGW;
        TItem ta, tb;
        decode(gw, ta); p0_titem_load(ta, F.lane, slot0);
        for (int j = 0; j < cnt; j += 2) {
            { const int jn = j + 1 < cnt ? j + 1 : cnt - 1; decode(gw + jn * NGW, tb); p0_titem_load(tb, F.lane, slot0 + 8192u); }
            p0_titem_finish(ta, scr0, F.lane, j == 0);
            if (j + 1 >= cnt) break;
            { const int jn = j + 2 < cnt ? j + 2 : cnt - 1; decode(gw + jn * NGW, ta); p0_titem_load(ta, F.lane, slot0); }
            p0_titem_finish(tb, scr1, F.lane, false);
        }
        asm volatile("s_waitcnt vmcnt(0)" ::: "memory");
    }
    { const int gt = F.vcu * 512 + F.tid, NGT = F.G * 512;
      const float* pck = INP(A, I_CK); const float* pcv = INP(A, I_CV);
      for (int i0 = gt; i0 < 2 * 262144; i0 += 4 * NGT) { f32x4 v[4];
#pragma unroll
          for (int q = 0; q < 4; ++q) { const int i = i0 + q * NGT; if (i < 2 * 262144) { const int which = i >= 262144; const int j = which ? i - 262144 : i; v[q] = *(const GAS f32x4*)((which ? pcv : pck) + (size_t)j * 4); } }
#pragma unroll
          for (int q = 0; q < 4; ++q) { const int i = i0 + q * NGT; if (i < 2 * 262144) { const int which = i >= 262144; const int j = which ? i - 262144 : i; v2u o; o.x = pk2(v[q][0], v[q][1]); o.y = pk2(v[q][2], v[q][3]);
              *(GAS v2u*)((bf16*)(F.ws + (which ? WS_CV : WS_CK)) + (size_t)j * 4) = o; } } } }
    if (blockIdx.x == (unsigned)(F.G - 1)) {
        const double fr[8] = {1.0, 0.31622776601683794, 0.1, 0.031622776601683794, 0.01, 0.0031622776601683794, 0.001, 0.00031622776601683794};
        float* rope = (float*)(F.ws + WS_ROPE);
        { const int pos = F.tid >> 3, j = F.tid & 7; double f = fr[0];
#pragma unroll
          for (int q = 1; q < 8; ++q) f = (j == q) ? fr[q] : f;
          float co, si; sincos_d((double)pos * f, co, si); rope[pos * 16 + j * 2] = co; rope[pos * 16 + j * 2 + 1] = si; }
        { const float* rgl = INP(A, I_RGLAM); float* sp8 = (float*)(F.ws + WS_SP8);
          for (int i = F.tid; i < 2 * 2 * 256; i += 512) sp8[i] = 8.0f * 1.4426950408889634f * log1pf(expf(-rgl[i])); }
        if (F.tid < 2) { const int l = F.tid; const float* dl = INP(A, I_DLAM) + l * 128; float s1 = 0.f, s2 = 0.f;
            for (int i = 0; i < 32; ++i) { s1 += dl[i] * dl[32 + i]; s2 += dl[64 + i] * dl[96 + i]; }
            const float lam_init = 0.8f - 0.6f * expf(-0.3f * (float)l);
            ((float*)(F.ws + WS_LAM))[l] = expf(s1) - expf(s2) + lam_init; }
    }
}
__device__ __forceinline__ void prep0_phase(Frame& F, const Args& A) {
    PHASE_IDS(F);
    bf16* XN = (bf16*)((unsigned char*)F.out + OUT_XN_BYTES); float* SS0 = (float*)(F.ws + WS_SS); const float* mod = (const float*)(F.ws + WS_MOD);
    const float* xp = INP(A, I_XP); const float* xsm = INP(A, I_XS) - (size_t)MC * D; const float* nw = INP(A, I_NORMW);
    const int gw = F.vcu * NWAVES + F.wave, NGW = F.G * NWAVES; const int lane = F.lane;
    const int cmb = (int)blockIdx.x & 3, sl = cmb >> 1, which = cmb & 1, slot = (int)blockIdx.x >> 2; const int N = which ? DFF : DIN;
    const int ntile = which ? 4 : 3, ncol = which ? 64 : 48; const bool active = which ? (slot < 64) : (slot < 48);
    const int tile = F.wave & 3, kh = F.wave >> 2; const bool has = active && tile < ntile;
    const int n0 = (active ? slot : 0) * ncol + (tile < ntile ? tile : 0) * 16;
    LAS float* sh = (LAS float*)F.lds;
    LAS float* red = sh + 9 * 1024;
    { const float* shg = mod + (size_t)sl * 9 * 6144 + (which ? 3072 : 0);
      for (int i = F.tid; i < 9 * 256; i += 512) { const int mi = i >> 8, k4 = i & 255; *(LAS f32x4*)(sh + mi * 1024 + 4 * k4) = *(const f32x4*)(shg + (size_t)mi * 6144 + 4 * k4); } }
    const bf16* wbase = which ? (const bf16*)(F.ws + WS_W1) + (size_t)sl * DFF * D : (const bf16*)(F.ws + WS_WIN) + (size_t)sl * DIN * D;
    v4u wf[16];
    { const bf16* wt = wbase + (size_t)(n0 + (lane & 15)) * D + kh * 512 + (lane >> 4) * 8;
#pragma unroll
      for (int st = 0; st < 16; ++st) wf[st] = *(const GAS v4u*)(wt + 32 * st); }
    REP(13) for (int r0 = gw; r0 < M; r0 += 4 * NGW) {
        f32x4 v[4][4];
#pragma unroll
        for (int q = 0; q < 4; ++q) { const int r = r0 + q * NGW; const float* xr = (r < MC ? xp : xsm) + (size_t)r * D;
#pragma unroll
            for (int j = 0; j < 4; ++j) v[q][j] = *(const GAS f32x4*)(xr + 256 * j + 4 * lane); }
#pragma unroll
        for (int q = 0; q < 4; ++q) { const int r = r0 + q * NGW; const int mi = r < MC ? 0 : 1 + ((r - MC) >> 11);
            const float* mp = mod + (size_t)mi * 6144 + 1024;
            float sq = 0.f;
#pragma unroll
            for (int j = 0; j < 4; ++j) sq += (v[q][j][0] * v[q][j][0] + v[q][j][1] * v[q][j][1]) + (v[q][j][2] * v[q][j][2] + v[q][j][3] * v[q][j][3]);
#pragma unroll
            for (int j = 0; j < 4; ++j) { const int c = 256 * j + 4 * lane; const f32x4 w = *(const GAS f32x4*)(nw + c), sc = *(const GAS f32x4*)(mp + c);
                v2u pk; pk.x = pk2(v[q][j][0] * w[0] * (1.0f + sc[0]), v[q][j][1] * w[1] * (1.0f + sc[1])); pk.y = pk2(v[q][j][2] * w[2] * (1.0f + sc[2]), v[q][j][3] * w[3] * (1.0f + sc[3])); *(GAS v2u*)(XN + (size_t)r * D + c) = pk; }
            sq = wave_sum(sq, lane); if (lane == 0) *(GAS float*)(SS0 + r) = sq; }
    }
    __syncthreads();
    { const int mi = lane & 15, kg = lane >> 4; const LAS float* sp = sh + (mi < 9 ? mi : 0) * 1024 + kh * 512 + kg * 8; const float keep = mi < 9 ? 1.0f : 0.0f;
      pg8::f32x4 acc = {0.f, 0.f, 0.f, 0.f};
#pragma unroll
      for (int st = 0; st < 16; ++st) { const f32x4 s0 = *(const LAS f32x4*)(sp + 32 * st), s1 = *(const LAS f32x4*)(sp + 32 * st + 4);
          float x[8] = {s0[0] * keep, s0[1] * keep, s0[2] * keep, s0[3] * keep, s1[0] * keep, s1[1] * keep, s1[2] * keep, s1[3] * keep}; v4u hi, lo;
          hi.x = pg8::cvt_pk_bf16(x[0], x[1]); hi.y = pg8::cvt_pk_bf16(x[2], x[3]); hi.z = pg8::cvt_pk_bf16(x[4], x[5]); hi.w = pg8::cvt_pk_bf16(x[6], x[7]);
          lo.x = pg8::cvt_pk_bf16(x[0] - bflo(hi.x), x[1] - bfhi(hi.x)); lo.y = pg8::cvt_pk_bf16(x[2] - bflo(hi.y), x[3] - bfhi(hi.y));
          lo.z = pg8::cvt_pk_bf16(x[4] - bflo(hi.z), x[5] - bfhi(hi.z)); lo.w = pg8::cvt_pk_bf16(x[6] - bflo(hi.w), x[7] - bfhi(hi.w));
          const pg8::bf16x8 bw = __builtin_bit_cast(pg8::bf16x8, wf[st]);
          acc = __builtin_amdgcn_mfma_f32_16x16x32_bf16(__builtin_bit_cast(pg8::bf16x8, hi), bw, acc, 0, 0, 0);
          acc = __builtin_amdgcn_mfma_f32_16x16x32_bf16(__builtin_bit_cast(pg8::bf16x8, lo), bw, acc, 0, 0, 0); }
      if (kh == 1) *(LAS pg8::f32x4*)(red + (tile * 64 + lane) * 4) = acc;
      __syncthreads();
      if (kh == 0 && has) { const pg8::f32x4 o = *(const LAS pg8::f32x4*)(red + (tile * 64 + lane) * 4);
          float* obase = (float*)(F.ws + WS_SW) + (which ? 2 * 9 * 2304 + (size_t)sl * 9 * 4096 : (size_t)sl * 9 * 2304);
#pragma unroll
          for (int e = 0; e < 4; ++e) { const int m2 = 4 * kg + e; if (m2 < 9) *(GAS float*)(obase + (size_t)m2 * N + n0 + (lane & 15)) = acc[e] + o[e]; } }
      __syncthreads(); }
}
typedef short bf16x8_t __attribute__((ext_vector_type(8)));
typedef float f32x16 __attribute__((ext_vector_type(16)));
typedef short v4i16_t __attribute__((ext_vector_type(4)));
__device__ __forceinline__ unsigned cvtpk(float lo, float hi) { unsigned r; asm volatile("v_cvt_pk_bf16_f32 %0, %1, %2" : "=v"(r) : "v"(lo), "v"(hi)); return r; }
__device__ __forceinline__ bf16x8_t pack8(float a0, float a1, float a2, float a3, float a4, float a5, float a6, float a7) {
    v4u w; w.x = cvtpk(a0, a1); w.y = cvtpk(a2, a3); w.z = cvtpk(a4, a5); w.w = cvtpk(a6, a7); return __builtin_bit_cast(bf16x8_t, w); }
__device__ __forceinline__ v4i16_t lds_tr(LAS unsigned char* p) { return __builtin_amdgcn_ds_read_tr16_b64_v4i16((LAS v4i16_t*)p); }
#define MFMA32(a, b, c) __builtin_amdgcn_mfma_f32_32x32x16_bf16((a), (b), (c), 0, 0, 0)


__device__ __forceinline__ void attn_unit(Frame& F, const Args& A, int l, bool lat, int seq, int hd, int qb, float lam, float sub_mul) {
    LAS unsigned char* L = F.lds;
    const bf16* Z = (const bf16*)(F.ws + WS_Z); bf16* Y = (bf16*)(F.ws + WS_Y);
    const bf16* CK = (const bf16*)(F.ws + WS_CK); const bf16* CV = (const bf16*)(F.ws + WS_CV);
    int lane; LANE_ID(lane); const int w = F.wave, tid = w * 64 + lane, r32 = lane & 31, h = lane >> 5;
    const int zrow0 = lat ? MC + seq * 2048 : seq * 256;
    const int qrow = zrow0 + qb * 256 + w * 32 + r32;
    bf16x8_t qf[2][2];
#pragma unroll
    for (int s = 0; s < 2; ++s)
#pragma unroll
        for (int ks = 0; ks < 2; ++ks) qf[s][ks] = *(const bf16x8_t*)(Z + (size_t)qrow * DIN + hd * 64 + s * 32 + ks * 16 + h * 8);
    const int NT = lat ? 36 : 4;
    const unsigned lds0 = (unsigned)(uintptr_t)L;
    const int srow = 8 * w + (lane >> 3), spc = lane & 7;
    const int kch = spc ^ ((srow >> 1) & 7), vch = spc ^ (((srow >> 1) & 1) << 2);
    const size_t cbk = ((size_t)((seq * 2 + l) * 4 + hd) * 256 + srow) * 64 + kch * 8, cbv = ((size_t)((seq * 2 + l) * 4 + hd) * 256 + srow) * 64 + vch * 8;
    const size_t zbk = (size_t)(zrow0 + srow) * DIN + 256 + hd * 64 + kch * 8, zbv = (size_t)(zrow0 + srow) * DIN + 512 + hd * 64 + vch * 8;
#define ATT_DMA(tn, slot) do { const unsigned sb_ = (unsigned)(slot) * 16384u + (unsigned)w * 1024u; \
        const bf16* ks_ = (lat && (tn) < 4) ? CK + cbk + (size_t)(tn) * 4096 : Z + zbk + (size_t)((tn) - (lat ? 4 : 0)) * 64 * DIN; \
        const bf16* vs_ = (lat && (tn) < 4) ? CV + cbv + (size_t)(tn) * 4096 : Z + zbv + (size_t)((tn) - (lat ? 4 : 0)) * 64 * DIN; \
        glds16(ks_, (unsigned)__builtin_amdgcn_readfirstlane((int)(lds0 + sb_))); glds16(vs_, (unsigned)__builtin_amdgcn_readfirstlane((int)(lds0 + sb_ + 8192u))); } while (0)
    unsigned koff[2][2];
#pragma unroll
    for (int s = 0; s < 2; ++s)
#pragma unroll
        for (int ks = 0; ks < 2; ++ks) koff[s][ks] = r32 * 128 + (((s * 4 + ks * 2 + h) ^ ((r32 >> 1) & 7)) << 4);
    const int q_ = (lane & 15) >> 2, p_ = lane & 3, g1 = (lane >> 4) & 1, sw = (lane >> 3) & 1;
    const unsigned vb0 = 8192 + (4 * h + q_) * 128 + (((2 * g1 + (p_ >> 1)) ^ (sw << 2)) << 4) + (p_ & 1) * 8;
    const unsigned vb1 = 8192 + (4 * h + q_) * 128 + (((4 + 2 * g1 + (p_ >> 1)) ^ (sw << 2)) << 4) + (p_ & 1) * 8;
    ATT_DMA(0, 0); ATT_DMA(1, 1);
    __builtin_amdgcn_s_waitcnt(0x0F70);
    float mref[2] = {0.f, 0.f}, ls[2] = {0.f, 0.f};
    f32x16 o[2][2];
#pragma unroll
    for (int s = 0; s < 2; ++s)
#pragma unroll
        for (int db = 0; db < 2; ++db)
#pragma unroll
            for (int r = 0; r < 16; ++r) o[s][db][r] = 0.f;
    for (int t = 0, par = 0; t < NT; ++t, par = (par == 2 ? 0 : par + 1)) {
        const unsigned bo = (unsigned)par * 16384u;
        if (t + 1 < NT) asm volatile("s_waitcnt vmcnt(2)" ::: "memory"); else asm volatile("s_waitcnt vmcnt(0)" ::: "memory");
        __builtin_amdgcn_s_barrier(); asm volatile("" ::: "memory");
        if (t + 2 < NT) ATT_DMA(t + 2, (par == 0 ? 2 : par - 1));
        bf16x8_t kf[2][2][2], vf[2][4];
#pragma unroll
        for (int s = 0; s < 2; ++s)
#pragma unroll
            for (int ks = 0; ks < 2; ++ks) { kf[s][ks][0] = *(const LAS bf16x8_t*)(L + bo + koff[s][ks]); kf[s][ks][1] = *(const LAS bf16x8_t*)(L + bo + koff[s][ks] + 4096); }
#pragma unroll
        for (int db = 0; db < 2; ++db)
#pragma unroll
            for (int sp = 0; sp < 4; ++sp) { LAS unsigned char* vp = L + bo + (db ? vb1 : vb0) + sp * 2048; const v4i16_t lo = lds_tr(vp), hi = lds_tr(vp + 1024);
                vf[db][sp] = (bf16x8_t){lo[0], lo[1], lo[2], lo[3], hi[0], hi[1], hi[2], hi[3]}; }
        f32x16 p[2][2];
#pragma unroll
        for (int s = 0; s < 2; ++s) { const float nm = -mref[s];
#pragma unroll
            for (int r = 0; r < 16; ++r) { p[s][0][r] = nm; p[s][1][r] = nm; }
#pragma unroll
            for (int ks = 0; ks < 2; ++ks) { p[s][0] = MFMA32(kf[s][ks][0], qf[s][ks], p[s][0]); p[s][1] = MFMA32(kf[s][ks][1], qf[s][ks], p[s][1]); } }
        __builtin_amdgcn_sched_barrier(0);
        bf16x8_t pb[2][4];
#pragma unroll
        for (int s = 0; s < 2; ++s) {
            f32x16& p0 = p[s][0]; f32x16& p1 = p[s][1];
            float ma = fmaxf(fmaxf(p0[0], p0[1]), p1[0]), mb = fmaxf(fmaxf(p0[2], p0[3]), p1[1]); ma = fmaxf(fmaxf(ma, p1[2]), p1[3]);
#pragma unroll
            for (int r = 4; r < 16; r += 4) { ma = fmaxf(fmaxf(ma, p0[r]), p0[r + 1]); mb = fmaxf(fmaxf(mb, p0[r + 2]), p0[r + 3]); ma = fmaxf(fmaxf(ma, p1[r]), p1[r + 1]); mb = fmaxf(fmaxf(mb, p1[r + 2]), p1[r + 3]); }
            float mt = fmaxf(ma, mb); mt = fmaxf(mt, shx(mt, 32, lane));
            if (t == 0 || __any(mt > 8.0f)) {
                const float dl = (t == 0) ? mt : fmaxf(mt, 0.f); mref[s] += dl; const float al = (t == 0) ? 1.0f : __builtin_amdgcn_exp2f(-dl); ls[s] *= al;
#pragma unroll
                for (int r = 0; r < 16; ++r) { p0[r] -= dl; p1[r] -= dl; }
#pragma unroll
                for (int db = 0; db < 2; ++db)
#pragma unroll
                    for (int r = 0; r < 16; ++r) o[s][db][r] *= al; }
            float rs0 = 0.f, rs1 = 0.f;
#pragma unroll
            for (int r = 0; r < 16; ++r) { p0[r] = __builtin_amdgcn_exp2f(p0[r]); p1[r] = __builtin_amdgcn_exp2f(p1[r]); rs0 += p0[r]; asm volatile("" : "+v"(rs0)); rs1 += p1[r]; asm volatile("" : "+v"(rs1)); }
            ls[s] += rs0 + rs1;
            pb[s][0] = pack8(p0[0], p0[1], p0[2], p0[3], p0[4], p0[5], p0[6], p0[7]); pb[s][1] = pack8(p0[8], p0[9], p0[10], p0[11], p0[12], p0[13], p0[14], p0[15]);
            pb[s][2] = pack8(p1[0], p1[1], p1[2], p1[3], p1[4], p1[5], p1[6], p1[7]); pb[s][3] = pack8(p1[8], p1[9], p1[10], p1[11], p1[12], p1[13], p1[14], p1[15]);
            if (s == 0) {
                __builtin_amdgcn_sched_barrier(0);
#pragma unroll
                for (int db = 0; db < 2; ++db)
#pragma unroll
                    for (int sp = 0; sp < 4; ++sp) o[0][db] = MFMA32(vf[db][sp], pb[0][sp], o[0][db]);
            }
        }
        __builtin_amdgcn_sched_barrier(0);
#pragma unroll
        for (int db = 0; db < 2; ++db)
#pragma unroll
            for (int sp = 0; sp < 4; ++sp) o[1][db] = MFMA32(vf[db][sp], pb[1][sp], o[1][db]);
        __builtin_amdgcn_sched_barrier(0);
    }
    const float l0 = ls[0] + shx(ls[0], 32, lane), l1 = ls[1] + shx(ls[1], 32, lane);
    const float i0 = 1.0f / l0, i1 = lam / l1;
    float ss = 0.f;
#pragma unroll
    for (int db = 0; db < 2; ++db)
#pragma unroll
        for (int r = 0; r < 16; ++r) { const float v = o[0][db][r] * i0 - o[1][db][r] * i1; o[0][db][r] = v; ss += v * v; }
    ss += shx(ss, 32, lane);
    const float rn = sub_mul / sqrtf(ss * (1.0f / 64.0f) + EPS);
    const float* subw = INP(A, I_SUBLN) + l * 64;
    bf16* yrow = Y + (size_t)qrow * D + hd * 64;
#pragma unroll
    for (int db = 0; db < 2; ++db)
#pragma unroll
        for (int g = 0; g < 4; ++g) { const int d0 = 32 * db + 8 * g + 4 * h; const f32x4 sw4 = *(const f32x4*)(subw + d0);
            v2u pk; pk.x = cvtpk(o[0][db][4 * g] * rn * sw4[0], o[0][db][4 * g + 1] * rn * sw4[1]); pk.y = cvtpk(o[0][db][4 * g + 2] * rn * sw4[2], o[0][db][4 * g + 3] * rn * sw4[3]);
            *(GAS v2u*)(yrow + d0) = pk; }
    __syncthreads();
}


__device__ __forceinline__ float sigm(float x) { return __builtin_amdgcn_rcpf(1.0f + __builtin_amdgcn_exp2f(-1.4426950408889634f * x)); }
template <int DIRB> __device__ __forceinline__ void grp_comp(const f32x16& a, const f32x16& b, int g, float& Ag, float& Bg) {
    const float a0 = a[4 * g], a1 = a[4 * g + 1], a2 = a[4 * g + 2], a3 = a[4 * g + 3], b0 = b[4 * g], b1 = b[4 * g + 1], b2 = b[4 * g + 2], b3 = b[4 * g + 3];
    Ag = (a0 * a1) * (a2 * a3);
    if (!DIRB) { float t = b0; t = a1 * t + b1; t = a2 * t + b2; t = a3 * t + b3; Bg = t; }
    else { float t = b3; t = a2 * t + b2; t = a1 * t + b1; t = a0 * t + b0; Bg = t; }
}
template <int DIRB> __device__ __forceinline__ void wave_comp(const f32x16& a, const f32x16& b, int h, int lane, float& Aw, float& Bw) {
    Aw = 1.f; Bw = 0.f;
#pragma unroll
    for (int gi = 0; gi < 4; ++gi) { const int g = DIRB ? 3 - gi : gi;
        float Ag, Bg; grp_comp<DIRB>(a, b, g, Ag, Bg);
        const float Ao = shx(Ag, 32, lane), Bo = shx(Bg, 32, lane);
        const float A0 = h ? Ao : Ag, B0 = h ? Bo : Bg, A1 = h ? Ag : Ao, B1 = h ? Bg : Bo;
        float Ap, Bp;
        if (!DIRB) { Ap = A0 * A1; Bp = A1 * B0 + B1; } else { Ap = A0 * A1; Bp = A0 * B1 + B0; }
        Bw = Ap * Bw + Bp; Aw *= Ap; }
}
template <int DIRB> __device__ __forceinline__ void scan_final(const f32x16& a, const f32x16& b, int h, int lane, float X, f32x16& hout) {
    float S = X;
#pragma unroll
    for (int gi = 0; gi < 4; ++gi) { const int g = DIRB ? 3 - gi : gi;
        float Ag, Bg; grp_comp<DIRB>(a, b, g, Ag, Bg);
        const float Ao = shx(Ag, 32, lane), Bo = shx(Bg, 32, lane);
        const float A0 = h ? Ao : Ag, B0 = h ? Bo : Bg, A1 = h ? Ag : Ao, B1 = h ? Bg : Bo;
        if (!DIRB) { float st = h ? (Ao * S + Bo) : S;
#pragma unroll
            for (int e = 0; e < 4; ++e) { st = a[4 * g + e] * st + b[4 * g + e]; hout[4 * g + e] = st; }
            S = A1 * (A0 * S + B0) + B1; }
        else { float st = h ? S : (Ao * S + Bo);
#pragma unroll
            for (int e = 3; e >= 0; --e) { st = a[4 * g + e] * st + b[4 * g + e]; hout[4 * g + e] = st; }
            S = A0 * (A1 * S + B1) + B0; } }
}
__device__ __forceinline__ void rglru_unit(Frame& F, const Args& A, int l, int mode, int seq, int n, int chunk, int pv = 0) {
    const bf16* Z = (const bf16*)(F.ws + WS_Z); bf16* Y = (bf16*)(F.ws + WS_Y); const bf16* RGWT = (const bf16*)(F.ws + WS_RGWT);
    float* CARRY = (float*)(F.ws + (l == 0 ? WS_CARRY : WS_CARRY1));
    unsigned* rg_cnt = (unsigned*)(F.ws + WS_CTL) + CW_RG + 16 * ((l * 8 + seq) * 4 + n);
    int lane; LANE_ID(lane); const int w = F.wave, r32 = lane & 31, h = lane >> 5;
    const bool lat = mode != 0; const int T = lat ? 2048 : 256; const int row0 = lat ? MC + seq * 2048 : seq * 256; const int t0 = chunk * 256 + w * 32;
    LAS float* comp = (LAS float*)F.lds;
    LAS float* xcar = (LAS float*)(F.lds + 8192);
    LAS unsigned char* GR = F.lds + 16384 + w * 4096;
    LAS unsigned char* YO = F.lds + 16384 + 32768 + w * 4096;
    LAS float* CWL = (LAS float*)(F.lds + 81920 + w * 1280);
    const float* p_rgb = INP(A, I_RGB); const float* p_sp8 = (const float*)(F.ws + WS_SP8); const float* p_cw = INP(A, I_CCW) + l * 4 * 256; const float* p_cb = INP(A, I_CCB) + l * 256; const float* p_st = INP(A, I_ST);
    v4u gq[4];
    if (mode != 1) { const bf16* gp = Z + (size_t)(row0 + t0 + r32) * DIN + 1792 + n * 64 + h * 32;
#pragma unroll
        for (int q = 0; q < 4; ++q) gq[q] = *(const v4u*)(gp + 8 * q); }
    const int tk = t0 + r32;
    v4u zq[4][4];
#pragma unroll
    for (int ks = 0; ks < 4; ++ks) { const int c8 = n * 64 + 16 * ks + 8 * h;
#pragma unroll
        for (int j = 0; j < 4; ++j) { const int tt = tk + j - 2; const bool ok = tt >= 0 && tt < T; const int tc = ok ? tt : tk;
            zq[ks][j] = *(const v4u*)(Z + (size_t)(row0 + tc) * DIN + 1536 + c8); } }
    bf16x8_t wf[2][2][4];
#pragma unroll
    for (int dir = 0; dir < 2; ++dir)
#pragma unroll
        for (int gt = 0; gt < 2; ++gt) { const bf16* wp = RGWT + (size_t)((((l * 2 + dir) * 2 + gt) * 4 + n) * 4096) + r32 * 64 + 8 * h;
#pragma unroll
            for (int ks = 0; ks < 4; ++ks) wf[dir][gt][ks] = *(const bf16x8_t*)(wp + 16 * ks); }
    float cwv[5], kbr[2][2], kbi[2][2], ksp[2][2];
#pragma unroll
    for (int j = 0; j < 4; ++j) cwv[j] = ((const GAS float*)p_cw)[j * 256 + n * 64 + lane];
    cwv[4] = ((const GAS float*)p_cb)[n * 64 + lane];
#pragma unroll
    for (int hb = 0; hb < 2; ++hb)
#pragma unroll
        for (int dir = 0; dir < 2; ++dir) { const int c = n * 64 + 32 * hb + r32;
            kbr[hb][dir] = ((const GAS float*)p_rgb)[((l * 2 + dir) * 2 + 0) * 256 + c]; kbi[hb][dir] = ((const GAS float*)p_rgb)[((l * 2 + dir) * 2 + 1) * 256 + c]; ksp[hb][dir] = ((const GAS float*)p_sp8)[(l * 2 + dir) * 256 + c]; }
    if (mode == 2 && w == 0) { const int c = n * 64 + lane;
        for (unsigned spins = 0; spins < (1u << 20); ++spins) { const unsigned cdone = (unsigned)__builtin_amdgcn_readfirstlane((int)__hip_atomic_load(rg_cnt, __ATOMIC_RELAXED, __HIP_MEMORY_SCOPE_AGENT)); if (cdone >= 16u) break; __builtin_amdgcn_s_sleep(2); }
        float Xf = p_st[(size_t)((seq * 2 + l) * 2 + 0) * 256 + c], Xb = p_st[(size_t)((seq * 2 + l) * 2 + 1) * 256 + c];
        unsigned long long cf[8], cbk[8];
#pragma unroll
        for (int cc = 0; cc < 8; ++cc) { cf[cc] = __hip_atomic_load((const unsigned long long*)(CARRY + ((size_t)(((seq * 8 + cc) * 4 + n) * 2) * 64 + lane) * 2), __ATOMIC_RELAXED, __HIP_MEMORY_SCOPE_AGENT);
                                         cbk[cc] = __hip_atomic_load((const unsigned long long*)(CARRY + ((size_t)(((seq * 8 + cc) * 4 + n) * 2 + 1) * 64 + lane) * 2), __ATOMIC_RELAXED, __HIP_MEMORY_SCOPE_AGENT); }
#pragma unroll
        for (int cc = 0; cc < 8; ++cc) if (cc < chunk) Xf = __uint_as_float((unsigned)cf[cc]) * Xf + __uint_as_float((unsigned)(cf[cc] >> 32));
#pragma unroll
        for (int cc = 7; cc >= 0; --cc) if (cc > chunk) Xb = __uint_as_float((unsigned)cbk[cc]) * Xb + __uint_as_float((unsigned)(cbk[cc] >> 32));
        xcar[lane] = Xf; xcar[64 + lane] = Xb; }
    __builtin_amdgcn_sched_barrier(0);
    if (mode != 1) {
#pragma unroll
        for (int q = 0; q < 4; ++q) *(LAS v4u*)(GR + r32 * 128 + (h * 4 + q) * 16) = gq[q]; }
#pragma unroll
    for (int j = 0; j < 5; ++j) CWL[j * 64 + lane] = cwv[j];
    bf16x8_t xa[4];
#pragma unroll
    for (int ks = 0; ks < 4; ++ks) { const int cl8 = 16 * ks + 8 * h; const f32x4 cb0 = *(const LAS f32x4*)(CWL + 4 * 64 + cl8), cb1 = *(const LAS f32x4*)(CWL + 4 * 64 + cl8 + 4);
        float x[8] = {cb0[0], cb0[1], cb0[2], cb0[3], cb1[0], cb1[1], cb1[2], cb1[3]};
#pragma unroll
        for (int j = 0; j < 4; ++j) { const int tt = tk + j - 2; const float k = (tt >= 0 && tt < T) ? 1.f : 0.f; const v4u z = zq[ks][j]; const f32x4 w0 = *(const LAS f32x4*)(CWL + j * 64 + cl8), w1 = *(const LAS f32x4*)(CWL + j * 64 + cl8 + 4);
            x[0] += k * w0[0] * bflo(z.x); x[1] += k * w0[1] * bfhi(z.x); x[2] += k * w0[2] * bflo(z.y); x[3] += k * w0[3] * bfhi(z.y);
            x[4] += k * w1[0] * bflo(z.z); x[5] += k * w1[1] * bfhi(z.z); x[6] += k * w1[2] * bflo(z.w); x[7] += k * w1[3] * bfhi(z.w); }
        xa[ks] = pack8(x[0], x[1], x[2], x[3], x[4], x[5], x[6], x[7]); }
#pragma unroll 1
    for (int cb2 = 0; cb2 < 2; ++cb2) {
        const int cl = 32 * cb2 + r32, c = n * 64 + cl;
        LAS float* cmp = comp + cb2 * 1024;
        float cbr[2], cbi[2], csp[2];
#pragma unroll
        for (int dir = 0; dir < 2; ++dir) { cbr[dir] = cb2 ? kbr[1][dir] : kbr[0][dir]; cbi[dir] = cb2 ? kbi[1][dir] : kbi[0][dir]; csp[dir] = cb2 ? ksp[1][dir] : ksp[0][dir]; }
        f32x16 xcD;
#pragma unroll
        for (int r = 0; r < 16; ++r) xcD[r] = 0.f;
#pragma unroll
        for (int ks = 0; ks < 4; ++ks) { const bool hit = (cl >> 3) == (2 * ks + h); const int e = r32 & 7;
            bf16x8_t idf;
#pragma unroll
            for (int q = 0; q < 8; ++q) idf[q] = (hit && e == q) ? (short)0x3F80 : (short)0;
            xcD = MFMA32(xa[ks], idf, xcD); }
        f32x16 av[2], bv[2];
#pragma unroll
        for (int dir = 0; dir < 2; ++dir) {
            f32x16 gr, gi; const float biasr = cbr[dir], biasi = cbi[dir];
#pragma unroll
            for (int r = 0; r < 16; ++r) { gr[r] = biasr; gi[r] = biasi; }
#pragma unroll
            for (int ks = 0; ks < 4; ++ks) { gr = MFMA32(xa[ks], wf[dir][0][ks], gr); gi = MFMA32(xa[ks], wf[dir][1][ks], gi); }
            if (cb2 == 0) {
#pragma unroll
                for (int gt = 0; gt < 2; ++gt) { const bf16* wp = RGWT + (size_t)((((l * 2 + dir) * 2 + gt) * 4 + n) * 4096) + (32 + r32) * 64 + 8 * h;
#pragma unroll
                    for (int ks = 0; ks < 4; ++ks) wf[dir][gt][ks] = *(const bf16x8_t*)(wp + 16 * ks); } }
            const float sp8 = csp[dir];
#pragma unroll
            for (int r = 0; r < 16; ++r) { const float rr = sigm(gr[r]), ii = sigm(gi[r]);
                const float a = __builtin_amdgcn_exp2f(-rr * sp8);
                av[dir][r] = a; bv[dir][r] = __builtin_amdgcn_sqrtf(fmaxf(1.0f - a * a, 0.f)) * ii * xcD[r]; }
        }
        { float Aw, Bw;
          wave_comp<0>(av[0], bv[0], h, lane, Aw, Bw); if (h == 0) { cmp[((0 * 8 + w) * 32 + r32) * 2] = Aw; cmp[((0 * 8 + w) * 32 + r32) * 2 + 1] = Bw; }
          wave_comp<1>(av[1], bv[1], h, lane, Aw, Bw); if (h == 0) { cmp[((1 * 8 + w) * 32 + r32) * 2] = Aw; cmp[((1 * 8 + w) * 32 + r32) * 2 + 1] = Bw; } }
        __syncthreads();
        if (w == 0 && mode != 2 && h == 0) {
            float Af = 1.f, Bf = 0.f, Ab = 1.f, Bb = 0.f;
#pragma unroll
            for (int ww = 0; ww < 8; ++ww) { const float a0 = cmp[((0 * 8 + ww) * 32 + r32) * 2], b0 = cmp[((0 * 8 + ww) * 32 + r32) * 2 + 1]; Bf = a0 * Bf + b0; Af *= a0; }
#pragma unroll
            for (int ww = 7; ww >= 0; --ww) { const float a1 = cmp[((1 * 8 + ww) * 32 + r32) * 2], b1 = cmp[((1 * 8 + ww) * 32 + r32) * 2 + 1]; Bb = a1 * Bb + b1; Ab *= a1; }
            if (mode == 1) { float* cp = CARRY + ((size_t)(((seq * 8 + chunk) * 4 + n) * 2) * 64 + cl) * 2;
                __hip_atomic_store((unsigned long long*)cp, ((unsigned long long)__float_as_uint(Bf) << 32) | __float_as_uint(Af), __ATOMIC_RELAXED, __HIP_MEMORY_SCOPE_AGENT);
                __hip_atomic_store((unsigned long long*)(cp + 128), ((unsigned long long)__float_as_uint(Bb) << 32) | __float_as_uint(Ab), __ATOMIC_RELAXED, __HIP_MEMORY_SCOPE_AGENT); }
            else { F.out[OUT_ST + (size_t)((seq * 2 + l) * 2 + 0) * 256 + c] = Bf; F.out[OUT_ST + (size_t)((seq * 2 + l) * 2 + 1) * 256 + c] = Bb; }
        }
        if (w == 0 && mode == 1) { asm volatile("s_waitcnt vmcnt(0)" ::: "memory");
            if (lane == 0) __hip_atomic_fetch_add(rg_cnt, 1u, __ATOMIC_RELAXED, __HIP_MEMORY_SCOPE_AGENT); }
        if (mode != 1) {
            float Xf = 0.f, Xb = 0.f; if (mode == 2) { Xf = xcar[cl]; Xb = xcar[64 + cl]; }
#pragma unroll
            for (int ww = 0; ww < 8; ++ww) if (ww < w) Xf = cmp[((0 * 8 + ww) * 32 + r32) * 2] * Xf + cmp[((0 * 8 + ww) * 32 + r32) * 2 + 1];
#pragma unroll
            for (int ww = 7; ww >= 0; --ww) if (ww > w) Xb = cmp[((1 * 8 + ww) * 32 + r32) * 2] * Xb + cmp[((1 * 8 + ww) * 32 + r32) * 2 + 1];
            f32x16 hf, hb;
            scan_final<0>(av[0], bv[0], h, lane, Xf, hf); scan_final<1>(av[1], bv[1], h, lane, Xb, hb);
#pragma unroll
            for (int r = 0; r < 16; r += 2) { const int tl = (r & 3) + 8 * (r >> 2) + 4 * h;
                const float g0 = bf2f(*(const LAS unsigned short*)(GR + tl * 128 + cl * 2)), g1 = bf2f(*(const LAS unsigned short*)(GR + (tl + 1) * 128 + cl * 2));
                const float u0 = 2.0f * 0.7978845608028654f * (g0 + 0.044715f * g0 * g0 * g0), u1 = 2.0f * 0.7978845608028654f * (g1 + 0.044715f * g1 * g1 * g1);
                const unsigned pk = cvtpk((hf[r] + hb[r]) * g0 * sigm(u0), (hf[r + 1] + hb[r + 1]) * g1 * sigm(u1));
                *(LAS unsigned short*)(YO + tl * 128 + cl * 2) = (unsigned short)pk; *(LAS unsigned short*)(YO + (tl + 1) * 128 + cl * 2) = (unsigned short)(pk >> 16); }
        }
        __builtin_amdgcn_sched_barrier(0);
    }
    if (mode != 1) {
        bf16* yp = Y + (size_t)(row0 + t0 + r32) * D + 512 + n * 64 + h * 32;
#pragma unroll
        for (int q = 0; q < 4; ++q) *(GAS v4u*)(yp + 8 * q) = *(const LAS v4u*)(YO + r32 * 128 + (h * 4 + q) * 16);
    }
    __syncthreads();
}

__device__ __forceinline__ void pool_item(int WIN, const bf16* Z, bf16* Y, const bf16* PT, const float* pscale, int l, int tt, int g, int lane, LAS unsigned char* LP) {
    const int r32 = lane & 31, h = lane >> 5;
    const int rowt0 = tt * 32; const bool lat = rowt0 >= MC; const int T = lat ? 2048 : 256;
    const int seq0 = lat ? MC + ((rowt0 - MC) & ~2047) : (rowt0 & ~255); const int tpos0 = rowt0 - seq0, tpos = tpos0 + r32;
    const int left = WIN >> 1; const int lo = max(tpos - left, 0), hi = min(tpos + WIN - 1 - left, T - 1); const float inv = 1.0f / (float)(hi - lo + 1);
    const int NCH = (32 + WIN - 1) * 8;
    LAS unsigned char* TILE = LP; LAS unsigned char* YO = LP + 8192;
    const GAS bf16* zc = (const GAS bf16*)Z + (size_t)seq0 * DIN + 2048 + g * 64;
    bf16x8_t wq[2][4]; float sc[2];
#pragma unroll
    for (int cb2 = 0; cb2 < 2; ++cb2) { const int d = 32 * cb2 + r32; const GAS bf16* wt = (const GAS bf16*)PT + (size_t)(l * 4 + g) * 4096 + d * 64 + 8 * h;
#pragma unroll
        for (int ks = 0; ks < 4; ++ks) wq[cb2][ks] = *(const GAS bf16x8_t*)(wt + 16 * ks);
        sc[cb2] = ((const GAS float*)pscale)[l * 256 + g * 64 + d]; }
    v4u zt[6];
#pragma unroll
    for (int i = 0; i < 6; ++i) { int q = lane + 64 * i; q = q < NCH ? q : NCH - 1; const int row = q >> 3, c = q & 7; const int t2 = tpos0 - left + row; const int tc = (t2 >= 0 && t2 < T) ? t2 : tpos0;
        zt[i] = *(const GAS v4u*)(zc + (size_t)tc * DIN + 8 * c); }
#pragma unroll
    for (int i = 0; i < 6; ++i) { int q = lane + 64 * i; q = q < NCH ? q : NCH - 1; const int row = q >> 3, c = q & 7; *(LAS v4u*)(TILE + row * 144 + c * 16) = zt[i]; }
    float sm[4][8];
#pragma unroll
    for (int ks = 0; ks < 4; ++ks)
#pragma unroll
        for (int e = 0; e < 8; ++e) sm[ks][e] = 0.f;
    const LAS unsigned char* tp = TILE + r32 * 144 + h * 16;
#pragma unroll 1
    for (int j = 0; j < WIN; ++j) { const int t2 = tpos - left + j; const float k = (t2 >= 0 && t2 < T) ? 1.f : 0.f;
#pragma unroll
        for (int ks = 0; ks < 4; ++ks) { const v4u z = *(const LAS v4u*)(tp + j * 144 + ks * 32);
            sm[ks][0] += k * bflo(z.x); sm[ks][1] += k * bfhi(z.x); sm[ks][2] += k * bflo(z.y); sm[ks][3] += k * bfhi(z.y); sm[ks][4] += k * bflo(z.z); sm[ks][5] += k * bfhi(z.z); sm[ks][6] += k * bflo(z.w); sm[ks][7] += k * bfhi(z.w); } }
    bf16x8_t pa[4];
#pragma unroll
    for (int ks = 0; ks < 4; ++ks) { const v4u z0 = *(const LAS v4u*)(tp + left * 144 + ks * 32);
        pa[ks] = pack8(sm[ks][0] * inv - bflo(z0.x), sm[ks][1] * inv - bfhi(z0.x), sm[ks][2] * inv - bflo(z0.y), sm[ks][3] * inv - bfhi(z0.y), sm[ks][4] * inv - bflo(z0.z), sm[ks][5] * inv - bfhi(z0.z), sm[ks][6] * inv - bflo(z0.w), sm[ks][7] * inv - bfhi(z0.w)); }
#pragma unroll
    for (int cb2 = 0; cb2 < 2; ++cb2) { const int d = 32 * cb2 + r32;
        f32x16 acc;
#pragma unroll
        for (int r = 0; r < 16; ++r) acc[r] = 0.f;
#pragma unroll
        for (int ks = 0; ks < 4; ++ks) acc = MFMA32(pa[ks], wq[cb2][ks], acc);
        const float scd = sc[cb2];
#pragma unroll
        for (int r = 0; r < 16; r += 2) { const int row = rowt0 + (r & 3) + 8 * (r >> 2) + 4 * h; const unsigned pk = cvtpk(acc[r] * scd, acc[r + 1] * scd);
            const int tl = row - rowt0; *(LAS unsigned short*)(YO + tl * 128 + d * 2) = (unsigned short)pk; *(LAS unsigned short*)(YO + (tl + 1) * 128 + d * 2) = (unsigned short)(pk >> 16); } }
    { bf16* yp = Y + (size_t)(rowt0 + r32) * D + 768 + g * 64 + h * 32;
#pragma unroll
      for (int q = 0; q < 4; ++q) *(GAS v4u*)(yp + 8 * q) = *(const LAS v4u*)(YO + r32 * 128 + (h * 4 + q) * 16); }
}
__device__ __forceinline__ void mix_pool(Frame& F, const Args& A, int l) {
    PHASE_IDS(F);
    const bf16* Z = (const bf16*)(F.ws + WS_Z); bf16* Y = (bf16*)(F.ws + WS_Y); const bf16* PT = (const bf16*)(F.ws + WS_POOLT); const float* ps = INP(A, I_POOLS);
    const int gw = F.vcu * NWAVES + F.wave, NGW = F.G * NWAVES;
    const int hgw = (F.G >> 1) * NWAVES;
    const bool heavy = F.vcu < (F.G >> 1); const int hw = heavy ? gw : gw - hgw;
    for (int k = 0; k < 3; ++k) { int it;
        if (F.G == 256) { if (heavy) { if (k > 0) break; it = hw; } else { if (k > 1) break; it = hgw + k * hgw + hw; } }
        else { it = gw + k * NGW; }
        if (it >= (M / 32) * 4) break;
        const int g = it / (M / 32), tt = it % (M / 32);
        LAS unsigned char* yo = F.lds + F.wave * 12288;
        pool_item(2 << g, Z, Y, PT, ps, l, tt, g, F.lane, yo); }
    __syncthreads();
}
__device__ __forceinline__ void mix_conv(Frame& F, const Args& A, int l) {
    PHASE_IDS(F);
    const GAS bf16* Z = (const GAS bf16*)(F.ws + WS_Z); bf16* Y = (bf16*)(F.ws + WS_Y); const GAS float* cw = (const GAS float*)(INP(A, I_CBW) + l * 3 * 256);
    const int gt = F.vcu * 512 + F.tid, NGT = F.G * 512;
    for (int i = gt; i < (M / 8) * 32; i += NGT) {
        const int tg = i >> 5, c8 = (i & 31) * 8; const int r0 = tg * 8; const bool lat = r0 >= MC; const int T = lat ? 2048 : 256; const int t0 = lat ? ((r0 - MC) & 2047) : (r0 & 255);
        f32x4 wv[3][2];
#pragma unroll
        for (int j = 0; j < 3; ++j) { wv[j][0] = *(const GAS f32x4*)(cw + j * 256 + c8); wv[j][1] = *(const GAS f32x4*)(cw + j * 256 + c8 + 4); }
        v4u za[10], zb[10], zg[8];
#pragma unroll
        for (int k = 0; k < 10; ++k) { const int t = t0 - 1 + k; const bool ok = t >= 0 && t < T; const int tc = ok ? t : t0; const GAS bf16* zp = Z + (size_t)(r0 - t0 + tc) * DIN + c8;
            za[k] = *(const GAS v4u*)(zp + 1024); zb[k] = *(const GAS v4u*)(zp + 1280); }
#pragma unroll
        for (int q = 0; q < 8; ++q) zg[q] = *(const GAS v4u*)(Z + (size_t)(r0 + q) * DIN + 768 + c8);
        float w[3][8];
#pragma unroll
        for (int j = 0; j < 3; ++j) { w[j][0] = wv[j][0][0]; w[j][1] = wv[j][0][1]; w[j][2] = wv[j][0][2]; w[j][3] = wv[j][0][3]; w[j][4] = wv[j][1][0]; w[j][5] = wv[j][1][1]; w[j][6] = wv[j][1][2]; w[j][7] = wv[j][1][3]; }
        float pm[8], pc[8], pn[8];
        auto prod = [&](int k, float (&o)[8]) { const int t = t0 - 1 + k; const float kk = (t >= 0 && t < T) ? 1.f : 0.f; const v4u a = za[k], b = zb[k];
            o[0] = kk * bflo(a.x) * bflo(b.x); o[1] = kk * bfhi(a.x) * bfhi(b.x); o[2] = kk * bflo(a.y) * bflo(b.y); o[3] = kk * bfhi(a.y) * bfhi(b.y);
            o[4] = kk * bflo(a.z) * bflo(b.z); o[5] = kk * bfhi(a.z) * bfhi(b.z); o[6] = kk * bflo(a.w) * bflo(b.w); o[7] = kk * bfhi(a.w) * bfhi(b.w); };
        prod(0, pm); prod(1, pc);
#pragma unroll
        for (int q = 0; q < 8; ++q) { prod(q + 2, pn);
            const v4u gb = zg[q];
            const float g[8] = {bflo(gb.x), bfhi(gb.x), bflo(gb.y), bfhi(gb.y), bflo(gb.z), bfhi(gb.z), bflo(gb.w), bfhi(gb.w)};
            float o[8];
#pragma unroll
            for (int e = 0; e < 8; ++e) { o[e] = g[e] * (w[0][e] * pm[e] + w[1][e] * pc[e] + w[2][e] * pn[e]); pm[e] = pc[e]; pc[e] = pn[e]; }
            v4u ov; ov.x = cvtpk(o[0], o[1]); ov.y = cvtpk(o[2], o[3]); ov.z = cvtpk(o[4], o[5]); ov.w = cvtpk(o[6], o[7]);
            *(GAS v4u*)(Y + (size_t)(r0 + q) * D + 256 + c8) = ov; }
    }
}

#define GEMM_PHASE(EPI, g, E, MM, NN) do { pg8::StaticOrder S_; S_.init((MM), (NN), F.G, (int)blockIdx.x, 0); pg8::Unit u0_; const bool in0_ = S_.next(0, u0_); \
    pg8::gemm_phase<EPI, pg8::StaticOrder, true, true, false>(F.lds, (g), S_, (E), F.wave0, bpf_ && in0_); \
    if (S_.splits()) { pg8::StaticOrder S1_; S1_.init((MM), (NN), F.G, (int)blockIdx.x, 1); pg8::gemm_phase<EPI, pg8::StaticOrder, true, true, true>(F.lds, (g), S1_, (E), F.wave0, bpf_ && !in0_); } bpf_ = false; } while (0)
#define GEMM_PREFETCH(Bt, MM, NN, KK) do { if (!MK_PER_PHASE) { bpf_ = gemm_prefetch_b(F.lds, (const pg8::bf16_t*)(Bt), (MM), (NN), (KK), F.G, (int)blockIdx.x, F.wave0); } } while (0)

constexpr int PH_PER_LAYER = 8, NPHASE = 2 + 2 * PH_PER_LAYER + 1;
__global__ void __launch_bounds__(NWAVES * 64, 2) fwd_kernel(Args args) {
    extern __shared__ __attribute__((aligned(16))) unsigned char lds[];
    Frame F;
    F.lds = (LAS unsigned char*)lds; F.lds0 = F.lds; F.tid = threadIdx.x; F.lane = F.tid & 63; F.wave = __builtin_amdgcn_readfirstlane(F.tid >> 6); F.wave0 = F.wave;
    F.G = gridDim.x; { const int bx = blockIdx.x; F.vcu = (F.G % 8 == 0) ? (bx % 8) * (F.G / 8) + bx / 8 : bx; F.vcu0 = F.vcu; }
    F.out = args.out; F.ws = args.ws; F.out0 = args.out; F.ws0 = args.ws;
    volatile LAS unsigned* MISC = (volatile LAS unsigned*)(F.lds + MISC_OFF);
    for (int u = F.tid; u < (LDS_BYTES - LDSCTL_OFF) / 4; u += NWAVES * 64) ((LAS unsigned*)(F.lds + LDSCTL_OFF))[u] = 0u;
    __syncthreads();
    if (F.tid < 25) { const unsigned long long pv = (unsigned long long)args.in[F.tid]; ((LAS unsigned*)(F.lds + LDSCTL_OFF))[2 * F.tid] = (unsigned)pv; ((LAS unsigned*)(F.lds + LDSCTL_OFF))[2 * F.tid + 1] = (unsigned)(pv >> 32); }
    __syncthreads();
    XcdBarrier bar; bar.bar = (unsigned*)(args.ws + WS_CTL) + CW_BAR; bar.x = 0; bar.st = nullptr;
#if !MK_PER_PHASE
    bar = xcd_barrier_post((unsigned*)(args.ws + WS_CTL) + CW_BAR, MISC + 8);
#endif
#if MK_PER_PHASE
    const int lo = args.ph_lo, hi = args.ph_hi;
#define IN(k) (lo <= (k) && (k) < hi)
#define SEAM(k) do { } while (0)
#else
#define IN(k) true
#define SEAM(k) xcd_barrier(bar, bpf_, F.wave0)
#endif
    bool bpf_ = false;
    REP(4) { if (IN(0)) { p0_prologue(F, args); } SEAM(0); }

    REP(3) { if (IN(1)) { prep0_phase(F, args); } if (!((PROBE_REP >> 3) & 1) || rep_ == 1) GEMM_PREFETCH((const bf16*)(F.ws + WS_WIN), M, DIN, D); SEAM(1); }
    for (int l = 0; l < 2; ++l) {
        const int pb = 2 + l * PH_PER_LAYER;
        REP(0) if (IN(pb + 0)) { PHASE_IDS(F);
            pg8::Gemm g{(const bf16*)((const unsigned char*)F.out + OUT_XN_BYTES), (const bf16*)(F.ws + WS_WIN) + (size_t)l * DIN * D, M, DIN, D};
            pg8::EpiIn E{(bf16*)(F.ws + WS_Z), (const float*)(F.ws + WS_ROPE), F.out + OUT_CK, F.out + OUT_CV, l, (const float*)(F.ws + WS_SS) + (size_t)(l == 0 ? 0 : 2) * M, (const float*)(F.ws + WS_SW) + (size_t)l * 9 * 2304};
            GEMM_PHASE(pg8::EpiIn, g, E, M, DIN);
            SEAM(pb + 0); }
        if (IN(pb + 1)) {
            PHASE_IDS(F); const float lam = ((const float*)(F.ws + WS_LAM))[l]; const float sub_mul = 1.0f - (0.8f - 0.6f * expf(-0.3f * (float)l));
            for (int u = F.vcu; u < 512; u += F.G) {
                if (u >= 384) { const int v = u - 384; attn_unit(F, args, l, false, v >> 2, v & 3, 0, lam, sub_mul); }
                else { const int mode = u < 256 ? 1 : 0; const int v = u < 256 ? u : u - 256; rglru_unit(F, args, l, mode, mode == 0 ? (v >> 2) : (v >> 5), mode == 0 ? (v & 3) : ((v >> 3) & 3), mode == 0 ? 0 : (v & 7)); } }
            mix_conv(F, args, l); mix_pool(F, args, l);
            PHASE_IDS(F);
            for (int u = F.vcu; u < 512; u += F.G) {
                if (u < 256) attn_unit(F, args, l, true, u >> 5, (u >> 3) & 3, u & 7, lam, sub_mul);
                else { const int v = u - 256; rglru_unit(F, args, l, 2, v >> 5, (v >> 3) & 3, v & 7); } }
            GEMM_PREFETCH((const bf16*)(F.ws + WS_WOUT) + (size_t)l * D * D, M, D, D);
        } SEAM(pb + 1);
        if (IN(pb + 3)) { PHASE_IDS(F); const float* modl = (const float*)(F.ws + WS_MOD) + (size_t)l * 9 * 6144;
            pg8::Gemm g{(const bf16*)(F.ws + WS_Y), (const bf16*)(F.ws + WS_WOUT) + (size_t)l * D * D, M, D, D};
            bf16* XR = (bf16*)(F.ws + WS_XR); bf16* XNp = (bf16*)((unsigned char*)F.out + OUT_XN_BYTES);
            if (l == 0) { pg8::EpiGateRes<false> E{(const void*)INP(args, I_XP), (const void*)(INP(args, I_XS) - (size_t)MC * D), XR, modl + 2048, 0, XNp, INP(args, I_NORMW) + (size_t)(l * 2 + 1) * D, modl + 4096, (float*)(F.ws + WS_SS) + (size_t)1 * M};
                GEMM_PHASE(pg8::EpiGateRes<false>, g, E, M, D); }
            else { pg8::EpiGateRes<true> E{(const void*)XR, (const void*)XR, XR, modl + 2048, 0, XNp, INP(args, I_NORMW) + (size_t)(l * 2 + 1) * D, modl + 4096, (float*)(F.ws + WS_SS) + (size_t)3 * M};
                GEMM_PHASE(pg8::EpiGateRes<true>, g, E, M, D); }
            GEMM_PREFETCH((const bf16*)(F.ws + WS_W1) + (size_t)l * DFF * D, MP0, DFF, D);
        } SEAM(pb + 3);
        for (int hf = 0; hf < 2; ++hf) {
            const int mrow0 = hf == 0 ? 0 : MP0, mrows = hf == 0 ? MP0 : M - MP0;
            REP(2) if (IN(pb + 4 + 2 * hf)) { PHASE_IDS(F);
                pg8::Gemm g{(const bf16*)((const unsigned char*)F.out + OUT_XN_BYTES) + (size_t)mrow0 * D, (const bf16*)(F.ws + WS_W1) + (size_t)l * DFF * D, mrows, DFF, D};
                pg8::EpiRelu2 E{(bf16*)(F.ws + WS_Y), (const float*)(F.ws + WS_SS) + (size_t)(l == 0 ? 1 : 3) * M, (const float*)(F.ws + WS_SW) + 2 * 9 * 2304 + (size_t)l * 9 * 4096, mrow0};
                GEMM_PHASE(pg8::EpiRelu2, g, E, mrows, DFF);
                if (!((PROBE_REP >> 2) & 1) || rep_ == 1) GEMM_PREFETCH((const bf16*)(F.ws + WS_W2) + (size_t)l * D * DFF, mrows, D, DFF);
                SEAM(pb + 4 + 2 * hf); }
            if (IN(pb + 5 + 2 * hf)) { PHASE_IDS(F); const float* modl = (const float*)(F.ws + WS_MOD) + (size_t)l * 9 * 6144;
                pg8::Gemm g{(const bf16*)(F.ws + WS_Y), (const bf16*)(F.ws + WS_W2) + (size_t)l * D * DFF, mrows, D, DFF};
                bf16* XR = (bf16*)(F.ws + WS_XR);
                if (l == 0) {
                    pg8::EpiGateRes<true> E{(const void*)XR, (const void*)XR, XR, modl + 5120, mrow0, (bf16*)((unsigned char*)F.out + OUT_XN_BYTES), INP(args, I_NORMW) + (size_t)2 * D, modl + 9 * 6144 + 1024, (float*)(F.ws + WS_SS) + (size_t)2 * M};
                    GEMM_PHASE(pg8::EpiGateRes<true>, g, E, mrows, D); }
                else {
                    pg8::EpiFinal E{XR, F.out, modl + 5120, mrow0, INP(args, I_FNW), (float*)(F.ws + WS_SS) + (size_t)4 * M, (unsigned*)(F.ws + WS_CTL) + CW_FIN};
                    GEMM_PHASE(pg8::EpiFinal, g, E, mrows, D); }
                if (hf == 0) GEMM_PREFETCH((const bf16*)(F.ws + WS_W1) + (size_t)l * DFF * D, M - MP0, DFF, D);
                else if (l == 0) GEMM_PREFETCH((const bf16*)(F.ws + WS_WIN) + (size_t)1 * DIN * D, M, DIN, D);
            } if (!(l == 1 && hf == 1)) SEAM(pb + 5 + 2 * hf);
        }
    }
    if ((PROBE_REP >> 12) & 1) { for (int q = 0; q < 20; ++q) xcd_barrier(bar, false, F.wave0); }

#undef IN
#undef SEAM
}

extern "C" void kernel_launch(void* const* d_in, const int* in_sizes, int n_in, void* d_out, int out_size, void* d_ws, size_t ws_size, hipStream_t stream) {
    static int grid = 0;
    if (grid == 0) {
        if (n_in != 25 || out_size != (int)(OUT_ST + 32 * 2 * 2 * 256) || ws_size < WS_END) { fprintf(stderr, "kernel_launch: unexpected shapes (n_in %d out %d ws %zu)\n", n_in, out_size, ws_size); grid = -1; return; }
        int dev = 0, cus = 0;
        if (hipGetDevice(&dev) != hipSuccess || hipDeviceGetAttribute(&cus, hipDeviceAttributeMultiprocessorCount, dev) != hipSuccess) { grid = -1; return; }
        if (hipFuncSetAttribute((const void*)fwd_kernel, hipFuncAttributeMaxDynamicSharedMemorySize, LDS_BYTES) != hipSuccess) { fprintf(stderr, "kernel_launch: hipFuncSetAttribute failed\n"); grid = -1; return; }
        int per_cu = 0;
        if (hipOccupancyMaxActiveBlocksPerMultiprocessor(&per_cu, (const void*)fwd_kernel, NWAVES * 64, LDS_BYTES) != hipSuccess || per_cu < 1) fprintf(stderr, "kernel_launch: occupancy query says %d\n", per_cu);
        (void)hipGetLastError();
        if (cus != 256) { fprintf(stderr, "kernel_launch: this kernel is laid out for a 256-CU grid (prep0's shift-row slots, the fused final norm's one-unit-per-workgroup phase); the device reports %d CUs\n", cus); grid = -1; return; }
        grid = cus;
    }
    if (grid < 0) return;
    (void)hipMemsetAsync((char*)d_ws + WS_CTL, 0, CTL_ZERO_BYTES, stream);
    Args a{};
    for (int i = 0; i < 25; ++i) a.in[i] = (const float*)d_in[i];
    a.out = (float*)d_out; a.ws = (unsigned char*)d_ws;
#if MK_PER_PHASE
    for (int p = 0; p < NPHASE; ++p) { a.ph_lo = p; a.ph_hi = p + 1; hipLaunchKernelGGL(fwd_kernel, dim3(grid), dim3(NWAVES * 64), LDS_BYTES, stream, a); }
#else
    a.ph_lo = 0; a.ph_hi = NPHASE; hipLaunchKernelGGL(fwd_kernel, dim3(grid), dim3(NWAVES * 64), LDS_BYTES, stream, a);
#endif
}
```

```cpp
#include <hip/hip_runtime.h>
#include <cstdio>
#include <cstdint>

#ifndef PROBE_REP
#define PROBE_REP 0
#endif
#ifndef PROBE_VAR
#define PROBE_VAR 0
#endif
#define REP(bit) for (int rep_ = 0; rep_ < (((PROBE_REP) >> (bit)) & 1) + 1; ++rep_)
#ifndef MK_PER_PHASE
#define MK_PER_PHASE 0
#endif


#define LANE_ID(v) asm volatile("v_mbcnt_lo_u32_b32 %0, -1, 0\n\tv_mbcnt_hi_u32_b32 %0, -1, %0" : "=v"(v))
__device__ __forceinline__ float shx(float v, int mask, int lane) { return __builtin_bit_cast(float, __builtin_amdgcn_ds_bpermute((lane ^ mask) << 2, __builtin_bit_cast(int, v))); }
__device__ __forceinline__ float shidx(float v, int src) { return __builtin_bit_cast(float, __builtin_amdgcn_ds_bpermute(src << 2, __builtin_bit_cast(int, v))); }

namespace pg8 {
#define PG8_LAS __attribute__((address_space(3)))
typedef unsigned short bf16_t;
typedef short bf16x8 __attribute__((ext_vector_type(8)));
typedef float f32x4 __attribute__((ext_vector_type(4)));
typedef unsigned u32x4 __attribute__((ext_vector_type(4)));
constexpr int BM = 256, BK = 64, HALF = 128, HTB = HALF * BK * 2, STAGE_BYTES = 8 * HTB, NXCD = 8, WGM = 8;

__host__ __device__ __forceinline__ int lds_byte(int r, int c) { const int st = (r >> 4) * 2 + (c >> 5), rr = r & 15, cc = c & 31, ob = rr * 64 + cc * 2; return st * 1024 + (ob ^ (((ob >> 9) & 1) << 5)); }
__host__ __device__ __forceinline__ void stage_rc(int b, int& R, int& C) { const int st = b / 1024, sb = b % 1024, swz = sb ^ (((sb >> 9) & 1) << 5); R = (st >> 1) * 16 + swz / 64; C = (st & 1) * 32 + (swz % 64) / 2; }
__host__ __device__ __forceinline__ int perm32(int rho) { const int n = rho >> 4, i = rho & 15; return 8 * (i >> 2) + 4 * n + (i & 3); }

struct Unit { int pm, pn, single, sub; };
struct Gemm { const bf16_t* A; const bf16_t* Bt; int M, N, K; };

struct StaticOrder {
    int nM, nN, nwg, G, c, R, rem, part;
    __host__ __device__ void init(int M, int N, int G_, int c_, int part_ = 0) { nM = M / BM; nN = N / BM; nwg = nM * nN; G = G_; c = c_; R = nwg / G; rem = nwg - R * G; part = part_; }
    __host__ __device__ bool splits() const { return rem > 0 && 2 * rem <= G; }
    __host__ __device__ bool next(int i, Unit& u) const {
        long L; u.single = 0; u.sub = 0;
        if (part == 0) { if (i < R) L = (long)i * G + c; else if (i == R && rem > 0 && !splits()) { L = (long)R * G + c; if (L >= nwg) return false; } else return false; }
        else { if (i != 0 || !splits() || c >= 2 * rem) return false; L = (long)R * G + (c >> 1); u.single = 1; u.sub = c & 1; }
        int wgid = (int)L; { const int q = nwg / NXCD, r = nwg % NXCD, xcd = wgid % NXCD, off = wgid / NXCD; wgid = (xcd < r ? xcd * (q + 1) : r * (q + 1) + (xcd - r) * q) + off; }
        const int nig = WGM * nN, gid = wgid / nig, fm = gid * WGM, gsz = (nM - fm) < WGM ? (nM - fm) : WGM;
        u.pm = fm + ((wgid % nig) % gsz); u.pn = (wgid % nig) / gsz; return true;
    }
    __device__ __forceinline__ void a_ready(const Unit&) const {}
    __device__ __forceinline__ void done(const Unit&) const {}
};

__device__ __forceinline__ unsigned cvt_pk_bf16(float lo, float hi) { unsigned r; asm volatile("v_cvt_pk_bf16_f32 %0, %1, %2" : "=v"(r) : "v"(lo), "v"(hi)); return r; }

template <bool WT> __device__ __forceinline__ void st16(void* p, u32x4 v) {
    if constexpr (WT) asm volatile("global_store_dwordx4 %0, %1, off sc1\n\ts_nop 1" :: "v"(p), "v"(v) : "memory");     else *(__attribute__((address_space(1))) u32x4*)p = v; }
template <bool WT> __device__ __forceinline__ void st16(void* p, f32x4 v) { st16<WT>(p, __builtin_bit_cast(u32x4, v)); }


struct EpiIn {
    static constexpr bool PERM = true, AFTER_DRAIN = false;
    bf16_t* Z; const float* rope; float* ck_out; float* cv_out; int layer; const float* ss; const float* sw;
    template <bool WT> __device__ __forceinline__ void run(const f32x4 (&acc)[2][2][4][2], const Unit& u, int wr, int wc, int fr, int fq) const {
        asm volatile("" : "+v"(fr), "+v"(fq));
        const int pn = u.pn; const bool lat = u.pm >= 32; const bool dorope = lat && pn <= 1;
        const int row0 = u.pm * BM + (u.single ? u.sub * HALF : 0) + wr * 64 + fr; const int colw = wc * 32 + 8 * fq;
        const float qs = (pn == 0) ? 0.25503486f : 1.0f;
        const int mi = u.pm < 32 ? 0 : 1 + ((u.pm - 32) >> 3);
        f32x4 swv[2][2];
#pragma unroll
        for (int bj = 0; bj < 2; ++bj)
#pragma unroll
            for (int n = 0; n < 2; ++n) swv[bj][n] = *(const f32x4*)(sw + (size_t)mi * 2304 + pn * BM + bj * HALF + colw + 4 * n);
        float ssv[2][4];
#pragma unroll
        for (int ai = 0; ai < 2; ++ai)
#pragma unroll
            for (int m = 0; m < 4; ++m) ssv[ai][m] = ss[row0 + (u.single ? 0 : ai) * HALF + m * 16];
        f32x4 cs[4], csn[4];
        if (dorope) { const int t = (row0 - 8192) & 2047; const int pos = (fq >> 1) ? (t & 63) : (t >> 6); const f32x4* rp = (const f32x4*)(rope + pos * 16);
#pragma unroll
            for (int e = 0; e < 4; ++e) cs[e] = rp[e]; }
#pragma unroll
        for (int ai = 0; ai < 2; ++ai) { if (ai == 1 && u.single) break;
#pragma unroll
            for (int m = 0; m < 4; ++m) {
                const int row = row0 + ai * HALF + m * 16;
                const float rs = 1.0f / sqrtf(ssv[ai][m] * (1.0f / 1024.0f) + 1e-6f);
                if (dorope && !(ai == 1 && m == 3)) { const int rown = row0 + (m == 3 ? HALF : ai * HALF + (m + 1) * 16); const int t = (rown - 8192) & 2047; const int pos = (fq >> 1) ? (t & 63) : (t >> 6);
                    const f32x4* rp = (const f32x4*)(rope + pos * 16);
#pragma unroll
                    for (int e = 0; e < 4; ++e) csn[e] = rp[e]; }
#pragma unroll
                for (int bj = 0; bj < 2; ++bj) {
                    float v[8];
#pragma unroll
                    for (int e = 0; e < 4; ++e) { v[e] = acc[ai][bj][m][0][e] * rs + swv[bj][0][e]; v[4 + e] = acc[ai][bj][m][1][e] * rs + swv[bj][1][e]; }
                    if (dorope) {
#pragma unroll
                        for (int e = 0; e < 8; ++e) { const float pr = shx(v[e], 16, fr + 16 * fq); const float c = cs[e >> 1][(e & 1) * 2], s = cs[e >> 1][(e & 1) * 2 + 1];
                            v[e] = (fq & 1) ? (v[e] * c + pr * s) : (v[e] * c - pr * s); }
                    }
                    if (!lat && (pn == 1 || pn == 2)) {
                        float* co = (pn == 1) ? ck_out : cv_out; const int b = row >> 8, t = row & 255; const int cc = bj * HALF + colw; const int hd = cc >> 6, d = cc & 63;
                        float* op = co + ((size_t)((b * 2 + layer) * 4 + hd) * 256 + t) * 64 + d;
                        st16<WT>(op, (f32x4){v[0], v[1], v[2], v[3]}); st16<WT>(op + 4, (f32x4){v[4], v[5], v[6], v[7]});
                    }
                    u32x4 w; w.x = cvt_pk_bf16(v[0] * qs, v[1] * qs); w.y = cvt_pk_bf16(v[2] * qs, v[3] * qs); w.z = cvt_pk_bf16(v[4] * qs, v[5] * qs); w.w = cvt_pk_bf16(v[6] * qs, v[7] * qs);
                    st16<WT>(Z + (size_t)row * 2304 + pn * BM + bj * HALF + colw, w);
                }
                if (dorope && !(ai == 1 && m == 3)) {
#pragma unroll
                    for (int e = 0; e < 4; ++e) cs[e] = csn[e]; }
            } }
    }
};
__device__ __forceinline__ void unpack8(const u32x4 w, float (&o)[8]) {
    o[0] = __uint_as_float(w.x << 16); o[1] = __uint_as_float(w.x & 0xffff0000u); o[2] = __uint_as_float(w.y << 16); o[3] = __uint_as_float(w.y & 0xffff0000u);
    o[4] = __uint_as_float(w.z << 16); o[5] = __uint_as_float(w.z & 0xffff0000u); o[6] = __uint_as_float(w.w << 16); o[7] = __uint_as_float(w.w & 0xffff0000u); }
template <bool RES_BF16> struct EpiGateRes {
    static constexpr bool PERM = true, AFTER_DRAIN = false;
    const void* res_c; const void* res_l; bf16_t* xr; const float* gate; int rowbase;
    bf16_t* xs; const float* nw; const float* nscale; float* ssq;
    template <bool WT> __device__ __forceinline__ void run(const f32x4 (&acc)[2][2][4][2], const Unit& u, int wr, int wc, int fr, int fq) const {
        asm volatile("" : "+v"(fr), "+v"(fq));
        const int grow0 = rowbase + u.pm * BM; const int mi = grow0 < 8192 ? 0 : 1 + ((grow0 - 8192) >> 11);
        const void* res = grow0 < 8192 ? res_c : res_l;
        const int row0 = grow0 + (u.single ? u.sub * HALF : 0) + wr * 64 + fr, col0 = u.pn * BM + wc * 32 + 8 * fq;
        f32x4 gv[2][2], fv[2][2];
#pragma unroll
        for (int bj = 0; bj < 2; ++bj)
#pragma unroll
            for (int n = 0; n < 2; ++n) { gv[bj][n] = *(const f32x4*)(gate + (size_t)mi * 6144 + col0 + bj * HALF + 4 * n);
                if (xs) { const f32x4 w = *(const f32x4*)(nw + col0 + bj * HALF + 4 * n); f32x4 f = w;
                    if (nscale) { const f32x4 sc = *(const f32x4*)(nscale + (size_t)mi * 6144 + col0 + bj * HALF + 4 * n); f = w * (sc + 1.0f); }
                    fv[bj][n] = f; } }
        constexpr int RD = RES_BF16 ? 3 : 2;
        u32x4 rb[8][2]; f32x4 rf[8][4];
#define EGR_FETCH(c) do { const size_t o_ = (size_t)(row0 + (u.single ? 0 : ((c) >> 2)) * HALF + ((c) & 3) * 16) * 1024 + col0; _Pragma("unroll") for (int bj = 0; bj < 2; ++bj) { \
            if (RES_BF16) rb[c][bj] = *(const u32x4*)((const bf16_t*)res + o_ + bj * HALF); \
            else { rf[c][2 * bj] = *(const f32x4*)((const float*)res + o_ + bj * HALF); rf[c][2 * bj + 1] = *(const f32x4*)((const float*)res + o_ + bj * HALF + 4); } } } while (0)
#pragma unroll
        for (int c = 0; c < RD; ++c) EGR_FETCH(c);
#pragma unroll
        for (int ai = 0; ai < 2; ++ai) { if (ai == 1 && u.single) break;
#pragma unroll
            for (int m = 0; m < 4; ++m) { const size_t off = (size_t)(row0 + ai * HALF + m * 16) * 1024 + col0; const int c = ai * 4 + m;
                if (c + RD < 8) EGR_FETCH(c + RD);
                float sq = 0.f;
#pragma unroll
                for (int bj = 0; bj < 2; ++bj) { float r[8];
                    if (RES_BF16) unpack8(rb[c][bj], r);
                    else { const f32x4 r0 = rf[c][2 * bj], r1 = rf[c][2 * bj + 1];
                        r[0] = r0[0]; r[1] = r0[1]; r[2] = r0[2]; r[3] = r0[3]; r[4] = r1[0]; r[5] = r1[1]; r[6] = r1[2]; r[7] = r1[3]; }
                    float x[8];
#pragma unroll
                    for (int e = 0; e < 4; ++e) { x[e] = r[e] + gv[bj][0][e] * acc[ai][bj][m][0][e]; x[4 + e] = r[4 + e] + gv[bj][1][e] * acc[ai][bj][m][1][e]; }
#pragma unroll
                    for (int e = 0; e < 8; ++e) sq += x[e] * x[e];
                    u32x4 w; w.x = cvt_pk_bf16(x[0], x[1]); w.y = cvt_pk_bf16(x[2], x[3]); w.z = cvt_pk_bf16(x[4], x[5]); w.w = cvt_pk_bf16(x[6], x[7]);
                    st16<WT>(xr + off + bj * HALF, w);
                    if (xs) { u32x4 v; v.x = cvt_pk_bf16(x[0] * fv[bj][0][0], x[1] * fv[bj][0][1]); v.y = cvt_pk_bf16(x[2] * fv[bj][0][2], x[3] * fv[bj][0][3]);
                        v.z = cvt_pk_bf16(x[4] * fv[bj][1][0], x[5] * fv[bj][1][1]); v.w = cvt_pk_bf16(x[6] * fv[bj][1][2], x[7] * fv[bj][1][3]); st16<WT>(xs + off + bj * HALF, v); } }
                if (ssq) { const int ln = fr + 16 * fq; sq += shx(sq, 16, ln); sq += shx(sq, 32, ln); if (fq == 0) atomicAdd(ssq + row0 + ai * HALF + m * 16, sq); } } }
#undef EGR_FETCH
    }
};
struct EpiFinal {
    static constexpr bool PERM = true, AFTER_DRAIN = false;
    const bf16_t* res; float* out; const float* gate; int rowbase; const float* nw; float* ssq; unsigned* fin_cnt;
    template <bool WT> __device__ __forceinline__ void run(const f32x4 (&acc_c)[2][2][4][2], const Unit& u, int wr, int wc, int fr, int fq) const {
        asm volatile("" : "+v"(fr), "+v"(fq));
        f32x4 (&acc)[2][2][4][2] = const_cast<f32x4 (&)[2][2][4][2]>(acc_c);
        const int grow0 = rowbase + u.pm * BM; const int mi = grow0 < 8192 ? 0 : 1 + ((grow0 - 8192) >> 11);
        const int row0 = grow0 + (u.single ? u.sub * HALF : 0) + wr * 64 + fr, col0 = u.pn * BM + wc * 32 + 8 * fq; const int ln = fr + 16 * fq;
        f32x4 gv[2][2];
#pragma unroll
        for (int bj = 0; bj < 2; ++bj)
#pragma unroll
            for (int n = 0; n < 2; ++n) gv[bj][n] = *(const f32x4*)(gate + (size_t)mi * 6144 + col0 + bj * HALF + 4 * n);
        u32x4 rb[8][2];
#define EFN_FETCH(c) do { const size_t o_ = (size_t)(row0 + (u.single ? 0 : ((c) >> 2)) * HALF + ((c) & 3) * 16) * 1024 + col0; _Pragma("unroll") for (int bj = 0; bj < 2; ++bj) rb[c][bj] = *(const u32x4*)(res + o_ + bj * HALF); } while (0)
#pragma unroll
        for (int c = 0; c < 3; ++c) EFN_FETCH(c);
#pragma unroll
        for (int ai = 0; ai < 2; ++ai) { if (ai == 1 && u.single) break;
#pragma unroll
            for (int m = 0; m < 4; ++m) { const int c = ai * 4 + m; float sq = 0.f;
                if (c + 3 < 8) EFN_FETCH(c + 3);
#pragma unroll
                for (int bj = 0; bj < 2; ++bj) { float r[8]; unpack8(rb[c][bj], r);
#pragma unroll
                    for (int e = 0; e < 4; ++e) { const float x0 = r[e] + gv[bj][0][e] * acc[ai][bj][m][0][e], x1 = r[4 + e] + gv[bj][1][e] * acc[ai][bj][m][1][e];
                        acc[ai][bj][m][0][e] = x0; acc[ai][bj][m][1][e] = x1; sq += x0 * x0 + x1 * x1; } }
                sq += shx(sq, 16, ln); sq += shx(sq, 32, ln); if (fq == 0) atomicAdd(ssq + row0 + ai * HALF + m * 16, sq); } }
#undef EFN_FETCH
        asm volatile("s_waitcnt vmcnt(0)" ::: "memory");
        const int hp0 = (grow0 >> 7) + (u.single ? u.sub : 0);
        if (ln == 0) { __hip_atomic_fetch_add(fin_cnt + 16 * hp0, 1u, __ATOMIC_RELAXED, __HIP_MEMORY_SCOPE_AGENT); if (!u.single) __hip_atomic_fetch_add(fin_cnt + 16 * (hp0 + 1), 1u, __ATOMIC_RELAXED, __HIP_MEMORY_SCOPE_AGENT); }
        for (unsigned spins = 0; spins < (1u << 20); ++spins) {
            unsigned c0 = __hip_atomic_load(fin_cnt + 16 * hp0, __ATOMIC_RELAXED, __HIP_MEMORY_SCOPE_AGENT); unsigned c1 = u.single ? 32u : __hip_atomic_load(fin_cnt + 16 * (hp0 + 1), __ATOMIC_RELAXED, __HIP_MEMORY_SCOPE_AGENT);
            c0 = (unsigned)__builtin_amdgcn_readfirstlane((int)c0); c1 = (unsigned)__builtin_amdgcn_readfirstlane((int)c1);
            if (c0 >= 32u && c1 >= 32u) break;
            __builtin_amdgcn_s_sleep(2); }
        f32x4 wv[2][2];
#pragma unroll
        for (int bj = 0; bj < 2; ++bj)
#pragma unroll
            for (int n = 0; n < 2; ++n) wv[bj][n] = *(const f32x4*)(nw + col0 + bj * HALF + 4 * n);
        float sstv[2][4];
#pragma unroll
        for (int ai = 0; ai < 2; ++ai)
#pragma unroll
            for (int m = 0; m < 4; ++m) sstv[ai][m] = __hip_atomic_load(ssq + row0 + (u.single ? 0 : ai) * HALF + m * 16, __ATOMIC_RELAXED, __HIP_MEMORY_SCOPE_AGENT);
#pragma unroll
        for (int ai = 0; ai < 2; ++ai) { if (ai == 1 && u.single) break;
#pragma unroll
            for (int m = 0; m < 4; ++m) { const int row = row0 + ai * HALF + m * 16; const size_t off = (size_t)row * 1024 + col0;
                const float sst = sstv[ai][m]; const float rs = 1.0f / sqrtf(sst * (1.0f / 1024.0f) + 1e-6f);
#pragma unroll
                for (int bj = 0; bj < 2; ++bj)
#pragma unroll
                    for (int n = 0; n < 2; ++n) *(f32x4*)(out + off + bj * HALF + 4 * n) = acc[ai][bj][m][n] * rs * wv[bj][n]; } }
    }
};
struct EpiRelu2 {
    static constexpr bool PERM = true, AFTER_DRAIN = false;
    bf16_t* H; const float* ss; const float* sw; int rowbase;
    template <bool WT> __device__ __forceinline__ void run(const f32x4 (&acc)[2][2][4][2], const Unit& u, int wr, int wc, int fr, int fq) const {
        asm volatile("" : "+v"(fr), "+v"(fq));
        const int row0 = u.pm * BM + (u.single ? u.sub * HALF : 0) + wr * 64 + fr; const int col0 = u.pn * BM + wc * 32 + 8 * fq;
        const int grow0 = rowbase + u.pm * BM; const int mi = grow0 < 8192 ? 0 : 1 + ((grow0 - 8192) >> 11);
        f32x4 swv[2][2];
#pragma unroll
        for (int bj = 0; bj < 2; ++bj)
#pragma unroll
            for (int n = 0; n < 2; ++n) swv[bj][n] = *(const f32x4*)(sw + (size_t)mi * 4096 + col0 + bj * HALF + 4 * n);
        float ssv[2][4];
#pragma unroll
        for (int ai = 0; ai < 2; ++ai)
#pragma unroll
            for (int m = 0; m < 4; ++m) ssv[ai][m] = ss[rowbase + row0 + (u.single ? 0 : ai) * HALF + m * 16];
#pragma unroll
        for (int ai = 0; ai < 2; ++ai) { if (ai == 1 && u.single) break;
#pragma unroll
            for (int m = 0; m < 4; ++m) { bf16_t* rowp = H + (size_t)(row0 + ai * HALF + m * 16) * 4096 + col0;
                const float rs = 1.0f / sqrtf(ssv[ai][m] * (1.0f / 1024.0f) + 1e-6f);
#pragma unroll
                for (int bj = 0; bj < 2; ++bj) { f32x4 v0 = acc[ai][bj][m][0] * rs + swv[bj][0], v1 = acc[ai][bj][m][1] * rs + swv[bj][1];
#pragma unroll
                    for (int e = 0; e < 4; ++e) { const float a = fmaxf(v0[e], 0.f), b = fmaxf(v1[e], 0.f); v0[e] = a * a; v1[e] = b * b; }
                    u32x4 w; w.x = cvt_pk_bf16(v0[0], v0[1]); w.y = cvt_pk_bf16(v0[2], v0[3]); w.z = cvt_pk_bf16(v1[0], v1[1]); w.w = cvt_pk_bf16(v1[2], v1[3]);
                    st16<WT>(rowp + bj * HALF, w); } } }
    }
};

template <class Epi, class Sched, bool ALIGN_EPI = false, bool SP2 = false, bool SINGLE = false>
__device__ __forceinline__ void gemm_phase(PG8_LAS unsigned char* lds, const Gemm g, const Sched& S, const Epi& E, int wave_id) {
    int tid; asm volatile("v_mbcnt_lo_u32_b32 %0, -1, 0\n\tv_mbcnt_hi_u32_b32 %0, -1, %0" : "=v"(tid)); tid += wave_id * 64;
    const int wid = __builtin_amdgcn_readfirstlane(tid >> 6), lane = tid & 63, wr = wid >> 2, wc = wid & 3, fr = lane & 15, fq = lane >> 4;
    const int K = g.K, nt = K / BK;
    unsigned voffA[2], voffB[2];
#pragma unroll
    for (int i = 0; i < 2; ++i) { int R, C; stage_rc(tid * 16 + i * 8192, R, C); const int Rb = Epi::PERM ? ((R & ~31) + perm32(R & 31)) : R;
        voffA[i] = (unsigned)(R * K + C) * 2u; voffB[i] = (unsigned)(Rb * K + C) * 2u; }
    const size_t kstep = (size_t)(BK * 2);
    const size_t hstep = (size_t)HALF * K * 2;
    const size_t tstep = 2 * hstep;
    const unsigned ldsw = (unsigned)wid * 1024u;
    const int aoff = lds_byte(wr * 64 + fr, fq * 8), boff = lds_byte(wc * 32 + fr, fq * 8);
#define PG8_SA(b, h) (((b) * 2 + (h)) * HTB)
#define PG8_SB(b, h) ((4 + (b) * 2 + (h)) * HTB)
#define PG8_STAGE(bufoff, gbase, voff) do { _Pragma("unroll") for (int _i = 0; _i < 2; ++_i) \
        __builtin_amdgcn_global_load_lds((const unsigned*)((const char*)(gbase) + (voff)[_i]), (PG8_LAS unsigned*)(lds + (bufoff) + ldsw + _i * 8192), 16, 0, 0); } while (0)
#define PG8_LDA(dst, b, h) do { _Pragma("unroll") for (int m = 0; m < 4; ++m) _Pragma("unroll") for (int k = 0; k < 2; ++k) dst[m][k] = *(const PG8_LAS bf16x8*)(lds + PG8_SA(b, h) + aoff + m * 2048 + k * 1024); } while (0)
#define PG8_LDB(dst, b, h) do { _Pragma("unroll") for (int n = 0; n < 2; ++n) _Pragma("unroll") for (int k = 0; k < 2; ++k) dst[n][k] = *(const PG8_LAS bf16x8*)(lds + PG8_SB(b, h) + boff + n * 2048 + k * 1024); } while (0)
#define PG8_MMA(ai, bj, At, Bt) do { __builtin_amdgcn_s_setprio(1); _Pragma("unroll") for (int m = 0; m < 4; ++m) _Pragma("unroll") for (int n = 0; n < 2; ++n) _Pragma("unroll") for (int k = 0; k < 2; ++k) \
        acc[ai][bj][m][n] = __builtin_amdgcn_mfma_f32_16x16x32_bf16(Bt[n][k], At[m][k], acc[ai][bj][m][n], 0, 0, 0); __builtin_amdgcn_s_setprio(0); } while (0)
#define PG8_WAIT_V(n) asm volatile("s_waitcnt vmcnt(" #n ")" ::: "memory")
#define PG8_WAIT_L(n) asm volatile("s_waitcnt lgkmcnt(" #n ")" ::: "memory")
#define PG8_BAR __builtin_amdgcn_s_barrier()
#define PG8_SCHED __builtin_amdgcn_sched_barrier(0)
    Unit cur, nxt; int ui = 0;
    if (!S.next(0, cur)) return;
    f32x4 acc[2][2][4][2];
#pragma unroll
    for (int a = 0; a < 2; ++a)
#pragma unroll
        for (int b = 0; b < 2; ++b)
#pragma unroll
            for (int m = 0; m < 4; ++m)
#pragma unroll
                for (int n = 0; n < 2; ++n) acc[a][b][m][n] = (f32x4){0.f, 0.f, 0.f, 0.f};
    bf16x8 At[4][2], B0[2][2], B1[2][2];
    const char* cA = (const char*)g.A + (size_t)cur.pm * tstep + (cur.single ? (size_t)cur.sub * hstep : (size_t)0); const char* cB = (const char*)g.Bt + (size_t)cur.pn * tstep;
    constexpr bool full = !SINGLE; const unsigned hA = SINGLE ? 0u : (unsigned)hstep;
    S.a_ready(cur);
    if constexpr (SP2) {
        PG8_STAGE(PG8_SB(0, 0), cB, voffB); PG8_STAGE(PG8_SB(0, 1), cB + hstep, voffB); PG8_STAGE(PG8_SA(0, 0), cA, voffA); PG8_STAGE(PG8_SA(0, 1), cA + hA, voffA);
        if (wr == 1) PG8_BAR;
        PG8_WAIT_V(2); PG8_BAR;
        PG8_STAGE(PG8_SB(1, 0), cB + kstep, voffB); PG8_STAGE(PG8_SA(1, 0), cA + kstep, voffA); PG8_STAGE(PG8_SB(1, 1), cB + hstep + kstep, voffB);
        PG8_WAIT_V(6); PG8_BAR;
    } else {
        PG8_STAGE(PG8_SB(0, 0), cB, voffB); PG8_STAGE(PG8_SA(0, 0), cA, voffA); PG8_STAGE(PG8_SB(0, 1), cB + hstep, voffB); PG8_STAGE(PG8_SA(0, 1), cA + hA, voffA);
        if (wr == 1) PG8_BAR;
        PG8_WAIT_V(4); PG8_BAR;
        PG8_STAGE(PG8_SB(1, 0), cB + kstep, voffB); PG8_STAGE(PG8_SA(1, 0), cA + kstep, voffA); PG8_STAGE(PG8_SB(1, 1), cB + hstep + kstep, voffB);
        PG8_WAIT_V(6); PG8_BAR;
    }
    for (;;) {
        const bool has_next = S.next(ui + 1, nxt);
        const char* nA = has_next ? (const char*)g.A + (size_t)nxt.pm * tstep + (nxt.single ? (size_t)nxt.sub * hstep : (size_t)0) : cA; const char* nB = has_next ? (const char*)g.Bt + (size_t)nxt.pn * tstep : cB;

        for (int t = 0; t < nt; t += 2) {
            const bool last = (t == nt - 2);
            const char* a1 = cA + (size_t)(t + 1) * kstep;
            const char* a2 = last ? nA : cA + (size_t)(t + 2) * kstep; const char* b2 = last ? nB : cB + (size_t)(t + 2) * kstep;
            const char* a3 = a2 + kstep; const char* b3 = b2 + kstep; const unsigned h2 = hA;
            if (last && has_next) S.a_ready(nxt);
            if constexpr (SP2) {
            PG8_LDB(B0, 0, 0); PG8_LDB(B1, 0, 1); PG8_SCHED; PG8_LDA(At, 0, 0); PG8_STAGE(PG8_SA(1, 1), a1 + hA, voffA);
            PG8_WAIT_V(8); PG8_WAIT_L(0); PG8_BAR; PG8_MMA(0, 0, At, B0); PG8_MMA(0, 1, At, B1); PG8_BAR; PG8_SCHED;
            if constexpr (full) PG8_LDA(At, 0, 1); PG8_STAGE(PG8_SB(0, 0), b2, voffB); PG8_STAGE(PG8_SB(0, 1), b2 + hstep, voffB); PG8_STAGE(PG8_SA(0, 0), a2, voffA);
            PG8_WAIT_V(8); PG8_WAIT_L(0); PG8_BAR; if constexpr (full) { PG8_MMA(1, 0, At, B0); PG8_MMA(1, 1, At, B1); } PG8_BAR; PG8_SCHED;
            PG8_LDB(B0, 1, 0); PG8_LDB(B1, 1, 1); PG8_SCHED; PG8_LDA(At, 1, 0); PG8_STAGE(PG8_SA(0, 1), a2 + h2, voffA);
            PG8_WAIT_V(8); PG8_WAIT_L(0); PG8_BAR; PG8_MMA(0, 0, At, B0); PG8_MMA(0, 1, At, B1); PG8_BAR; PG8_SCHED;
            if constexpr (full) PG8_LDA(At, 1, 1); PG8_STAGE(PG8_SB(1, 0), b3, voffB); PG8_STAGE(PG8_SB(1, 1), b3 + hstep, voffB); PG8_STAGE(PG8_SA(1, 0), a3, voffA);
            PG8_WAIT_V(8); PG8_WAIT_L(0); PG8_BAR; if constexpr (full) { PG8_MMA(1, 0, At, B0); PG8_MMA(1, 1, At, B1); } PG8_BAR; PG8_SCHED;
            } else {
            PG8_LDB(B0, 0, 0); PG8_SCHED; PG8_LDA(At, 0, 0); PG8_STAGE(PG8_SA(1, 1), a1 + hA, voffA);
            PG8_WAIT_L(8); PG8_BAR; PG8_WAIT_L(0); PG8_MMA(0, 0, At, B0); PG8_BAR; PG8_SCHED;
            PG8_LDB(B1, 0, 1); PG8_STAGE(PG8_SB(0, 0), b2, voffB);
            PG8_BAR; PG8_WAIT_L(0); PG8_MMA(0, 1, At, B1); PG8_BAR;
            PG8_LDA(At, 0, 1); PG8_STAGE(PG8_SA(0, 0), a2, voffA);
            PG8_BAR; PG8_WAIT_L(0); if constexpr (full) PG8_MMA(1, 0, At, B0); PG8_BAR; PG8_SCHED;
            PG8_STAGE(PG8_SB(0, 1), b2 + hstep, voffB);
            PG8_WAIT_V(6); PG8_BAR; if constexpr (full) PG8_MMA(1, 1, At, B1); PG8_BAR;
            PG8_LDB(B0, 1, 0); PG8_SCHED; PG8_LDA(At, 1, 0); PG8_STAGE(PG8_SA(0, 1), a2 + h2, voffA);
            PG8_WAIT_L(8); PG8_BAR; PG8_WAIT_L(0); PG8_MMA(0, 0, At, B0); PG8_BAR; PG8_SCHED;
            PG8_LDB(B1, 1, 1); PG8_STAGE(PG8_SB(1, 0), b3, voffB);
            PG8_BAR; PG8_WAIT_L(0); PG8_MMA(0, 1, At, B1); PG8_BAR;
            PG8_LDA(At, 1, 1); PG8_STAGE(PG8_SA(1, 0), a3, voffA);
            PG8_BAR; PG8_WAIT_L(0); if constexpr (full) PG8_MMA(1, 0, At, B0); PG8_BAR; PG8_SCHED;
            PG8_STAGE(PG8_SB(1, 1), b3 + hstep, voffB);
            PG8_WAIT_V(6); PG8_BAR; if constexpr (full) PG8_MMA(1, 1, At, B1); PG8_BAR;
            }
        }
        if constexpr (ALIGN_EPI) { if (wr == 0) PG8_BAR; }
        if constexpr (!Epi::AFTER_DRAIN) { int ln_; LANE_ID(ln_); E.template run<SINGLE>(acc, cur, wr, wc, ln_ & 15, ln_ >> 4); S.done(cur); }
        if (!has_next) break;
#pragma unroll
        for (int a = 0; a < 2; ++a)
#pragma unroll
            for (int b = 0; b < 2; ++b)
#pragma unroll
                for (int m = 0; m < 4; ++m)
#pragma unroll
                    for (int n = 0; n < 2; ++n) acc[a][b][m][n] = (f32x4){0.f, 0.f, 0.f, 0.f};
        cur = nxt; cA = nA; cB = nB; ++ui;
        if constexpr (ALIGN_EPI) { if (wr == 1) PG8_BAR; }
    }
    PG8_WAIT_V(0);
    if constexpr (!ALIGN_EPI) { if (wr == 0) PG8_BAR; }
    PG8_BAR;
#undef PG8_SA
#undef PG8_SB
#undef PG8_STAGE
#undef PG8_LDA
#undef PG8_LDB
#undef PG8_MMA
#undef PG8_WAIT_V
#undef PG8_WAIT_L
#undef PG8_BAR
#undef PG8_SCHED
}
}

constexpr int NWAVES = 8;
constexpr int D = 1024, MC = 8192, ML = 16384, M = MC + ML, DIN = 2304, DFF = 4096, DG = 256, MP0 = 16384;
constexpr float EPS = 1e-6f;
constexpr size_t MiB = 1u << 20;
constexpr size_t WS_CTL = 0, CTL_ZERO_BYTES = 1 * MiB;
constexpr size_t WS_MOD = 1 * MiB;
constexpr size_t WS_ROPE = WS_MOD + 2 * 9 * 6144 * 4;
constexpr size_t WS_LAM = WS_ROPE + 64 * 16 * 4;
constexpr size_t WS_RGWT = WS_LAM + 256;
constexpr size_t WS_POOLT = WS_RGWT + 32 * 4096 * 2;
constexpr size_t WS_CARRY = WS_POOLT + 8 * 4096 * 2;
constexpr size_t WS_WIN = 2 * MiB;
constexpr size_t WS_WOUT = WS_WIN + 2ull * 2304 * 1024 * 2;
constexpr size_t WS_W1 = WS_WOUT + 2ull * 1024 * 1024 * 2;
constexpr size_t WS_W2 = WS_W1 + 2ull * 4096 * 1024 * 2;
constexpr size_t WS_CK = WS_W2 + 2ull * 4096 * 1024 * 2;
constexpr size_t WS_CV = WS_CK + 2 * MiB;
constexpr size_t WS_SW = 51 * MiB;
constexpr size_t WS_SS = 512 * 1024;
constexpr size_t WS_CARRY1 = 51 * MiB + 512 * 1024;
constexpr size_t WS_SP8 = WS_CARRY1 + 256 * 1024;
constexpr size_t WS_XN = 52 * MiB;
constexpr size_t WS_XR = 52 * MiB;
constexpr size_t OUT_XN_BYTES = 48 * MiB;
constexpr size_t WS_Y = 100 * MiB;
constexpr size_t WS_Z = 148 * MiB;
constexpr size_t WS_END = 256 * MiB;
static_assert(WS_SS + 5ull * 24576 * 4 <= CTL_ZERO_BYTES && WS_SW + 2ull * 9 * 6400 * 4 <= WS_XN, "ss/sw map");
static_assert(WS_CARRY + 8 * 8 * 4 * 2 * 64 * 2 * 4 <= WS_WIN && WS_CV + 2 * MiB <= WS_XN && WS_Z + (size_t)M * DIN * 2 <= WS_END, "d_ws map");
constexpr int CW_BAR = 4096, CW_FIN = 8192, CW_RG = 12288;
constexpr size_t OUT_Y = 0, OUT_CK = (size_t)M * D, OUT_CV = OUT_CK + 32ull * 2 * 4 * 256 * 64, OUT_ST = OUT_CV + 32ull * 2 * 4 * 256 * 64;
constexpr int RING_BYTES = 131072, LDSCTL_OFF = RING_BYTES, MISC_OFF = LDSCTL_OFF + 320, LDS_BYTES = 147456;

#define GAS __attribute__((address_space(1)))
#define LAS __attribute__((address_space(3)))
typedef unsigned short bf16;
typedef unsigned v4u __attribute__((ext_vector_type(4)));
typedef unsigned v2u __attribute__((ext_vector_type(2)));
typedef float f32x4 __attribute__((ext_vector_type(4)));
typedef GAS unsigned gu32;
#define RLX_AGENT __ATOMIC_RELAXED, __HIP_MEMORY_SCOPE_AGENT
#define LDS_WAIT() asm volatile("s_waitcnt lgkmcnt(0)" ::: "memory")
__device__ __forceinline__ unsigned f2bf(float f) { unsigned u = __builtin_bit_cast(unsigned, f); return (u + 0x7fffu + ((u >> 16) & 1u)) >> 16; }
__device__ __forceinline__ unsigned pk2(float lo, float hi) { return f2bf(lo) | (f2bf(hi) << 16); }
__device__ __forceinline__ float bf2f(unsigned h) { return __uint_as_float(h << 16); }
__device__ __forceinline__ float bflo(unsigned w) { return __uint_as_float(w << 16); }
__device__ __forceinline__ float bfhi(unsigned w) { return __uint_as_float(w & 0xffff0000u); }

#define XB_TMO      128
#define XB_XCNT(j)  (256  + 64 * (j))
#define XB_XSUB(j)  (1280 + 64 * (j))
#define XB_XGEN(j)  (2304 + 64 * (j))
#define XB_TOP      3328
#define XB_TOPGEN   3392
#define XCD_BAR_WORDS 3456
#define XB_SPIN_CAP (1u << 18)
__device__ __forceinline__ unsigned xb_ld(unsigned* p)              { return __hip_atomic_load(p, __ATOMIC_RELAXED, __HIP_MEMORY_SCOPE_AGENT); }
__device__ __forceinline__ unsigned xb_add(unsigned* p, unsigned v) { return __hip_atomic_fetch_add(p, v, __ATOMIC_RELAXED, __HIP_MEMORY_SCOPE_AGENT); }
__device__ __forceinline__ unsigned xb_xcc_id() { return (unsigned)__builtin_amdgcn_s_getreg((3 << 11) | 20) & 0xFu; }
#define XB_SPIN(cond, bar) do { unsigned _sp = 0; while (cond) { __builtin_amdgcn_s_sleep(1); \
    if ((++_sp & 255u) == 0u) { if (xb_ld(&(bar)[XB_TMO])) break; if (_sp > XB_SPIN_CAP) { atomicAdd(&(bar)[XB_TMO], 1u); break; } } } } while (0)
struct XcdBarrier { unsigned* bar; unsigned x; volatile LAS unsigned* st; };
__device__ __forceinline__ XcdBarrier xcd_barrier_post(unsigned* bar, volatile LAS unsigned* st) {
    XcdBarrier b; b.bar = bar; b.x = xb_xcc_id(); b.st = st;
    if (threadIdx.x == 0) (void)xb_add(&bar[XB_XCNT(b.x)], 1u);
    return b;
}
__device__ __forceinline__ void xcd_barrier_complete(unsigned* bar, unsigned x, unsigned& nloc, unsigned& nx) {
    const unsigned G = gridDim.x * gridDim.y * gridDim.z;
    unsigned sum, cnt, mine, sp = 0u;
    for (;;) {
        sum = 0u; cnt = 0u;
        for (unsigned j = 0; j < 16; ++j) { const unsigned c = xb_ld(&bar[XB_XCNT(j)]); sum += c; cnt += (c > 0u) ? 1u : 0u; }
        mine = xb_ld(&bar[XB_XCNT(x)]);
        if (sum == G) break;
        __builtin_amdgcn_s_sleep(1);
        if ((++sp & 255u) == 0u) { if (xb_ld(&bar[XB_TMO])) break; if (sp > XB_SPIN_CAP) { atomicAdd(&bar[XB_TMO], 1u); break; } }
    }
    nloc = mine > 0u ? mine : 1u; nx = cnt > 0u ? cnt : 1u;
}
__device__ __forceinline__ void xcd_barrier(const XcdBarrier& b) {
    asm volatile("s_waitcnt vmcnt(0)" ::: "memory");
    __syncthreads();
    if (threadIdx.x == 0) {
        unsigned* bar = b.bar; asm volatile("" : "+s"(bar)); unsigned bx_ = b.x; asm volatile("" : "+s"(bx_));
        __builtin_amdgcn_s_waitcnt(0);
        unsigned nloc = b.st[0], nx = b.st[1];
        if (nloc == 0u) { xcd_barrier_complete(bar, bx_, nloc, nx); b.st[0] = nloc; b.st[1] = nx; }
        const unsigned old = xb_add(&bar[XB_XSUB(bx_)], 1u);
        const unsigned gen = old / nloc;
        if (old + 1u == (gen + 1u) * nloc) {
            __builtin_amdgcn_fence(__ATOMIC_RELEASE, "agent");
            asm volatile("s_waitcnt vmcnt(0)" ::: "memory");
            const unsigned og = xb_add(&bar[XB_TOP], 1u);
            const unsigned tg = og / nx;
            if (og + 1u == (tg + 1u) * nx) xb_add(&bar[XB_TOPGEN], 1u);
            else XB_SPIN(xb_ld(&bar[XB_TOPGEN]) == tg, bar);
            __builtin_amdgcn_fence(__ATOMIC_ACQUIRE, "agent");
            xb_add(&bar[XB_XGEN(bx_)], 1u);
            asm volatile("s_waitcnt vmcnt(0)" ::: "memory");
        } else {
            XB_SPIN(xb_ld(&bar[XB_XGEN(bx_)]) == gen, bar);
            __builtin_amdgcn_fence(__ATOMIC_ACQUIRE, "agent");
            asm volatile("s_waitcnt vmcnt(0)" ::: "memory");
        }
    }
    __syncthreads();
}

struct Args { const float* in[25]; float* out; unsigned char* ws; int ph_lo, ph_hi; };
#define INP(A_, i) inp_ptr(F, (i))
struct Frame {
    LAS unsigned char* lds; LAS unsigned char* lds0; int tid, lane, wave, wave0, vcu, vcu0, G;
    float* out; unsigned char* ws; float* out0; unsigned char* ws0;
};
__device__ __forceinline__ const float* inp_ptr(const Frame& F, int i) {
    const volatile LAS unsigned* t = (const volatile LAS unsigned*)(F.lds + 131072) + 2 * i;
    const unsigned lo = __builtin_amdgcn_readfirstlane(t[0]), hi = __builtin_amdgcn_readfirstlane(t[1]);
    return (const float*)(((unsigned long long)hi << 32) | lo);
}
#define PHASE_IDS(F) do { int t_; asm volatile("v_mbcnt_lo_u32_b32 %0, -1, 0\n\tv_mbcnt_hi_u32_b32 %0, -1, %0" : "=v"(t_)); int wv_ = (F).wave0; asm volatile("" : "+s"(wv_)); int vc_ = (F).vcu0; asm volatile("" : "+s"(vc_)); (F).vcu = vc_; (F).lane = t_; (F).wave = wv_; (F).tid = wv_ * 64 + t_; \
    unsigned l_ = (unsigned)(uintptr_t)(F).lds0; asm volatile("" : "+s"(l_)); (F).lds = (LAS unsigned char*)(uintptr_t)l_; unsigned char* w_ = (F).ws0; asm volatile("" : "+s"(w_)); (F).ws = w_; float* o_ = (F).out0; asm volatile("" : "+s"(o_)); (F).out = o_; } while (0)
enum { I_XP = 0, I_XS, I_CK, I_CV, I_ST, I_C, I_CCTX, I_WADA, I_BADA, I_NORMW, I_WIN, I_DLAM, I_SUBLN, I_CBW, I_CCW, I_CCB, I_RGW, I_RGB, I_RGLAM, I_POOLW, I_POOLS, I_WOUT, I_W1, I_W2, I_FNW };

__device__ __forceinline__ float wave_sum(float v, int lane) {
#pragma unroll
    for (int o = 1; o < 64; o <<= 1) v += shx(v, o, lane);
    return v;
}
__device__ __forceinline__ float wave_max(float v, int lane) {
#pragma unroll
    for (int o = 1; o < 64; o <<= 1) v = fmaxf(v, shx(v, o, lane));
    return v;
}
__device__ __forceinline__ float gelu_tanh(float x) { const float u = 0.7978845608028654f * (x + 0.044715f * x * x * x); return 0.5f * x * (1.0f + tanhf(u)); }

__device__ __forceinline__ void glds16(const void* gsrc, unsigned lds_dst) { unsigned keep;
    asm volatile("s_mov_b32 %0, m0\n\ts_mov_b32 m0, %2\n\ts_nop 0\n\tglobal_load_lds_dwordx4 %1, off\n\ts_mov_b32 m0, %0" : "=&s"(keep) : "v"(gsrc), "s"(lds_dst) : "memory"); }
struct TItem { const float* W; bf16* WT; int K, N, item; };
__device__ __forceinline__ void p0_titem_load(const TItem& t, int lane, unsigned slot) {
    const int nblk = t.N / 32, kb = t.item / nblk, nb = t.item % nblk, k0 = 64 * kb, n0 = 32 * nb;
    const float* src = t.W + (size_t)(k0 + (lane >> 3)) * t.N + n0;
#pragma unroll
    for (int i = 0; i < 8; ++i) glds16(src + (size_t)(8 * i) * t.N + 4 * ((lane & 7) ^ i), slot + 1024u * i);
}
__device__ __forceinline__ void p0_titem_finish(const TItem& t, const LAS float* scr, int lane, bool first) {
    const int nblk = t.N / 32, kb = t.item / nblk, nb = t.item % nblk, k0 = 64 * kb, n0 = 32 * nb;
    if (first) asm volatile("s_waitcnt vmcnt(8)" ::: "memory"); else asm volatile("s_waitcnt vmcnt(12)" ::: "memory");
    const int c = lane & 7;
#pragma unroll
    for (int j = 0; j < 4; ++j) { const int n = (lane >> 3) + 8 * j; const LAS float* sp = scr + (8 * c) * 32 + (((n >> 2) ^ c) << 2) + (n & 3);
        v4u o; o.x = pk2(sp[0 * 32], sp[1 * 32]); o.y = pk2(sp[2 * 32], sp[3 * 32]); o.z = pk2(sp[4 * 32], sp[5 * 32]); o.w = pk2(sp[6 * 32], sp[7 * 32]);
        *(GAS v4u*)(t.WT + (size_t)(n0 + n) * t.K + k0 + 8 * c) = o; }
    LDS_WAIT(); asm volatile("" ::: "memory");
}
__device__ __forceinline__ void p0_mod_item(Frame& F, const Args& A, int item) {
    const int l = item / 96, n0 = (item % 96) * 64;
    LAS float* sv = (LAS float*)F.lds;
    LAS float* red = sv + 9 * 1024;
    const float* c = INP(A, I_C); const float* cctx = INP(A, I_CCTX);
    for (int i = F.tid; i < 9 * 1024; i += 512) { const int mi = i >> 10, k = i & 1023; const float v = mi == 0 ? cctx[k] : c[(mi - 1) * 1024 + k]; sv[i] = v / (1.0f + expf(-v)); }
    __syncthreads();
    const int cg = F.tid & 15, rg = F.tid >> 4;
    float acc[9][4];
#pragma unroll
    for (int a = 0; a < 9; ++a)
#pragma unroll
        for (int j = 0; j < 4; ++j) acc[a][j] = 0.f;
    const float* wp = INP(A, I_WADA) + (size_t)l * 1024 * 6144 + n0 + cg * 4;
#pragma unroll 1
    for (int i0 = 0; i0 < 32; i0 += 8) { f32x4 w[8];
#pragma unroll
        for (int q = 0; q < 8; ++q) w[q] = *(const GAS f32x4*)(wp + (size_t)(rg + 32 * (i0 + q)) * 6144);
#pragma unroll
        for (int q = 0; q < 8; ++q) { const int k = rg + 32 * (i0 + q);
#pragma unroll
            for (int a = 0; a < 9; ++a) { const float sx = sv[a * 1024 + k];
#pragma unroll
                for (int j = 0; j < 4; ++j) acc[a][j] += sx * w[q][j]; } } }
#pragma unroll
    for (int a = 0; a < 9; ++a)
#pragma unroll
        for (int j = 0; j < 4; ++j) red[(rg * 9 + a) * 64 + cg * 4 + j] = acc[a][j];
    __syncthreads();
    float* mod = (float*)(F.ws + WS_MOD);
    for (int o = F.tid; o < 9 * 64; o += 512) { const int mi = o >> 6, n = o & 63; float sm = INP(A, I_BADA)[l * 6144 + n0 + n];
#pragma unroll 8
        for (int r = 0; r < 32; ++r) sm += red[(r * 9 + mi) * 64 + n];
        mod[(size_t)(l * 9 + mi) * 6144 + n0 + n] = sm; }
    __syncthreads();
}
__device__ __forceinline__ void sincos_d(double a, float& co, float& si) {
    const double TWO_PI = 6.283185307179586476925286766559;
    const double n = (double)(long long)(a / TWO_PI + 0.5);
    const double r = a - n * TWO_PI;
    const double r2 = r * r; double ts = r, tc = 1.0, ss = r, sc = 1.0;
    for (int k = 1; k <= 14; ++k) { tc = -tc * r2 / (double)((2 * k - 1) * (2 * k)); sc += tc; ts = -ts * r2 / (double)((2 * k) * (2 * k + 1)); ss += ts; }
    co = (float)sc; si = (float)ss;
}
__device__ __forceinline__ void p0_prologue(Frame& F, const Args& A) {
    PHASE_IDS(F);
    if (blockIdx.x < 192) p0_mod_item(F, A, blockIdx.x);
    const unsigned slot0 = (unsigned)__builtin_amdgcn_readfirstlane((int)(unsigned)(size_t)(F.lds + F.wave * 16384));
    const LAS float* scr0 = (const LAS float*)(F.lds + F.wave * 16384); const LAS float* scr1 = scr0 + 2048;
    const int gw = F.vcu * NWAVES + F.wave, NGW = F.G * NWAVES;
    constexpr int I_IN = 16 * 72, I_OUT = 16 * 32, I_1 = 16 * 128, I_2 = 64 * 32, I_L = I_IN + I_OUT + I_1 + I_2, I_RG = 32 * 2, I_PW = 8 * 2;
    constexpr int NITEMS = 2 * I_L + I_RG + I_PW;
    const float* pw_in = INP(A, I_WIN); const float* pw_out = INP(A, I_WOUT); const float* pw_1 = INP(A, I_W1); const float* pw_2 = INP(A, I_W2); const float* pw_rg = INP(A, I_RGW); const float* pw_pl = INP(A, I_POOLW);
    auto decode = [&](int it, TItem& t) {
        int r = it;
        if (r < 2 * I_L) { const int l = r / I_L; r -= l * I_L;
            if (r < I_IN) { t = TItem{pw_in + (size_t)l * 1024 * 2304, (bf16*)(F.ws + WS_WIN) + (size_t)l * 2304 * 1024, 1024, 2304, r}; return; } r -= I_IN;
            if (r < I_OUT) { t = TItem{pw_out + (size_t)l * 1024 * 1024, (bf16*)(F.ws + WS_WOUT) + (size_t)l * 1024 * 1024, 1024, 1024, r}; return; } r -= I_OUT;
            if (r < I_1) { t = TItem{pw_1 + (size_t)l * 1024 * 4096, (bf16*)(F.ws + WS_W1) + (size_t)l * 4096 * 1024, 1024, 4096, r}; return; } r -= I_1;
            t = TItem{pw_2 + (size_t)l * 4096 * 1024, (bf16*)(F.ws + WS_W2) + (size_t)l * 1024 * 4096, 4096, 1024, r}; return; }
        r -= 2 * I_L;
        if (r < I_RG) { const int mi = r >> 1; t = TItem{pw_rg + (size_t)mi * 4096, (bf16*)(F.ws + WS_RGWT) + (size_t)mi * 4096, 64, 64, r & 1}; return; } r -= I_RG;
        { const int mi = r >> 1; t = TItem{pw_pl + (size_t)mi * 4096, (bf16*)(F.ws + WS_POOLT) + (size_t)mi * 4096, 64, 64, r & 1}; }
    };
    if (gw < NITEMS) {
        const int cnt = (NITEMS - gw + NGW - 1) / NGW;
        TItem ta, tb;
        decode(gw, ta); p0_titem_load(ta, F.lane, slot0);
        for (int j = 0; j < cnt; j += 2) {
            { const int jn = j + 1 < cnt ? j + 1 : cnt - 1; decode(gw + jn * NGW, tb); p0_titem_load(tb, F.lane, slot0 + 8192u); }
            p0_titem_finish(ta, scr0, F.lane, j == 0);
            if (j + 1 >= cnt) break;
            { const int jn = j + 2 < cnt ? j + 2 : cnt - 1; decode(gw + jn * NGW, ta); p0_titem_load(ta, F.lane, slot0); }
            p0_titem_finish(tb, scr1, F.lane, false);
        }
        asm volatile("s_waitcnt vmcnt(0)" ::: "memory");
    }
    { const int gt = F.vcu * 512 + F.tid, NGT = F.G * 512;
      const float* pck = INP(A, I_CK); const float* pcv = INP(A, I_CV);
      for (int i0 = gt; i0 < 2 * 262144; i0 += 4 * NGT) { f32x4 v[4];
#pragma unroll
          for (int q = 0; q < 4; ++q) { const int i = i0 + q * NGT; if (i < 2 * 262144) { const int which = i >= 262144; const int j = which ? i - 262144 : i; v[q] = *(const GAS f32x4*)((which ? pcv : pck) + (size_t)j * 4); } }
#pragma unroll
          for (int q = 0; q < 4; ++q) { const int i = i0 + q * NGT; if (i < 2 * 262144) { const int which = i >= 262144; const int j = which ? i - 262144 : i; v2u o; o.x = pk2(v[q][0], v[q][1]); o.y = pk2(v[q][2], v[q][3]);
              *(GAS v2u*)((bf16*)(F.ws + (which ? WS_CV : WS_CK)) + (size_t)j * 4) = o; } } } }
    if (blockIdx.x == (unsigned)(F.G - 1)) {
        const double fr[8] = {1.0, 0.31622776601683794, 0.1, 0.031622776601683794, 0.01, 0.0031622776601683794, 0.001, 0.00031622776601683794};
        float* rope = (float*)(F.ws + WS_ROPE);
        { const int pos = F.tid >> 3, j = F.tid & 7; double f = fr[0];
#pragma unroll
          for (int q = 1; q < 8; ++q) f = (j == q) ? fr[q] : f;
          float co, si; sincos_d((double)pos * f, co, si); rope[pos * 16 + j * 2] = co; rope[pos * 16 + j * 2 + 1] = si; }
        { const float* rgl = INP(A, I_RGLAM); float* sp8 = (float*)(F.ws + WS_SP8);
          for (int i = F.tid; i < 2 * 2 * 256; i += 512) sp8[i] = 8.0f * 1.4426950408889634f * log1pf(expf(-rgl[i])); }
        if (F.tid < 2) { const int l = F.tid; const float* dl = INP(A, I_DLAM) + l * 128; float s1 = 0.f, s2 = 0.f;
            for (int i = 0; i < 32; ++i) { s1 += dl[i] * dl[32 + i]; s2 += dl[64 + i] * dl[96 + i]; }
            const float lam_init = 0.8f - 0.6f * expf(-0.3f * (float)l);
            ((float*)(F.ws + WS_LAM))[l] = expf(s1) - expf(s2) + lam_init; }
    }
}
__device__ __forceinline__ void prep0_phase(Frame& F, const Args& A) {
    PHASE_IDS(F);
    bf16* XN = (bf16*)((unsigned char*)F.out + OUT_XN_BYTES); float* SS0 = (float*)(F.ws + WS_SS); const float* mod = (const float*)(F.ws + WS_MOD);
    const float* xp = INP(A, I_XP); const float* xsm = INP(A, I_XS) - (size_t)MC * D; const float* nw = INP(A, I_NORMW);
    const int gw = F.vcu * NWAVES + F.wave, NGW = F.G * NWAVES; const int lane = F.lane;
    const int cmb = (int)blockIdx.x & 3, sl = cmb >> 1, which = cmb & 1, slot = (int)blockIdx.x >> 2; const int N = which ? DFF : DIN;
    const int ntile = which ? 4 : 3, ncol = which ? 64 : 48; const bool active = which ? (slot < 64) : (slot < 48);
    const int tile = F.wave & 3, kh = F.wave >> 2; const bool has = active && tile < ntile;
    const int n0 = (active ? slot : 0) * ncol + (tile < ntile ? tile : 0) * 16;
    LAS float* sh = (LAS float*)F.lds;
    LAS float* red = sh + 9 * 1024;
    { const float* shg = mod + (size_t)sl * 9 * 6144 + (which ? 3072 : 0);
      for (int i = F.tid; i < 9 * 256; i += 512) { const int mi = i >> 8, k4 = i & 255; *(LAS f32x4*)(sh + mi * 1024 + 4 * k4) = *(const f32x4*)(shg + (size_t)mi * 6144 + 4 * k4); } }
    const bf16* wbase = which ? (const bf16*)(F.ws + WS_W1) + (size_t)sl * DFF * D : (const bf16*)(F.ws + WS_WIN) + (size_t)sl * DIN * D;
    v4u wf[16];
    { const bf16* wt = wbase + (size_t)(n0 + (lane & 15)) * D + kh * 512 + (lane >> 4) * 8;
#pragma unroll
      for (int st = 0; st < 16; ++st) wf[st] = *(const GAS v4u*)(wt + 32 * st); }
    REP(13) for (int r0 = gw; r0 < M; r0 += 4 * NGW) {
        f32x4 v[4][4];
#pragma unroll
        for (int q = 0; q < 4; ++q) { const int r = r0 + q * NGW; const float* xr = (r < MC ? xp : xsm) + (size_t)r * D;
#pragma unroll
            for (int j = 0; j < 4; ++j) v[q][j] = *(const GAS f32x4*)(xr + 256 * j + 4 * lane); }
#pragma unroll
        for (int q = 0; q < 4; ++q) { const int r = r0 + q * NGW; const int mi = r < MC ? 0 : 1 + ((r - MC) >> 11);
            const float* mp = mod + (size_t)mi * 6144 + 1024;
            float sq = 0.f;
#pragma unroll
            for (int j = 0; j < 4; ++j) sq += (v[q][j][0] * v[q][j][0] + v[q][j][1] * v[q][j][1]) + (v[q][j][2] * v[q][j][2] + v[q][j][3] * v[q][j][3]);
#pragma unroll
            for (int j = 0; j < 4; ++j) { const int c = 256 * j + 4 * lane; const f32x4 w = *(const GAS f32x4*)(nw + c), sc = *(const GAS f32x4*)(mp + c);
                v2u pk; pk.x = pk2(v[q][j][0] * w[0] * (1.0f + sc[0]), v[q][j][1] * w[1] * (1.0f + sc[1])); pk.y = pk2(v[q][j][2] * w[2] * (1.0f + sc[2]), v[q][j][3] * w[3] * (1.0f + sc[3])); *(GAS v2u*)(XN + (size_t)r * D + c) = pk; }
            sq = wave_sum(sq, lane); if (lane == 0) *(GAS float*)(SS0 + r) = sq; }
    }
    __syncthreads();
    { const int mi = lane & 15, kg = lane >> 4; const LAS float* sp = sh + (mi < 9 ? mi : 0) * 1024 + kh * 512 + kg * 8; const float keep = mi < 9 ? 1.0f : 0.0f;
      pg8::f32x4 acc = {0.f, 0.f, 0.f, 0.f};
#pragma unroll
      for (int st = 0; st < 16; ++st) { const f32x4 s0 = *(const LAS f32x4*)(sp + 32 * st), s1 = *(const LAS f32x4*)(sp + 32 * st + 4);
          float x[8] = {s0[0] * keep, s0[1] * keep, s0[2] * keep, s0[3] * keep, s1[0] * keep, s1[1] * keep, s1[2] * keep, s1[3] * keep}; v4u hi, lo;
          hi.x = pg8::cvt_pk_bf16(x[0], x[1]); hi.y = pg8::cvt_pk_bf16(x[2], x[3]); hi.z = pg8::cvt_pk_bf16(x[4], x[5]); hi.w = pg8::cvt_pk_bf16(x[6], x[7]);
          lo.x = pg8::cvt_pk_bf16(x[0] - bflo(hi.x), x[1] - bfhi(hi.x)); lo.y = pg8::cvt_pk_bf16(x[2] - bflo(hi.y), x[3] - bfhi(hi.y));
          lo.z = pg8::cvt_pk_bf16(x[4] - bflo(hi.z), x[5] - bfhi(hi.z)); lo.w = pg8::cvt_pk_bf16(x[6] - bflo(hi.w), x[7] - bfhi(hi.w));
          const pg8::bf16x8 bw = __builtin_bit_cast(pg8::bf16x8, wf[st]);
          acc = __builtin_amdgcn_mfma_f32_16x16x32_bf16(__builtin_bit_cast(pg8::bf16x8, hi), bw, acc, 0, 0, 0);
          acc = __builtin_amdgcn_mfma_f32_16x16x32_bf16(__builtin_bit_cast(pg8::bf16x8, lo), bw, acc, 0, 0, 0); }
      if (kh == 1) *(LAS pg8::f32x4*)(red + (tile * 64 + lane) * 4) = acc;
      __syncthreads();
      if (kh == 0 && has) { const pg8::f32x4 o = *(const LAS pg8::f32x4*)(red + (tile * 64 + lane) * 4);
          float* obase = (float*)(F.ws + WS_SW) + (which ? 2 * 9 * 2304 + (size_t)sl * 9 * 4096 : (size_t)sl * 9 * 2304);
#pragma unroll
          for (int e = 0; e < 4; ++e) { const int m2 = 4 * kg + e; if (m2 < 9) *(GAS float*)(obase + (size_t)m2 * N + n0 + (lane & 15)) = acc[e] + o[e]; } }
      __syncthreads(); }
}
typedef short bf16x8_t __attribute__((ext_vector_type(8)));
typedef float f32x16 __attribute__((ext_vector_type(16)));
typedef short v4i16_t __attribute__((ext_vector_type(4)));
__device__ __forceinline__ unsigned cvtpk(float lo, float hi) { unsigned r; asm volatile("v_cvt_pk_bf16_f32 %0, %1, %2" : "=v"(r) : "v"(lo), "v"(hi)); return r; }
__device__ __forceinline__ bf16x8_t pack8(float a0, float a1, float a2, float a3, float a4, float a5, float a6, float a7) {
    v4u w; w.x = cvtpk(a0, a1); w.y = cvtpk(a2, a3); w.z = cvtpk(a4, a5); w.w = cvtpk(a6, a7); return __builtin_bit_cast(bf16x8_t, w); }
__device__ __forceinline__ v4i16_t lds_tr(LAS unsigned char* p) { return __builtin_amdgcn_ds_read_tr16_b64_v4i16((LAS v4i16_t*)p); }
#define MFMA32(a, b, c) __builtin_amdgcn_mfma_f32_32x32x16_bf16((a), (b), (c), 0, 0, 0)


__device__ __forceinline__ void attn_unit(Frame& F, const Args& A, int l, bool lat, int seq, int hd, int qb, float lam, float sub_mul) {
    LAS unsigned char* L = F.lds;
    const bf16* Z = (const bf16*)(F.ws + WS_Z); bf16* Y = (bf16*)(F.ws + WS_Y);
    const bf16* CK = (const bf16*)(F.ws + WS_CK); const bf16* CV = (const bf16*)(F.ws + WS_CV);
    int lane; LANE_ID(lane); const int w = F.wave, tid = w * 64 + lane, r32 = lane & 31, h = lane >> 5;
    const int zrow0 = lat ? MC + seq * 2048 : seq * 256;
    const int qrow = zrow0 + qb * 256 + w * 32 + r32;
    bf16x8_t qf[2][2];
#pragma unroll
    for (int s = 0; s < 2; ++s)
#pragma unroll
        for (int ks = 0; ks < 2; ++ks) qf[s][ks] = *(const bf16x8_t*)(Z + (size_t)qrow * DIN + hd * 64 + s * 32 + ks * 16 + h * 8);
    const int NT = lat ? 36 : 4;
    const unsigned lds0 = (unsigned)(uintptr_t)L;
    const int srow = 8 * w + (lane >> 3), spc = lane & 7;
    const int kch = spc ^ ((srow >> 1) & 7), vch = spc ^ (((srow >> 1) & 1) << 2);
    const size_t cbk = ((size_t)((seq * 2 + l) * 4 + hd) * 256 + srow) * 64 + kch * 8, cbv = ((size_t)((seq * 2 + l) * 4 + hd) * 256 + srow) * 64 + vch * 8;
    const size_t zbk = (size_t)(zrow0 + srow) * DIN + 256 + hd * 64 + kch * 8, zbv = (size_t)(zrow0 + srow) * DIN + 512 + hd * 64 + vch * 8;
#define ATT_DMA(tn, slot) do { const unsigned sb_ = (unsigned)(slot) * 16384u + (unsigned)w * 1024u; \
        const bf16* ks_ = (lat && (tn) < 4) ? CK + cbk + (size_t)(tn) * 4096 : Z + zbk + (size_t)((tn) - (lat ? 4 : 0)) * 64 * DIN; \
        const bf16* vs_ = (lat && (tn) < 4) ? CV + cbv + (size_t)(tn) * 4096 : Z + zbv + (size_t)((tn) - (lat ? 4 : 0)) * 64 * DIN; \
        glds16(ks_, (unsigned)__builtin_amdgcn_readfirstlane((int)(lds0 + sb_))); glds16(vs_, (unsigned)__builtin_amdgcn_readfirstlane((int)(lds0 + sb_ + 8192u))); } while (0)
    unsigned koff[2][2];
#pragma unroll
    for (int s = 0; s < 2; ++s)
#pragma unroll
        for (int ks = 0; ks < 2; ++ks) koff[s][ks] = r32 * 128 + (((s * 4 + ks * 2 + h) ^ ((r32 >> 1) & 7)) << 4);
    const int q_ = (lane & 15) >> 2, p_ = lane & 3, g1 = (lane >> 4) & 1, sw = (lane >> 3) & 1;
    const unsigned vb0 = 8192 + (4 * h + q_) * 128 + (((2 * g1 + (p_ >> 1)) ^ (sw << 2)) << 4) + (p_ & 1) * 8;
    const unsigned vb1 = 8192 + (4 * h + q_) * 128 + (((4 + 2 * g1 + (p_ >> 1)) ^ (sw << 2)) << 4) + (p_ & 1) * 8;
    ATT_DMA(0, 0); ATT_DMA(1, 1);
    __builtin_amdgcn_s_waitcnt(0x0F70);
    float mref[2] = {0.f, 0.f}, ls[2] = {0.f, 0.f};
    f32x16 o[2][2];
#pragma unroll
    for (int s = 0; s < 2; ++s)
#pragma unroll
        for (int db = 0; db < 2; ++db)
#pragma unroll
            for (int r = 0; r < 16; ++r) o[s][db][r] = 0.f;
    for (int t = 0, par = 0; t < NT; ++t, par = (par == 2 ? 0 : par + 1)) {
        const unsigned bo = (unsigned)par * 16384u;
        if (t + 1 < NT) asm volatile("s_waitcnt vmcnt(2)" ::: "memory"); else asm volatile("s_waitcnt vmcnt(0)" ::: "memory");
        __builtin_amdgcn_s_barrier(); asm volatile("" ::: "memory");
        if (t + 2 < NT) ATT_DMA(t + 2, (par == 0 ? 2 : par - 1));
        bf16x8_t kf[2][2][2], vf[2][4];
#pragma unroll
        for (int s = 0; s < 2; ++s)
#pragma unroll
            for (int ks = 0; ks < 2; ++ks) { kf[s][ks][0] = *(const LAS bf16x8_t*)(L + bo + koff[s][ks]); kf[s][ks][1] = *(const LAS bf16x8_t*)(L + bo + koff[s][ks] + 4096); }
#pragma unroll
        for (int db = 0; db < 2; ++db)
#pragma unroll
            for (int sp = 0; sp < 4; ++sp) { LAS unsigned char* vp = L + bo + (db ? vb1 : vb0) + sp * 2048; const v4i16_t lo = lds_tr(vp), hi = lds_tr(vp + 1024);
                vf[db][sp] = (bf16x8_t){lo[0], lo[1], lo[2], lo[3], hi[0], hi[1], hi[2], hi[3]}; }
        f32x16 p[2][2];
#pragma unroll
        for (int s = 0; s < 2; ++s) { const float nm = -mref[s];
#pragma unroll
            for (int r = 0; r < 16; ++r) { p[s][0][r] = nm; p[s][1][r] = nm; }
#pragma unroll
            for (int ks = 0; ks < 2; ++ks) { p[s][0] = MFMA32(kf[s][ks][0], qf[s][ks], p[s][0]); p[s][1] = MFMA32(kf[s][ks][1], qf[s][ks], p[s][1]); } }
        __builtin_amdgcn_sched_barrier(0);
        bf16x8_t pb[2][4];
#pragma unroll
        for (int s = 0; s < 2; ++s) {
            f32x16& p0 = p[s][0]; f32x16& p1 = p[s][1];
            float ma = fmaxf(fmaxf(p0[0], p0[1]), p1[0]), mb = fmaxf(fmaxf(p0[2], p0[3]), p1[1]); ma = fmaxf(fmaxf(ma, p1[2]), p1[3]);
#pragma unroll
            for (int r = 4; r < 16; r += 4) { ma = fmaxf(fmaxf(ma, p0[r]), p0[r + 1]); mb = fmaxf(fmaxf(mb, p0[r + 2]), p0[r + 3]); ma = fmaxf(fmaxf(ma, p1[r]), p1[r + 1]); mb = fmaxf(fmaxf(mb, p1[r + 2]), p1[r + 3]); }
            float mt = fmaxf(ma, mb); mt = fmaxf(mt, shx(mt, 32, lane));
            if (t == 0 || __any(mt > 8.0f)) {
                const float dl = (t == 0) ? mt : fmaxf(mt, 0.f); mref[s] += dl; const float al = (t == 0) ? 1.0f : __builtin_amdgcn_exp2f(-dl); ls[s] *= al;
#pragma unroll
                for (int r = 0; r < 16; ++r) { p0[r] -= dl; p1[r] -= dl; }
#pragma unroll
                for (int db = 0; db < 2; ++db)
#pragma unroll
                    for (int r = 0; r < 16; ++r) o[s][db][r] *= al; }
            float rs0 = 0.f, rs1 = 0.f;
#pragma unroll
            for (int r = 0; r < 16; ++r) { p0[r] = __builtin_amdgcn_exp2f(p0[r]); p1[r] = __builtin_amdgcn_exp2f(p1[r]); rs0 += p0[r]; asm volatile("" : "+v"(rs0)); rs1 += p1[r]; asm volatile("" : "+v"(rs1)); }
            ls[s] += rs0 + rs1;
            pb[s][0] = pack8(p0[0], p0[1], p0[2], p0[3], p0[4], p0[5], p0[6], p0[7]); pb[s][1] = pack8(p0[8], p0[9], p0[10], p0[11], p0[12], p0[13], p0[14], p0[15]);
            pb[s][2] = pack8(p1[0], p1[1], p1[2], p1[3], p1[4], p1[5], p1[6], p1[7]); pb[s][3] = pack8(p1[8], p1[9], p1[10], p1[11], p1[12], p1[13], p1[14], p1[15]);
            if (s == 0) {
                __builtin_amdgcn_sched_barrier(0);
#pragma unroll
                for (int db = 0; db < 2; ++db)
#pragma unroll
                    for (int sp = 0; sp < 4; ++sp) o[0][db] = MFMA32(vf[db][sp], pb[0][sp], o[0][db]);
            }
        }
        __builtin_amdgcn_sched_barrier(0);
#pragma unroll
        for (int db = 0; db < 2; ++db)
#pragma unroll
            for (int sp = 0; sp < 4; ++sp) o[1][db] = MFMA32(vf[db][sp], pb[1][sp], o[1][db]);
        __builtin_amdgcn_sched_barrier(0);
    }
    const float l0 = ls[0] + shx(ls[0], 32, lane), l1 = ls[1] + shx(ls[1], 32, lane);
    const float i0 = 1.0f / l0, i1 = lam / l1;
    float ss = 0.f;
#pragma unroll
    for (int db = 0; db < 2; ++db)
#pragma unroll
        for (int r = 0; r < 16; ++r) { const float v = o[0][db][r] * i0 - o[1][db][r] * i1; o[0][db][r] = v; ss += v * v; }
    ss += shx(ss, 32, lane);
    const float rn = sub_mul / sqrtf(ss * (1.0f / 64.0f) + EPS);
    const float* subw = INP(A, I_SUBLN) + l * 64;
    bf16* yrow = Y + (size_t)qrow * D + hd * 64;
#pragma unroll
    for (int db = 0; db < 2; ++db)
#pragma unroll
        for (int g = 0; g < 4; ++g) { const int d0 = 32 * db + 8 * g + 4 * h; const f32x4 sw4 = *(const f32x4*)(subw + d0);
            v2u pk; pk.x = cvtpk(o[0][db][4 * g] * rn * sw4[0], o[0][db][4 * g + 1] * rn * sw4[1]); pk.y = cvtpk(o[0][db][4 * g + 2] * rn * sw4[2], o[0][db][4 * g + 3] * rn * sw4[3]);
            *(GAS v2u*)(yrow + d0) = pk; }
    __syncthreads();
}


__device__ __forceinline__ float sigm(float x) { return __builtin_amdgcn_rcpf(1.0f + __builtin_amdgcn_exp2f(-1.4426950408889634f * x)); }
template <int DIRB> __device__ __forceinline__ void grp_comp(const f32x16& a, const f32x16& b, int g, float& Ag, float& Bg) {
    const float a0 = a[4 * g], a1 = a[4 * g + 1], a2 = a[4 * g + 2], a3 = a[4 * g + 3], b0 = b[4 * g], b1 = b[4 * g + 1], b2 = b[4 * g + 2], b3 = b[4 * g + 3];
    Ag = (a0 * a1) * (a2 * a3);
    if (!DIRB) { float t = b0; t = a1 * t + b1; t = a2 * t + b2; t = a3 * t + b3; Bg = t; }
    else { float t = b3; t = a2 * t + b2; t = a1 * t + b1; t = a0 * t + b0; Bg = t; }
}
template <int DIRB> __device__ __forceinline__ void wave_comp(const f32x16& a, const f32x16& b, int h, int lane, float& Aw, float& Bw) {
    Aw = 1.f; Bw = 0.f;
#pragma unroll
    for (int gi = 0; gi < 4; ++gi) { const int g = DIRB ? 3 - gi : gi;
        float Ag, Bg; grp_comp<DIRB>(a, b, g, Ag, Bg);
        const float Ao = shx(Ag, 32, lane), Bo = shx(Bg, 32, lane);
        const float A0 = h ? Ao : Ag, B0 = h ? Bo : Bg, A1 = h ? Ag : Ao, B1 = h ? Bg : Bo;
        float Ap, Bp;
        if (!DIRB) { Ap = A0 * A1; Bp = A1 * B0 + B1; } else { Ap = A0 * A1; Bp = A0 * B1 + B0; }
        Bw = Ap * Bw + Bp; Aw *= Ap; }
}
template <int DIRB> __device__ __forceinline__ void scan_final(const f32x16& a, const f32x16& b, int h, int lane, float X, f32x16& hout) {
    float S = X;
#pragma unroll
    for (int gi = 0; gi < 4; ++gi) { const int g = DIRB ? 3 - gi : gi;
        float Ag, Bg; grp_comp<DIRB>(a, b, g, Ag, Bg);
        const float Ao = shx(Ag, 32, lane), Bo = shx(Bg, 32, lane);
        const float A0 = h ? Ao : Ag, B0 = h ? Bo : Bg, A1 = h ? Ag : Ao, B1 = h ? Bg : Bo;
        if (!DIRB) { float st = h ? (Ao * S + Bo) : S;
#pragma unroll
            for (int e = 0; e < 4; ++e) { st = a[4 * g + e] * st + b[4 * g + e]; hout[4 * g + e] = st; }
            S = A1 * (A0 * S + B0) + B1; }
        else { float st = h ? S : (Ao * S + Bo);
#pragma unroll
            for (int e = 3; e >= 0; --e) { st = a[4 * g + e] * st + b[4 * g + e]; hout[4 * g + e] = st; }
            S = A0 * (A1 * S + B1) + B0; } }
}
__device__ __forceinline__ void rglru_unit(Frame& F, const Args& A, int l, int mode, int seq, int n, int chunk, int pv = 0) {
    const bf16* Z = (const bf16*)(F.ws + WS_Z); bf16* Y = (bf16*)(F.ws + WS_Y); const bf16* RGWT = (const bf16*)(F.ws + WS_RGWT);
    float* CARRY = (float*)(F.ws + (l == 0 ? WS_CARRY : WS_CARRY1));
    unsigned* rg_cnt = (unsigned*)(F.ws + WS_CTL) + CW_RG + 16 * ((l * 8 + seq) * 4 + n);
    int lane; LANE_ID(lane); const int w = F.wave, r32 = lane & 31, h = lane >> 5;
    const bool lat = mode != 0; const int T = lat ? 2048 : 256; const int row0 = lat ? MC + seq * 2048 : seq * 256; const int t0 = chunk * 256 + w * 32;
    LAS float* comp = (LAS float*)F.lds;
    LAS float* xcar = (LAS float*)(F.lds + 8192);
    LAS float* xst = xcar + 128;
    LAS unsigned char* GR = F.lds + 16384 + w * 4096;
    LAS unsigned char* YO = F.lds + 16384 + 32768 + w * 4096;
    LAS float* CWL = (LAS float*)(F.lds + 81920 + w * 1280);
    const float* p_rgb = INP(A, I_RGB); const float* p_sp8 = (const float*)(F.ws + WS_SP8); const float* p_cw = INP(A, I_CCW) + l * 4 * 256; const float* p_cb = INP(A, I_CCB) + l * 256; const float* p_st = INP(A, I_ST);
    v4u gq[4];
    { const bf16* gp = Z + (size_t)(row0 + t0 + r32) * DIN + 1792 + n * 64 + h * 32;
#pragma unroll
        for (int q = 0; q < 4; ++q) gq[q] = *(const v4u*)(gp + 8 * q); }
    const int tk = t0 + r32;
    v4u zq[4][4];
#pragma unroll
    for (int ks = 0; ks < 4; ++ks) { const int c8 = n * 64 + 16 * ks + 8 * h;
#pragma unroll
        for (int j = 0; j < 4; ++j) { const int tt = tk + j - 2; const bool ok = tt >= 0 && tt < T; const int tc = ok ? tt : tk;
            zq[ks][j] = *(const v4u*)(Z + (size_t)(row0 + tc) * DIN + 1536 + c8); } }
    bf16x8_t wf[2][2][4];
#pragma unroll
    for (int dir = 0; dir < 2; ++dir)
#pragma unroll
        for (int gt = 0; gt < 2; ++gt) { const bf16* wp = RGWT + (size_t)((((l * 2 + dir) * 2 + gt) * 4 + n) * 4096) + r32 * 64 + 8 * h;
#pragma unroll
            for (int ks = 0; ks < 4; ++ks) wf[dir][gt][ks] = *(const bf16x8_t*)(wp + 16 * ks); }
    float cwv[5], kbr[2][2], kbi[2][2], ksp[2][2];
#pragma unroll
    for (int j = 0; j < 4; ++j) cwv[j] = ((const GAS float*)p_cw)[j * 256 + n * 64 + lane];
    cwv[4] = ((const GAS float*)p_cb)[n * 64 + lane];
#pragma unroll
    for (int hb = 0; hb < 2; ++hb)
#pragma unroll
        for (int dir = 0; dir < 2; ++dir) { const int c = n * 64 + 32 * hb + r32;
            kbr[hb][dir] = ((const GAS float*)p_rgb)[((l * 2 + dir) * 2 + 0) * 256 + c]; kbi[hb][dir] = ((const GAS float*)p_rgb)[((l * 2 + dir) * 2 + 1) * 256 + c]; ksp[hb][dir] = ((const GAS float*)p_sp8)[(l * 2 + dir) * 256 + c]; }
    float st0 = 0.f, st1 = 0.f;
    if (lat && w == 0) { const int c = n * 64 + lane; st0 = p_st[(size_t)((seq * 2 + l) * 2 + 0) * 256 + c]; st1 = p_st[(size_t)((seq * 2 + l) * 2 + 1) * 256 + c]; }
    __builtin_amdgcn_sched_barrier(0);
    if (lat && w == 0) { xst[lane] = st0; xst[64 + lane] = st1; }
#pragma unroll
    for (int q = 0; q < 4; ++q) *(LAS v4u*)(GR + r32 * 128 + (h * 4 + q) * 16) = gq[q];
#pragma unroll
    for (int j = 0; j < 5; ++j) CWL[j * 64 + lane] = cwv[j];
    bf16x8_t xa[4];
#pragma unroll
    for (int ks = 0; ks < 4; ++ks) { const int cl8 = 16 * ks + 8 * h; const f32x4 cb0 = *(const LAS f32x4*)(CWL + 4 * 64 + cl8), cb1 = *(const LAS f32x4*)(CWL + 4 * 64 + cl8 + 4);
        float x[8] = {cb0[0], cb0[1], cb0[2], cb0[3], cb1[0], cb1[1], cb1[2], cb1[3]};
#pragma unroll
        for (int j = 0; j < 4; ++j) { const int tt = tk + j - 2; const float k = (tt >= 0 && tt < T) ? 1.f : 0.f; const v4u z = zq[ks][j]; const f32x4 w0 = *(const LAS f32x4*)(CWL + j * 64 + cl8), w1 = *(const LAS f32x4*)(CWL + j * 64 + cl8 + 4);
            x[0] += k * w0[0] * bflo(z.x); x[1] += k * w0[1] * bfhi(z.x); x[2] += k * w0[2] * bflo(z.y); x[3] += k * w0[3] * bfhi(z.y);
            x[4] += k * w1[0] * bflo(z.z); x[5] += k * w1[1] * bfhi(z.z); x[6] += k * w1[2] * bflo(z.w); x[7] += k * w1[3] * bfhi(z.w); }
        xa[ks] = pack8(x[0], x[1], x[2], x[3], x[4], x[5], x[6], x[7]); }
#pragma unroll 1
    for (int cb2 = 0; cb2 < 2; ++cb2) {
        const int cl = 32 * cb2 + r32, c = n * 64 + cl;
        LAS float* cmp = comp + cb2 * 1024;
        float cbr[2], cbi[2], csp[2];
#pragma unroll
        for (int dir = 0; dir < 2; ++dir) { cbr[dir] = cb2 ? kbr[1][dir] : kbr[0][dir]; cbi[dir] = cb2 ? kbi[1][dir] : kbi[0][dir]; csp[dir] = cb2 ? ksp[1][dir] : ksp[0][dir]; }
        f32x16 xcD;
#pragma unroll
        for (int r = 0; r < 16; ++r) xcD[r] = 0.f;
#pragma unroll
        for (int ks = 0; ks < 4; ++ks) { const bool hit = (cl >> 3) == (2 * ks + h); const int e = r32 & 7;
            bf16x8_t idf;
#pragma unroll
            for (int q = 0; q < 8; ++q) idf[q] = (hit && e == q) ? (short)0x3F80 : (short)0;
            xcD = MFMA32(xa[ks], idf, xcD); }
        f32x16 av[2], bv[2];
#pragma unroll
        for (int dir = 0; dir < 2; ++dir) {
            f32x16 gr, gi; const float biasr = cbr[dir], biasi = cbi[dir];
#pragma unroll
            for (int r = 0; r < 16; ++r) { gr[r] = biasr; gi[r] = biasi; }
#pragma unroll
            for (int ks = 0; ks < 4; ++ks) { gr = MFMA32(xa[ks], wf[dir][0][ks], gr); gi = MFMA32(xa[ks], wf[dir][1][ks], gi); }
            if (cb2 == 0) {
#pragma unroll
                for (int gt = 0; gt < 2; ++gt) { const bf16* wp = RGWT + (size_t)((((l * 2 + dir) * 2 + gt) * 4 + n) * 4096) + (32 + r32) * 64 + 8 * h;
#pragma unroll
                    for (int ks = 0; ks < 4; ++ks) wf[dir][gt][ks] = *(const bf16x8_t*)(wp + 16 * ks); } }
            const float sp8 = csp[dir];
#pragma unroll
            for (int r = 0; r < 16; ++r) { const float rr = sigm(gr[r]), ii = sigm(gi[r]);
                const float a = __builtin_amdgcn_exp2f(-rr * sp8);
                av[dir][r] = a; bv[dir][r] = __builtin_amdgcn_sqrtf(fmaxf(1.0f - a * a, 0.f)) * ii * xcD[r]; }
        }
        { float Aw, Bw;
          wave_comp<0>(av[0], bv[0], h, lane, Aw, Bw); if (h == 0) { cmp[((0 * 8 + w) * 32 + r32) * 2] = Aw; cmp[((0 * 8 + w) * 32 + r32) * 2 + 1] = Bw; }
          wave_comp<1>(av[1], bv[1], h, lane, Aw, Bw); if (h == 0) { cmp[((1 * 8 + w) * 32 + r32) * 2] = Aw; cmp[((1 * 8 + w) * 32 + r32) * 2 + 1] = Bw; } }
        __syncthreads();
        if (w == 0 && h == 0) {
            float Af = 1.f, Bf = 0.f, Ab = 1.f, Bb = 0.f;
#pragma unroll
            for (int ww = 0; ww < 8; ++ww) { const float a0 = cmp[((0 * 8 + ww) * 32 + r32) * 2], b0 = cmp[((0 * 8 + ww) * 32 + r32) * 2 + 1]; Bf = a0 * Bf + b0; Af *= a0; }
#pragma unroll
            for (int ww = 7; ww >= 0; --ww) { const float a1 = cmp[((1 * 8 + ww) * 32 + r32) * 2], b1 = cmp[((1 * 8 + ww) * 32 + r32) * 2 + 1]; Bb = a1 * Bb + b1; Ab *= a1; }
            if (lat) { float* cp = CARRY + ((size_t)(((seq * 8 + chunk) * 4 + n) * 2) * 64 + cl) * 2;
                __hip_atomic_store((unsigned long long*)cp, ((unsigned long long)__float_as_uint(Bf) << 32) | __float_as_uint(Af), __ATOMIC_RELAXED, __HIP_MEMORY_SCOPE_AGENT);
                __hip_atomic_store((unsigned long long*)(cp + 128), ((unsigned long long)__float_as_uint(Bb) << 32) | __float_as_uint(Ab), __ATOMIC_RELAXED, __HIP_MEMORY_SCOPE_AGENT); }
            else { F.out[OUT_ST + (size_t)((seq * 2 + l) * 2 + 0) * 256 + c] = Bf; F.out[OUT_ST + (size_t)((seq * 2 + l) * 2 + 1) * 256 + c] = Bb; }
        }
        if (lat) {
            if (w == 0) {
                asm volatile("s_waitcnt vmcnt(0)" ::: "memory");
                if (lane == 0) __hip_atomic_fetch_add(rg_cnt + cb2, 1u, __ATOMIC_RELAXED, __HIP_MEMORY_SCOPE_AGENT);
                for (unsigned spins = 0; spins < (1u << 20); ++spins) { const unsigned cdone = (unsigned)__builtin_amdgcn_readfirstlane((int)__hip_atomic_load(rg_cnt + cb2, __ATOMIC_RELAXED, __HIP_MEMORY_SCOPE_AGENT)); if (cdone >= 8u) break; __builtin_amdgcn_s_sleep(1); }
                if (h == 0) {
                    unsigned long long cq[8];
#pragma unroll
                    for (int cc = 0; cc < 8; ++cc) cq[cc] = __hip_atomic_load((const unsigned long long*)(CARRY + ((size_t)(((seq * 8 + cc) * 4 + n) * 2 + (cc > chunk ? 1 : 0)) * 64 + cl) * 2), __ATOMIC_RELAXED, __HIP_MEMORY_SCOPE_AGENT);
                    float Xf = xst[cl], Xb = xst[64 + cl];
#pragma unroll
                    for (int cc = 0; cc < 8; ++cc) if (cc < chunk) Xf = __uint_as_float((unsigned)cq[cc]) * Xf + __uint_as_float((unsigned)(cq[cc] >> 32));
#pragma unroll
                    for (int cc = 7; cc >= 0; --cc) if (cc > chunk) Xb = __uint_as_float((unsigned)cq[cc]) * Xb + __uint_as_float((unsigned)(cq[cc] >> 32));
                    xcar[cl] = Xf; xcar[64 + cl] = Xb; } }
            __syncthreads(); }
        {
            float Xf = 0.f, Xb = 0.f; if (lat) { Xf = xcar[cl]; Xb = xcar[64 + cl]; }
#pragma unroll
            for (int ww = 0; ww < 8; ++ww) if (ww < w) Xf = cmp[((0 * 8 + ww) * 32 + r32) * 2] * Xf + cmp[((0 * 8 + ww) * 32 + r32) * 2 + 1];
#pragma unroll
            for (int ww = 7; ww >= 0; --ww) if (ww > w) Xb = cmp[((1 * 8 + ww) * 32 + r32) * 2] * Xb + cmp[((1 * 8 + ww) * 32 + r32) * 2 + 1];
            f32x16 hf, hb;
            scan_final<0>(av[0], bv[0], h, lane, Xf, hf); scan_final<1>(av[1], bv[1], h, lane, Xb, hb);
#pragma unroll
            for (int r = 0; r < 16; r += 2) { const int tl = (r & 3) + 8 * (r >> 2) + 4 * h;
                const float g0 = bf2f(*(const LAS unsigned short*)(GR + tl * 128 + cl * 2)), g1 = bf2f(*(const LAS unsigned short*)(GR + (tl + 1) * 128 + cl * 2));
                const float u0 = 2.0f * 0.7978845608028654f * (g0 + 0.044715f * g0 * g0 * g0), u1 = 2.0f * 0.7978845608028654f * (g1 + 0.044715f * g1 * g1 * g1);
                const unsigned pk = cvtpk((hf[r] + hb[r]) * g0 * sigm(u0), (hf[r + 1] + hb[r + 1]) * g1 * sigm(u1));
                *(LAS unsigned short*)(YO + tl * 128 + cl * 2) = (unsigned short)pk; *(LAS unsigned short*)(YO + (tl + 1) * 128 + cl * 2) = (unsigned short)(pk >> 16); }
        }
        __builtin_amdgcn_sched_barrier(0);
    }
    {
        bf16* yp = Y + (size_t)(row0 + t0 + r32) * D + 512 + n * 64 + h * 32;
#pragma unroll
        for (int q = 0; q < 4; ++q) *(GAS v4u*)(yp + 8 * q) = *(const LAS v4u*)(YO + r32 * 128 + (h * 4 + q) * 16);
    }
    __syncthreads();
}

__device__ __forceinline__ void pool_item(int WIN, const bf16* Z, bf16* Y, const bf16* PT, const float* pscale, int l, int tt, int g, int lane, LAS unsigned char* LP) {
    const int r32 = lane & 31, h = lane >> 5;
    const int rowt0 = tt * 32; const bool lat = rowt0 >= MC; const int T = lat ? 2048 : 256;
    const int seq0 = lat ? MC + ((rowt0 - MC) & ~2047) : (rowt0 & ~255); const int tpos0 = rowt0 - seq0, tpos = tpos0 + r32;
    const int left = WIN >> 1; const int lo = max(tpos - left, 0), hi = min(tpos + WIN - 1 - left, T - 1); const float inv = 1.0f / (float)(hi - lo + 1);
    const int NCH = (32 + WIN - 1) * 8;
    LAS unsigned char* TILE = LP; LAS unsigned char* YO = LP + 8192;
    const GAS bf16* zc = (const GAS bf16*)Z + (size_t)seq0 * DIN + 2048 + g * 64;
    bf16x8_t wq[2][4]; float sc[2];
#pragma unroll
    for (int cb2 = 0; cb2 < 2; ++cb2) { const int d = 32 * cb2 + r32; const GAS bf16* wt = (const GAS bf16*)PT + (size_t)(l * 4 + g) * 4096 + d * 64 + 8 * h;
#pragma unroll
        for (int ks = 0; ks < 4; ++ks) wq[cb2][ks] = *(const GAS bf16x8_t*)(wt + 16 * ks);
        sc[cb2] = ((const GAS float*)pscale)[l * 256 + g * 64 + d]; }
    v4u zt[6];
#pragma unroll
    for (int i = 0; i < 6; ++i) { int q = lane + 64 * i; q = q < NCH ? q : NCH - 1; const int row = q >> 3, c = q & 7; const int t2 = tpos0 - left + row; const int tc = (t2 >= 0 && t2 < T) ? t2 : tpos0;
        zt[i] = *(const GAS v4u*)(zc + (size_t)tc * DIN + 8 * c); }
#pragma unroll
    for (int i = 0; i < 6; ++i) { int q = lane + 64 * i; q = q < NCH ? q : NCH - 1; const int row = q >> 3, c = q & 7; *(LAS v4u*)(TILE + row * 144 + c * 16) = zt[i]; }
    float sm[4][8];
#pragma unroll
    for (int ks = 0; ks < 4; ++ks)
#pragma unroll
        for (int e = 0; e < 8; ++e) sm[ks][e] = 0.f;
    const LAS unsigned char* tp = TILE + r32 * 144 + h * 16;
#pragma unroll 1
    for (int j = 0; j < WIN; ++j) { const int t2 = tpos - left + j; const float k = (t2 >= 0 && t2 < T) ? 1.f : 0.f;
#pragma unroll
        for (int ks = 0; ks < 4; ++ks) { const v4u z = *(const LAS v4u*)(tp + j * 144 + ks * 32);
            sm[ks][0] += k * bflo(z.x); sm[ks][1] += k * bfhi(z.x); sm[ks][2] += k * bflo(z.y); sm[ks][3] += k * bfhi(z.y); sm[ks][4] += k * bflo(z.z); sm[ks][5] += k * bfhi(z.z); sm[ks][6] += k * bflo(z.w); sm[ks][7] += k * bfhi(z.w); } }
    bf16x8_t pa[4];
#pragma unroll
    for (int ks = 0; ks < 4; ++ks) { const v4u z0 = *(const LAS v4u*)(tp + left * 144 + ks * 32);
        pa[ks] = pack8(sm[ks][0] * inv - bflo(z0.x), sm[ks][1] * inv - bfhi(z0.x), sm[ks][2] * inv - bflo(z0.y), sm[ks][3] * inv - bfhi(z0.y), sm[ks][4] * inv - bflo(z0.z), sm[ks][5] * inv - bfhi(z0.z), sm[ks][6] * inv - bflo(z0.w), sm[ks][7] * inv - bfhi(z0.w)); }
#pragma unroll
    for (int cb2 = 0; cb2 < 2; ++cb2) { const int d = 32 * cb2 + r32;
        f32x16 acc;
#pragma unroll
        for (int r = 0; r < 16; ++r) acc[r] = 0.f;
#pragma unroll
        for (int ks = 0; ks < 4; ++ks) acc = MFMA32(pa[ks], wq[cb2][ks], acc);
        const float scd = sc[cb2];
#pragma unroll
        for (int r = 0; r < 16; r += 2) { const int row = rowt0 + (r & 3) + 8 * (r >> 2) + 4 * h; const unsigned pk = cvtpk(acc[r] * scd, acc[r + 1] * scd);
            const int tl = row - rowt0; *(LAS unsigned short*)(YO + tl * 128 + d * 2) = (unsigned short)pk; *(LAS unsigned short*)(YO + (tl + 1) * 128 + d * 2) = (unsigned short)(pk >> 16); } }
    { bf16* yp = Y + (size_t)(rowt0 + r32) * D + 768 + g * 64 + h * 32;
#pragma unroll
      for (int q = 0; q < 4; ++q) *(GAS v4u*)(yp + 8 * q) = *(const LAS v4u*)(YO + r32 * 128 + (h * 4 + q) * 16); }
}
__device__ __forceinline__ void mix_pool(Frame& F, const Args& A, int l) {
    PHASE_IDS(F);
    const bf16* Z = (const bf16*)(F.ws + WS_Z); bf16* Y = (bf16*)(F.ws + WS_Y); const bf16* PT = (const bf16*)(F.ws + WS_POOLT); const float* ps = INP(A, I_POOLS);
    const int gw = F.vcu * NWAVES + F.wave, NGW = F.G * NWAVES;
    const int hgw = (F.G >> 1) * NWAVES;
    const bool heavy = F.vcu < (F.G >> 1); const int hw = heavy ? gw : gw - hgw;
    for (int k = 0; k < 3; ++k) { int it;
        if (F.G == 256) { if (heavy) { if (k > 0) break; it = hw; } else { if (k > 1) break; it = hgw + k * hgw + hw; } }
        else { it = gw + k * NGW; }
        if (it >= (M / 32) * 4) break;
        const int g = it / (M / 32), tt = it % (M / 32);
        LAS unsigned char* yo = F.lds + F.wave * 12288;
        pool_item(2 << g, Z, Y, PT, ps, l, tt, g, F.lane, yo); }
    __syncthreads();
}
__device__ __forceinline__ void mix_conv(Frame& F, const Args& A, int l) {
    PHASE_IDS(F);
    const GAS bf16* Z = (const GAS bf16*)(F.ws + WS_Z); bf16* Y = (bf16*)(F.ws + WS_Y); const GAS float* cw = (const GAS float*)(INP(A, I_CBW) + l * 3 * 256);
    const int gt = F.vcu * 512 + F.tid, NGT = F.G * 512;
    for (int i = gt; i < (M / 8) * 32; i += NGT) {
        const int tg = i >> 5, c8 = (i & 31) * 8; const int r0 = tg * 8; const bool lat = r0 >= MC; const int T = lat ? 2048 : 256; const int t0 = lat ? ((r0 - MC) & 2047) : (r0 & 255);
        f32x4 wv[3][2];
#pragma unroll
        for (int j = 0; j < 3; ++j) { wv[j][0] = *(const GAS f32x4*)(cw + j * 256 + c8); wv[j][1] = *(const GAS f32x4*)(cw + j * 256 + c8 + 4); }
        v4u za[10], zb[10], zg[8];
#pragma unroll
        for (int k = 0; k < 10; ++k) { const int t = t0 - 1 + k; const bool ok = t >= 0 && t < T; const int tc = ok ? t : t0; const GAS bf16* zp = Z + (size_t)(r0 - t0 + tc) * DIN + c8;
            za[k] = *(const GAS v4u*)(zp + 1024); zb[k] = *(const GAS v4u*)(zp + 1280); }
#pragma unroll
        for (int q = 0; q < 8; ++q) zg[q] = *(const GAS v4u*)(Z + (size_t)(r0 + q) * DIN + 768 + c8);
        float w[3][8];
#pragma unroll
        for (int j = 0; j < 3; ++j) { w[j][0] = wv[j][0][0]; w[j][1] = wv[j][0][1]; w[j][2] = wv[j][0][2]; w[j][3] = wv[j][0][3]; w[j][4] = wv[j][1][0]; w[j][5] = wv[j][1][1]; w[j][6] = wv[j][1][2]; w[j][7] = wv[j][1][3]; }
        float pm[8], pc[8], pn[8];
        auto prod = [&](int k, float (&o)[8]) { const int t = t0 - 1 + k; const float kk = (t >= 0 && t < T) ? 1.f : 0.f; const v4u a = za[k], b = zb[k];
            o[0] = kk * bflo(a.x) * bflo(b.x); o[1] = kk * bfhi(a.x) * bfhi(b.x); o[2] = kk * bflo(a.y) * bflo(b.y); o[3] = kk * bfhi(a.y) * bfhi(b.y);
            o[4] = kk * bflo(a.z) * bflo(b.z); o[5] = kk * bfhi(a.z) * bfhi(b.z); o[6] = kk * bflo(a.w) * bflo(b.w); o[7] = kk * bfhi(a.w) * bfhi(b.w); };
        prod(0, pm); prod(1, pc);
#pragma unroll
        for (int q = 0; q < 8; ++q) { prod(q + 2, pn);
            const v4u gb = zg[q];
            const float g[8] = {bflo(gb.x), bfhi(gb.x), bflo(gb.y), bfhi(gb.y), bflo(gb.z), bfhi(gb.z), bflo(gb.w), bfhi(gb.w)};
            float o[8];
#pragma unroll
            for (int e = 0; e < 8; ++e) { o[e] = g[e] * (w[0][e] * pm[e] + w[1][e] * pc[e] + w[2][e] * pn[e]); pm[e] = pc[e]; pc[e] = pn[e]; }
            v4u ov; ov.x = cvtpk(o[0], o[1]); ov.y = cvtpk(o[2], o[3]); ov.z = cvtpk(o[4], o[5]); ov.w = cvtpk(o[6], o[7]);
            *(GAS v4u*)(Y + (size_t)(r0 + q) * D + 256 + c8) = ov; }
    }
}

#define GEMM_PHASE(EPI, g, E, MM, NN) do { pg8::StaticOrder S_; S_.init((MM), (NN), F.G, (int)blockIdx.x, 0); \
    pg8::gemm_phase<EPI, pg8::StaticOrder, true, true, false>(F.lds, (g), S_, (E), F.wave0); \
    if (S_.splits()) { pg8::StaticOrder S1_; S1_.init((MM), (NN), F.G, (int)blockIdx.x, 1); pg8::gemm_phase<EPI, pg8::StaticOrder, true, true, true>(F.lds, (g), S1_, (E), F.wave0); } } while (0)

constexpr int PH_PER_LAYER = 8, NPHASE = 2 + 2 * PH_PER_LAYER + 1;
__global__ void __launch_bounds__(NWAVES * 64, 2) fwd_kernel(Args args) {
    extern __shared__ __attribute__((aligned(16))) unsigned char lds[];
    Frame F;
    F.lds = (LAS unsigned char*)lds; F.lds0 = F.lds; F.tid = threadIdx.x; F.lane = F.tid & 63; F.wave = __builtin_amdgcn_readfirstlane(F.tid >> 6); F.wave0 = F.wave;
    F.G = gridDim.x; { const int bx = blockIdx.x; F.vcu = (F.G % 8 == 0) ? (bx % 8) * (F.G / 8) + bx / 8 : bx; F.vcu0 = F.vcu; }
    F.out = args.out; F.ws = args.ws; F.out0 = args.out; F.ws0 = args.ws;
    volatile LAS unsigned* MISC = (volatile LAS unsigned*)(F.lds + MISC_OFF);
    for (int u = F.tid; u < (LDS_BYTES - LDSCTL_OFF) / 4; u += NWAVES * 64) ((LAS unsigned*)(F.lds + LDSCTL_OFF))[u] = 0u;
    __syncthreads();
    if (F.tid < 25) { const unsigned long long pv = (unsigned long long)args.in[F.tid]; ((LAS unsigned*)(F.lds + LDSCTL_OFF))[2 * F.tid] = (unsigned)pv; ((LAS unsigned*)(F.lds + LDSCTL_OFF))[2 * F.tid + 1] = (unsigned)(pv >> 32); }
    __syncthreads();
    XcdBarrier bar; bar.bar = (unsigned*)(args.ws + WS_CTL) + CW_BAR; bar.x = 0; bar.st = nullptr;
#if !MK_PER_PHASE
    bar = xcd_barrier_post((unsigned*)(args.ws + WS_CTL) + CW_BAR, MISC + 8);
#endif
#if MK_PER_PHASE
    const int lo = args.ph_lo, hi = args.ph_hi;
#define IN(k) (lo <= (k) && (k) < hi)
#define SEAM(k) do { } while (0)
#else
#define IN(k) true
#define SEAM(k) xcd_barrier(bar)
#endif
    REP(4) { if (IN(0)) { p0_prologue(F, args); } SEAM(0); }

    REP(3) { if (IN(1)) { prep0_phase(F, args); } SEAM(1); }
    for (int l = 0; l < 2; ++l) {
        const int pb = 2 + l * PH_PER_LAYER;
        REP(0) if (IN(pb + 0)) { PHASE_IDS(F);
            pg8::Gemm g{(const bf16*)((const unsigned char*)F.out + OUT_XN_BYTES), (const bf16*)(F.ws + WS_WIN) + (size_t)l * DIN * D, M, DIN, D};
            pg8::EpiIn E{(bf16*)(F.ws + WS_Z), (const float*)(F.ws + WS_ROPE), F.out + OUT_CK, F.out + OUT_CV, l, (const float*)(F.ws + WS_SS) + (size_t)(l == 0 ? 0 : 2) * M, (const float*)(F.ws + WS_SW) + (size_t)l * 9 * 2304};
            GEMM_PHASE(pg8::EpiIn, g, E, M, DIN);
            SEAM(pb + 0); }
        if (IN(pb + 1)) {
            PHASE_IDS(F); const float lam = ((const float*)(F.ws + WS_LAM))[l]; const float sub_mul = 1.0f - (0.8f - 0.6f * expf(-0.3f * (float)l));
            for (int u = F.vcu; u < 512; u += F.G) {
                if (u >= 384) { const int v = u - 384; attn_unit(F, args, l, false, v >> 2, v & 3, 0, lam, sub_mul); }
                else { const int mode = u < 256 ? 1 : 0; const int v = u < 256 ? u : u - 256; rglru_unit(F, args, l, mode, mode == 0 ? (v >> 2) : (v >> 5), mode == 0 ? (v & 3) : ((v >> 3) & 3), mode == 0 ? 0 : (v & 7)); } }
            mix_conv(F, args, l); mix_pool(F, args, l);
            PHASE_IDS(F);
            for (int u = F.vcu; u < 256; u += F.G) attn_unit(F, args, l, true, u >> 5, (u >> 3) & 3, u & 7, lam, sub_mul);
        } SEAM(pb + 1);
        if (IN(pb + 3)) { PHASE_IDS(F); const float* modl = (const float*)(F.ws + WS_MOD) + (size_t)l * 9 * 6144;
            pg8::Gemm g{(const bf16*)(F.ws + WS_Y), (const bf16*)(F.ws + WS_WOUT) + (size_t)l * D * D, M, D, D};
            bf16* XR = (bf16*)(F.ws + WS_XR); bf16* XNp = (bf16*)((unsigned char*)F.out + OUT_XN_BYTES);
            if (l == 0) { pg8::EpiGateRes<false> E{(const void*)INP(args, I_XP), (const void*)(INP(args, I_XS) - (size_t)MC * D), XR, modl + 2048, 0, XNp, INP(args, I_NORMW) + (size_t)(l * 2 + 1) * D, modl + 4096, (float*)(F.ws + WS_SS) + (size_t)1 * M};
                GEMM_PHASE(pg8::EpiGateRes<false>, g, E, M, D); }
            else { pg8::EpiGateRes<true> E{(const void*)XR, (const void*)XR, XR, modl + 2048, 0, XNp, INP(args, I_NORMW) + (size_t)(l * 2 + 1) * D, modl + 4096, (float*)(F.ws + WS_SS) + (size_t)3 * M};
                GEMM_PHASE(pg8::EpiGateRes<true>, g, E, M, D); }
        } SEAM(pb + 3);
        for (int hf = 0; hf < 2; ++hf) {
            const int mrow0 = hf == 0 ? 0 : MP0, mrows = hf == 0 ? MP0 : M - MP0;
            REP(2) if (IN(pb + 4 + 2 * hf)) { PHASE_IDS(F);
                pg8::Gemm g{(const bf16*)((const unsigned char*)F.out + OUT_XN_BYTES) + (size_t)mrow0 * D, (const bf16*)(F.ws + WS_W1) + (size_t)l * DFF * D, mrows, DFF, D};
                pg8::EpiRelu2 E{(bf16*)(F.ws + WS_Y), (const float*)(F.ws + WS_SS) + (size_t)(l == 0 ? 1 : 3) * M, (const float*)(F.ws + WS_SW) + 2 * 9 * 2304 + (size_t)l * 9 * 4096, mrow0};
                GEMM_PHASE(pg8::EpiRelu2, g, E, mrows, DFF);
                SEAM(pb + 4 + 2 * hf); }
            if (IN(pb + 5 + 2 * hf)) { PHASE_IDS(F); const float* modl = (const float*)(F.ws + WS_MOD) + (size_t)l * 9 * 6144;
                pg8::Gemm g{(const bf16*)(F.ws + WS_Y), (const bf16*)(F.ws + WS_W2) + (size_t)l * D * DFF, mrows, D, DFF};
                bf16* XR = (bf16*)(F.ws + WS_XR);
                if (l == 0) {
                    pg8::EpiGateRes<true> E{(const void*)XR, (const void*)XR, XR, modl + 5120, mrow0, (bf16*)((unsigned char*)F.out + OUT_XN_BYTES), INP(args, I_NORMW) + (size_t)2 * D, modl + 9 * 6144 + 1024, (float*)(F.ws + WS_SS) + (size_t)2 * M};
                    GEMM_PHASE(pg8::EpiGateRes<true>, g, E, mrows, D); }
                else {
                    pg8::EpiFinal E{XR, F.out, modl + 5120, mrow0, INP(args, I_FNW), (float*)(F.ws + WS_SS) + (size_t)4 * M, (unsigned*)(F.ws + WS_CTL) + CW_FIN};
                    GEMM_PHASE(pg8::EpiFinal, g, E, mrows, D); }
            } if (!(l == 1 && hf == 1)) SEAM(pb + 5 + 2 * hf);
        }
    }
    if ((PROBE_REP >> 12) & 1) { for (int q = 0; q < 20; ++q) xcd_barrier(bar); }

#undef IN
#undef SEAM
}

extern "C" void kernel_launch(void* const* d_in, const int* in_sizes, int n_in, void* d_out, int out_size, void* d_ws, size_t ws_size, hipStream_t stream) {
    static int grid = 0;
    if (grid == 0) {
        if (n_in != 25 || out_size != (int)(OUT_ST + 32 * 2 * 2 * 256) || ws_size < WS_END) { fprintf(stderr, "kernel_launch: unexpected shapes (n_in %d out %d ws %zu)\n", n_in, out_size, ws_size); grid = -1; return; }
        int dev = 0, cus = 0;
        if (hipGetDevice(&dev) != hipSuccess || hipDeviceGetAttribute(&cus, hipDeviceAttributeMultiprocessorCount, dev) != hipSuccess) { grid = -1; return; }
        if (hipFuncSetAttribute((const void*)fwd_kernel, hipFuncAttributeMaxDynamicSharedMemorySize, LDS_BYTES) != hipSuccess) { fprintf(stderr, "kernel_launch: hipFuncSetAttribute failed\n"); grid = -1; return; }
        int per_cu = 0;
        if (hipOccupancyMaxActiveBlocksPerMultiprocessor(&per_cu, (const void*)fwd_kernel, NWAVES * 64, LDS_BYTES) != hipSuccess || per_cu < 1) fprintf(stderr, "kernel_launch: occupancy query says %d\n", per_cu);
        (void)hipGetLastError();
        if (cus != 256) { fprintf(stderr, "kernel_launch: this kernel is laid out for a 256-CU grid (prep0's shift-row slots, the fused final norm's one-unit-per-workgroup phase); the device reports %d CUs\n", cus); grid = -1; return; }
        grid = cus;
    }
    if (grid < 0) return;
    (void)hipMemsetAsync((char*)d_ws + WS_CTL, 0, CTL_ZERO_BYTES, stream);
    Args a{};
    for (int i = 0; i < 25; ++i) a.in[i] = (const float*)d_in[i];
    a.out = (float*)d_out; a.ws = (unsigned char*)d_ws;
#if MK_PER_PHASE
    for (int p = 0; p < NPHASE; ++p) { a.ph_lo = p; a.ph_hi = p + 1; hipLaunchKernelGGL(fwd_kernel, dim3(grid), dim3(NWAVES * 64), LDS_BYTES, stream, a); }
#else
    a.ph_lo = 0; a.ph_hi = NPHASE; hipLaunchKernelGGL(fwd_kernel, dim3(grid), dim3(NWAVES * 64), LDS_BYTES, stream, a);
#endif
}
```

```cpp
#include <hip/hip_runtime.h>
#include <cstdio>
#include <cstdint>

#ifndef PROBE_REP
#define PROBE_REP 0
#endif
#ifndef PROBE_VAR
#define PROBE_VAR 0
#endif
#define REP(bit) for (int rep_ = 0; rep_ < (((PROBE_REP) >> (bit)) & 1) + 1; ++rep_)
#ifndef MK_PER_PHASE
#define MK_PER_PHASE 0
#endif


#define LANE_ID(v) asm volatile("v_mbcnt_lo_u32_b32 %0, -1, 0\n\tv_mbcnt_hi_u32_b32 %0, -1, %0" : "=v"(v))
__device__ __forceinline__ float shx(float v, int mask, int lane) { return __builtin_bit_cast(float, __builtin_amdgcn_ds_bpermute((lane ^ mask) << 2, __builtin_bit_cast(int, v))); }
__device__ __forceinline__ float shidx(float v, int src) { return __builtin_bit_cast(float, __builtin_amdgcn_ds_bpermute(src << 2, __builtin_bit_cast(int, v))); }

namespace pg8 {
#define PG8_LAS __attribute__((address_space(3)))
typedef unsigned short bf16_t;
typedef short bf16x8 __attribute__((ext_vector_type(8)));
typedef float f32x4 __attribute__((ext_vector_type(4)));
typedef unsigned u32x4 __attribute__((ext_vector_type(4)));
constexpr int BM = 256, BK = 64, HALF = 128, HTB = HALF * BK * 2, STAGE_BYTES = 8 * HTB, NXCD = 8, WGM = 8;

__host__ __device__ __forceinline__ int lds_byte(int r, int c) { const int st = (r >> 4) * 2 + (c >> 5), rr = r & 15, cc = c & 31, ob = rr * 64 + cc * 2; return st * 1024 + (ob ^ (((ob >> 9) & 1) << 5)); }
__host__ __device__ __forceinline__ void stage_rc(int b, int& R, int& C) { const int st = b / 1024, sb = b % 1024, swz = sb ^ (((sb >> 9) & 1) << 5); R = (st >> 1) * 16 + swz / 64; C = (st & 1) * 32 + (swz % 64) / 2; }
__host__ __device__ __forceinline__ int perm32(int rho) { const int n = rho >> 4, i = rho & 15; return 8 * (i >> 2) + 4 * n + (i & 3); }

struct Unit { int pm, pn, single, sub; };
struct Gemm { const bf16_t* A; const bf16_t* Bt; int M, N, K; };

struct StaticOrder {
    int nM, nN, nwg, G, c, R, rem, part;
    __host__ __device__ void init(int M, int N, int G_, int c_, int part_ = 0) { nM = M / BM; nN = N / BM; nwg = nM * nN; G = G_; c = c_; R = nwg / G; rem = nwg - R * G; part = part_; }
    __host__ __device__ bool splits() const { return rem > 0 && 2 * rem <= G; }
    __host__ __device__ bool next(int i, Unit& u) const {
        long L; u.single = 0; u.sub = 0;
        if (part == 0) { if (i < R) L = (long)i * G + c; else if (i == R && rem > 0 && !splits()) { L = (long)R * G + c; if (L >= nwg) return false; } else return false; }
        else { if (i != 0 || !splits() || c >= 2 * rem) return false; L = (long)R * G + (c >> 1); u.single = 1; u.sub = c & 1; }
        int wgid = (int)L; { const int q = nwg / NXCD, r = nwg % NXCD, xcd = wgid % NXCD, off = wgid / NXCD; wgid = (xcd < r ? xcd * (q + 1) : r * (q + 1) + (xcd - r) * q) + off; }
        const int nig = WGM * nN, gid = wgid / nig, fm = gid * WGM, gsz = (nM - fm) < WGM ? (nM - fm) : WGM;
        u.pm = fm + ((wgid % nig) % gsz); u.pn = (wgid % nig) / gsz; return true;
    }
    __device__ __forceinline__ void a_ready(const Unit&) const {}
    __device__ __forceinline__ void done(const Unit&) const {}
};

__device__ __forceinline__ unsigned cvt_pk_bf16(float lo, float hi) { unsigned r; asm volatile("v_cvt_pk_bf16_f32 %0, %1, %2" : "=v"(r) : "v"(lo), "v"(hi)); return r; }

template <bool WT> __device__ __forceinline__ void st16(void* p, u32x4 v) {
    if constexpr (WT) asm volatile("global_store_dwordx4 %0, %1, off sc1\n\ts_nop 1" :: "v"(p), "v"(v) : "memory");     else *(__attribute__((address_space(1))) u32x4*)p = v; }
template <bool WT> __device__ __forceinline__ void st16(void* p, f32x4 v) { st16<WT>(p, __builtin_bit_cast(u32x4, v)); }


struct EpiIn {
    static constexpr bool PERM = true, AFTER_DRAIN = false;
    bf16_t* Z; const float* rope; const float* ss; const float* sw;
    template <bool WT> __device__ __forceinline__ void run(const f32x4 (&acc)[2][2][4][2], const Unit& u, int wr, int wc, int fr, int fq) const {
        asm volatile("" : "+v"(fr), "+v"(fq));
        const int pn = u.pn; const bool lat = u.pm >= 32; const bool dorope = lat && pn <= 1;
        const int row0 = u.pm * BM + (u.single ? u.sub * HALF : 0) + wr * 64 + fr; const int colw = wc * 32 + 8 * fq;
        const float qs = (pn == 0) ? 0.25503486f : 1.0f;
        const int mi = u.pm < 32 ? 0 : 1 + ((u.pm - 32) >> 3);
        f32x4 swv[2][2];
#pragma unroll
        for (int bj = 0; bj < 2; ++bj)
#pragma unroll
            for (int n = 0; n < 2; ++n) swv[bj][n] = *(const f32x4*)(sw + (size_t)mi * 2304 + pn * BM + bj * HALF + colw + 4 * n);
        float ssv[2][4];
#pragma unroll
        for (int ai = 0; ai < 2; ++ai)
#pragma unroll
            for (int m = 0; m < 4; ++m) ssv[ai][m] = ss[row0 + (u.single ? 0 : ai) * HALF + m * 16];
        f32x4 cs[4], csn[4];
        if (dorope) { const int t = (row0 - 8192) & 2047; const int pos = (fq >> 1) ? (t & 63) : (t >> 6); const f32x4* rp = (const f32x4*)(rope + pos * 16);
#pragma unroll
            for (int e = 0; e < 4; ++e) cs[e] = rp[e]; }
#pragma unroll
        for (int ai = 0; ai < 2; ++ai) { if (ai == 1 && u.single) break;
#pragma unroll
            for (int m = 0; m < 4; ++m) {
                const int row = row0 + ai * HALF + m * 16;
                const float rs = 1.0f / sqrtf(ssv[ai][m] * (1.0f / 1024.0f) + 1e-6f);
                if (dorope && !(ai == 1 && m == 3)) { const int rown = row0 + (m == 3 ? HALF : ai * HALF + (m + 1) * 16); const int t = (rown - 8192) & 2047; const int pos = (fq >> 1) ? (t & 63) : (t >> 6);
                    const f32x4* rp = (const f32x4*)(rope + pos * 16);
#pragma unroll
                    for (int e = 0; e < 4; ++e) csn[e] = rp[e]; }
#pragma unroll
                for (int bj = 0; bj < 2; ++bj) {
                    float v[8];
#pragma unroll
                    for (int e = 0; e < 4; ++e) { v[e] = acc[ai][bj][m][0][e] * rs + swv[bj][0][e]; v[4 + e] = acc[ai][bj][m][1][e] * rs + swv[bj][1][e]; }
                    if (dorope) {
#pragma unroll
                        for (int e = 0; e < 8; ++e) { const float pr = shx(v[e], 16, fr + 16 * fq); const float c = cs[e >> 1][(e & 1) * 2], s = cs[e >> 1][(e & 1) * 2 + 1];
                            v[e] = (fq & 1) ? (v[e] * c + pr * s) : (v[e] * c - pr * s); }
                    }
                    u32x4 w; w.x = cvt_pk_bf16(v[0] * qs, v[1] * qs); w.y = cvt_pk_bf16(v[2] * qs, v[3] * qs); w.z = cvt_pk_bf16(v[4] * qs, v[5] * qs); w.w = cvt_pk_bf16(v[6] * qs, v[7] * qs);
                    st16<WT>(Z + (size_t)row * 2304 + pn * BM + bj * HALF + colw, w);
                }
                if (dorope && !(ai == 1 && m == 3)) {
#pragma unroll
                    for (int e = 0; e < 4; ++e) cs[e] = csn[e]; }
            } }
    }
};
__device__ __forceinline__ void unpack8(const u32x4 w, float (&o)[8]) {
    o[0] = __uint_as_float(w.x << 16); o[1] = __uint_as_float(w.x & 0xffff0000u); o[2] = __uint_as_float(w.y << 16); o[3] = __uint_as_float(w.y & 0xffff0000u);
    o[4] = __uint_as_float(w.z << 16); o[5] = __uint_as_float(w.z & 0xffff0000u); o[6] = __uint_as_float(w.w << 16); o[7] = __uint_as_float(w.w & 0xffff0000u); }
template <bool RES_BF16> struct EpiGateRes {
    static constexpr bool PERM = true, AFTER_DRAIN = false;
    const void* res_c; const void* res_l; bf16_t* xr; const float* gate; int rowbase;
    bf16_t* xs; const float* nw; const float* nscale; float* ssq;
    template <bool WT> __device__ __forceinline__ void run(const f32x4 (&acc)[2][2][4][2], const Unit& u, int wr, int wc, int fr, int fq) const {
        asm volatile("" : "+v"(fr), "+v"(fq));
        const int grow0 = rowbase + u.pm * BM; const int mi = grow0 < 8192 ? 0 : 1 + ((grow0 - 8192) >> 11);
        const void* res = grow0 < 8192 ? res_c : res_l;
        const int row0 = grow0 + (u.single ? u.sub * HALF : 0) + wr * 64 + fr, col0 = u.pn * BM + wc * 32 + 8 * fq;
        f32x4 gv[2][2], fv[2][2];
#pragma unroll
        for (int bj = 0; bj < 2; ++bj)
#pragma unroll
            for (int n = 0; n < 2; ++n) { gv[bj][n] = *(const f32x4*)(gate + (size_t)mi * 6144 + col0 + bj * HALF + 4 * n);
                if (xs) { const f32x4 w = *(const f32x4*)(nw + col0 + bj * HALF + 4 * n); f32x4 f = w;
                    if (nscale) { const f32x4 sc = *(const f32x4*)(nscale + (size_t)mi * 6144 + col0 + bj * HALF + 4 * n); f = w * (sc + 1.0f); }
                    fv[bj][n] = f; } }
        constexpr int RD = RES_BF16 ? 3 : 2;
        u32x4 rb[8][2]; f32x4 rf[8][4];
#define EGR_FETCH(c) do { const size_t o_ = (size_t)(row0 + (u.single ? 0 : ((c) >> 2)) * HALF + ((c) & 3) * 16) * 1024 + col0; _Pragma("unroll") for (int bj = 0; bj < 2; ++bj) { \
            if (RES_BF16) rb[c][bj] = *(const u32x4*)((const bf16_t*)res + o_ + bj * HALF); \
            else { rf[c][2 * bj] = *(const f32x4*)((const float*)res + o_ + bj * HALF); rf[c][2 * bj + 1] = *(const f32x4*)((const float*)res + o_ + bj * HALF + 4); } } } while (0)
#pragma unroll
        for (int c = 0; c < RD; ++c) EGR_FETCH(c);
#pragma unroll
        for (int ai = 0; ai < 2; ++ai) { if (ai == 1 && u.single) break;
#pragma unroll
            for (int m = 0; m < 4; ++m) { const size_t off = (size_t)(row0 + ai * HALF + m * 16) * 1024 + col0; const int c = ai * 4 + m;
                if (c + RD < 8) EGR_FETCH(c + RD);
                float sq = 0.f;
#pragma unroll
                for (int bj = 0; bj < 2; ++bj) { float r[8];
                    if (RES_BF16) unpack8(rb[c][bj], r);
                    else { const f32x4 r0 = rf[c][2 * bj], r1 = rf[c][2 * bj + 1];
                        r[0] = r0[0]; r[1] = r0[1]; r[2] = r0[2]; r[3] = r0[3]; r[4] = r1[0]; r[5] = r1[1]; r[6] = r1[2]; r[7] = r1[3]; }
                    float x[8];
#pragma unroll
                    for (int e = 0; e < 4; ++e) { x[e] = r[e] + gv[bj][0][e] * acc[ai][bj][m][0][e]; x[4 + e] = r[4 + e] + gv[bj][1][e] * acc[ai][bj][m][1][e]; }
#pragma unroll
                    for (int e = 0; e < 8; ++e) sq += x[e] * x[e];
                    u32x4 w; w.x = cvt_pk_bf16(x[0], x[1]); w.y = cvt_pk_bf16(x[2], x[3]); w.z = cvt_pk_bf16(x[4], x[5]); w.w = cvt_pk_bf16(x[6], x[7]);
                    st16<WT>(xr + off + bj * HALF, w);
                    if (xs) { u32x4 v; v.x = cvt_pk_bf16(x[0] * fv[bj][0][0], x[1] * fv[bj][0][1]); v.y = cvt_pk_bf16(x[2] * fv[bj][0][2], x[3] * fv[bj][0][3]);
                        v.z = cvt_pk_bf16(x[4] * fv[bj][1][0], x[5] * fv[bj][1][1]); v.w = cvt_pk_bf16(x[6] * fv[bj][1][2], x[7] * fv[bj][1][3]); st16<WT>(xs + off + bj * HALF, v); } }
                if (ssq) { const int ln = fr + 16 * fq; sq += shx(sq, 16, ln); sq += shx(sq, 32, ln); if (fq == 0) atomicAdd(ssq + row0 + ai * HALF + m * 16, sq); } } }
#undef EGR_FETCH
    }
};
struct EpiFinal {
    static constexpr bool PERM = true, AFTER_DRAIN = false;
    const bf16_t* res; float* out; const float* gate; int rowbase; const float* nw; float* ssq; unsigned* fin_cnt;
    template <bool WT> __device__ __forceinline__ void run(const f32x4 (&acc_c)[2][2][4][2], const Unit& u, int wr, int wc, int fr, int fq) const {
        asm volatile("" : "+v"(fr), "+v"(fq));
        f32x4 (&acc)[2][2][4][2] = const_cast<f32x4 (&)[2][2][4][2]>(acc_c);
        const int grow0 = rowbase + u.pm * BM; const int mi = grow0 < 8192 ? 0 : 1 + ((grow0 - 8192) >> 11);
        const int row0 = grow0 + (u.single ? u.sub * HALF : 0) + wr * 64 + fr, col0 = u.pn * BM + wc * 32 + 8 * fq; const int ln = fr + 16 * fq;
        f32x4 gv[2][2];
#pragma unroll
        for (int bj = 0; bj < 2; ++bj)
#pragma unroll
            for (int n = 0; n < 2; ++n) gv[bj][n] = *(const f32x4*)(gate + (size_t)mi * 6144 + col0 + bj * HALF + 4 * n);
        u32x4 rb[8][2];
#define EFN_FETCH(c) do { const size_t o_ = (size_t)(row0 + (u.single ? 0 : ((c) >> 2)) * HALF + ((c) & 3) * 16) * 1024 + col0; _Pragma("unroll") for (int bj = 0; bj < 2; ++bj) rb[c][bj] = *(const u32x4*)(res + o_ + bj * HALF); } while (0)
#pragma unroll
        for (int c = 0; c < 3; ++c) EFN_FETCH(c);
#pragma unroll
        for (int ai = 0; ai < 2; ++ai) { if (ai == 1 && u.single) break;
#pragma unroll
            for (int m = 0; m < 4; ++m) { const int c = ai * 4 + m; float sq = 0.f;
                if (c + 3 < 8) EFN_FETCH(c + 3);
#pragma unroll
                for (int bj = 0; bj < 2; ++bj) { float r[8]; unpack8(rb[c][bj], r);
#pragma unroll
                    for (int e = 0; e < 4; ++e) { const float x0 = r[e] + gv[bj][0][e] * acc[ai][bj][m][0][e], x1 = r[4 + e] + gv[bj][1][e] * acc[ai][bj][m][1][e];
                        acc[ai][bj][m][0][e] = x0; acc[ai][bj][m][1][e] = x1; sq += x0 * x0 + x1 * x1; } }
                sq += shx(sq, 16, ln); sq += shx(sq, 32, ln); if (fq == 0) atomicAdd(ssq + row0 + ai * HALF + m * 16, sq); } }
#undef EFN_FETCH
        asm volatile("s_waitcnt vmcnt(0)" ::: "memory");
        const int hp0 = (grow0 >> 7) + (u.single ? u.sub : 0);
        if (ln == 0) { __hip_atomic_fetch_add(fin_cnt + 16 * hp0, 1u, __ATOMIC_RELAXED, __HIP_MEMORY_SCOPE_AGENT); if (!u.single) __hip_atomic_fetch_add(fin_cnt + 16 * (hp0 + 1), 1u, __ATOMIC_RELAXED, __HIP_MEMORY_SCOPE_AGENT); }
        for (unsigned spins = 0; spins < (1u << 20); ++spins) {
            unsigned c0 = __hip_atomic_load(fin_cnt + 16 * hp0, __ATOMIC_RELAXED, __HIP_MEMORY_SCOPE_AGENT); unsigned c1 = u.single ? 32u : __hip_atomic_load(fin_cnt + 16 * (hp0 + 1), __ATOMIC_RELAXED, __HIP_MEMORY_SCOPE_AGENT);
            c0 = (unsigned)__builtin_amdgcn_readfirstlane((int)c0); c1 = (unsigned)__builtin_amdgcn_readfirstlane((int)c1);
            if (c0 >= 32u && c1 >= 32u) break;
            __builtin_amdgcn_s_sleep(2); }
        f32x4 wv[2][2];
#pragma unroll
        for (int bj = 0; bj < 2; ++bj)
#pragma unroll
            for (int n = 0; n < 2; ++n) wv[bj][n] = *(const f32x4*)(nw + col0 + bj * HALF + 4 * n);
        float sstv[2][4];
#pragma unroll
        for (int ai = 0; ai < 2; ++ai)
#pragma unroll
            for (int m = 0; m < 4; ++m) sstv[ai][m] = __hip_atomic_load(ssq + row0 + (u.single ? 0 : ai) * HALF + m * 16, __ATOMIC_RELAXED, __HIP_MEMORY_SCOPE_AGENT);
#pragma unroll
        for (int ai = 0; ai < 2; ++ai) { if (ai == 1 && u.single) break;
#pragma unroll
            for (int m = 0; m < 4; ++m) { const int row = row0 + ai * HALF + m * 16; const size_t off = (size_t)row * 1024 + col0;
                const float sst = sstv[ai][m]; const float rs = 1.0f / sqrtf(sst * (1.0f / 1024.0f) + 1e-6f);
#pragma unroll
                for (int bj = 0; bj < 2; ++bj)
#pragma unroll
                    for (int n = 0; n < 2; ++n) *(f32x4*)(out + off + bj * HALF + 4 * n) = acc[ai][bj][m][n] * rs * wv[bj][n]; } }
    }
};
struct EpiRelu2 {
    static constexpr bool PERM = true, AFTER_DRAIN = false;
    bf16_t* H; const float* ss; const float* sw; int rowbase;
    template <bool WT> __device__ __forceinline__ void run(const f32x4 (&acc)[2][2][4][2], const Unit& u, int wr, int wc, int fr, int fq) const {
        asm volatile("" : "+v"(fr), "+v"(fq));
        const int row0 = u.pm * BM + (u.single ? u.sub * HALF : 0) + wr * 64 + fr; const int col0 = u.pn * BM + wc * 32 + 8 * fq;
        const int grow0 = rowbase + u.pm * BM; const int mi = grow0 < 8192 ? 0 : 1 + ((grow0 - 8192) >> 11);
        f32x4 swv[2][2];
#pragma unroll
        for (int bj = 0; bj < 2; ++bj)
#pragma unroll
            for (int n = 0; n < 2; ++n) swv[bj][n] = *(const f32x4*)(sw + (size_t)mi * 4096 + col0 + bj * HALF + 4 * n);
        float ssv[2][4];
#pragma unroll
        for (int ai = 0; ai < 2; ++ai)
#pragma unroll
            for (int m = 0; m < 4; ++m) ssv[ai][m] = ss[rowbase + row0 + (u.single ? 0 : ai) * HALF + m * 16];
#pragma unroll
        for (int ai = 0; ai < 2; ++ai) { if (ai == 1 && u.single) break;
#pragma unroll
            for (int m = 0; m < 4; ++m) { bf16_t* rowp = H + (size_t)(row0 + ai * HALF + m * 16) * 4096 + col0;
                const float rs = 1.0f / sqrtf(ssv[ai][m] * (1.0f / 1024.0f) + 1e-6f);
#pragma unroll
                for (int bj = 0; bj < 2; ++bj) { f32x4 v0 = acc[ai][bj][m][0] * rs + swv[bj][0], v1 = acc[ai][bj][m][1] * rs + swv[bj][1];
#pragma unroll
                    for (int e = 0; e < 4; ++e) { const float a = fmaxf(v0[e], 0.f), b = fmaxf(v1[e], 0.f); v0[e] = a * a; v1[e] = b * b; }
                    u32x4 w; w.x = cvt_pk_bf16(v0[0], v0[1]); w.y = cvt_pk_bf16(v0[2], v0[3]); w.z = cvt_pk_bf16(v1[0], v1[1]); w.w = cvt_pk_bf16(v1[2], v1[3]);
                    st16<WT>(rowp + bj * HALF, w); } } }
    }
};

template <class Epi, class Sched, bool ALIGN_EPI = false, bool SP2 = false, bool SINGLE = false>
__device__ __forceinline__ void gemm_phase(PG8_LAS unsigned char* lds, const Gemm g, const Sched& S, const Epi& E, int wave_id) {
    int tid; asm volatile("v_mbcnt_lo_u32_b32 %0, -1, 0\n\tv_mbcnt_hi_u32_b32 %0, -1, %0" : "=v"(tid)); tid += wave_id * 64;
    const int wid = __builtin_amdgcn_readfirstlane(tid >> 6), lane = tid & 63, wr = wid >> 2, wc = wid & 3, fr = lane & 15, fq = lane >> 4;
    const int K = g.K, nt = K / BK;
    unsigned voffA[2], voffB[2];
#pragma unroll
    for (int i = 0; i < 2; ++i) { int R, C; stage_rc(tid * 16 + i * 8192, R, C); const int Rb = Epi::PERM ? ((R & ~31) + perm32(R & 31)) : R;
        voffA[i] = (unsigned)(R * K + C) * 2u; voffB[i] = (unsigned)(Rb * K + C) * 2u; }
    const size_t kstep = (size_t)(BK * 2);
    const size_t hstep = (size_t)HALF * K * 2;
    const size_t tstep = 2 * hstep;
    const unsigned ldsw = (unsigned)wid * 1024u;
    const int aoff = lds_byte(wr * 64 + fr, fq * 8), boff = lds_byte(wc * 32 + fr, fq * 8);
#define PG8_SA(b, h) (((b) * 2 + (h)) * HTB)
#define PG8_SB(b, h) ((4 + (b) * 2 + (h)) * HTB)
#define PG8_STAGE(bufoff, gbase, voff) do { _Pragma("unroll") for (int _i = 0; _i < 2; ++_i) \
        __builtin_amdgcn_global_load_lds((const unsigned*)((const char*)(gbase) + (voff)[_i]), (PG8_LAS unsigned*)(lds + (bufoff) + ldsw + _i * 8192), 16, 0, 0); } while (0)
#define PG8_LDA(dst, b, h) do { _Pragma("unroll") for (int m = 0; m < 4; ++m) _Pragma("unroll") for (int k = 0; k < 2; ++k) dst[m][k] = *(const PG8_LAS bf16x8*)(lds + PG8_SA(b, h) + aoff + m * 2048 + k * 1024); } while (0)
#define PG8_LDB(dst, b, h) do { _Pragma("unroll") for (int n = 0; n < 2; ++n) _Pragma("unroll") for (int k = 0; k < 2; ++k) dst[n][k] = *(const PG8_LAS bf16x8*)(lds + PG8_SB(b, h) + boff + n * 2048 + k * 1024); } while (0)
#define PG8_MMA(ai, bj, At, Bt) do { __builtin_amdgcn_s_setprio(1); _Pragma("unroll") for (int m = 0; m < 4; ++m) _Pragma("unroll") for (int n = 0; n < 2; ++n) _Pragma("unroll") for (int k = 0; k < 2; ++k) \
        acc[ai][bj][m][n] = __builtin_amdgcn_mfma_f32_16x16x32_bf16(Bt[n][k], At[m][k], acc[ai][bj][m][n], 0, 0, 0); __builtin_amdgcn_s_setprio(0); } while (0)
#define PG8_WAIT_V(n) asm volatile("s_waitcnt vmcnt(" #n ")" ::: "memory")
#define PG8_WAIT_L(n) asm volatile("s_waitcnt lgkmcnt(" #n ")" ::: "memory")
#define PG8_BAR __builtin_amdgcn_s_barrier()
#define PG8_SCHED __builtin_amdgcn_sched_barrier(0)
    Unit cur, nxt; int ui = 0;
    if (!S.next(0, cur)) return;
    f32x4 acc[2][2][4][2];
#pragma unroll
    for (int a = 0; a < 2; ++a)
#pragma unroll
        for (int b = 0; b < 2; ++b)
#pragma unroll
            for (int m = 0; m < 4; ++m)
#pragma unroll
                for (int n = 0; n < 2; ++n) acc[a][b][m][n] = (f32x4){0.f, 0.f, 0.f, 0.f};
    bf16x8 At[4][2], B0[2][2], B1[2][2];
    const char* cA = (const char*)g.A + (size_t)cur.pm * tstep + (cur.single ? (size_t)cur.sub * hstep : (size_t)0); const char* cB = (const char*)g.Bt + (size_t)cur.pn * tstep;
    constexpr bool full = !SINGLE; const unsigned hA = SINGLE ? 0u : (unsigned)hstep;
    S.a_ready(cur);
    if constexpr (SP2) {
        PG8_STAGE(PG8_SB(0, 0), cB, voffB); PG8_STAGE(PG8_SB(0, 1), cB + hstep, voffB); PG8_STAGE(PG8_SA(0, 0), cA, voffA); PG8_STAGE(PG8_SA(0, 1), cA + hA, voffA);
        if (wr == 1) PG8_BAR;
        PG8_WAIT_V(2); PG8_BAR;
        PG8_STAGE(PG8_SB(1, 0), cB + kstep, voffB); PG8_STAGE(PG8_SA(1, 0), cA + kstep, voffA); PG8_STAGE(PG8_SB(1, 1), cB + hstep + kstep, voffB);
        PG8_WAIT_V(6); PG8_BAR;
    } else {
        PG8_STAGE(PG8_SB(0, 0), cB, voffB); PG8_STAGE(PG8_SA(0, 0), cA, voffA); PG8_STAGE(PG8_SB(0, 1), cB + hstep, voffB); PG8_STAGE(PG8_SA(0, 1), cA + hA, voffA);
        if (wr == 1) PG8_BAR;
        PG8_WAIT_V(4); PG8_BAR;
        PG8_STAGE(PG8_SB(1, 0), cB + kstep, voffB); PG8_STAGE(PG8_SA(1, 0), cA + kstep, voffA); PG8_STAGE(PG8_SB(1, 1), cB + hstep + kstep, voffB);
        PG8_WAIT_V(6); PG8_BAR;
    }
    for (;;) {
        const bool has_next = S.next(ui + 1, nxt);
        const char* nA = has_next ? (const char*)g.A + (size_t)nxt.pm * tstep + (nxt.single ? (size_t)nxt.sub * hstep : (size_t)0) : cA; const char* nB = has_next ? (const char*)g.Bt + (size_t)nxt.pn * tstep : cB;

        for (int t = 0; t < nt; t += 2) {
            const bool last = (t == nt - 2);
            const char* a1 = cA + (size_t)(t + 1) * kstep;
            const char* a2 = last ? nA : cA + (size_t)(t + 2) * kstep; const char* b2 = last ? nB : cB + (size_t)(t + 2) * kstep;
            const char* a3 = a2 + kstep; const char* b3 = b2 + kstep; const unsigned h2 = hA;
            if (last && has_next) S.a_ready(nxt);
            if constexpr (SP2) {
            PG8_LDB(B0, 0, 0); PG8_LDB(B1, 0, 1); PG8_SCHED; PG8_LDA(At, 0, 0); PG8_STAGE(PG8_SA(1, 1), a1 + hA, voffA);
            PG8_WAIT_V(8); PG8_WAIT_L(0); PG8_BAR; PG8_MMA(0, 0, At, B0); PG8_MMA(0, 1, At, B1); PG8_BAR; PG8_SCHED;
            if constexpr (full) PG8_LDA(At, 0, 1); PG8_STAGE(PG8_SB(0, 0), b2, voffB); PG8_STAGE(PG8_SB(0, 1), b2 + hstep, voffB); PG8_STAGE(PG8_SA(0, 0), a2, voffA);
            PG8_WAIT_V(8); PG8_WAIT_L(0); PG8_BAR; if constexpr (full) { PG8_MMA(1, 0, At, B0); PG8_MMA(1, 1, At, B1); } PG8_BAR; PG8_SCHED;
            PG8_LDB(B0, 1, 0); PG8_LDB(B1, 1, 1); PG8_SCHED; PG8_LDA(At, 1, 0); PG8_STAGE(PG8_SA(0, 1), a2 + h2, voffA);
            PG8_WAIT_V(8); PG8_WAIT_L(0); PG8_BAR; PG8_MMA(0, 0, At, B0); PG8_MMA(0, 1, At, B1); PG8_BAR; PG8_SCHED;
            if constexpr (full) PG8_LDA(At, 1, 1); PG8_STAGE(PG8_SB(1, 0), b3, voffB); PG8_STAGE(PG8_SB(1, 1), b3 + hstep, voffB); PG8_STAGE(PG8_SA(1, 0), a3, voffA);
            PG8_WAIT_V(8); PG8_WAIT_L(0); PG8_BAR; if constexpr (full) { PG8_MMA(1, 0, At, B0); PG8_MMA(1, 1, At, B1); } PG8_BAR; PG8_SCHED;
            } else {
            PG8_LDB(B0, 0, 0); PG8_SCHED; PG8_LDA(At, 0, 0); PG8_STAGE(PG8_SA(1, 1), a1 + hA, voffA);
            PG8_WAIT_L(8); PG8_BAR; PG8_WAIT_L(0); PG8_MMA(0, 0, At, B0); PG8_BAR; PG8_SCHED;
            PG8_LDB(B1, 0, 1); PG8_STAGE(PG8_SB(0, 0), b2, voffB);
            PG8_BAR; PG8_WAIT_L(0); PG8_MMA(0, 1, At, B1); PG8_BAR;
            PG8_LDA(At, 0, 1); PG8_STAGE(PG8_SA(0, 0), a2, voffA);
            PG8_BAR; PG8_WAIT_L(0); if constexpr (full) PG8_MMA(1, 0, At, B0); PG8_BAR; PG8_SCHED;
            PG8_STAGE(PG8_SB(0, 1), b2 + hstep, voffB);
            PG8_WAIT_V(6); PG8_BAR; if constexpr (full) PG8_MMA(1, 1, At, B1); PG8_BAR;
            PG8_LDB(B0, 1, 0); PG8_SCHED; PG8_LDA(At, 1, 0); PG8_STAGE(PG8_SA(0, 1), a2 + h2, voffA);
            PG8_WAIT_L(8); PG8_BAR; PG8_WAIT_L(0); PG8_MMA(0, 0, At, B0); PG8_BAR; PG8_SCHED;
            PG8_LDB(B1, 1, 1); PG8_STAGE(PG8_SB(1, 0), b3, voffB);
            PG8_BAR; PG8_WAIT_L(0); PG8_MMA(0, 1, At, B1); PG8_BAR;
            PG8_LDA(At, 1, 1); PG8_STAGE(PG8_SA(1, 0), a3, voffA);
            PG8_BAR; PG8_WAIT_L(0); if constexpr (full) PG8_MMA(1, 0, At, B0); PG8_BAR; PG8_SCHED;
            PG8_STAGE(PG8_SB(1, 1), b3 + hstep, voffB);
            PG8_WAIT_V(6); PG8_BAR; if constexpr (full) PG8_MMA(1, 1, At, B1); PG8_BAR;
            }
        }
        if constexpr (ALIGN_EPI) { if (wr == 0) PG8_BAR; }
        if constexpr (!Epi::AFTER_DRAIN) { int ln_; LANE_ID(ln_); E.template run<SINGLE>(acc, cur, wr, wc, ln_ & 15, ln_ >> 4); S.done(cur); }
        if (!has_next) break;
#pragma unroll
        for (int a = 0; a < 2; ++a)
#pragma unroll
            for (int b = 0; b < 2; ++b)
#pragma unroll
                for (int m = 0; m < 4; ++m)
#pragma unroll
                    for (int n = 0; n < 2; ++n) acc[a][b][m][n] = (f32x4){0.f, 0.f, 0.f, 0.f};
        cur = nxt; cA = nA; cB = nB; ++ui;
        if constexpr (ALIGN_EPI) { if (wr == 1) PG8_BAR; }
    }
    PG8_WAIT_V(0);
    if constexpr (!ALIGN_EPI) { if (wr == 0) PG8_BAR; }
    PG8_BAR;
#undef PG8_SA
#undef PG8_SB
#undef PG8_STAGE
#undef PG8_LDA
#undef PG8_LDB
#undef PG8_MMA
#undef PG8_WAIT_V
#undef PG8_WAIT_L
#undef PG8_BAR
#undef PG8_SCHED
}
}

constexpr int NWAVES = 8;
constexpr int D = 1024, MC = 8192, ML = 16384, M = MC + ML, DIN = 2304, DFF = 4096, DG = 256, MP0 = 16384;
constexpr float EPS = 1e-6f;
constexpr size_t MiB = 1u << 20;
constexpr size_t WS_CTL = 0, CTL_ZERO_BYTES = 1 * MiB;
constexpr size_t WS_MOD = 1 * MiB;
constexpr size_t WS_ROPE = WS_MOD + 2 * 9 * 6144 * 4;
constexpr size_t WS_LAM = WS_ROPE + 64 * 16 * 4;
constexpr size_t WS_RGWT = WS_LAM + 256;
constexpr size_t WS_POOLT = WS_RGWT + 32 * 4096 * 2;
constexpr size_t WS_CARRY = WS_POOLT + 8 * 4096 * 2;
constexpr size_t WS_WIN = 2 * MiB;
constexpr size_t WS_WOUT = WS_WIN + 2ull * 2304 * 1024 * 2;
constexpr size_t WS_W1 = WS_WOUT + 2ull * 1024 * 1024 * 2;
constexpr size_t WS_W2 = WS_W1 + 2ull * 4096 * 1024 * 2;
constexpr size_t WS_CK = WS_W2 + 2ull * 4096 * 1024 * 2;
constexpr size_t WS_CV = WS_CK + 2 * MiB;
constexpr size_t WS_SW = 51 * MiB;
constexpr size_t WS_SS = 512 * 1024;
constexpr size_t WS_CARRY1 = 51 * MiB + 512 * 1024;
constexpr size_t WS_SP8 = WS_CARRY1 + 256 * 1024;
constexpr size_t WS_XN = 52 * MiB;
constexpr size_t WS_XR = 52 * MiB;
constexpr size_t OUT_XN_BYTES = 48 * MiB;
constexpr size_t WS_Y = 100 * MiB;
constexpr size_t WS_Z = 148 * MiB;
constexpr size_t WS_END = 256 * MiB;
static_assert(WS_SS + 5ull * 24576 * 4 <= CTL_ZERO_BYTES && WS_SW + 2ull * 9 * 6400 * 4 <= WS_XN, "ss/sw map");
static_assert(WS_CARRY + 8 * 8 * 4 * 2 * 64 * 2 * 4 <= WS_WIN && WS_CV + 2 * MiB <= WS_XN && WS_Z + (size_t)M * DIN * 2 <= WS_END, "d_ws map");
constexpr int CW_BAR = 4096, CW_FIN = 8192, CW_RG = 12288;
constexpr size_t OUT_Y = 0, OUT_CK = (size_t)M * D, OUT_CV = OUT_CK + 32ull * 2 * 4 * 256 * 64, OUT_ST = OUT_CV + 32ull * 2 * 4 * 256 * 64;
constexpr int RING_BYTES = 131072, LDSCTL_OFF = RING_BYTES, MISC_OFF = LDSCTL_OFF + 320, LDS_BYTES = 147456;

#define GAS __attribute__((address_space(1)))
#define LAS __attribute__((address_space(3)))
typedef unsigned short bf16;
typedef unsigned v4u __attribute__((ext_vector_type(4)));
typedef unsigned v2u __attribute__((ext_vector_type(2)));
typedef float f32x4 __attribute__((ext_vector_type(4)));
typedef GAS unsigned gu32;
#define RLX_AGENT __ATOMIC_RELAXED, __HIP_MEMORY_SCOPE_AGENT
#define LDS_WAIT() asm volatile("s_waitcnt lgkmcnt(0)" ::: "memory")
__device__ __forceinline__ unsigned f2bf(float f) { unsigned u = __builtin_bit_cast(unsigned, f); return (u + 0x7fffu + ((u >> 16) & 1u)) >> 16; }
__device__ __forceinline__ unsigned pk2(float lo, float hi) { return f2bf(lo) | (f2bf(hi) << 16); }
__device__ __forceinline__ float bf2f(unsigned h) { return __uint_as_float(h << 16); }
__device__ __forceinline__ float bflo(unsigned w) { return __uint_as_float(w << 16); }
__device__ __forceinline__ float bfhi(unsigned w) { return __uint_as_float(w & 0xffff0000u); }

#define XB_TMO      128
#define XB_XCNT(j)  (256  + 64 * (j))
#define XB_XSUB(j)  (1280 + 64 * (j))
#define XB_XGEN(j)  (2304 + 64 * (j))
#define XB_TOP      3328
#define XB_TOPGEN   3392
#define XCD_BAR_WORDS 3456
#define XB_SPIN_CAP (1u << 18)
__device__ __forceinline__ unsigned xb_ld(unsigned* p)              { return __hip_atomic_load(p, __ATOMIC_RELAXED, __HIP_MEMORY_SCOPE_AGENT); }
__device__ __forceinline__ unsigned xb_add(unsigned* p, unsigned v) { return __hip_atomic_fetch_add(p, v, __ATOMIC_RELAXED, __HIP_MEMORY_SCOPE_AGENT); }
__device__ __forceinline__ unsigned xb_xcc_id() { return (unsigned)__builtin_amdgcn_s_getreg((3 << 11) | 20) & 0xFu; }
#define XB_SPIN(cond, bar) do { unsigned _sp = 0; while (cond) { __builtin_amdgcn_s_sleep(1); \
    if ((++_sp & 255u) == 0u) { if (xb_ld(&(bar)[XB_TMO])) break; if (_sp > XB_SPIN_CAP) { atomicAdd(&(bar)[XB_TMO], 1u); break; } } } } while (0)
struct XcdBarrier { unsigned* bar; unsigned x; volatile LAS unsigned* st; };
__device__ __forceinline__ XcdBarrier xcd_barrier_post(unsigned* bar, volatile LAS unsigned* st) {
    XcdBarrier b; b.bar = bar; b.x = xb_xcc_id(); b.st = st;
    if (threadIdx.x == 0) (void)xb_add(&bar[XB_XCNT(b.x)], 1u);
    return b;
}
__device__ __forceinline__ void xcd_barrier_complete(unsigned* bar, unsigned x, unsigned& nloc, unsigned& nx) {
    const unsigned G = gridDim.x * gridDim.y * gridDim.z;
    unsigned sum, cnt, mine, sp = 0u;
    for (;;) {
        sum = 0u; cnt = 0u;
        for (unsigned j = 0; j < 16; ++j) { const unsigned c = xb_ld(&bar[XB_XCNT(j)]); sum += c; cnt += (c > 0u) ? 1u : 0u; }
        mine = xb_ld(&bar[XB_XCNT(x)]);
        if (sum == G) break;
        __builtin_amdgcn_s_sleep(1);
        if ((++sp & 255u) == 0u) { if (xb_ld(&bar[XB_TMO])) break; if (sp > XB_SPIN_CAP) { atomicAdd(&bar[XB_TMO], 1u); break; } }
    }
    nloc = mine > 0u ? mine : 1u; nx = cnt > 0u ? cnt : 1u;
}
__device__ __forceinline__ void xcd_barrier(const XcdBarrier& b) {
    asm volatile("s_waitcnt vmcnt(0)" ::: "memory");
    __syncthreads();
    if (threadIdx.x == 0) {
        unsigned* bar = b.bar; asm volatile("" : "+s"(bar)); unsigned bx_ = b.x; asm volatile("" : "+s"(bx_));
        __builtin_amdgcn_s_waitcnt(0);
        unsigned nloc = b.st[0], nx = b.st[1];
        if (nloc == 0u) { xcd_barrier_complete(bar, bx_, nloc, nx); b.st[0] = nloc; b.st[1] = nx; }
        const unsigned old = xb_add(&bar[XB_XSUB(bx_)], 1u);
        const unsigned gen = old / nloc;
        if (old + 1u == (gen + 1u) * nloc) {
            __builtin_amdgcn_fence(__ATOMIC_RELEASE, "agent");
            asm volatile("s_waitcnt vmcnt(0)" ::: "memory");
            const unsigned og = xb_add(&bar[XB_TOP], 1u);
            const unsigned tg = og / nx;
            if (og + 1u == (tg + 1u) * nx) xb_add(&bar[XB_TOPGEN], 1u);
            else XB_SPIN(xb_ld(&bar[XB_TOPGEN]) == tg, bar);
            __builtin_amdgcn_fence(__ATOMIC_ACQUIRE, "agent");
            xb_add(&bar[XB_XGEN(bx_)], 1u);
            asm volatile("s_waitcnt vmcnt(0)" ::: "memory");
        } else {
            XB_SPIN(xb_ld(&bar[XB_XGEN(bx_)]) == gen, bar);
            __builtin_amdgcn_fence(__ATOMIC_ACQUIRE, "agent");
            asm volatile("s_waitcnt vmcnt(0)" ::: "memory");
        }
    }
    __syncthreads();
}

struct Args { const float* in[25]; float* out; unsigned char* ws; int ph_lo, ph_hi; };
#define INP(A_, i) inp_ptr(F, (i))
struct Frame {
    LAS unsigned char* lds; LAS unsigned char* lds0; int tid, lane, wave, wave0, vcu, vcu0, G;
    float* out; unsigned char* ws; float* out0; unsigned char* ws0;
};
__device__ __forceinline__ const float* inp_ptr(const Frame& F, int i) {
    const volatile LAS unsigned* t = (const volatile LAS unsigned*)(F.lds + 131072) + 2 * i;
    const unsigned lo = __builtin_amdgcn_readfirstlane(t[0]), hi = __builtin_amdgcn_readfirstlane(t[1]);
    return (const float*)(((unsigned long long)hi << 32) | lo);
}
#define PHASE_IDS(F) do { int t_; asm volatile("v_mbcnt_lo_u32_b32 %0, -1, 0\n\tv_mbcnt_hi_u32_b32 %0, -1, %0" : "=v"(t_)); int wv_ = (F).wave0; asm volatile("" : "+s"(wv_)); int vc_ = (F).vcu0; asm volatile("" : "+s"(vc_)); (F).vcu = vc_; (F).lane = t_; (F).wave = wv_; (F).tid = wv_ * 64 + t_; \
    unsigned l_ = (unsigned)(uintptr_t)(F).lds0; asm volatile("" : "+s"(l_)); (F).lds = (LAS unsigned char*)(uintptr_t)l_; unsigned char* w_ = (F).ws0; asm volatile("" : "+s"(w_)); (F).ws = w_; float* o_ = (F).out0; asm volatile("" : "+s"(o_)); (F).out = o_; } while (0)
enum { I_XP = 0, I_XS, I_CK, I_CV, I_ST, I_C, I_CCTX, I_WADA, I_BADA, I_NORMW, I_WIN, I_DLAM, I_SUBLN, I_CBW, I_CCW, I_CCB, I_RGW, I_RGB, I_RGLAM, I_POOLW, I_POOLS, I_WOUT, I_W1, I_W2, I_FNW };

__device__ __forceinline__ float wave_sum(float v, int lane) {
#pragma unroll
    for (int o = 1; o < 64; o <<= 1) v += shx(v, o, lane);
    return v;
}
__device__ __forceinline__ float wave_max(float v, int lane) {
#pragma unroll
    for (int o = 1; o < 64; o <<= 1) v = fmaxf(v, shx(v, o, lane));
    return v;
}
__device__ __forceinline__ float gelu_tanh(float x) { const float u = 0.7978845608028654f * (x + 0.044715f * x * x * x); return 0.5f * x * (1.0f + tanhf(u)); }

__device__ __forceinline__ void glds16(const void* gsrc, unsigned lds_dst) { unsigned keep;
    asm volatile("s_mov_b32 %0, m0\n\ts_mov_b32 m0, %2\n\ts_nop 0\n\tglobal_load_lds_dwordx4 %1, off\n\ts_mov_b32 m0, %0" : "=&s"(keep) : "v"(gsrc), "s"(lds_dst) : "memory"); }
struct TItem { const float* W; bf16* WT; int K, N, item; };
__device__ __forceinline__ void p0_titem_load(const TItem& t, int lane, unsigned slot) {
    const int nblk = t.N / 32, kb = t.item / nblk, nb = t.item % nblk, k0 = 64 * kb, n0 = 32 * nb;
    const float* src = t.W + (size_t)(k0 + (lane >> 3)) * t.N + n0;
#pragma unroll
    for (int i = 0; i < 8; ++i) glds16(src + (size_t)(8 * i) * t.N + 4 * ((lane & 7) ^ i), slot + 1024u * i);
}
__device__ __forceinline__ void p0_titem_finish(const TItem& t, const LAS float* scr, int lane, bool first) {
    const int nblk = t.N / 32, kb = t.item / nblk, nb = t.item % nblk, k0 = 64 * kb, n0 = 32 * nb;
    if (first) asm volatile("s_waitcnt vmcnt(8)" ::: "memory"); else asm volatile("s_waitcnt vmcnt(12)" ::: "memory");
    const int c = lane & 7;
#pragma unroll
    for (int j = 0; j < 4; ++j) { const int n = (lane >> 3) + 8 * j; const LAS float* sp = scr + (8 * c) * 32 + (((n >> 2) ^ c) << 2) + (n & 3);
        v4u o; o.x = pk2(sp[0 * 32], sp[1 * 32]); o.y = pk2(sp[2 * 32], sp[3 * 32]); o.z = pk2(sp[4 * 32], sp[5 * 32]); o.w = pk2(sp[6 * 32], sp[7 * 32]);
        *(GAS v4u*)(t.WT + (size_t)(n0 + n) * t.K + k0 + 8 * c) = o; }
    LDS_WAIT(); asm volatile("" ::: "memory");
}
__device__ __forceinline__ void p0_mod_item(Frame& F, const Args& A, int item) {
    const int l = item / 96, n0 = (item % 96) * 64;
    LAS float* sv = (LAS float*)F.lds;
    LAS float* red = sv + 9 * 1024;
    const float* c = INP(A, I_C); const float* cctx = INP(A, I_CCTX);
    for (int i = F.tid; i < 9 * 1024; i += 512) { const int mi = i >> 10, k = i & 1023; const float v = mi == 0 ? cctx[k] : c[(mi - 1) * 1024 + k]; sv[i] = v / (1.0f + expf(-v)); }
    __syncthreads();
    const int cg = F.tid & 15, rg = F.tid >> 4;
    float acc[9][4];
#pragma unroll
    for (int a = 0; a < 9; ++a)
#pragma unroll
        for (int j = 0; j < 4; ++j) acc[a][j] = 0.f;
    const float* wp = INP(A, I_WADA) + (size_t)l * 1024 * 6144 + n0 + cg * 4;
#pragma unroll 1
    for (int i0 = 0; i0 < 32; i0 += 8) { f32x4 w[8];
#pragma unroll
        for (int q = 0; q < 8; ++q) w[q] = *(const GAS f32x4*)(wp + (size_t)(rg + 32 * (i0 + q)) * 6144);
#pragma unroll
        for (int q = 0; q < 8; ++q) { const int k = rg + 32 * (i0 + q);
#pragma unroll
            for (int a = 0; a < 9; ++a) { const float sx = sv[a * 1024 + k];
#pragma unroll
                for (int j = 0; j < 4; ++j) acc[a][j] += sx * w[q][j]; } } }
#pragma unroll
    for (int a = 0; a < 9; ++a)
#pragma unroll
        for (int j = 0; j < 4; ++j) red[(rg * 9 + a) * 64 + cg * 4 + j] = acc[a][j];
    __syncthreads();
    float* mod = (float*)(F.ws + WS_MOD);
    for (int o = F.tid; o < 9 * 64; o += 512) { const int mi = o >> 6, n = o & 63; float sm = INP(A, I_BADA)[l * 6144 + n0 + n];
#pragma unroll 8
        for (int r = 0; r < 32; ++r) sm += red[(r * 9 + mi) * 64 + n];
        mod[(size_t)(l * 9 + mi) * 6144 + n0 + n] = sm; }
    __syncthreads();
}
__device__ __forceinline__ void sincos_d(double a, float& co, float& si) {
    const double TWO_PI = 6.283185307179586476925286766559;
    const double n = (double)(long long)(a / TWO_PI + 0.5);
    const double r = a - n * TWO_PI;
    const double r2 = r * r; double ts = r, tc = 1.0, ss = r, sc = 1.0;
    for (int k = 1; k <= 14; ++k) { tc = -tc * r2 / (double)((2 * k - 1) * (2 * k)); sc += tc; ts = -ts * r2 / (double)((2 * k) * (2 * k + 1)); ss += ts; }
    co = (float)sc; si = (float)ss;
}
__device__ __forceinline__ void p0_prologue(Frame& F, const Args& A) {
    PHASE_IDS(F);
    if (blockIdx.x < 192) p0_mod_item(F, A, blockIdx.x);
    const unsigned slot0 = (unsigned)__builtin_amdgcn_readfirstlane((int)(unsigned)(size_t)(F.lds + F.wave * 16384));
    const LAS float* scr0 = (const LAS float*)(F.lds + F.wave * 16384); const LAS float* scr1 = scr0 + 2048;
    const int gw = F.vcu * NWAVES + F.wave, NGW = F.G * NWAVES;
    constexpr int I_IN = 16 * 72, I_OUT = 16 * 32, I_1 = 16 * 128, I_2 = 64 * 32, I_L = I_IN + I_OUT + I_1 + I_2, I_RG = 32 * 2, I_PW = 8 * 2;
    constexpr int NITEMS = 2 * I_L + I_RG + I_PW;
    const float* pw_in = INP(A, I_WIN); const float* pw_out = INP(A, I_WOUT); const float* pw_1 = INP(A, I_W1); const float* pw_2 = INP(A, I_W2); const float* pw_rg = INP(A, I_RGW); const float* pw_pl = INP(A, I_POOLW);
    auto decode = [&](int it, TItem& t) {
        int r = it;
        if (r < 2 * I_L) { const int l = r / I_L; r -= l * I_L;
            if (r < I_IN) { t = TItem{pw_in + (size_t)l * 1024 * 2304, (bf16*)(F.ws + WS_WIN) + (size_t)l * 2304 * 1024, 1024, 2304, r}; return; } r -= I_IN;
            if (r < I_OUT) { t = TItem{pw_out + (size_t)l * 1024 * 1024, (bf16*)(F.ws + WS_WOUT) + (size_t)l * 1024 * 1024, 1024, 1024, r}; return; } r -= I_OUT;
            if (r < I_1) { t = TItem{pw_1 + (size_t)l * 1024 * 4096, (bf16*)(F.ws + WS_W1) + (size_t)l * 4096 * 1024, 1024, 4096, r}; return; } r -= I_1;
            t = TItem{pw_2 + (size_t)l * 4096 * 1024, (bf16*)(F.ws + WS_W2) + (size_t)l * 1024 * 4096, 4096, 1024, r}; return; }
        r -= 2 * I_L;
        if (r < I_RG) { const int mi = r >> 1; t = TItem{pw_rg + (size_t)mi * 4096, (bf16*)(F.ws + WS_RGWT) + (size_t)mi * 4096, 64, 64, r & 1}; return; } r -= I_RG;
        { const int mi = r >> 1; t = TItem{pw_pl + (size_t)mi * 4096, (bf16*)(F.ws + WS_POOLT) + (size_t)mi * 4096, 64, 64, r & 1}; }
    };
    if (gw < NITEMS) {
        const int cnt = (NITEMS - gw + NGW - 1) / NGW;
        TItem ta, tb;
        decode(gw, ta); p0_titem_load(ta, F.lane, slot0);
        for (int j = 0; j < cnt; j += 2) {
            { const int jn = j + 1 < cnt ? j + 1 : cnt - 1; decode(gw + jn * NGW, tb); p0_titem_load(tb, F.lane, slot0 + 8192u); }
            p0_titem_finish(ta, scr0, F.lane, j == 0);
            if (j + 1 >= cnt) break;
            { const int jn = j + 2 < cnt ? j + 2 : cnt - 1; decode(gw + jn * NGW, ta); p0_titem_load(ta, F.lane, slot0); }
            p0_titem_finish(tb, scr1, F.lane, false);
        }
        asm volatile("s_waitcnt vmcnt(0)" ::: "memory");
    }
    { const int gt = F.vcu * 512 + F.tid, NGT = F.G * 512;
      const float* pck = INP(A, I_CK); const float* pcv = INP(A, I_CV);
      for (int i0 = gt; i0 < 2 * 262144; i0 += 4 * NGT) { f32x4 v[4];
#pragma unroll
          for (int q = 0; q < 4; ++q) { const int i = i0 + q * NGT; if (i < 2 * 262144) { const int which = i >= 262144; const int j = which ? i - 262144 : i; v[q] = *(const GAS f32x4*)((which ? pcv : pck) + (size_t)j * 4); } }
#pragma unroll
          for (int q = 0; q < 4; ++q) { const int i = i0 + q * NGT; if (i < 2 * 262144) { const int which = i >= 262144; const int j = which ? i - 262144 : i; v2u o; o.x = pk2(v[q][0], v[q][1]); o.y = pk2(v[q][2], v[q][3]);
              *(GAS v2u*)((bf16*)(F.ws + (which ? WS_CV : WS_CK)) + (size_t)j * 4) = o; } } } }
    if (blockIdx.x == (unsigned)(F.G - 1)) {
        const double fr[8] = {1.0, 0.31622776601683794, 0.1, 0.031622776601683794, 0.01, 0.0031622776601683794, 0.001, 0.00031622776601683794};
        float* rope = (float*)(F.ws + WS_ROPE);
        { const int pos = F.tid >> 3, j = F.tid & 7; double f = fr[0];
#pragma unroll
          for (int q = 1; q < 8; ++q) f = (j == q) ? fr[q] : f;
          float co, si; sincos_d((double)pos * f, co, si); rope[pos * 16 + j * 2] = co; rope[pos * 16 + j * 2 + 1] = si; }
        { const float* rgl = INP(A, I_RGLAM); float* sp8 = (float*)(F.ws + WS_SP8);
          for (int i = F.tid; i < 2 * 2 * 256; i += 512) sp8[i] = 8.0f * 1.4426950408889634f * log1pf(expf(-rgl[i])); }
        if (F.tid < 2) { const int l = F.tid; const float* dl = INP(A, I_DLAM) + l * 128; float s1 = 0.f, s2 = 0.f;
            for (int i = 0; i < 32; ++i) { s1 += dl[i] * dl[32 + i]; s2 += dl[64 + i] * dl[96 + i]; }
            const float lam_init = 0.8f - 0.6f * expf(-0.3f * (float)l);
            ((float*)(F.ws + WS_LAM))[l] = expf(s1) - expf(s2) + lam_init; }
    }
}
__device__ __forceinline__ void prep0_phase(Frame& F, const Args& A) {
    PHASE_IDS(F);
    bf16* XN = (bf16*)((unsigned char*)F.out + OUT_XN_BYTES); float* SS0 = (float*)(F.ws + WS_SS); const float* mod = (const float*)(F.ws + WS_MOD);
    const float* xp = INP(A, I_XP); const float* xsm = INP(A, I_XS) - (size_t)MC * D; const float* nw = INP(A, I_NORMW);
    const int gw = F.vcu * NWAVES + F.wave, NGW = F.G * NWAVES; const int lane = F.lane;
    const int cmb = (int)blockIdx.x & 3, sl = cmb >> 1, which = cmb & 1, slot = (int)blockIdx.x >> 2; const int N = which ? DFF : DIN;
    const int ntile = which ? 4 : 3, ncol = which ? 64 : 48; const bool active = which ? (slot < 64) : (slot < 48);
    const int tile = F.wave & 3, kh = F.wave >> 2; const bool has = active && tile < ntile;
    const int n0 = (active ? slot : 0) * ncol + (tile < ntile ? tile : 0) * 16;
    LAS float* sh = (LAS float*)F.lds;
    LAS float* red = sh + 9 * 1024;
    { const float* shg = mod + (size_t)sl * 9 * 6144 + (which ? 3072 : 0);
      for (int i = F.tid; i < 9 * 256; i += 512) { const int mi = i >> 8, k4 = i & 255; *(LAS f32x4*)(sh + mi * 1024 + 4 * k4) = *(const f32x4*)(shg + (size_t)mi * 6144 + 4 * k4); } }
    const bf16* wbase = which ? (const bf16*)(F.ws + WS_W1) + (size_t)sl * DFF * D : (const bf16*)(F.ws + WS_WIN) + (size_t)sl * DIN * D;
    v4u wf[16];
    { const bf16* wt = wbase + (size_t)(n0 + (lane & 15)) * D + kh * 512 + (lane >> 4) * 8;
#pragma unroll
      for (int st = 0; st < 16; ++st) wf[st] = *(const GAS v4u*)(wt + 32 * st); }
    REP(13) for (int r0 = gw; r0 < M; r0 += 4 * NGW) {
        f32x4 v[4][4];
#pragma unroll
        for (int q = 0; q < 4; ++q) { const int r = r0 + q * NGW; const float* xr = (r < MC ? xp : xsm) + (size_t)r * D;
#pragma unroll
            for (int j = 0; j < 4; ++j) v[q][j] = *(const GAS f32x4*)(xr + 256 * j + 4 * lane); }
#pragma unroll
        for (int q = 0; q < 4; ++q) { const int r = r0 + q * NGW; const int mi = r < MC ? 0 : 1 + ((r - MC) >> 11);
            const float* mp = mod + (size_t)mi * 6144 + 1024;
            float sq = 0.f;
#pragma unroll
            for (int j = 0; j < 4; ++j) sq += (v[q][j][0] * v[q][j][0] + v[q][j][1] * v[q][j][1]) + (v[q][j][2] * v[q][j][2] + v[q][j][3] * v[q][j][3]);
#pragma unroll
            for (int j = 0; j < 4; ++j) { const int c = 256 * j + 4 * lane; const f32x4 w = *(const GAS f32x4*)(nw + c), sc = *(const GAS f32x4*)(mp + c);
                v2u pk; pk.x = pk2(v[q][j][0] * w[0] * (1.0f + sc[0]), v[q][j][1] * w[1] * (1.0f + sc[1])); pk.y = pk2(v[q][j][2] * w[2] * (1.0f + sc[2]), v[q][j][3] * w[3] * (1.0f + sc[3])); *(GAS v2u*)(XN + (size_t)r * D + c) = pk; }
            sq = wave_sum(sq, lane); if (lane == 0) *(GAS float*)(SS0 + r) = sq; }
    }
    __syncthreads();
    { const int mi = lane & 15, kg = lane >> 4; const LAS float* sp = sh + (mi < 9 ? mi : 0) * 1024 + kh * 512 + kg * 8; const float keep = mi < 9 ? 1.0f : 0.0f;
      pg8::f32x4 acc = {0.f, 0.f, 0.f, 0.f};
#pragma unroll
      for (int st = 0; st < 16; ++st) { const f32x4 s0 = *(const LAS f32x4*)(sp + 32 * st), s1 = *(const LAS f32x4*)(sp + 32 * st + 4);
          float x[8] = {s0[0] * keep, s0[1] * keep, s0[2] * keep, s0[3] * keep, s1[0] * keep, s1[1] * keep, s1[2] * keep, s1[3] * keep}; v4u hi, lo;
          hi.x = pg8::cvt_pk_bf16(x[0], x[1]); hi.y = pg8::cvt_pk_bf16(x[2], x[3]); hi.z = pg8::cvt_pk_bf16(x[4], x[5]); hi.w = pg8::cvt_pk_bf16(x[6], x[7]);
          lo.x = pg8::cvt_pk_bf16(x[0] - bflo(hi.x), x[1] - bfhi(hi.x)); lo.y = pg8::cvt_pk_bf16(x[2] - bflo(hi.y), x[3] - bfhi(hi.y));
          lo.z = pg8::cvt_pk_bf16(x[4] - bflo(hi.z), x[5] - bfhi(hi.z)); lo.w = pg8::cvt_pk_bf16(x[6] - bflo(hi.w), x[7] - bfhi(hi.w));
          const pg8::bf16x8 bw = __builtin_bit_cast(pg8::bf16x8, wf[st]);
          acc = __builtin_amdgcn_mfma_f32_16x16x32_bf16(__builtin_bit_cast(pg8::bf16x8, hi), bw, acc, 0, 0, 0);
          acc = __builtin_amdgcn_mfma_f32_16x16x32_bf16(__builtin_bit_cast(pg8::bf16x8, lo), bw, acc, 0, 0, 0); }
      if (kh == 1) *(LAS pg8::f32x4*)(red + (tile * 64 + lane) * 4) = acc;
      __syncthreads();
      if (kh == 0 && has) { const pg8::f32x4 o = *(const LAS pg8::f32x4*)(red + (tile * 64 + lane) * 4);
          float* obase = (float*)(F.ws + WS_SW) + (which ? 2 * 9 * 2304 + (size_t)sl * 9 * 4096 : (size_t)sl * 9 * 2304);
#pragma unroll
          for (int e = 0; e < 4; ++e) { const int m2 = 4 * kg + e; if (m2 < 9) *(GAS float*)(obase + (size_t)m2 * N + n0 + (lane & 15)) = acc[e] + o[e]; } }
      __syncthreads(); }
}
typedef short bf16x8_t __attribute__((ext_vector_type(8)));
typedef float f32x16 __attribute__((ext_vector_type(16)));
typedef short v4i16_t __attribute__((ext_vector_type(4)));
__device__ __forceinline__ unsigned cvtpk(float lo, float hi) { unsigned r; asm volatile("v_cvt_pk_bf16_f32 %0, %1, %2" : "=v"(r) : "v"(lo), "v"(hi)); return r; }
__device__ __forceinline__ bf16x8_t pack8(float a0, float a1, float a2, float a3, float a4, float a5, float a6, float a7) {
    v4u w; w.x = cvtpk(a0, a1); w.y = cvtpk(a2, a3); w.z = cvtpk(a4, a5); w.w = cvtpk(a6, a7); return __builtin_bit_cast(bf16x8_t, w); }
__device__ __forceinline__ v4i16_t lds_tr(LAS unsigned char* p) { return __builtin_amdgcn_ds_read_tr16_b64_v4i16((LAS v4i16_t*)p); }
#define MFMA32(a, b, c) __builtin_amdgcn_mfma_f32_32x32x16_bf16((a), (b), (c), 0, 0, 0)


__device__ __forceinline__ void attn_unit(Frame& F, const Args& A, int l, bool lat, int seq, int hd, int qb, float lam, float sub_mul) {
    LAS unsigned char* L = F.lds;
    const bf16* Z = (const bf16*)(F.ws + WS_Z); bf16* Y = (bf16*)(F.ws + WS_Y);
    const bf16* CK = (const bf16*)(F.ws + WS_CK); const bf16* CV = (const bf16*)(F.ws + WS_CV);
    int lane; LANE_ID(lane); const int w = F.wave, tid = w * 64 + lane, r32 = lane & 31, h = lane >> 5;
    const int zrow0 = lat ? MC + seq * 2048 : seq * 256;
    const int qrow = zrow0 + qb * 256 + w * 32 + r32;
    bf16x8_t qf[2][2];
#pragma unroll
    for (int s = 0; s < 2; ++s)
#pragma unroll
        for (int ks = 0; ks < 2; ++ks) qf[s][ks] = *(const bf16x8_t*)(Z + (size_t)qrow * DIN + hd * 64 + s * 32 + ks * 16 + h * 8);
    const int NT = lat ? 36 : 4;
    const unsigned lds0 = (unsigned)(uintptr_t)L;
    const int srow = 8 * w + (lane >> 3), spc = lane & 7;
    const int kch = spc ^ ((srow >> 1) & 7), vch = spc ^ (((srow >> 1) & 1) << 2);
    const size_t cbk = ((size_t)((seq * 2 + l) * 4 + hd) * 256 + srow) * 64 + kch * 8, cbv = ((size_t)((seq * 2 + l) * 4 + hd) * 256 + srow) * 64 + vch * 8;
    const size_t zbk = (size_t)(zrow0 + srow) * DIN + 256 + hd * 64 + kch * 8, zbv = (size_t)(zrow0 + srow) * DIN + 512 + hd * 64 + vch * 8;
#define ATT_DMA(tn, slot) do { const unsigned sb_ = (unsigned)(slot) * 16384u + (unsigned)w * 1024u; \
        const bf16* ks_ = (lat && (tn) < 4) ? CK + cbk + (size_t)(tn) * 4096 : Z + zbk + (size_t)((tn) - (lat ? 4 : 0)) * 64 * DIN; \
        const bf16* vs_ = (lat && (tn) < 4) ? CV + cbv + (size_t)(tn) * 4096 : Z + zbv + (size_t)((tn) - (lat ? 4 : 0)) * 64 * DIN; \
        glds16(ks_, (unsigned)__builtin_amdgcn_readfirstlane((int)(lds0 + sb_))); glds16(vs_, (unsigned)__builtin_amdgcn_readfirstlane((int)(lds0 + sb_ + 8192u))); } while (0)
    unsigned koff[2][2];
#pragma unroll
    for (int s = 0; s < 2; ++s)
#pragma unroll
        for (int ks = 0; ks < 2; ++ks) koff[s][ks] = r32 * 128 + (((s * 4 + ks * 2 + h) ^ ((r32 >> 1) & 7)) << 4);
    const int q_ = (lane & 15) >> 2, p_ = lane & 3, g1 = (lane >> 4) & 1, sw = (lane >> 3) & 1;
    const unsigned vb0 = 8192 + (4 * h + q_) * 128 + (((2 * g1 + (p_ >> 1)) ^ (sw << 2)) << 4) + (p_ & 1) * 8;
    const unsigned vb1 = 8192 + (4 * h + q_) * 128 + (((4 + 2 * g1 + (p_ >> 1)) ^ (sw << 2)) << 4) + (p_ & 1) * 8;
    ATT_DMA(0, 0); ATT_DMA(1, 1);
    __builtin_amdgcn_s_waitcnt(0x0F70);
    float mref[2] = {0.f, 0.f}, ls[2] = {0.f, 0.f};
    f32x16 o[2][2];
#pragma unroll
    for (int s = 0; s < 2; ++s)
#pragma unroll
        for (int db = 0; db < 2; ++db)
#pragma unroll
            for (int r = 0; r < 16; ++r) o[s][db][r] = 0.f;
    for (int t = 0, par = 0; t < NT; ++t, par = (par == 2 ? 0 : par + 1)) {
        const unsigned bo = (unsigned)par * 16384u;
        if (t + 1 < NT) asm volatile("s_waitcnt vmcnt(2)" ::: "memory"); else asm volatile("s_waitcnt vmcnt(0)" ::: "memory");
        __builtin_amdgcn_s_barrier(); asm volatile("" ::: "memory");
        if (t + 2 < NT) ATT_DMA(t + 2, (par == 0 ? 2 : par - 1));
        bf16x8_t kf[2][2][2], vf[2][4];
#pragma unroll
        for (int s = 0; s < 2; ++s)
#pragma unroll
            for (int ks = 0; ks < 2; ++ks) { kf[s][ks][0] = *(const LAS bf16x8_t*)(L + bo + koff[s][ks]); kf[s][ks][1] = *(const LAS bf16x8_t*)(L + bo + koff[s][ks] + 4096); }
#pragma unroll
        for (int db = 0; db < 2; ++db)
#pragma unroll
            for (int sp = 0; sp < 4; ++sp) { LAS unsigned char* vp = L + bo + (db ? vb1 : vb0) + sp * 2048; const v4i16_t lo = lds_tr(vp), hi = lds_tr(vp + 1024);
                vf[db][sp] = (bf16x8_t){lo[0], lo[1], lo[2], lo[3], hi[0], hi[1], hi[2], hi[3]}; }
        f32x16 p[2][2];
#pragma unroll
        for (int s = 0; s < 2; ++s) { const float nm = -mref[s];
#pragma unroll
            for (int r = 0; r < 16; ++r) { p[s][0][r] = nm; p[s][1][r] = nm; }
#pragma unroll
            for (int ks = 0; ks < 2; ++ks) { p[s][0] = MFMA32(kf[s][ks][0], qf[s][ks], p[s][0]); p[s][1] = MFMA32(kf[s][ks][1], qf[s][ks], p[s][1]); } }
        __builtin_amdgcn_sched_barrier(0);
        bf16x8_t pb[2][4];
#pragma unroll
        for (int s = 0; s < 2; ++s) {
            f32x16& p0 = p[s][0]; f32x16& p1 = p[s][1];
            float ma = fmaxf(fmaxf(p0[0], p0[1]), p1[0]), mb = fmaxf(fmaxf(p0[2], p0[3]), p1[1]); ma = fmaxf(fmaxf(ma, p1[2]), p1[3]);
#pragma unroll
            for (int r = 4; r < 16; r += 4) { ma = fmaxf(fmaxf(ma, p0[r]), p0[r + 1]); mb = fmaxf(fmaxf(mb, p0[r + 2]), p0[r + 3]); ma = fmaxf(fmaxf(ma, p1[r]), p1[r + 1]); mb = fmaxf(fmaxf(mb, p1[r + 2]), p1[r + 3]); }
            float mt = fmaxf(ma, mb); mt = fmaxf(mt, shx(mt, 32, lane));
            if (t == 0 || __any(mt > 8.0f)) {
                const float dl = (t == 0) ? mt : fmaxf(mt, 0.f); mref[s] += dl; const float al = (t == 0) ? 1.0f : __builtin_amdgcn_exp2f(-dl); ls[s] *= al;
#pragma unroll
                for (int r = 0; r < 16; ++r) { p0[r] -= dl; p1[r] -= dl; }
#pragma unroll
                for (int db = 0; db < 2; ++db)
#pragma unroll
                    for (int r = 0; r < 16; ++r) o[s][db][r] *= al; }
            float rs0 = 0.f, rs1 = 0.f;
#pragma unroll
            for (int r = 0; r < 16; ++r) { p0[r] = __builtin_amdgcn_exp2f(p0[r]); p1[r] = __builtin_amdgcn_exp2f(p1[r]); rs0 += p0[r]; asm volatile("" : "+v"(rs0)); rs1 += p1[r]; asm volatile("" : "+v"(rs1)); }
            ls[s] += rs0 + rs1;
            pb[s][0] = pack8(p0[0], p0[1], p0[2], p0[3], p0[4], p0[5], p0[6], p0[7]); pb[s][1] = pack8(p0[8], p0[9], p0[10], p0[11], p0[12], p0[13], p0[14], p0[15]);
            pb[s][2] = pack8(p1[0], p1[1], p1[2], p1[3], p1[4], p1[5], p1[6], p1[7]); pb[s][3] = pack8(p1[8], p1[9], p1[10], p1[11], p1[12], p1[13], p1[14], p1[15]);
            if (s == 0) {
                __builtin_amdgcn_sched_barrier(0);
#pragma unroll
                for (int db = 0; db < 2; ++db)
#pragma unroll
                    for (int sp = 0; sp < 4; ++sp) o[0][db] = MFMA32(vf[db][sp], pb[0][sp], o[0][db]);
            }
        }
        __builtin_amdgcn_sched_barrier(0);
#pragma unroll
        for (int db = 0; db < 2; ++db)
#pragma unroll
            for (int sp = 0; sp < 4; ++sp) o[1][db] = MFMA32(vf[db][sp], pb[1][sp], o[1][db]);
        __builtin_amdgcn_sched_barrier(0);
    }
    const float l0 = ls[0] + shx(ls[0], 32, lane), l1 = ls[1] + shx(ls[1], 32, lane);
    const float i0 = 1.0f / l0, i1 = lam / l1;
    float ss = 0.f;
#pragma unroll
    for (int db = 0; db < 2; ++db)
#pragma unroll
        for (int r = 0; r < 16; ++r) { const float v = o[0][db][r] * i0 - o[1][db][r] * i1; o[0][db][r] = v; ss += v * v; }
    ss += shx(ss, 32, lane);
    const float rn = sub_mul / sqrtf(ss * (1.0f / 64.0f) + EPS);
    const float* subw = INP(A, I_SUBLN) + l * 64;
    bf16* yrow = Y + (size_t)qrow * D + hd * 64;
#pragma unroll
    for (int db = 0; db < 2; ++db)
#pragma unroll
        for (int g = 0; g < 4; ++g) { const int d0 = 32 * db + 8 * g + 4 * h; const f32x4 sw4 = *(const f32x4*)(subw + d0);
            v2u pk; pk.x = cvtpk(o[0][db][4 * g] * rn * sw4[0], o[0][db][4 * g + 1] * rn * sw4[1]); pk.y = cvtpk(o[0][db][4 * g + 2] * rn * sw4[2], o[0][db][4 * g + 3] * rn * sw4[3]);
            *(GAS v2u*)(yrow + d0) = pk; }
    __syncthreads();
}


__device__ __forceinline__ float sigm(float x) { return __builtin_amdgcn_rcpf(1.0f + __builtin_amdgcn_exp2f(-1.4426950408889634f * x)); }
template <int DIRB> __device__ __forceinline__ void grp_comp(const f32x16& a, const f32x16& b, int g, float& Ag, float& Bg) {
    const float a0 = a[4 * g], a1 = a[4 * g + 1], a2 = a[4 * g + 2], a3 = a[4 * g + 3], b0 = b[4 * g], b1 = b[4 * g + 1], b2 = b[4 * g + 2], b3 = b[4 * g + 3];
    Ag = (a0 * a1) * (a2 * a3);
    if (!DIRB) { float t = b0; t = a1 * t + b1; t = a2 * t + b2; t = a3 * t + b3; Bg = t; }
    else { float t = b3; t = a2 * t + b2; t = a1 * t + b1; t = a0 * t + b0; Bg = t; }
}
template <int DIRB> __device__ __forceinline__ void wave_comp(const f32x16& a, const f32x16& b, int h, int lane, float& Aw, float& Bw) {
    Aw = 1.f; Bw = 0.f;
#pragma unroll
    for (int gi = 0; gi < 4; ++gi) { const int g = DIRB ? 3 - gi : gi;
        float Ag, Bg; grp_comp<DIRB>(a, b, g, Ag, Bg);
        const float Ao = shx(Ag, 32, lane), Bo = shx(Bg, 32, lane);
        const float A0 = h ? Ao : Ag, B0 = h ? Bo : Bg, A1 = h ? Ag : Ao, B1 = h ? Bg : Bo;
        float Ap, Bp;
        if (!DIRB) { Ap = A0 * A1; Bp = A1 * B0 + B1; } else { Ap = A0 * A1; Bp = A0 * B1 + B0; }
        Bw = Ap * Bw + Bp; Aw *= Ap; }
}
template <int DIRB> __device__ __forceinline__ void scan_final(const f32x16& a, const f32x16& b, int h, int lane, float X, f32x16& hout) {
    float S = X;
#pragma unroll
    for (int gi = 0; gi < 4; ++gi) { const int g = DIRB ? 3 - gi : gi;
        float Ag, Bg; grp_comp<DIRB>(a, b, g, Ag, Bg);
        const float Ao = shx(Ag, 32, lane), Bo = shx(Bg, 32, lane);
        const float A0 = h ? Ao : Ag, B0 = h ? Bo : Bg, A1 = h ? Ag : Ao, B1 = h ? Bg : Bo;
        if (!DIRB) { float st = h ? (Ao * S + Bo) : S;
#pragma unroll
            for (int e = 0; e < 4; ++e) { st = a[4 * g + e] * st + b[4 * g + e]; hout[4 * g + e] = st; }
            S = A1 * (A0 * S + B0) + B1; }
        else { float st = h ? S : (Ao * S + Bo);
#pragma unroll
            for (int e = 3; e >= 0; --e) { st = a[4 * g + e] * st + b[4 * g + e]; hout[4 * g + e] = st; }
            S = A0 * (A1 * S + B1) + B0; } }
}
__device__ __forceinline__ void rglru_unit(Frame& F, const Args& A, int l, int mode, int seq, int n, int chunk, int pv = 0) {
    const bf16* Z = (const bf16*)(F.ws + WS_Z); bf16* Y = (bf16*)(F.ws + WS_Y); const bf16* RGWT = (const bf16*)(F.ws + WS_RGWT);
    float* CARRY = (float*)(F.ws + (l == 0 ? WS_CARRY : WS_CARRY1));
    unsigned* rg_cnt = (unsigned*)(F.ws + WS_CTL) + CW_RG + 16 * ((l * 8 + seq) * 4 + n);
    int lane; LANE_ID(lane); const int w = F.wave, r32 = lane & 31, h = lane >> 5;
    const bool lat = mode != 0; const int T = lat ? 2048 : 256; const int row0 = lat ? MC + seq * 2048 : seq * 256; const int t0 = chunk * 256 + w * 32;
    LAS float* comp = (LAS float*)F.lds;
    LAS float* xcar = (LAS float*)(F.lds + 8192);
    LAS float* xst = xcar + 128;
    LAS unsigned char* GR = F.lds + 16384 + w * 4096;
    LAS unsigned char* YO = F.lds + 16384 + 32768 + w * 4096;
    LAS float* CWL = (LAS float*)(F.lds + 81920 + w * 1280);
    const float* p_rgb = INP(A, I_RGB); const float* p_sp8 = (const float*)(F.ws + WS_SP8); const float* p_cw = INP(A, I_CCW) + l * 4 * 256; const float* p_cb = INP(A, I_CCB) + l * 256; const float* p_st = INP(A, I_ST);
    v4u gq[4];
    { const bf16* gp = Z + (size_t)(row0 + t0 + r32) * DIN + 1792 + n * 64 + h * 32;
#pragma unroll
        for (int q = 0; q < 4; ++q) gq[q] = *(const v4u*)(gp + 8 * q); }
    const int tk = t0 + r32;
    v4u zq[4][4];
#pragma unroll
    for (int ks = 0; ks < 4; ++ks) { const int c8 = n * 64 + 16 * ks + 8 * h;
#pragma unroll
        for (int j = 0; j < 4; ++j) { const int tt = tk + j - 2; const bool ok = tt >= 0 && tt < T; const int tc = ok ? tt : tk;
            zq[ks][j] = *(const v4u*)(Z + (size_t)(row0 + tc) * DIN + 1536 + c8); } }
    bf16x8_t wf[2][2][4];
#pragma unroll
    for (int dir = 0; dir < 2; ++dir)
#pragma unroll
        for (int gt = 0; gt < 2; ++gt) { const bf16* wp = RGWT + (size_t)((((l * 2 + dir) * 2 + gt) * 4 + n) * 4096) + r32 * 64 + 8 * h;
#pragma unroll
            for (int ks = 0; ks < 4; ++ks) wf[dir][gt][ks] = *(const bf16x8_t*)(wp + 16 * ks); }
    float cwv[5], kbr[2][2], kbi[2][2], ksp[2][2];
#pragma unroll
    for (int j = 0; j < 4; ++j) cwv[j] = ((const GAS float*)p_cw)[j * 256 + n * 64 + lane];
    cwv[4] = ((const GAS float*)p_cb)[n * 64 + lane];
#pragma unroll
    for (int hb = 0; hb < 2; ++hb)
#pragma unroll
        for (int dir = 0; dir < 2; ++dir) { const int c = n * 64 + 32 * hb + r32;
            kbr[hb][dir] = ((const GAS float*)p_rgb)[((l * 2 + dir) * 2 + 0) * 256 + c]; kbi[hb][dir] = ((const GAS float*)p_rgb)[((l * 2 + dir) * 2 + 1) * 256 + c]; ksp[hb][dir] = ((const GAS float*)p_sp8)[(l * 2 + dir) * 256 + c]; }
    float st0 = 0.f, st1 = 0.f;
    if (lat && w == 0) { const int c = n * 64 + lane; st0 = p_st[(size_t)((seq * 2 + l) * 2 + 0) * 256 + c]; st1 = p_st[(size_t)((seq * 2 + l) * 2 + 1) * 256 + c]; }
    __builtin_amdgcn_sched_barrier(0);
    if (lat && w == 0) { xst[lane] = st0; xst[64 + lane] = st1; }
#pragma unroll
    for (int q = 0; q < 4; ++q) *(LAS v4u*)(GR + r32 * 128 + (h * 4 + q) * 16) = gq[q];
#pragma unroll
    for (int j = 0; j < 5; ++j) CWL[j * 64 + lane] = cwv[j];
    bf16x8_t xa[4];
#pragma unroll
    for (int ks = 0; ks < 4; ++ks) { const int cl8 = 16 * ks + 8 * h; const f32x4 cb0 = *(const LAS f32x4*)(CWL + 4 * 64 + cl8), cb1 = *(const LAS f32x4*)(CWL + 4 * 64 + cl8 + 4);
        float x[8] = {cb0[0], cb0[1], cb0[2], cb0[3], cb1[0], cb1[1], cb1[2], cb1[3]};
#pragma unroll
        for (int j = 0; j < 4; ++j) { const int tt = tk + j - 2; const float k = (tt >= 0 && tt < T) ? 1.f : 0.f; const v4u z = zq[ks][j]; const f32x4 w0 = *(const LAS f32x4*)(CWL + j * 64 + cl8), w1 = *(const LAS f32x4*)(CWL + j * 64 + cl8 + 4);
            x[0] += k * w0[0] * bflo(z.x); x[1] += k * w0[1] * bfhi(z.x); x[2] += k * w0[2] * bflo(z.y); x[3] += k * w0[3] * bfhi(z.y);
            x[4] += k * w1[0] * bflo(z.z); x[5] += k * w1[1] * bfhi(z.z); x[6] += k * w1[2] * bflo(z.w); x[7] += k * w1[3] * bfhi(z.w); }
        xa[ks] = pack8(x[0], x[1], x[2], x[3], x[4], x[5], x[6], x[7]); }
#pragma unroll 1
    for (int cb2 = 0; cb2 < 2; ++cb2) {
        const int cl = 32 * cb2 + r32, c = n * 64 + cl;
        LAS float* cmp = comp + cb2 * 1024;
        float cbr[2], cbi[2], csp[2];
#pragma unroll
        for (int dir = 0; dir < 2; ++dir) { cbr[dir] = cb2 ? kbr[1][dir] : kbr[0][dir]; cbi[dir] = cb2 ? kbi[1][dir] : kbi[0][dir]; csp[dir] = cb2 ? ksp[1][dir] : ksp[0][dir]; }
        f32x16 xcD;
#pragma unroll
        for (int r = 0; r < 16; ++r) xcD[r] = 0.f;
#pragma unroll
        for (int ks = 0; ks < 4; ++ks) { const bool hit = (cl >> 3) == (2 * ks + h); const int e = r32 & 7;
            bf16x8_t idf;
#pragma unroll
            for (int q = 0; q < 8; ++q) idf[q] = (hit && e == q) ? (short)0x3F80 : (short)0;
            xcD = MFMA32(xa[ks], idf, xcD); }
        f32x16 av[2], bv[2];
#pragma unroll
        for (int dir = 0; dir < 2; ++dir) {
            f32x16 gr, gi; const float biasr = cbr[dir], biasi = cbi[dir];
#pragma unroll
            for (int r = 0; r < 16; ++r) { gr[r] = biasr; gi[r] = biasi; }
#pragma unroll
            for (int ks = 0; ks < 4; ++ks) { gr = MFMA32(xa[ks], wf[dir][0][ks], gr); gi = MFMA32(xa[ks], wf[dir][1][ks], gi); }
            if (cb2 == 0) {
#pragma unroll
                for (int gt = 0; gt < 2; ++gt) { const bf16* wp = RGWT + (size_t)((((l * 2 + dir) * 2 + gt) * 4 + n) * 4096) + (32 + r32) * 64 + 8 * h;
#pragma unroll
                    for (int ks = 0; ks < 4; ++ks) wf[dir][gt][ks] = *(const bf16x8_t*)(wp + 16 * ks); } }
            const float sp8 = csp[dir];
#pragma unroll
            for (int r = 0; r < 16; ++r) { const float rr = sigm(gr[r]), ii = sigm(gi[r]);
                const float a = __builtin_amdgcn_exp2f(-rr * sp8);
                av[dir][r] = a; bv[dir][r] = __builtin_amdgcn_sqrtf(fmaxf(1.0f - a * a, 0.f)) * ii * xcD[r]; }
        }
        { float Aw, Bw;
          wave_comp<0>(av[0], bv[0], h, lane, Aw, Bw); if (h == 0) { cmp[((0 * 8 + w) * 32 + r32) * 2] = Aw; cmp[((0 * 8 + w) * 32 + r32) * 2 + 1] = Bw; }
          wave_comp<1>(av[1], bv[1], h, lane, Aw, Bw); if (h == 0) { cmp[((1 * 8 + w) * 32 + r32) * 2] = Aw; cmp[((1 * 8 + w) * 32 + r32) * 2 + 1] = Bw; } }
        __syncthreads();
        if (w == 0 && h == 0) {
            float Af = 1.f, Bf = 0.f, Ab = 1.f, Bb = 0.f;
#pragma unroll
            for (int ww = 0; ww < 8; ++ww) { const float a0 = cmp[((0 * 8 + ww) * 32 + r32) * 2], b0 = cmp[((0 * 8 + ww) * 32 + r32) * 2 + 1]; Bf = a0 * Bf + b0; Af *= a0; }
#pragma unroll
            for (int ww = 7; ww >= 0; --ww) { const float a1 = cmp[((1 * 8 + ww) * 32 + r32) * 2], b1 = cmp[((1 * 8 + ww) * 32 + r32) * 2 + 1]; Bb = a1 * Bb + b1; Ab *= a1; }
            if (lat) { float* cp = CARRY + ((size_t)(((seq * 8 + chunk) * 4 + n) * 2) * 64 + cl) * 2;
                __hip_atomic_store((unsigned long long*)cp, ((unsigned long long)__float_as_uint(Bf) << 32) | __float_as_uint(Af), __ATOMIC_RELAXED, __HIP_MEMORY_SCOPE_AGENT);
                __hip_atomic_store((unsigned long long*)(cp + 128), ((unsigned long long)__float_as_uint(Bb) << 32) | __float_as_uint(Ab), __ATOMIC_RELAXED, __HIP_MEMORY_SCOPE_AGENT); }
            else { F.out[OUT_ST + (size_t)((seq * 2 + l) * 2 + 0) * 256 + c] = Bf; F.out[OUT_ST + (size_t)((seq * 2 + l) * 2 + 1) * 256 + c] = Bb; }
        }
        if (lat) {
            if (w == 0) {
                asm volatile("s_waitcnt vmcnt(0)" ::: "memory");
                if (lane == 0) __hip_atomic_fetch_add(rg_cnt + cb2, 1u, __ATOMIC_RELAXED, __HIP_MEMORY_SCOPE_AGENT);
                for (unsigned spins = 0; spins < (1u << 20); ++spins) { const unsigned cdone = (unsigned)__builtin_amdgcn_readfirstlane((int)__hip_atomic_load(rg_cnt + cb2, __ATOMIC_RELAXED, __HIP_MEMORY_SCOPE_AGENT)); if (cdone >= 8u) break; __builtin_amdgcn_s_sleep(1); }
                if (h == 0) {
                    unsigned long long cq[8];
#pragma unroll
                    for (int cc = 0; cc < 8; ++cc) cq[cc] = __hip_atomic_load((const unsigned long long*)(CARRY + ((size_t)(((seq * 8 + cc) * 4 + n) * 2 + (cc > chunk ? 1 : 0)) * 64 + cl) * 2), __ATOMIC_RELAXED, __HIP_MEMORY_SCOPE_AGENT);
                    float Xf = xst[cl], Xb = xst[64 + cl];
#pragma unroll
                    for (int cc = 0; cc < 8; ++cc) if (cc < chunk) Xf = __uint_as_float((unsigned)cq[cc]) * Xf + __uint_as_float((unsigned)(cq[cc] >> 32));
#pragma unroll
                    for (int cc = 7; cc >= 0; --cc) if (cc > chunk) Xb = __uint_as_float((unsigned)cq[cc]) * Xb + __uint_as_float((unsigned)(cq[cc] >> 32));
                    xcar[cl] = Xf; xcar[64 + cl] = Xb; } }
            __syncthreads(); }
        {
            float Xf = 0.f, Xb = 0.f; if (lat) { Xf = xcar[cl]; Xb = xcar[64 + cl]; }
#pragma unroll
            for (int ww = 0; ww < 8; ++ww) if (ww < w) Xf = cmp[((0 * 8 + ww) * 32 + r32) * 2] * Xf + cmp[((0 * 8 + ww) * 32 + r32) * 2 + 1];
#pragma unroll
            for (int ww = 7; ww >= 0; --ww) if (ww > w) Xb = cmp[((1 * 8 + ww) * 32 + r32) * 2] * Xb + cmp[((1 * 8 + ww) * 32 + r32) * 2 + 1];
            f32x16 hf, hb;
            scan_final<0>(av[0], bv[0], h, lane, Xf, hf); scan_final<1>(av[1], bv[1], h, lane, Xb, hb);
#pragma unroll
            for (int r = 0; r < 16; r += 2) { const int tl = (r & 3) + 8 * (r >> 2) + 4 * h;
                const float g0 = bf2f(*(const LAS unsigned short*)(GR + tl * 128 + cl * 2)), g1 = bf2f(*(const LAS unsigned short*)(GR + (tl + 1) * 128 + cl * 2));
                const float u0 = 2.0f * 0.7978845608028654f * (g0 + 0.044715f * g0 * g0 * g0), u1 = 2.0f * 0.7978845608028654f * (g1 + 0.044715f * g1 * g1 * g1);
                const unsigned pk = cvtpk((hf[r] + hb[r]) * g0 * sigm(u0), (hf[r + 1] + hb[r + 1]) * g1 * sigm(u1));
                *(LAS unsigned short*)(YO + tl * 128 + cl * 2) = (unsigned short)pk; *(LAS unsigned short*)(YO + (tl + 1) * 128 + cl * 2) = (unsigned short)(pk >> 16); }
        }
        __builtin_amdgcn_sched_barrier(0);
    }
    {
        bf16* yp = Y + (size_t)(row0 + t0 + r32) * D + 512 + n * 64 + h * 32;
#pragma unroll
        for (int q = 0; q < 4; ++q) *(GAS v4u*)(yp + 8 * q) = *(const LAS v4u*)(YO + r32 * 128 + (h * 4 + q) * 16);
    }
    __syncthreads();
}

__device__ __forceinline__ void pool_item(int WIN, const bf16* Z, bf16* Y, const bf16* PT, const float* pscale, int l, int tt, int g, int lane, LAS unsigned char* LP) {
    const int r32 = lane & 31, h = lane >> 5;
    const int rowt0 = tt * 32; const bool lat = rowt0 >= MC; const int T = lat ? 2048 : 256;
    const int seq0 = lat ? MC + ((rowt0 - MC) & ~2047) : (rowt0 & ~255); const int tpos0 = rowt0 - seq0, tpos = tpos0 + r32;
    const int left = WIN >> 1; const int lo = max(tpos - left, 0), hi = min(tpos + WIN - 1 - left, T - 1); const float inv = 1.0f / (float)(hi - lo + 1);
    const int NCH = (32 + WIN - 1) * 8;
    LAS unsigned char* TILE = LP; LAS unsigned char* YO = LP + 8192;
    const GAS bf16* zc = (const GAS bf16*)Z + (size_t)seq0 * DIN + 2048 + g * 64;
    bf16x8_t wq[2][4]; float sc[2];
#pragma unroll
    for (int cb2 = 0; cb2 < 2; ++cb2) { const int d = 32 * cb2 + r32; const GAS bf16* wt = (const GAS bf16*)PT + (size_t)(l * 4 + g) * 4096 + d * 64 + 8 * h;
#pragma unroll
        for (int ks = 0; ks < 4; ++ks) wq[cb2][ks] = *(const GAS bf16x8_t*)(wt + 16 * ks);
        sc[cb2] = ((const GAS float*)pscale)[l * 256 + g * 64 + d]; }
    v4u zt[6];
#pragma unroll
    for (int i = 0; i < 6; ++i) { int q = lane + 64 * i; q = q < NCH ? q : NCH - 1; const int row = q >> 3, c = q & 7; const int t2 = tpos0 - left + row; const int tc = (t2 >= 0 && t2 < T) ? t2 : tpos0;
        zt[i] = *(const GAS v4u*)(zc + (size_t)tc * DIN + 8 * c); }
#pragma unroll
    for (int i = 0; i < 6; ++i) { int q = lane + 64 * i; q = q < NCH ? q : NCH - 1; const int row = q >> 3, c = q & 7; *(LAS v4u*)(TILE + row * 144 + c * 16) = zt[i]; }
    float sm[4][8];
#pragma unroll
    for (int ks = 0; ks < 4; ++ks)
#pragma unroll
        for (int e = 0; e < 8; ++e) sm[ks][e] = 0.f;
    const LAS unsigned char* tp = TILE + r32 * 144 + h * 16;
#pragma unroll 1
    for (int j = 0; j < WIN; ++j) { const int t2 = tpos - left + j; const float k = (t2 >= 0 && t2 < T) ? 1.f : 0.f;
#pragma unroll
        for (int ks = 0; ks < 4; ++ks) { const v4u z = *(const LAS v4u*)(tp + j * 144 + ks * 32);
            sm[ks][0] += k * bflo(z.x); sm[ks][1] += k * bfhi(z.x); sm[ks][2] += k * bflo(z.y); sm[ks][3] += k * bfhi(z.y); sm[ks][4] += k * bflo(z.z); sm[ks][5] += k * bfhi(z.z); sm[ks][6] += k * bflo(z.w); sm[ks][7] += k * bfhi(z.w); } }
    bf16x8_t pa[4];
#pragma unroll
    for (int ks = 0; ks < 4; ++ks) { const v4u z0 = *(const LAS v4u*)(tp + left * 144 + ks * 32);
        pa[ks] = pack8(sm[ks][0] * inv - bflo(z0.x), sm[ks][1] * inv - bfhi(z0.x), sm[ks][2] * inv - bflo(z0.y), sm[ks][3] * inv - bfhi(z0.y), sm[ks][4] * inv - bflo(z0.z), sm[ks][5] * inv - bfhi(z0.z), sm[ks][6] * inv - bflo(z0.w), sm[ks][7] * inv - bfhi(z0.w)); }
#pragma unroll
    for (int cb2 = 0; cb2 < 2; ++cb2) { const int d = 32 * cb2 + r32;
        f32x16 acc;
#pragma unroll
        for (int r = 0; r < 16; ++r) acc[r] = 0.f;
#pragma unroll
        for (int ks = 0; ks < 4; ++ks) acc = MFMA32(pa[ks], wq[cb2][ks], acc);
        const float scd = sc[cb2];
#pragma unroll
        for (int r = 0; r < 16; r += 2) { const int row = rowt0 + (r & 3) + 8 * (r >> 2) + 4 * h; const unsigned pk = cvtpk(acc[r] * scd, acc[r + 1] * scd);
            const int tl = row - rowt0; *(LAS unsigned short*)(YO + tl * 128 + d * 2) = (unsigned short)pk; *(LAS unsigned short*)(YO + (tl + 1) * 128 + d * 2) = (unsigned short)(pk >> 16); } }
    { bf16* yp = Y + (size_t)(rowt0 + r32) * D + 768 + g * 64 + h * 32;
#pragma unroll
      for (int q = 0; q < 4; ++q) *(GAS v4u*)(yp + 8 * q) = *(const LAS v4u*)(YO + r32 * 128 + (h * 4 + q) * 16); }
}
__device__ __forceinline__ void mix_pool(Frame& F, const Args& A, int l) {
    PHASE_IDS(F);
    const bf16* Z = (const bf16*)(F.ws + WS_Z); bf16* Y = (bf16*)(F.ws + WS_Y); const bf16* PT = (const bf16*)(F.ws + WS_POOLT); const float* ps = INP(A, I_POOLS);
    const int gw = F.vcu * NWAVES + F.wave, NGW = F.G * NWAVES;
    const int hgw = (F.G >> 1) * NWAVES;
    const bool heavy = F.vcu < (F.G >> 1); const int hw = heavy ? gw : gw - hgw;
    for (int k = 0; k < 3; ++k) { int it;
        if (F.G == 256) { if (heavy) { if (k > 0) break; it = hw; } else { if (k > 1) break; it = hgw + k * hgw + hw; } }
        else { it = gw + k * NGW; }
        if (it >= (M / 32) * 4) break;
        const int g = it / (M / 32), tt = it % (M / 32);
        LAS unsigned char* yo = F.lds + F.wave * 12288;
        pool_item(2 << g, Z, Y, PT, ps, l, tt, g, F.lane, yo); }
    __syncthreads();
}
__device__ __forceinline__ void mix_conv(Frame& F, const Args& A, int l) {
    PHASE_IDS(F);
    const GAS bf16* Z = (const GAS bf16*)(F.ws + WS_Z); bf16* Y = (bf16*)(F.ws + WS_Y); const GAS float* cw = (const GAS float*)(INP(A, I_CBW) + l * 3 * 256);
    const int gt = F.vcu * 512 + F.tid, NGT = F.G * 512;
    for (int i = gt; i < (M / 8) * 32; i += NGT) {
        const int tg = i >> 5, c8 = (i & 31) * 8; const int r0 = tg * 8; const bool lat = r0 >= MC; const int T = lat ? 2048 : 256; const int t0 = lat ? ((r0 - MC) & 2047) : (r0 & 255);
        f32x4 wv[3][2];
#pragma unroll
        for (int j = 0; j < 3; ++j) { wv[j][0] = *(const GAS f32x4*)(cw + j * 256 + c8); wv[j][1] = *(const GAS f32x4*)(cw + j * 256 + c8 + 4); }
        v4u za[10], zb[10], zg[8];
#pragma unroll
        for (int k = 0; k < 10; ++k) { const int t = t0 - 1 + k; const bool ok = t >= 0 && t < T; const int tc = ok ? t : t0; const GAS bf16* zp = Z + (size_t)(r0 - t0 + tc) * DIN + c8;
            za[k] = *(const GAS v4u*)(zp + 1024); zb[k] = *(const GAS v4u*)(zp + 1280); }
#pragma unroll
        for (int q = 0; q < 8; ++q) zg[q] = *(const GAS v4u*)(Z + (size_t)(r0 + q) * DIN + 768 + c8);
        float w[3][8];
#pragma unroll
        for (int j = 0; j < 3; ++j) { w[j][0] = wv[j][0][0]; w[j][1] = wv[j][0][1]; w[j][2] = wv[j][0][2]; w[j][3] = wv[j][0][3]; w[j][4] = wv[j][1][0]; w[j][5] = wv[j][1][1]; w[j][6] = wv[j][1][2]; w[j][7] = wv[j][1][3]; }
        float pm[8], pc[8], pn[8];
        auto prod = [&](int k, float (&o)[8]) { const int t = t0 - 1 + k; const float kk = (t >= 0 && t < T) ? 1.f : 0.f; const v4u a = za[k], b = zb[k];
            o[0] = kk * bflo(a.x) * bflo(b.x); o[1] = kk * bfhi(a.x) * bfhi(b.x); o[2] = kk * bflo(a.y) * bflo(b.y); o[3] = kk * bfhi(a.y) * bfhi(b.y);
            o[4] = kk * bflo(a.z) * bflo(b.z); o[5] = kk * bfhi(a.z) * bfhi(b.z); o[6] = kk * bflo(a.w) * bflo(b.w); o[7] = kk * bfhi(a.w) * bfhi(b.w); };
        prod(0, pm); prod(1, pc);
#pragma unroll
        for (int q = 0; q < 8; ++q) { prod(q + 2, pn);
            const v4u gb = zg[q];
            const float g[8] = {bflo(gb.x), bfhi(gb.x), bflo(gb.y), bfhi(gb.y), bflo(gb.z), bfhi(gb.z), bflo(gb.w), bfhi(gb.w)};
            float o[8];
#pragma unroll
            for (int e = 0; e < 8; ++e) { o[e] = g[e] * (w[0][e] * pm[e] + w[1][e] * pc[e] + w[2][e] * pn[e]); pm[e] = pc[e]; pc[e] = pn[e]; }
            v4u ov; ov.x = cvtpk(o[0], o[1]); ov.y = cvtpk(o[2], o[3]); ov.z = cvtpk(o[4], o[5]); ov.w = cvtpk(o[6], o[7]);
            *(GAS v4u*)(Y + (size_t)(r0 + q) * D + 256 + c8) = ov; }
    }
}

__device__ __forceinline__ void mix_cache(Frame& F, const Args& A, int l) {
    PHASE_IDS(F);
    const int nwg = F.G >> 2, w0 = F.G - nwg; if (F.vcu < w0) return;
    const GAS bf16* Z = (const GAS bf16*)(F.ws + WS_Z); float* ok = F.out + OUT_CK; float* ov = F.out + OUT_CV;
    const int gt = (F.vcu - w0) * 512 + F.tid, NGT = nwg * 512; constexpr int NIT = MC * 64;
    for (int i0 = gt; i0 < NIT; i0 += 4 * NGT) { v4u z[4];
#pragma unroll
        for (int k = 0; k < 4; ++k) { int i = i0 + k * NGT; i = i < NIT ? i : gt; z[k] = *(const GAS v4u*)(Z + (size_t)(i >> 6) * DIN + 256 + 8 * (i & 63)); }
#pragma unroll
        for (int k = 0; k < 4; ++k) { const int i = i0 + k * NGT; if (i < NIT) { const int r = i >> 6, q = i & 63; const int b = r >> 8, t = r & 255, cc = (q & 31) * 8;
            float* op = ((q >> 5) ? ov : ok) + ((size_t)((b * 2 + l) * 4 + (cc >> 6)) * 256 + t) * 64 + (cc & 63); const v4u w = z[k];
            *(GAS f32x4*)op = (f32x4){bflo(w.x), bfhi(w.x), bflo(w.y), bfhi(w.y)}; *(GAS f32x4*)(op + 4) = (f32x4){bflo(w.z), bfhi(w.z), bflo(w.w), bfhi(w.w)}; } }
    }
}

#define GEMM_PHASE(EPI, g, E, MM, NN) do { pg8::StaticOrder S_; S_.init((MM), (NN), F.G, (int)blockIdx.x, 0); \
    pg8::gemm_phase<EPI, pg8::StaticOrder, true, true, false>(F.lds, (g), S_, (E), F.wave0); \
    if (S_.splits()) { pg8::StaticOrder S1_; S1_.init((MM), (NN), F.G, (int)blockIdx.x, 1); pg8::gemm_phase<EPI, pg8::StaticOrder, true, true, true>(F.lds, (g), S1_, (E), F.wave0); } } while (0)

constexpr int PH_PER_LAYER = 8, NPHASE = 2 + 2 * PH_PER_LAYER + 1;
__global__ void __launch_bounds__(NWAVES * 64, 2) fwd_kernel(Args args) {
    extern __shared__ __attribute__((aligned(16))) unsigned char lds[];
    Frame F;
    F.lds = (LAS unsigned char*)lds; F.lds0 = F.lds; F.tid = threadIdx.x; F.lane = F.tid & 63; F.wave = __builtin_amdgcn_readfirstlane(F.tid >> 6); F.wave0 = F.wave;
    F.G = gridDim.x; { const int bx = blockIdx.x; F.vcu = (F.G % 8 == 0) ? (bx % 8) * (F.G / 8) + bx / 8 : bx; F.vcu0 = F.vcu; }
    F.out = args.out; F.ws = args.ws; F.out0 = args.out; F.ws0 = args.ws;
    volatile LAS unsigned* MISC = (volatile LAS unsigned*)(F.lds + MISC_OFF);
    for (int u = F.tid; u < (LDS_BYTES - LDSCTL_OFF) / 4; u += NWAVES * 64) ((LAS unsigned*)(F.lds + LDSCTL_OFF))[u] = 0u;
    __syncthreads();
    if (F.tid < 25) { const unsigned long long pv = (unsigned long long)args.in[F.tid]; ((LAS unsigned*)(F.lds + LDSCTL_OFF))[2 * F.tid] = (unsigned)pv; ((LAS unsigned*)(F.lds + LDSCTL_OFF))[2 * F.tid + 1] = (unsigned)(pv >> 32); }
    __syncthreads();
    XcdBarrier bar; bar.bar = (unsigned*)(args.ws + WS_CTL) + CW_BAR; bar.x = 0; bar.st = nullptr;
#if !MK_PER_PHASE
    bar = xcd_barrier_post((unsigned*)(args.ws + WS_CTL) + CW_BAR, MISC + 8);
#endif
#if MK_PER_PHASE
    const int lo = args.ph_lo, hi = args.ph_hi;
#define IN(k) (lo <= (k) && (k) < hi)
#define SEAM(k) do { } while (0)
#else
#define IN(k) true
#define SEAM(k) xcd_barrier(bar)
#endif
    REP(4) { if (IN(0)) { p0_prologue(F, args); } SEAM(0); }

    REP(3) { if (IN(1)) { prep0_phase(F, args); } SEAM(1); }
    for (int l = 0; l < 2; ++l) {
        const int pb = 2 + l * PH_PER_LAYER;
        REP(0) if (IN(pb + 0)) { PHASE_IDS(F);
            pg8::Gemm g{(const bf16*)((const unsigned char*)F.out + OUT_XN_BYTES), (const bf16*)(F.ws + WS_WIN) + (size_t)l * DIN * D, M, DIN, D};
            pg8::EpiIn E{(bf16*)(F.ws + WS_Z), (const float*)(F.ws + WS_ROPE), (const float*)(F.ws + WS_SS) + (size_t)(l == 0 ? 0 : 2) * M, (const float*)(F.ws + WS_SW) + (size_t)l * 9 * 2304};
            GEMM_PHASE(pg8::EpiIn, g, E, M, DIN);
            SEAM(pb + 0); }
        if (IN(pb + 1)) {
            PHASE_IDS(F); const float lam = ((const float*)(F.ws + WS_LAM))[l]; const float sub_mul = 1.0f - (0.8f - 0.6f * expf(-0.3f * (float)l));
            for (int u = F.vcu; u < 512; u += F.G) {
                if (u >= 384) { const int v = u - 384; attn_unit(F, args, l, false, v >> 2, v & 3, 0, lam, sub_mul); }
                else { const int mode = u < 256 ? 1 : 0; const int v = u < 256 ? u : u - 256; rglru_unit(F, args, l, mode, mode == 0 ? (v >> 2) : (v >> 5), mode == 0 ? (v & 3) : ((v >> 3) & 3), mode == 0 ? 0 : (v & 7)); } }
            mix_conv(F, args, l); mix_cache(F, args, l); mix_pool(F, args, l);
            PHASE_IDS(F);
            for (int u = F.vcu; u < 256; u += F.G) attn_unit(F, args, l, true, u >> 5, (u >> 3) & 3, u & 7, lam, sub_mul);
        } SEAM(pb + 1);
        if (IN(pb + 3)) { PHASE_IDS(F); const float* modl = (const float*)(F.ws + WS_MOD) + (size_t)l * 9 * 6144;
            pg8::Gemm g{(const bf16*)(F.ws + WS_Y), (const bf16*)(F.ws + WS_WOUT) + (size_t)l * D * D, M, D, D};
            bf16* XR = (bf16*)(F.ws + WS_XR); bf16* XNp = (bf16*)((unsigned char*)F.out + OUT_XN_BYTES);
            if (l == 0) { pg8::EpiGateRes<false> E{(const void*)INP(args, I_XP), (const void*)(INP(args, I_XS) - (size_t)MC * D), XR, modl + 2048, 0, XNp, INP(args, I_NORMW) + (size_t)(l * 2 + 1) * D, modl + 4096, (float*)(F.ws + WS_SS) + (size_t)1 * M};
                GEMM_PHASE(pg8::EpiGateRes<false>, g, E, M, D); }
            else { pg8::EpiGateRes<true> E{(const void*)XR, (const void*)XR, XR, modl + 2048, 0, XNp, INP(args, I_NORMW) + (size_t)(l * 2 + 1) * D, modl + 4096, (float*)(F.ws + WS_SS) + (size_t)3 * M};
                GEMM_PHASE(pg8::EpiGateRes<true>, g, E, M, D); }
        } SEAM(pb + 3);
        for (int hf = 0; hf < 2; ++hf) {
            const int mrow0 = hf == 0 ? 0 : MP0, mrows = hf == 0 ? MP0 : M - MP0;
            REP(2) if (IN(pb + 4 + 2 * hf)) { PHASE_IDS(F);
                pg8::Gemm g{(const bf16*)((const unsigned char*)F.out + OUT_XN_BYTES) + (size_t)mrow0 * D, (const bf16*)(F.ws + WS_W1) + (size_t)l * DFF * D, mrows, DFF, D};
                pg8::EpiRelu2 E{(bf16*)(F.ws + WS_Y), (const float*)(F.ws + WS_SS) + (size_t)(l == 0 ? 1 : 3) * M, (const float*)(F.ws + WS_SW) + 2 * 9 * 2304 + (size_t)l * 9 * 4096, mrow0};
                GEMM_PHASE(pg8::EpiRelu2, g, E, mrows, DFF);
                SEAM(pb + 4 + 2 * hf); }
            if (IN(pb + 5 + 2 * hf)) { PHASE_IDS(F); const float* modl = (const float*)(F.ws + WS_MOD) + (size_t)l * 9 * 6144;
                pg8::Gemm g{(const bf16*)(F.ws + WS_Y), (const bf16*)(F.ws + WS_W2) + (size_t)l * D * DFF, mrows, D, DFF};
                bf16* XR = (bf16*)(F.ws + WS_XR);
                if (l == 0) {
                    pg8::EpiGateRes<true> E{(const void*)XR, (const void*)XR, XR, modl + 5120, mrow0, (bf16*)((unsigned char*)F.out + OUT_XN_BYTES), INP(args, I_NORMW) + (size_t)2 * D, modl + 9 * 6144 + 1024, (float*)(F.ws + WS_SS) + (size_t)2 * M};
                    GEMM_PHASE(pg8::EpiGateRes<true>, g, E, mrows, D); }
                else {
                    pg8::EpiFinal E{XR, F.out, modl + 5120, mrow0, INP(args, I_FNW), (float*)(F.ws + WS_SS) + (size_t)4 * M, (unsigned*)(F.ws + WS_CTL) + CW_FIN};
                    GEMM_PHASE(pg8::EpiFinal, g, E, mrows, D); }
            } if (!(l == 1 && hf == 1)) SEAM(pb + 5 + 2 * hf);
        }
    }
    if ((PROBE_REP >> 12) & 1) { for (int q = 0; q < 20; ++q) xcd_barrier(bar); }

#undef IN
#undef SEAM
}

extern "C" void kernel_launch(void* const* d_in, const int* in_sizes, int n_in, void* d_out, int out_size, void* d_ws, size_t ws_size, hipStream_t stream) {
    static int grid = 0;
    if (grid == 0) {
        if (n_in != 25 || out_size != (int)(OUT_ST + 32 * 2 * 2 * 256) || ws_size < WS_END) { fprintf(stderr, "kernel_launch: unexpected shapes (n_in %d out %d ws %zu)\n", n_in, out_size, ws_size); grid = -1; return; }
        int dev = 0, cus = 0;
        if (hipGetDevice(&dev) != hipSuccess || hipDeviceGetAttribute(&cus, hipDeviceAttributeMultiprocessorCount, dev) != hipSuccess) { grid = -1; return; }
        if (hipFuncSetAttribute((const void*)fwd_kernel, hipFuncAttributeMaxDynamicSharedMemorySize, LDS_BYTES) != hipSuccess) { fprintf(stderr, "kernel_launch: hipFuncSetAttribute failed\n"); grid = -1; return; }
        int per_cu = 0;
        if (hipOccupancyMaxActiveBlocksPerMultiprocessor(&per_cu, (const void*)fwd_kernel, NWAVES * 64, LDS_BYTES) != hipSuccess || per_cu < 1) fprintf(stderr, "kernel_launch: occupancy query says %d\n", per_cu);
        (void)hipGetLastError();
        if (cus != 256) { fprintf(stderr, "kernel_launch: this kernel is laid out for a 256-CU grid (prep0's shift-row slots, the fused final norm's one-unit-per-workgroup phase); the device reports %d CUs\n", cus); grid = -1; return; }
        grid = cus;
    }
    if (grid < 0) return;
    (void)hipMemsetAsync((char*)d_ws + WS_CTL, 0, CTL_ZERO_BYTES, stream);
    Args a{};
    for (int i = 0; i < 25; ++i) a.in[i] = (const float*)d_in[i];
    a.out = (float*)d_out; a.ws = (unsigned char*)d_ws;
#if MK_PER_PHASE
    for (int p = 0; p < NPHASE; ++p) { a.ph_lo = p; a.ph_hi = p + 1; hipLaunchKernelGGL(fwd_kernel, dim3(grid), dim3(NWAVES * 64), LDS_BYTES, stream, a); }
#else
    a.ph_lo = 0; a.ph_hi = NPHASE; hipLaunchKernelGGL(fwd_kernel, dim3(grid), dim3(NWAVES * 64), LDS_BYTES, stream, a);
#endif
}
```
